# Optimizing an MI355X kernel written in HIP

```python
import math
import jax, jax.numpy as jnp
from jax import lax
import numpy as np

D_MODEL = 1024
BATCH = 8
SEQ = 4096
DEPTH = 1

PLE_DIM = 256
NORM_EPS = 1e-6

MLA_HEADS = 8
MLA_Q_RANK = 256
MLA_KV_RANK = 128
MLA_NOPE_DIM = 64
MLA_ROPE_DIM = 32
MLA_V_DIM = 64
MLA_OUT = MLA_HEADS * MLA_V_DIM
ROPE_THETA = 10000.0
Q_BLOCK = 128

SSD_HEADS = 8
SSD_HEAD_DIM = 64
SSD_GROUPS = 2
SSD_HEADS_PER_GROUP = SSD_HEADS // SSD_GROUPS
SSD_STATE = 64
SSD_CONV = 5
SSD_CHUNK = 128
SSD_INNER = SSD_HEADS * SSD_HEAD_DIM
SSD_XBC = SSD_INNER + 2 * SSD_GROUPS * SSD_STATE
SSD_DIRECTIONS = 2

D_MIX = MLA_OUT + SSD_INNER
IN_PROJ_COLS = MLA_Q_RANK + MLA_KV_RANK + MLA_ROPE_DIM + SSD_INNER + SSD_XBC + SSD_DIRECTIONS * SSD_HEADS

N_EXPERT_GROUPS = 4
EXPERTS_PER_GROUP = 8
N_EXPERTS = N_EXPERT_GROUPS * EXPERTS_PER_GROUP
TOP_K_IN_GROUP = 2
D_EXPERT = 256

kernel_name = "hybrid_mla_ssd_hmoe_ple_encoder"


def rmsnorm(x, w):
    xf = x.astype(jnp.float32)
    xf = xf * lax.rsqrt(jnp.mean(xf * xf, axis=-1, keepdims=True) + NORM_EPS)
    return xf.astype(x.dtype) * w


def rotary(t, cos, sin):
    half = t.shape[-1] // 2
    t1, t2 = t[..., :half], t[..., half:]
    return jnp.concatenate([t1 * cos - t2 * sin, t2 * cos + t1 * sin], axis=-1).astype(t.dtype)


def rotary_tables(positions):
    inv_freq = 1.0 / (ROPE_THETA ** (jnp.arange(0, MLA_ROPE_DIM, 2, dtype=jnp.float32) / MLA_ROPE_DIM))
    ang = positions.astype(jnp.float32)[..., None] * inv_freq
    return jnp.cos(ang), jnp.sin(ang)


def mla_bidirectional_attention(q_nope, q_rope, k_nope, k_rope, v):
    b, s, h, _ = q_nope.shape
    nb = s // Q_BLOCK
    scale = (MLA_NOPE_DIM + MLA_ROPE_DIM) ** -0.5

    def to_blocks(t):
        return jnp.moveaxis(t.reshape(b, nb, Q_BLOCK, *t.shape[2:]), 1, 0)

    def block(qs):
        qn, qr = qs
        sc = (jnp.einsum("bqhd,bkhd->bhqk", qn, k_nope)
              + jnp.einsum("bqhr,bkr->bhqk", qr, k_rope))
        pr = jax.nn.softmax(sc.astype(jnp.float32) * scale, axis=-1).astype(v.dtype)
        return jnp.einsum("bhqk,bkhd->bqhd", pr, v)

    out = lax.map(block, (to_blocks(q_nope), to_blocks(q_rope)))
    return jnp.moveaxis(out, 0, 1).reshape(b, s, h * MLA_V_DIM)


def centred_depthwise_conv(x, w, bias):
    c = x.shape[-1]
    out = lax.conv_general_dilated(
        x, w[:, None, :].astype(x.dtype), window_strides=(1,),
        padding=[(SSD_CONV // 2, SSD_CONV // 2)],
        dimension_numbers=("NWC", "WIO", "NWC"), feature_group_count=c)
    return out + bias


def ssd_chunked_scan(xh, dt, a, bm, cm):
    b, s, g, r, p = xh.shape
    n = bm.shape[-1]
    c = s // SSD_CHUNK
    X = (xh * dt[..., None]).reshape(b, c, SSD_CHUNK, g, r, p)
    A = (dt * a).reshape(b, c, SSD_CHUNK, g, r).transpose(0, 3, 4, 1, 2)
    Bc = bm.reshape(b, c, SSD_CHUNK, g, n)
    Cc = cm.reshape(b, c, SSD_CHUNK, g, n)
    a_cs = jnp.cumsum(A, axis=-1)
    tri = jnp.tril(jnp.ones((SSD_CHUNK, SSD_CHUNK), dtype=bool))
    seg = a_cs[..., :, None] - a_cs[..., None, :]
    Lmat = jnp.exp(jnp.where(tri, seg, -jnp.inf))
    y_diag = jnp.einsum("bclgn,bcsgn,bgrcls,bcsgrp->bclgrp", Cc, Bc, Lmat, X)
    decay_states = jnp.exp(a_cs[..., -1:] - a_cs)
    states = jnp.einsum("bclgn,bgrcl,bclgrp->bcgrpn", Bc, decay_states, X)
    chunk_decay = jnp.exp(a_cs[..., -1])

    def step(hstate, inp):
        st, dc = inp
        return hstate * dc[..., None, None] + st, hstate

    _, h_prev = lax.scan(step, jnp.zeros_like(states[:, 0]),
                         (jnp.moveaxis(states, 1, 0), jnp.moveaxis(chunk_decay, -1, 0)))
    h_prev = jnp.moveaxis(h_prev, 0, 1)
    y_off = jnp.einsum("bclgn,bcgrpn,bgrcl->bclgrp", Cc, h_prev, jnp.exp(a_cs))
    return (y_diag + y_off).reshape(b, s, g, r, p)


def hybrid_token_mixer(h, cos, sin, w_in, q_norm_w, w_uq, kv_norm_w, w_ukv, attn_out_norm_w,
                       conv_w, conv_b, dt_bias, a_log, ssd_d, ssd_norm_w, w_o):
    b, s, _ = h.shape
    proj = h @ w_in
    o1 = MLA_Q_RANK
    o2 = o1 + MLA_KV_RANK
    o3 = o2 + MLA_ROPE_DIM
    o4 = o3 + SSD_INNER
    o5 = o4 + SSD_XBC
    c_q, c_kv, k_rope, z, xbc, dt_raw = jnp.split(proj, [o1, o2, o3, o4, o5], axis=-1)

    q = (rmsnorm(c_q, q_norm_w) @ w_uq).reshape(b, s, MLA_HEADS, MLA_NOPE_DIM + MLA_ROPE_DIM)
    q_nope = q[..., :MLA_NOPE_DIM]
    q_rope = rotary(q[..., MLA_NOPE_DIM:], cos[:, :, None, :], sin[:, :, None, :])
    kv = (rmsnorm(c_kv, kv_norm_w) @ w_ukv).reshape(b, s, MLA_HEADS, MLA_NOPE_DIM + MLA_V_DIM)
    k_nope, v = kv[..., :MLA_NOPE_DIM], kv[..., MLA_NOPE_DIM:]
    k_rope = rotary(k_rope, cos, sin)
    attn = mla_bidirectional_attention(q_nope, q_rope, k_nope, k_rope, v)
    attn = rmsnorm(attn, attn_out_norm_w)

    xbc = jax.nn.silu(centred_depthwise_conv(xbc, conv_w, conv_b))
    xs, bm, cm = jnp.split(xbc, [SSD_INNER, SSD_INNER + SSD_GROUPS * SSD_STATE], axis=-1)
    xh = xs.reshape(b, s, SSD_GROUPS, SSD_HEADS_PER_GROUP, SSD_HEAD_DIM)
    bm = bm.reshape(b, s, SSD_GROUPS, SSD_STATE)
    cm = cm.reshape(b, s, SSD_GROUPS, SSD_STATE)
    dt = jax.nn.softplus(
        (dt_raw.reshape(b, s, SSD_DIRECTIONS, SSD_GROUPS, SSD_HEADS_PER_GROUP)
         + dt_bias.reshape(SSD_DIRECTIONS, SSD_GROUPS, SSD_HEADS_PER_GROUP)).astype(jnp.float32))
    a = -jnp.exp(a_log.astype(jnp.float32)).reshape(SSD_DIRECTIONS, SSD_GROUPS, SSD_HEADS_PER_GROUP)
    y_fwd = ssd_chunked_scan(xh, dt[:, :, 0], a[0], bm, cm)
    y_bwd = jnp.flip(ssd_chunked_scan(jnp.flip(xh, 1), jnp.flip(dt[:, :, 1], 1), a[1],
                                      jnp.flip(bm, 1), jnp.flip(cm, 1)), 1)
    y = y_fwd + y_bwd + xh * ssd_d.reshape(SSD_GROUPS, SSD_HEADS_PER_GROUP)[..., None]
    y = y.reshape(b, s, SSD_INNER).astype(h.dtype)
    y = rmsnorm(y * jax.nn.silu(z), ssd_norm_w)

    return jnp.concatenate([attn, y], axis=-1) @ w_o


def hierarchical_moe(h, w_router_group, b_router_group, w_router_expert, b_router_expert,
                     w_exp_gate, w_exp_up, w_exp_down):
    b, s, _ = h.shape
    group_logits = (h @ w_router_group).astype(jnp.float32) + b_router_group
    group_prob = jax.nn.softmax(group_logits, axis=-1)
    g_idx = jnp.argmax(group_logits, axis=-1)
    g_weight = jnp.max(group_prob, axis=-1, keepdims=True)
    exp_logits = ((h @ w_router_expert).astype(jnp.float32) + b_router_expert).reshape(
        b, s, N_EXPERT_GROUPS, EXPERTS_PER_GROUP)
    sel_logits = jnp.einsum("bsge,bsg->bse", exp_logits,
                            jax.nn.one_hot(g_idx, N_EXPERT_GROUPS, dtype=jnp.float32))
    top_v, top_i = lax.top_k(sel_logits, TOP_K_IN_GROUP)
    w_k = jax.nn.softmax(top_v, axis=-1) * g_weight
    e_idx = g_idx[..., None] * EXPERTS_PER_GROUP + top_i
    combine = jnp.einsum("bsk,bske->bse", w_k,
                         jax.nn.one_hot(e_idx, N_EXPERTS, dtype=jnp.float32)).astype(h.dtype)
    y = jnp.zeros_like(h)
    for e in range(N_EXPERTS):
        he = jax.nn.silu(h @ w_exp_gate[e]) * (h @ w_exp_up[e])
        y = y + combine[..., e:e + 1] * (he @ w_exp_down[e])
    return y


def setup_inputs(seed: int = 0) -> dict:
    key = jax.random.key(seed)
    ks = jax.random.split(key, 40)
    f32 = jnp.float32

    def nrm(k, shape, fan_in):
        return jax.random.normal(k, shape, f32) * fan_in ** -0.5

    def gain(k, shape):
        return 1.0 + 0.02 * jax.random.normal(k, shape, f32)

    L = DEPTH
    x = jax.random.normal(ks[0], (BATCH, SEQ, D_MODEL), f32)
    p = jax.random.normal(ks[1], (DEPTH, BATCH, SEQ, PLE_DIM), f32)
    offsets = jax.random.randint(ks[2], (BATCH, 1), 0, 1024, dtype=jnp.int32)
    positions = (jnp.arange(SEQ, dtype=jnp.int32)[None, :] + offsets).astype(jnp.int32)

    dt_init = jnp.exp(jax.random.uniform(ks[14], (L, SSD_DIRECTIONS * SSD_HEADS), f32)
                      * (math.log(0.1) - math.log(0.001)) + math.log(0.001))
    dt_bias = dt_init + jnp.log(-jnp.expm1(-dt_init))
    a_log = jnp.log(jax.random.uniform(ks[15], (L, SSD_DIRECTIONS * SSD_HEADS), f32, 1.0, 16.0))

    return {
        "x": x,
        "p": p,
        "positions": positions,
        "attn_norm_w": gain(ks[3], (L, D_MODEL)),
        "w_in": nrm(ks[4], (L, D_MODEL, IN_PROJ_COLS), D_MODEL),
        "q_norm_w": gain(ks[5], (L, MLA_Q_RANK)),
        "w_uq": nrm(ks[6], (L, MLA_Q_RANK, MLA_HEADS * (MLA_NOPE_DIM + MLA_ROPE_DIM)), MLA_Q_RANK),
        "kv_norm_w": gain(ks[7], (L, MLA_KV_RANK)),
        "w_ukv": nrm(ks[8], (L, MLA_KV_RANK, MLA_HEADS * (MLA_NOPE_DIM + MLA_V_DIM)), MLA_KV_RANK),
        "attn_out_norm_w": gain(ks[9], (L, MLA_OUT)),
        "conv_w": nrm(ks[10], (L, SSD_CONV, SSD_XBC), SSD_CONV),
        "conv_b": 0.02 * jax.random.normal(ks[11], (L, SSD_XBC), f32),
        "dt_bias": dt_bias,
        "a_log": a_log,
        "ssd_d": 1.0 + 0.1 * jax.random.normal(ks[12], (L, SSD_HEADS), f32),
        "ssd_norm_w": gain(ks[13], (L, SSD_INNER)),
        "w_o": nrm(ks[16], (L, D_MIX, D_MODEL), D_MIX),
        "ffn_norm_w": gain(ks[17], (L, D_MODEL)),
        "w_router_group": nrm(ks[18], (L, D_MODEL, N_EXPERT_GROUPS), D_MODEL),
        "b_router_group": 0.01 * jax.random.normal(ks[19], (L, N_EXPERT_GROUPS), f32),
        "w_router_expert": nrm(ks[20], (L, D_MODEL, N_EXPERTS), D_MODEL),
        "b_router_expert": 0.01 * jax.random.normal(ks[21], (L, N_EXPERTS), f32),
        "w_exp_gate": nrm(ks[22], (L, N_EXPERTS, D_MODEL, D_EXPERT), D_MODEL),
        "w_exp_up": nrm(ks[23], (L, N_EXPERTS, D_MODEL, D_EXPERT), D_MODEL),
        "w_exp_down": nrm(ks[24], (L, N_EXPERTS, D_EXPERT, D_MODEL), D_EXPERT),
        "ple_norm_w": gain(ks[25], (L, D_MODEL)),
        "w_ple_gate": nrm(ks[26], (L, D_MODEL, D_MODEL), D_MODEL),
        "b_ple_gate": 0.02 * jax.random.normal(ks[27], (L, D_MODEL), f32),
        "w_ple_proj": nrm(ks[28], (L, PLE_DIM, D_MODEL), PLE_DIM),
        "ple_post_norm_w": gain(ks[29], (L, D_MODEL)),
        "final_norm_w": gain(ks[30], (D_MODEL,)),
    }


def reference(x, p, positions, attn_norm_w, w_in, q_norm_w, w_uq, kv_norm_w, w_ukv,
              attn_out_norm_w, conv_w, conv_b, dt_bias, a_log, ssd_d, ssd_norm_w, w_o,
              ffn_norm_w, w_router_group, b_router_group, w_router_expert, b_router_expert,
              w_exp_gate, w_exp_up, w_exp_down, ple_norm_w, w_ple_gate, b_ple_gate,
              w_ple_proj, ple_post_norm_w, final_norm_w):
    cos, sin = rotary_tables(positions)
    cos = cos.astype(x.dtype)
    sin = sin.astype(x.dtype)
    for i in range(DEPTH):
        h = rmsnorm(x, attn_norm_w[i])
        x = x + hybrid_token_mixer(h, cos, sin, w_in[i], q_norm_w[i], w_uq[i], kv_norm_w[i],
                                   w_ukv[i], attn_out_norm_w[i], conv_w[i], conv_b[i],
                                   dt_bias[i], a_log[i], ssd_d[i], ssd_norm_w[i], w_o[i])
        h = rmsnorm(x, ffn_norm_w[i])
        x = x + hierarchical_moe(h, w_router_group[i], b_router_group[i], w_router_expert[i],
                                 b_router_expert[i], w_exp_gate[i], w_exp_up[i], w_exp_down[i])
        gate = jax.nn.sigmoid(rmsnorm(x, ple_norm_w[i]) @ w_ple_gate[i] + b_ple_gate[i])
        ple = rmsnorm(p[i] @ w_ple_proj[i], ple_post_norm_w[i])
        x = x + gate * ple
    return rmsnorm(x, final_norm_w)
```

```cpp
#include <hip/hip_runtime.h>
#include <cstdio>
#include <cstdint>

#ifndef MK_PER_PHASE
#define MK_PER_PHASE 0
#endif

#define LAS __attribute__((address_space(3)))
#define GAS __attribute__((address_space(1)))
typedef unsigned short bf16_t;
typedef float f32x4 __attribute__((ext_vector_type(4)));
typedef unsigned u32x4 __attribute__((ext_vector_type(4)));
typedef unsigned u32x2 __attribute__((ext_vector_type(2)));

constexpr int NB = 8, S = 4096, T = NB * S, D = 1024;
constexpr int NH = 8, DQK = 96, DV = 64;
constexpr int PROJ_N = 1792, IN_COLS = 1712;
constexpr int PC_CQ = 0, PC_CKV = 256, PC_KR = 384, PC_DT = 416, PC_Z = 512, PC_XBC = 1024;
constexpr int XBC = 768;
constexpr float EPS = 1e-6f;
constexpr int NPHASES = 13;

constexpr size_t MiB = 1u << 20;
constexpr size_t WS_CTL = 0, CTL_ZERO_BYTES = 1 * MiB;
constexpr size_t WS_COS = 1 * MiB, WS_SIN = 3 * MiB, WS_DT = 5 * MiB, WS_ROUTE = 7 * MiB, WS_BUCKET = 8 * MiB;
constexpr size_t WS_RSTDQ = 12 * MiB, WS_RSTDKV = 12 * MiB + 128 * 1024, WS_RSTDPLE = 12 * MiB + 256 * 1024, WS_DTRAW = 13 * MiB;
constexpr size_t WS_WEIGHTS = 16 * MiB;
constexpr size_t WS_H = 80 * MiB;
constexpr size_t WS_PROJ = 144 * MiB;
constexpr size_t WS_Q = 256 * MiB, WS_K = 304 * MiB, WS_V = 352 * MiB;
constexpr size_t WS_MIX = 384 * MiB;
constexpr size_t WS_XBCC = 448 * MiB;
constexpr size_t WS_PB = 496 * MiB;
constexpr size_t WS_END = 512 * MiB;
constexpr int CW_BAR = 4096, CW_ECNT = 8192;

__device__ __forceinline__ unsigned f2bf(float f) { unsigned u = __builtin_bit_cast(unsigned, f); return (u + 0x7fffu + ((u >> 16) & 1u)) >> 16; }
__device__ __forceinline__ float bf2f(unsigned h) { return __builtin_bit_cast(float, h << 16); }
__device__ __forceinline__ unsigned pk2(float lo, float hi) { return f2bf(lo) | (f2bf(hi) << 16); }
__device__ __forceinline__ float wave_sum(float v) {
#pragma unroll
    for (int o = 1; o < 64; o <<= 1) v += __shfl_xor(v, o);
    return v;
}
__device__ __forceinline__ float silu_f(float v) { return v / (1.f + __expf(-v)); }

#define XB_TMO      128
#define XB_XCNT(j)  (256  + 64 * (j))
#define XB_XSUB(j)  (1280 + 64 * (j))
#define XB_XGEN(j)  (2304 + 64 * (j))
#define XB_TOP      3328
#define XB_TOPGEN   3392
#define XCD_BAR_WORDS 3456
#define XB_SPIN_CAP (1u << 22)

__device__ __forceinline__ unsigned xb_ld(unsigned* p)              { return __hip_atomic_load(p, __ATOMIC_RELAXED, __HIP_MEMORY_SCOPE_AGENT); }
__device__ __forceinline__ unsigned xb_add(unsigned* p, unsigned v) { return __hip_atomic_fetch_add(p, v, __ATOMIC_RELAXED, __HIP_MEMORY_SCOPE_AGENT); }
__device__ __forceinline__ unsigned xb_xcc_id() { return (unsigned)__builtin_amdgcn_s_getreg((3 << 11) | 20) & 0xFu; }
#define XB_SPIN(cond, bar) do { unsigned _sp = 0; while (cond) { __builtin_amdgcn_s_sleep(1); \
    if ((++_sp & 255u) == 0u) { if (xb_ld(&(bar)[XB_TMO])) break; if (_sp > XB_SPIN_CAP) { atomicAdd(&(bar)[XB_TMO], 1u); break; } } } } while (0)

struct XcdBarrier { unsigned* bar; unsigned x; volatile LAS unsigned* st; };
__device__ __forceinline__ XcdBarrier xcd_barrier_post(unsigned* bar, volatile LAS unsigned* st) {
    XcdBarrier b; b.bar = bar; b.x = xb_xcc_id(); b.st = st;
    if (threadIdx.x == 0) (void)xb_add(&bar[XB_XCNT(b.x)], 1u);
    return b;
}
__device__ __forceinline__ void xcd_barrier_complete(unsigned* bar, unsigned x, unsigned& nloc, unsigned& nx) {
    const unsigned G = gridDim.x * gridDim.y * gridDim.z;
    unsigned sum, cnt, mine, sp = 0u;
    for (;;) {
        sum = 0u; cnt = 0u; mine = 0u;
#pragma unroll
        for (unsigned j = 0; j < 16; ++j) { const unsigned c = xb_ld(&bar[XB_XCNT(j)]); sum += c; cnt += (c > 0u) ? 1u : 0u; mine = (j == x) ? c : mine; }
        if (sum == G) break;
        __builtin_amdgcn_s_sleep(1);
        if ((++sp & 255u) == 0u) { if (xb_ld(&bar[XB_TMO])) break; if (sp > XB_SPIN_CAP) { atomicAdd(&bar[XB_TMO], 1u); break; } }
    }
    nloc = mine > 0u ? mine : 1u; nx = cnt > 0u ? cnt : 1u;
}
__device__ __forceinline__ void xcd_barrier(const XcdBarrier& b) {
    asm volatile("s_waitcnt vmcnt(0)" ::: "memory");
    __syncthreads();
    if (threadIdx.x == 0) {
        unsigned* bar = b.bar;
        __builtin_amdgcn_s_waitcnt(0);
        unsigned nloc = b.st[0], nx = b.st[1];
        if (nloc == 0u) { xcd_barrier_complete(bar, b.x, nloc, nx); b.st[0] = nloc; b.st[1] = nx; }
        const unsigned old = xb_add(&bar[XB_XSUB(b.x)], 1u);
        const unsigned gen = old / nloc;
        if (old + 1u == (gen + 1u) * nloc) {
            __builtin_amdgcn_fence(__ATOMIC_RELEASE, "agent");
            asm volatile("s_waitcnt vmcnt(0)" ::: "memory");
            const unsigned og = xb_add(&bar[XB_TOP], 1u);
            const unsigned tg = og / nx;
            if (og + 1u == (tg + 1u) * nx) xb_add(&bar[XB_TOPGEN], 1u);
            else XB_SPIN(xb_ld(&bar[XB_TOPGEN]) == tg, bar);
            __builtin_amdgcn_fence(__ATOMIC_ACQUIRE, "agent");
            xb_add(&bar[XB_XGEN(b.x)], 1u);
            asm volatile("s_waitcnt vmcnt(0)" ::: "memory");
        } else {
            XB_SPIN(xb_ld(&bar[XB_XGEN(b.x)]) == gen, bar);
            __builtin_amdgcn_fence(__ATOMIC_ACQUIRE, "agent");
            asm volatile("s_waitcnt vmcnt(0)" ::: "memory");
        }
    }
    __syncthreads();
}

struct Args { const void* in[31]; float* out; unsigned char* ws; int ph_lo, ph_hi; };
#define IN_F(i) ((const float*)a.in[i])
enum { I_X = 0, I_P, I_POS, I_ATTN_NW, I_WIN, I_QNW, I_WUQ, I_KVNW, I_WUKV, I_AONW, I_CONVW, I_CONVB, I_DTB, I_ALOG, I_SSDD, I_SSDNW, I_WO, I_FFNNW,
       I_WRG, I_BRG, I_WRE, I_BRE, I_WEG, I_WEU, I_WED, I_PLENW, I_WPG, I_BPG, I_WPP, I_PPNW, I_FNW };

template <class FA, class FB, class FE>
__device__ __forceinline__ void naive_gemm(int M, int N, int K, FA fa, FB fb, FE fe, float* sm) {
    const int tid = threadIdx.x, tx = tid & 63, ty = tid >> 6;
    float* As = sm; float* Bs = sm + 64 * 17;
    const int ntm = M / 64, ntn = (N + 63) / 64;
    for (int tile = blockIdx.x; tile < ntm * ntn; tile += gridDim.x) {
        const int tm = tile / ntn, tn = tile % ntn;
        float acc[8];
#pragma unroll
        for (int j = 0; j < 8; ++j) acc[j] = 0.f;
        for (int k0 = 0; k0 < K; k0 += 16) {
            __syncthreads();
            for (int i = tid; i < 1024; i += 512) { const int r = i >> 4, c = i & 15; As[r * 17 + c] = fa(tm * 64 + r, k0 + c); }
            for (int i = tid; i < 1024; i += 512) { const int r = i >> 6, c = i & 63; const int n = tn * 64 + c; Bs[r * 64 + c] = (n < N) ? fb(k0 + r, n) : 0.f; }
            __syncthreads();
#pragma unroll
            for (int k = 0; k < 16; ++k) { const float b = Bs[k * 64 + tx];
#pragma unroll
                for (int j = 0; j < 8; ++j) acc[j] += As[(ty * 8 + j) * 17 + k] * b; }
        }
#pragma unroll
        for (int j = 0; j < 8; ++j) { const int m = tm * 64 + ty * 8 + j, n = tn * 64 + tx; if (n < N) fe(m, n, acc[j]); }
    }
    __syncthreads();
}

__device__ __forceinline__ int proj_src_col(int j) {
    if (j < 416) return j;
    if (j < 432) return 1696 + (j - 416);
    if (j < 512) return -1;
    if (j < 1024) return 416 + (j - 512);
    return 928 + (j - 1024);
}

__device__ __forceinline__ void rms_row_to_bf16(const float* xrow, const float* w, bf16_t* orow, int lane) {
    const f32x4* xr = (const f32x4*)xrow + lane; const f32x4* wr = (const f32x4*)w + lane;
    f32x4 v[4]; float s = 0.f;
#pragma unroll
    for (int j = 0; j < 4; ++j) { v[j] = xr[64 * j]; s += (v[j].x * v[j].x + v[j].y * v[j].y) + (v[j].z * v[j].z + v[j].w * v[j].w); }
    const float rstd = 1.f / sqrtf(wave_sum(s) * (1.f / D) + EPS);
    u32x2* o8 = (u32x2*)orow + lane;
#pragma unroll
    for (int j = 0; j < 4; ++j) { const f32x4 g = wr[64 * j]; u32x2 o; o.x = pk2(v[j].x * rstd * g.x, v[j].y * rstd * g.y); o.y = pk2(v[j].z * rstd * g.z, v[j].w * rstd * g.w); o8[64 * j] = o; }
}

constexpr int LDS_BYTES = 147456;
constexpr int MISC_OFF = 131072;

__global__ void __launch_bounds__(512, 2) fwd(Args a) {
    extern __shared__ __attribute__((aligned(16))) unsigned char lds_raw[];
    float* smf = (float*)lds_raw;
    const int tid = threadIdx.x, lane = tid & 63, wave = __builtin_amdgcn_readfirstlane(tid >> 6);
    const int G = gridDim.x, gw = blockIdx.x * 8 + wave, NGW = G * 8;
    const int gtid = blockIdx.x * 512 + tid, NGT = G * 512;
    unsigned char* ws = a.ws;
    unsigned* ctl = (unsigned*)(ws + WS_CTL);
    volatile LAS unsigned* MISC = (volatile LAS unsigned*)((LAS unsigned char*)lds_raw + MISC_OFF);
    if (tid < 32) MISC[tid] = 0u;
    __syncthreads();
#if !MK_PER_PHASE
    XcdBarrier bar = xcd_barrier_post(ctl + CW_BAR, MISC + 8);
#define GRID_BAR() xcd_barrier(bar)
#else
#define GRID_BAR() do {} while (0)
#endif
    const int lo = a.ph_lo, hi = a.ph_hi;
#define IN(k) (lo <= (k) && (k) < hi)
#define SEAM(k) do { if (IN(k) && IN((k) + 1)) GRID_BAR(); } while (0)

    const float* x = IN_F(I_X);
    float* out = a.out;
    bf16_t* H = (bf16_t*)(ws + WS_H);
    bf16_t* PROJ = (bf16_t*)(ws + WS_PROJ);
    bf16_t* PLERAW = (bf16_t*)(ws + WS_PROJ);
    bf16_t* Qb = (bf16_t*)(ws + WS_Q); bf16_t* Kb = (bf16_t*)(ws + WS_K); bf16_t* Vb = (bf16_t*)(ws + WS_V);
    bf16_t* MIX = (bf16_t*)(ws + WS_MIX);
    bf16_t* XBCC = (bf16_t*)(ws + WS_XBCC);
    float* YSSD = (float*)(ws + WS_H);
    float* COS = (float*)(ws + WS_COS); float* SIN = (float*)(ws + WS_SIN);
    float* DT = (float*)(ws + WS_DT); float* DTRAW = (float*)(ws + WS_DTRAW);
    float* RSTDQ = (float*)(ws + WS_RSTDQ); float* RSTDKV = (float*)(ws + WS_RSTDKV); float* RSTDPLE = (float*)(ws + WS_RSTDPLE);
    float* ROUTE = (float*)(ws + WS_ROUTE);
    int* BUCKET = (int*)(ws + WS_BUCKET);
    const int* pos = (const int*)a.in[I_POS];

    if (IN(0)) {
        for (int m = gw; m < T; m += NGW) rms_row_to_bf16(x + (size_t)m * D, IN_F(I_ATTN_NW), H + (size_t)m * D, lane);
        for (int i = gtid; i < T * 16; i += NGT) {
            const int t = i >> 4, f = i & 15;
            const float inv = 1.0f / powf(10000.0f, (float)(2 * f) / 32.0f);
            const float ang = (float)pos[t] * inv;
            COS[i] = cosf(ang); SIN[i] = sinf(ang);
        }
    }
    SEAM(0);
    if (IN(1)) {
        const float* w_in = IN_F(I_WIN);
        naive_gemm(T, PROJ_N, D,
            [&](int m, int k) { return bf2f(H[(size_t)m * D + k]); },
            [&](int k, int n) { const int oc = proj_src_col(n); return oc >= 0 ? w_in[(size_t)k * IN_COLS + oc] : 0.f; },
            [&](int m, int n, float v) { PROJ[(size_t)m * PROJ_N + n] = (bf16_t)f2bf(v); if (n >= PC_DT && n < PC_DT + 16) DTRAW[m * 16 + (n - PC_DT)] = v; }, smf);
    }
    SEAM(1);
    if (IN(2)) {
        for (int m = gw; m < T; m += NGW) {
            const bf16_t* pr = PROJ + (size_t)m * PROJ_N;
            float sq = 0.f, skv = 0.f;
#pragma unroll
            for (int j = 0; j < 4; ++j) { const float v = bf2f(pr[PC_CQ + lane + 64 * j]); sq += v * v; }
#pragma unroll
            for (int j = 0; j < 2; ++j) { const float v = bf2f(pr[PC_CKV + lane + 64 * j]); skv += v * v; }
            sq = wave_sum(sq); skv = wave_sum(skv);
            if (lane == 0) { RSTDQ[m] = 1.f / sqrtf(sq * (1.f / 256.f) + EPS); RSTDKV[m] = 1.f / sqrtf(skv * (1.f / 128.f) + EPS); }
        }
        const float* cw = IN_F(I_CONVW); const float* cb = IN_F(I_CONVB);
        for (size_t i = gtid; i < (size_t)T * XBC; i += NGT) {
            const int t = (int)(i / XBC), c = (int)(i % XBC), s = t & (S - 1);
            float acc = cb[c];
#pragma unroll
            for (int k = 0; k < 5; ++k) { const int ss = s + k - 2; if (ss >= 0 && ss < S) acc += cw[k * XBC + c] * bf2f(PROJ[(size_t)(t + k - 2) * PROJ_N + PC_XBC + c]); }
            XBCC[i] = (bf16_t)f2bf(silu_f(acc));
        }
        const float* dtb = IN_F(I_DTB);
        for (int i = gtid; i < T * 16; i += NGT) { const float v = DTRAW[i] + dtb[i & 15]; DT[i] = v > 20.f ? v : log1pf(expf(v)); }
        for (int i = gtid; i < T * 16; i += NGT) {
            const int t = i >> 4, f = i & 15, b = t / S, s = t % S;
            const float c = COS[i], sn = SIN[i];
            const float t1 = bf2f(PROJ[(size_t)t * PROJ_N + PC_KR + f]), t2 = bf2f(PROJ[(size_t)t * PROJ_N + PC_KR + 16 + f]);
            const bf16_t o1 = (bf16_t)f2bf(t1 * c - t2 * sn), o2 = (bf16_t)f2bf(t2 * c + t1 * sn);
            for (int h = 0; h < NH; ++h) { bf16_t* kr = Kb + ((size_t)(b * NH + h) * S + s) * DQK + 64; kr[f] = o1; kr[16 + f] = o2; }
        }
    }
    SEAM(2);
    if (IN(3)) {
        const float* w_uq = IN_F(I_WUQ); const float* qnw = IN_F(I_QNW);
        const float qscale = 0.10206207261596575f * 1.4426950408889634f;
        naive_gemm(T, 768, 256,
            [&](int m, int k) { return bf2f(PROJ[(size_t)m * PROJ_N + PC_CQ + k]) * RSTDQ[m] * qnw[k]; },
            [&](int k, int n) { return w_uq[k * 768 + n]; },
            [&](int m, int n, float v) { const int b = m / S, s = m % S, h = n / 96, d = n % 96; Qb[((size_t)(b * NH + h) * S + s) * DQK + d] = (bf16_t)f2bf(v * qscale); }, smf);
        const float* w_ukv = IN_F(I_WUKV); const float* kvnw = IN_F(I_KVNW);
        naive_gemm(T, 1024, 128,
            [&](int m, int k) { return bf2f(PROJ[(size_t)m * PROJ_N + PC_CKV + k]) * RSTDKV[m] * kvnw[k]; },
            [&](int k, int n) { return w_ukv[k * 1024 + n]; },
            [&](int m, int n, float v) { const int b = m / S, s = m % S, h = n >> 7, d = n & 127;
                if (d < 64) Kb[((size_t)(b * NH + h) * S + s) * DQK + d] = (bf16_t)f2bf(v); else Vb[((size_t)(b * NH + h) * S + s) * DV + (d - 64)] = (bf16_t)f2bf(v); }, smf);
    }
    SEAM(3);
    if (IN(4)) {
        for (int i = gtid; i < T * NH * 16; i += NGT) {
            const int f = i & 15, h = (i >> 4) & 7, t = i >> 7, b = t / S, s = t % S;
            bf16_t* q = Qb + ((size_t)(b * NH + h) * S + s) * DQK + 64;
            const float c = COS[t * 16 + f], sn = SIN[t * 16 + f];
            const float t1 = bf2f(q[f]), t2 = bf2f(q[16 + f]);
            q[f] = (bf16_t)f2bf(t1 * c - t2 * sn); q[16 + f] = (bf16_t)f2bf(t2 * c + t1 * sn);
        }
    }
    SEAM(4);
    if (IN(5)) {
        if (blockIdx.x < 64) {
            const int b = blockIdx.x >> 3, hd = blockIdx.x & 7, g = hd >> 2;
            const int p = tid >> 3, ng = tid & 7;
            float* Xs = smf; float* Bs = smf + 4096; float* Cs = smf + 8192; float* dts = smf + 12288;
            const float* alog = IN_F(I_ALOG);
            for (int dir = 0; dir < 2; ++dir) {
                const float av = -expf(alog[dir * 8 + hd]);
                float hst[8];
#pragma unroll
                for (int j = 0; j < 8; ++j) hst[j] = 0.f;
                for (int tile = 0; tile < S / 64; ++tile) {
                    const int s0 = dir == 0 ? tile * 64 : S - 64 - tile * 64;
                    __syncthreads();
                    for (int i = tid; i < 4096; i += 512) { const int r = i >> 6, c = i & 63; const bf16_t* row = XBCC + (size_t)(b * S + s0 + r) * XBC;
                        Xs[i] = bf2f(row[hd * 64 + c]); Bs[i] = bf2f(row[512 + g * 64 + c]); Cs[i] = bf2f(row[640 + g * 64 + c]); }
                    if (tid < 64) dts[tid] = DT[(size_t)(b * S + s0 + tid) * 16 + dir * 8 + hd];
                    __syncthreads();
                    for (int st = 0; st < 64; ++st) {
                        const int r = dir == 0 ? st : 63 - st;
                        const float dt = dts[r], dA = __expf(dt * av), coef = dt * Xs[r * 64 + p];
                        float part = 0.f;
#pragma unroll
                        for (int j = 0; j < 8; ++j) { hst[j] = hst[j] * dA + coef * Bs[r * 64 + ng * 8 + j]; part += hst[j] * Cs[r * 64 + ng * 8 + j]; }
                        part += __shfl_xor(part, 1); part += __shfl_xor(part, 2); part += __shfl_xor(part, 4);
                        if (ng == 0) { float* yp = YSSD + (size_t)(b * S + s0 + r) * 512 + hd * 64 + p; if (dir == 0) *yp = part; else *yp += part; }
                    }
                }
            }
            __syncthreads();
        }
        {
            float* Ks = smf; float* Vs = smf + 64 * 97;
            const int qi = tid >> 4, kl = tid & 15;
            for (int u = blockIdx.x; u < NB * NH * (S / 32); u += G) {
                const int bh = u / (S / 32), qb = u % (S / 32);
                const bf16_t* qrow = Qb + ((size_t)bh * S + qb * 32 + qi) * DQK;
                float q[96];
#pragma unroll
                for (int d = 0; d < 96; ++d) q[d] = bf2f(qrow[d]);
                float o[64];
#pragma unroll
                for (int d = 0; d < 64; ++d) o[d] = 0.f;
                float mrun = -1e30f, lrun = 0.f;
                for (int kt = 0; kt < S / 64; ++kt) {
                    __syncthreads();
                    const bf16_t* kbase = Kb + ((size_t)bh * S + kt * 64) * DQK; const bf16_t* vbase = Vb + ((size_t)bh * S + kt * 64) * DV;
                    for (int i = tid; i < 64 * 96; i += 512) { const int r = i / 96, c = i % 96; Ks[r * 97 + c] = bf2f(kbase[i]); }
                    for (int i = tid; i < 64 * 64; i += 512) { const int r = i >> 6, c = i & 63; Vs[r * 65 + c] = bf2f(vbase[i]); }
                    __syncthreads();
#pragma unroll 1
                    for (int j = 0; j < 4; ++j) {
                        const int key = kl + 16 * j;
                        float sc = 0.f;
#pragma unroll
                        for (int d = 0; d < 96; ++d) sc += q[d] * Ks[key * 97 + d];
                        const float mnew = fmaxf(mrun, sc), f = exp2f(mrun - mnew), pe = exp2f(sc - mnew);
                        lrun = lrun * f + pe; mrun = mnew;
#pragma unroll
                        for (int d = 0; d < 64; ++d) o[d] = o[d] * f + pe * Vs[key * 65 + d];
                    }
                }
                float mt = mrun;
                mt = fmaxf(mt, __shfl_xor(mt, 1)); mt = fmaxf(mt, __shfl_xor(mt, 2)); mt = fmaxf(mt, __shfl_xor(mt, 4)); mt = fmaxf(mt, __shfl_xor(mt, 8));
                const float f = exp2f(mrun - mt);
                float lt = lrun * f;
                lt += __shfl_xor(lt, 1); lt += __shfl_xor(lt, 2); lt += __shfl_xor(lt, 4); lt += __shfl_xor(lt, 8);
                const float rl = 1.f / lt;
                const int b = bh >> 3, h = bh & 7;
                bf16_t* orow = MIX + (size_t)(b * S + qb * 32 + qi) * D + h * 64;
#pragma unroll
                for (int d = 0; d < 64; ++d) {
                    float v = o[d] * f;
                    v += __shfl_xor(v, 1); v += __shfl_xor(v, 2); v += __shfl_xor(v, 4); v += __shfl_xor(v, 8);
                    if ((d & 15) == kl) orow[d] = (bf16_t)f2bf(v * rl);
                }
            }
            __syncthreads();
        }
    }
    SEAM(5);
    if (IN(6)) {
        const float* aonw = IN_F(I_AONW); const float* ssdd = IN_F(I_SSDD); const float* ssdnw = IN_F(I_SSDNW);
        for (int m = gw; m < T; m += NGW) {
            bf16_t* mr = MIX + (size_t)m * D;
            float v[8]; float ss = 0.f;
#pragma unroll
            for (int j = 0; j < 8; ++j) { v[j] = bf2f(mr[lane * 8 + j]); ss += v[j] * v[j]; }
            float rstd = 1.f / sqrtf(wave_sum(ss) * (1.f / 512.f) + EPS);
#pragma unroll
            for (int j = 0; j < 8; ++j) mr[lane * 8 + j] = (bf16_t)f2bf(v[j] * rstd * aonw[lane * 8 + j]);
            ss = 0.f;
#pragma unroll
            for (int j = 0; j < 8; ++j) { const int c = lane * 8 + j;
                const float y = YSSD[(size_t)m * 512 + c] + bf2f(XBCC[(size_t)m * XBC + c]) * ssdd[c >> 6];
                const float z = bf2f(PROJ[(size_t)m * PROJ_N + PC_Z + c]);
                v[j] = y * silu_f(z); ss += v[j] * v[j]; }
            rstd = 1.f / sqrtf(wave_sum(ss) * (1.f / 512.f) + EPS);
#pragma unroll
            for (int j = 0; j < 8; ++j) mr[512 + lane * 8 + j] = (bf16_t)f2bf(v[j] * rstd * ssdnw[lane * 8 + j]);
        }
    }
    SEAM(6);
    if (IN(7)) {
        const float* w_o = IN_F(I_WO);
        naive_gemm(T, D, D,
            [&](int m, int k) { return bf2f(MIX[(size_t)m * D + k]); },
            [&](int k, int n) { return w_o[(size_t)k * D + n]; },
            [&](int m, int n, float v) { out[(size_t)m * D + n] = x[(size_t)m * D + n] + v; }, smf);
    }
    SEAM(7);
    if (IN(8)) {
        const float* fw = IN_F(I_FFNNW); const float* wrg = IN_F(I_WRG); const float* brg = IN_F(I_BRG); const float* wre = IN_F(I_WRE); const float* bre = IN_F(I_BRE);
        for (int m = gw; m < T; m += NGW) {
            const f32x4* xr = (const f32x4*)(out + (size_t)m * D) + lane; const f32x4* wr = (const f32x4*)fw + lane;
            f32x4 v[4]; float s = 0.f;
#pragma unroll
            for (int j = 0; j < 4; ++j) { v[j] = xr[64 * j]; s += (v[j].x * v[j].x + v[j].y * v[j].y) + (v[j].z * v[j].z + v[j].w * v[j].w); }
            const float rstd = 1.f / sqrtf(wave_sum(s) * (1.f / D) + EPS);
            float acc[36];
#pragma unroll
            for (int j = 0; j < 36; ++j) acc[j] = 0.f;
            u32x2* o8 = (u32x2*)(H + (size_t)m * D) + lane;
#pragma unroll
            for (int j = 0; j < 4; ++j) {
                const f32x4 g = wr[64 * j]; f32x4 hn = v[j] * rstd * g;
                u32x2 o; o.x = pk2(hn.x, hn.y); o.y = pk2(hn.z, hn.w); o8[64 * j] = o;
#pragma unroll
                for (int e = 0; e < 4; ++e) { const int c = 4 * (64 * j + lane) + e; const float hv = hn[e];
#pragma unroll
                    for (int q = 0; q < 4; ++q) acc[q] += hv * wrg[c * 4 + q];
#pragma unroll
                    for (int q = 0; q < 32; ++q) acc[4 + q] += hv * wre[c * 32 + q]; }
            }
#pragma unroll
            for (int j = 0; j < 36; ++j) acc[j] = wave_sum(acc[j]);
            if (lane == 0) {
                float gl[4]; int gi = 0;
#pragma unroll
                for (int q = 0; q < 4; ++q) gl[q] = acc[q] + brg[q];
                float gmax = gl[0];
#pragma unroll
                for (int q = 1; q < 4; ++q) if (gl[q] > gmax) { gmax = gl[q]; gi = q; }
                float gs = 0.f;
#pragma unroll
                for (int q = 0; q < 4; ++q) gs += expf(gl[q] - gmax);
                const float gwt = 1.f / gs;
                float el[8];
#pragma unroll
                for (int q = 0; q < 8; ++q) { float vv = 0.f;
#pragma unroll
                    for (int g2 = 0; g2 < 4; ++g2) vv = (g2 == gi) ? acc[4 + g2 * 8 + q] + bre[g2 * 8 + q] : vv;
                    el[q] = vv; }
                int i0 = 0; float v0 = el[0];
#pragma unroll
                for (int q = 1; q < 8; ++q) if (el[q] > v0) { v0 = el[q]; i0 = q; }
                int i1 = -1; float v1 = -3.4e38f;
#pragma unroll
                for (int q = 0; q < 8; ++q) if (q != i0 && el[q] > v1) { v1 = el[q]; i1 = q; }
                const float e1 = expf(v1 - v0), w0 = gwt / (1.f + e1), w1 = gwt * e1 / (1.f + e1);
                const int ex0 = gi * 8 + i0, ex1 = gi * 8 + i1;
                ROUTE[m * 4 + 0] = __int_as_float(ex0); ROUTE[m * 4 + 1] = __int_as_float(ex1); ROUTE[m * 4 + 2] = w0; ROUTE[m * 4 + 3] = w1;
                const unsigned p0 = atomicAdd(ctl + CW_ECNT + 64 * ex0, 1u); BUCKET[(size_t)ex0 * T + p0] = m * 2;
                const unsigned p1 = atomicAdd(ctl + CW_ECNT + 64 * ex1, 1u); BUCKET[(size_t)ex1 * T + p1] = m * 2 + 1;
            }
        }
        const float* pp = IN_F(I_P); const float* wpp = IN_F(I_WPP);
        naive_gemm(T, D, 256,
            [&](int m, int k) { return pp[(size_t)m * 256 + k]; },
            [&](int k, int n) { return wpp[(size_t)k * D + n]; },
            [&](int m, int n, float v) { PLERAW[(size_t)m * D + n] = (bf16_t)f2bf(v); }, smf);
    }
    SEAM(8);
    if (IN(9)) {
        const float* weg = IN_F(I_WEG); const float* weu = IN_F(I_WEU); const float* wed = IN_F(I_WED);
        float* hs = smf; float* gu = smf + 1024; float* he = smf + 1536;
        for (int m = blockIdx.x; m < T; m += G) {
            __syncthreads();
            for (int i = tid; i < 1024; i += 512) hs[i] = bf2f(H[(size_t)m * D + i]);
            __syncthreads();
            float y0 = 0.f, y1 = 0.f;
            for (int k = 0; k < 2; ++k) {
                const int e = __float_as_int(ROUTE[m * 4 + k]); const float wk = ROUTE[m * 4 + 2 + k];
                const float* W = (tid < 256 ? weg : weu) + (size_t)e * 1024 * 256 + (tid & 255);
                float acc = 0.f;
#pragma unroll 8
                for (int c = 0; c < 1024; ++c) acc += hs[c] * W[(size_t)c * 256];
                gu[tid] = acc;
                __syncthreads();
                if (tid < 256) he[tid] = silu_f(gu[tid]) * gu[256 + tid];
                __syncthreads();
                const float* Wd = wed + (size_t)e * 256 * 1024;
                float a0 = 0.f, a1 = 0.f;
#pragma unroll 8
                for (int j = 0; j < 256; ++j) { const float hv = he[j]; a0 += hv * Wd[(size_t)j * 1024 + tid]; a1 += hv * Wd[(size_t)j * 1024 + 512 + tid]; }
                y0 += wk * a0; y1 += wk * a1;
                __syncthreads();
            }
            out[(size_t)m * D + tid] += y0; out[(size_t)m * D + 512 + tid] += y1;
        }
        __syncthreads();
    }
    SEAM(9);
    if (IN(10)) {
        for (int m = gw; m < T; m += NGW) {
            rms_row_to_bf16(out + (size_t)m * D, IN_F(I_PLENW), H + (size_t)m * D, lane);
            const bf16_t* pr = PLERAW + (size_t)m * D; float ss = 0.f;
#pragma unroll
            for (int j = 0; j < 16; ++j) { const float v = bf2f(pr[lane + 64 * j]); ss += v * v; }
            ss = wave_sum(ss);
            if (lane == 0) RSTDPLE[m] = 1.f / sqrtf(ss * (1.f / D) + EPS);
        }
    }
    SEAM(10);
    if (IN(11)) {
        const float* wpg = IN_F(I_WPG); const float* bpg = IN_F(I_BPG); const float* ppnw = IN_F(I_PPNW);
        naive_gemm(T, D, D,
            [&](int m, int k) { return bf2f(H[(size_t)m * D + k]); },
            [&](int k, int n) { return wpg[(size_t)k * D + n]; },
            [&](int m, int n, float v) { const float g = 1.f / (1.f + __expf(-(v + bpg[n]))); const float pl = bf2f(PLERAW[(size_t)m * D + n]) * RSTDPLE[m] * ppnw[n];
                out[(size_t)m * D + n] += g * pl; }, smf);
    }
    SEAM(11);
    if (IN(12)) {
        const float* fnw = IN_F(I_FNW);
        for (int m = gw; m < T; m += NGW) {
            f32x4* xr = (f32x4*)(out + (size_t)m * D) + lane; const f32x4* wr = (const f32x4*)fnw + lane;
            f32x4 v[4]; float s = 0.f;
#pragma unroll
            for (int j = 0; j < 4; ++j) { v[j] = xr[64 * j]; s += (v[j].x * v[j].x + v[j].y * v[j].y) + (v[j].z * v[j].z + v[j].w * v[j].w); }
            const float rstd = 1.f / sqrtf(wave_sum(s) * (1.f / D) + EPS);
#pragma unroll
            for (int j = 0; j < 4; ++j) xr[64 * j] = v[j] * rstd * wr[64 * j];
        }
    }
#undef IN
#undef SEAM
}

extern "C" void kernel_launch(void* const* d_in, const int* in_sizes, int n_in, void* d_out, int out_size, void* d_ws, size_t ws_size, hipStream_t stream) {
    static int grid = 0;
    if (grid == 0) {
        if (n_in != 31 || out_size != T * D || ws_size < WS_END) { fprintf(stderr, "kernel_launch: unexpected shapes (n_in %d out %d ws %zu)\n", n_in, out_size, ws_size); grid = -1; return; }
        int dev = 0, cus = 0, per_cu = 0;
        if (hipGetDevice(&dev) != hipSuccess || hipDeviceGetAttribute(&cus, hipDeviceAttributeMultiprocessorCount, dev) != hipSuccess) { grid = -1; return; }
        if (hipFuncSetAttribute((const void*)fwd, hipFuncAttributeMaxDynamicSharedMemorySize, LDS_BYTES) != hipSuccess) { fprintf(stderr, "kernel_launch: hipFuncSetAttribute failed\n"); grid = -1; return; }
        if (hipOccupancyMaxActiveBlocksPerMultiprocessor(&per_cu, (const void*)fwd, 512, LDS_BYTES) != hipSuccess || per_cu < 1) { fprintf(stderr, "kernel_launch: occupancy query says %d\n", per_cu); }
        (void)hipGetLastError();
        grid = cus;
    }
    if (grid < 0) return;
    (void)hipMemsetAsync((char*)d_ws + WS_CTL, 0, CTL_ZERO_BYTES, stream);
    Args a{};
    for (int i = 0; i < 31; ++i) a.in[i] = d_in[i];
    a.out = (float*)d_out; a.ws = (unsigned char*)d_ws;
#if MK_PER_PHASE
    for (int p = 0; p < NPHASES; ++p) { a.ph_lo = p; a.ph_hi = p + 1; hipLaunchKernelGGL(fwd, dim3(grid), dim3(512), LDS_BYTES, stream, a); }
#else
    a.ph_lo = 0; a.ph_hi = NPHASES;
    hipLaunchKernelGGL(fwd, dim3(grid), dim3(512), LDS_BYTES, stream, a);
#endif
}
```

```cpp
#include <hip/hip_runtime.h>
#include <cstdio>
#include <cstdint>

#ifndef MK_PER_PHASE
#define MK_PER_PHASE 0
#endif

#define LAS __attribute__((address_space(3)))
#define GAS __attribute__((address_space(1)))
typedef unsigned short bf16_t;
typedef float f32x4 __attribute__((ext_vector_type(4)));
typedef unsigned u32x4 __attribute__((ext_vector_type(4)));
typedef unsigned u32x2 __attribute__((ext_vector_type(2)));

constexpr int NB = 8, S = 4096, T = NB * S, D = 1024;
constexpr int NH = 8, DQK = 96, DV = 64;
constexpr int PROJ_N = 1792, IN_COLS = 1712;
constexpr int PC_CQ = 0, PC_CKV = 256, PC_KR = 384, PC_DT = 416, PC_Z = 512, PC_XBC = 1024;
constexpr int XBC = 768;
constexpr float EPS = 1e-6f;
constexpr int NPHASES = 12;

constexpr size_t MiB = 1u << 20;
constexpr size_t WS_CTL = 0, CTL_ZERO_BYTES = 1 * MiB;
constexpr size_t WS_COS = 1 * MiB, WS_SIN = 3 * MiB, WS_DT = 5 * MiB, WS_ROUTE = 7 * MiB, WS_BUCKET = 8 * MiB;
constexpr size_t WS_SSQQ = 12 * MiB, WS_SSQKV = 12 * MiB + 512 * 1024, WS_DTRAW = 13 * MiB, WS_SSQPLE = 15 * MiB;
constexpr size_t WS_WR = 7 * MiB + 512 * 1024;
constexpr size_t WS_WEIGHTS = 18 * MiB;
constexpr size_t WS_H = 80 * MiB;
constexpr size_t WS_PROJ = 144 * MiB;
constexpr size_t WS_HE = 208 * MiB;
constexpr size_t WS_Q = 256 * MiB, WS_K = 304 * MiB, WS_V = 352 * MiB;
constexpr size_t WS_MIX = 384 * MiB;
constexpr size_t WS_XBCC = 448 * MiB;
constexpr size_t WS_PB = 496 * MiB;
constexpr size_t WS_END = 512 * MiB;
constexpr int CW_BAR = 4096, CW_ECNT = 8192;

__device__ __forceinline__ unsigned f2bf(float f) { unsigned u = __builtin_bit_cast(unsigned, f); return (u + 0x7fffu + ((u >> 16) & 1u)) >> 16; }
__device__ __forceinline__ float bf2f(unsigned h) { return __builtin_bit_cast(float, h << 16); }
__device__ __forceinline__ unsigned pk2(float lo, float hi) { return f2bf(lo) | (f2bf(hi) << 16); }
__device__ __forceinline__ float wave_sum(float v) {
#pragma unroll
    for (int o = 1; o < 64; o <<= 1) v += __shfl_xor(v, o);
    return v;
}
__device__ __forceinline__ float silu_f(float v) { return v / (1.f + __expf(-v)); }

#define XB_TMO      128
#define XB_XCNT(j)  (256  + 64 * (j))
#define XB_XSUB(j)  (1280 + 64 * (j))
#define XB_XGEN(j)  (2304 + 64 * (j))
#define XB_TOP      3328
#define XB_TOPGEN   3392
#define XCD_BAR_WORDS 3456
#define XB_SPIN_CAP (1u << 22)

__device__ __forceinline__ unsigned xb_ld(unsigned* p)              { return __hip_atomic_load(p, __ATOMIC_RELAXED, __HIP_MEMORY_SCOPE_AGENT); }
__device__ __forceinline__ unsigned xb_add(unsigned* p, unsigned v) { return __hip_atomic_fetch_add(p, v, __ATOMIC_RELAXED, __HIP_MEMORY_SCOPE_AGENT); }
__device__ __forceinline__ unsigned xb_xcc_id() { return (unsigned)__builtin_amdgcn_s_getreg((3 << 11) | 20) & 0xFu; }
#define XB_SPIN(cond, bar) do { unsigned _sp = 0; while (cond) { __builtin_amdgcn_s_sleep(1); \
    if ((++_sp & 255u) == 0u) { if (xb_ld(&(bar)[XB_TMO])) break; if (_sp > XB_SPIN_CAP) { atomicAdd(&(bar)[XB_TMO], 1u); break; } } } } while (0)

struct XcdBarrier { unsigned* bar; unsigned x; volatile LAS unsigned* st; };
__device__ __forceinline__ XcdBarrier xcd_barrier_post(unsigned* bar, volatile LAS unsigned* st) {
    XcdBarrier b; b.bar = bar; b.x = xb_xcc_id(); b.st = st;
    if (threadIdx.x == 0) (void)xb_add(&bar[XB_XCNT(b.x)], 1u);
    return b;
}
__device__ __forceinline__ void xcd_barrier_complete(unsigned* bar, unsigned x, unsigned& nloc, unsigned& nx) {
    const unsigned G = gridDim.x * gridDim.y * gridDim.z;
    unsigned sum, cnt, mine, sp = 0u;
    for (;;) {
        sum = 0u; cnt = 0u; mine = 0u;
#pragma unroll
        for (unsigned j = 0; j < 16; ++j) { const unsigned c = xb_ld(&bar[XB_XCNT(j)]); sum += c; cnt += (c > 0u) ? 1u : 0u; mine = (j == x) ? c : mine; }
        if (sum == G) break;
        __builtin_amdgcn_s_sleep(1);
        if ((++sp & 255u) == 0u) { if (xb_ld(&bar[XB_TMO])) break; if (sp > XB_SPIN_CAP) { atomicAdd(&bar[XB_TMO], 1u); break; } }
    }
    nloc = mine > 0u ? mine : 1u; nx = cnt > 0u ? cnt : 1u;
}
__device__ __forceinline__ void xcd_barrier(const XcdBarrier& b) {
    asm volatile("s_waitcnt vmcnt(0)" ::: "memory");
    __syncthreads();
    if (threadIdx.x == 0) {
        unsigned* bar = b.bar;
        __builtin_amdgcn_s_waitcnt(0);
        unsigned nloc = b.st[0], nx = b.st[1];
        if (nloc == 0u) { xcd_barrier_complete(bar, b.x, nloc, nx); b.st[0] = nloc; b.st[1] = nx; }
        const unsigned old = xb_add(&bar[XB_XSUB(b.x)], 1u);
        const unsigned gen = old / nloc;
        if (old + 1u == (gen + 1u) * nloc) {
            __builtin_amdgcn_fence(__ATOMIC_RELEASE, "agent");
            asm volatile("s_waitcnt vmcnt(0)" ::: "memory");
            const unsigned og = xb_add(&bar[XB_TOP], 1u);
            const unsigned tg = og / nx;
            if (og + 1u == (tg + 1u) * nx) xb_add(&bar[XB_TOPGEN], 1u);
            else XB_SPIN(xb_ld(&bar[XB_TOPGEN]) == tg, bar);
            __builtin_amdgcn_fence(__ATOMIC_ACQUIRE, "agent");
            xb_add(&bar[XB_XGEN(b.x)], 1u);
            asm volatile("s_waitcnt vmcnt(0)" ::: "memory");
        } else {
            XB_SPIN(xb_ld(&bar[XB_XGEN(b.x)]) == gen, bar);
            __builtin_amdgcn_fence(__ATOMIC_ACQUIRE, "agent");
            asm volatile("s_waitcnt vmcnt(0)" ::: "memory");
        }
    }
    __syncthreads();
}


namespace pg8 {
typedef short bf16x8 __attribute__((ext_vector_type(8)));
constexpr int BM = 256, BK = 64, HALF = 128, HTB = HALF * BK * 2, STAGE_BYTES = 8 * HTB, NXCD = 8, WGM = 8;
__host__ __device__ __forceinline__ int lds_byte(int r, int c) { const int st = (r >> 4) * 2 + (c >> 5), rr = r & 15, cc = c & 31, ob = rr * 64 + cc * 2; return st * 1024 + (ob ^ (((ob >> 9) & 1) << 5)); }
__host__ __device__ __forceinline__ void stage_rc(int b, int& R, int& C) { const int st = b / 1024, sb = b % 1024, swz = sb ^ (((sb >> 9) & 1) << 5); R = (st >> 1) * 16 + swz / 64; C = (st & 1) * 32 + (swz % 64) / 2; }
__host__ __device__ __forceinline__ int perm32(int rho) { const int n = rho >> 4, i = rho & 15; return 8 * (i >> 2) + 4 * n + (i & 3); }
struct Unit { int pm, pn; };
struct Gemm { const bf16_t* A; const bf16_t* Bt; int M, N, K, lda, ldb; };
struct StaticOrder {
    int nM, nN, nwg, G, c;
    __host__ __device__ void init(int M, int N, int G_, int c_) { nM = M / BM; nN = N / BM; nwg = nM * nN; G = G_; c = c_; }
    __host__ __device__ bool next(int i, Unit& u) const {
        const long L = (long)i * G + c; if (L >= nwg) return false;
        int wgid = (int)L; { const int q = nwg / NXCD, r = nwg % NXCD, xcd = wgid % NXCD, off = wgid / NXCD; wgid = (xcd < r ? xcd * (q + 1) : r * (q + 1) + (xcd - r) * q) + off; }
        const int nig = WGM * nN, gid = wgid / nig, fm = gid * WGM, gsz = (nM - fm) < WGM ? (nM - fm) : WGM;
        u.pm = fm + ((wgid % nig) % gsz); u.pn = (wgid % nig) / gsz; return true;
    }
};
__device__ __forceinline__ unsigned cvt_pk_bf16(float lo, float hi) { unsigned r; asm volatile("v_cvt_pk_bf16_f32 %0, %1, %2" : "=v"(r) : "v"(lo), "v"(hi)); return r; }

template <class Epi, class Sched, bool GATHER = false>
__device__ __forceinline__ void gemm_phase(LAS unsigned char* lds, const Gemm g, const Sched& S, const Epi& E, const LAS unsigned* rowtab = nullptr) {
    int tid = threadIdx.x; asm volatile("" : "+v"(tid));
    const int wid = __builtin_amdgcn_readfirstlane(tid >> 6), lane = tid & 63, wr = wid >> 2, wc = wid & 3, fr = lane & 15, fq = lane >> 4;
    int nt = g.K / BK; asm volatile("" : "+s"(nt));
    unsigned vAc[2][2], vAn[2][2], voffB[2]; int RA[2], CA[2];
#pragma unroll
    for (int i = 0; i < 2; ++i) { int R, C; stage_rc(tid * 16 + i * 8192, R, C); const int Rb = Epi::PERM ? ((R & ~31) + perm32(R & 31)) : R; RA[i] = R; CA[i] = C;
        voffB[i] = (unsigned)(Rb * g.ldb + C) * 2u;
#pragma unroll
        for (int h = 0; h < 2; ++h) { vAc[h][i] = GATHER ? rowtab[h * HALF + R] + (unsigned)C * 2u : (unsigned)((h * HALF + R) * g.lda + C) * 2u; vAn[h][i] = vAc[h][i]; } }
    const size_t kstep = (size_t)(BK * 2);
    const size_t hstepB = (size_t)HALF * g.ldb * 2;
    const size_t tstepA = GATHER ? 0 : (size_t)BM * g.lda * 2, tstepB = 2 * hstepB;
    const unsigned ldsw = (unsigned)wid * 1024u;
    const int aoff = lds_byte(wr * 64 + fr, fq * 8), boff = lds_byte(wc * 32 + fr, fq * 8);
#define PG8_SA(b, h) (((b) * 2 + (h)) * HTB)
#define PG8_SB(b, h) ((4 + (b) * 2 + (h)) * HTB)
#define PG8_STAGE(bufoff, gbase, voff) do { _Pragma("unroll") for (int _i = 0; _i < 2; ++_i) \
        __builtin_amdgcn_global_load_lds((const unsigned*)((const char*)(gbase) + (voff)[_i]), (LAS unsigned*)(lds + (bufoff) + ldsw + _i * 8192), 16, 0, 0); } while (0)
#define PG8_LDA(dst, b, h) do { _Pragma("unroll") for (int m = 0; m < 4; ++m) _Pragma("unroll") for (int k = 0; k < 2; ++k) dst[m][k] = *(const LAS bf16x8*)(lds + PG8_SA(b, h) + aoff + m * 2048 + k * 1024); } while (0)
#define PG8_LDB(dst, b, h) do { _Pragma("unroll") for (int n = 0; n < 2; ++n) _Pragma("unroll") for (int k = 0; k < 2; ++k) dst[n][k] = *(const LAS bf16x8*)(lds + PG8_SB(b, h) + boff + n * 2048 + k * 1024); } while (0)
#define PG8_MMA(ai, bj, At, Bt) do { __builtin_amdgcn_s_setprio(1); _Pragma("unroll") for (int m = 0; m < 4; ++m) _Pragma("unroll") for (int n = 0; n < 2; ++n) _Pragma("unroll") for (int k = 0; k < 2; ++k) \
        acc[ai][bj][m][n] = __builtin_amdgcn_mfma_f32_16x16x32_bf16(Bt[n][k], At[m][k], acc[ai][bj][m][n], 0, 0, 0); __builtin_amdgcn_s_setprio(0); } while (0)
#define PG8_WAIT_V(n) asm volatile("s_waitcnt vmcnt(" #n ")" ::: "memory")
#define PG8_WAIT_L(n) asm volatile("s_waitcnt lgkmcnt(" #n ")" ::: "memory")
#define PG8_BAR __builtin_amdgcn_s_barrier()
#define PG8_SCHED __builtin_amdgcn_sched_barrier(0)
    Unit cur, nxt; int ui = 0;
    if (!S.next(0, cur)) return;
    f32x4 acc[2][2][4][2];
#pragma unroll
    for (int a = 0; a < 2; ++a)
#pragma unroll
        for (int b = 0; b < 2; ++b)
#pragma unroll
            for (int m = 0; m < 4; ++m)
#pragma unroll
                for (int n = 0; n < 2; ++n) acc[a][b][m][n] = (f32x4){0.f, 0.f, 0.f, 0.f};
    bf16x8 At[4][2], B0[2][2], B1[2][2];
    const char* cA = (const char*)g.A + (size_t)cur.pm * tstepA; const char* cB = (const char*)g.Bt + (size_t)cur.pn * tstepB;
    PG8_STAGE(PG8_SB(0, 0), cB, voffB); PG8_STAGE(PG8_SB(0, 1), cB + hstepB, voffB); PG8_STAGE(PG8_SA(0, 0), cA, vAc[0]); PG8_STAGE(PG8_SA(0, 1), cA, vAc[1]);
    if (wr == 1) PG8_BAR;
    PG8_WAIT_V(2); PG8_BAR;
    PG8_STAGE(PG8_SB(1, 0), cB + kstep, voffB); PG8_STAGE(PG8_SA(1, 0), cA + kstep, vAc[0]); PG8_STAGE(PG8_SB(1, 1), cB + hstepB + kstep, voffB);
    PG8_WAIT_V(6); PG8_BAR;
    for (;;) {
        const bool has_next = S.next(ui + 1, nxt);
        const char* nA = has_next ? (const char*)g.A + (size_t)nxt.pm * tstepA : cA; const char* nB = has_next ? (const char*)g.Bt + (size_t)nxt.pn * tstepB : cB;
        if (GATHER && has_next) {
#pragma unroll
            for (int i = 0; i < 2; ++i)
#pragma unroll
                for (int h = 0; h < 2; ++h) vAn[h][i] = rowtab[(ui + 1) * BM + h * HALF + RA[i]] + (unsigned)CA[i] * 2u;
        }
        for (int t = 0; t < nt; t += 2) {
            const bool last = (t == nt - 2);
            const char* a1 = cA + (size_t)(t + 1) * kstep;
            const char* a2 = last ? nA : cA + (size_t)(t + 2) * kstep; const char* b2 = last ? nB : cB + (size_t)(t + 2) * kstep;
            const char* a3 = a2 + kstep; const char* b3 = b2 + kstep;
            unsigned v2[2][2];
#pragma unroll
            for (int i = 0; i < 2; ++i)
#pragma unroll
                for (int h = 0; h < 2; ++h) v2[h][i] = (GATHER && last) ? vAn[h][i] : vAc[h][i];
            PG8_LDB(B0, 0, 0); PG8_LDB(B1, 0, 1); PG8_SCHED; PG8_LDA(At, 0, 0); PG8_STAGE(PG8_SA(1, 1), a1, vAc[1]);
            PG8_WAIT_V(8); PG8_WAIT_L(0); PG8_BAR; PG8_MMA(0, 0, At, B0); PG8_MMA(0, 1, At, B1); PG8_BAR; PG8_SCHED;
            PG8_LDA(At, 0, 1); PG8_STAGE(PG8_SB(0, 0), b2, voffB); PG8_STAGE(PG8_SB(0, 1), b2 + hstepB, voffB); PG8_STAGE(PG8_SA(0, 0), a2, v2[0]);
            PG8_WAIT_V(8); PG8_WAIT_L(0); PG8_BAR; PG8_MMA(1, 0, At, B0); PG8_MMA(1, 1, At, B1); PG8_BAR; PG8_SCHED;
            PG8_LDB(B0, 1, 0); PG8_LDB(B1, 1, 1); PG8_SCHED; PG8_LDA(At, 1, 0); PG8_STAGE(PG8_SA(0, 1), a2, v2[1]);
            PG8_WAIT_V(8); PG8_WAIT_L(0); PG8_BAR; PG8_MMA(0, 0, At, B0); PG8_MMA(0, 1, At, B1); PG8_BAR; PG8_SCHED;
            PG8_LDA(At, 1, 1); PG8_STAGE(PG8_SB(1, 0), b3, voffB); PG8_STAGE(PG8_SB(1, 1), b3 + hstepB, voffB); PG8_STAGE(PG8_SA(1, 0), a3, v2[0]);
            PG8_WAIT_V(8); PG8_WAIT_L(0); PG8_BAR; PG8_MMA(1, 0, At, B0); PG8_MMA(1, 1, At, B1); PG8_BAR; PG8_SCHED;
        }
        if (wr == 0) PG8_BAR;
        E(acc, cur, wr, wc, fr, fq);
        if (!has_next) break;
#pragma unroll
        for (int a = 0; a < 2; ++a)
#pragma unroll
            for (int b = 0; b < 2; ++b)
#pragma unroll
                for (int m = 0; m < 4; ++m)
#pragma unroll
                    for (int n = 0; n < 2; ++n) acc[a][b][m][n] = (f32x4){0.f, 0.f, 0.f, 0.f};
        cur = nxt; cA = nA; cB = nB; ++ui;
        if (GATHER) {
#pragma unroll
            for (int i = 0; i < 2; ++i)
#pragma unroll
                for (int h = 0; h < 2; ++h) vAc[h][i] = vAn[h][i];
        }
        if (wr == 1) PG8_BAR;
    }
    PG8_WAIT_V(0);
    PG8_BAR;
#undef PG8_SA
#undef PG8_SB
#undef PG8_STAGE
#undef PG8_LDA
#undef PG8_LDB
#undef PG8_MMA
#undef PG8_WAIT_V
#undef PG8_WAIT_L
#undef PG8_BAR
#undef PG8_SCHED
}
}

typedef f32x4 AccT[2][2][4][2];
__device__ __forceinline__ float sq4(const f32x4 v) { return (v.x * v.x + v.y * v.y) + (v.z * v.z + v.w * v.w); }
__device__ __forceinline__ u32x4 pack8(const f32x4 a, const f32x4 b) { u32x4 w; w.x = pg8::cvt_pk_bf16(a.x, a.y); w.y = pg8::cvt_pk_bf16(a.z, a.w); w.z = pg8::cvt_pk_bf16(b.x, b.y); w.w = pg8::cvt_pk_bf16(b.z, b.w); return w; }
__device__ __forceinline__ u32x2 pack4(const f32x4 a) { u32x2 w; w.x = pg8::cvt_pk_bf16(a.x, a.y); w.y = pg8::cvt_pk_bf16(a.z, a.w); return w; }

struct EpiInProj {
    static constexpr bool PERM = true;
    bf16_t* PROJ; float* DTRAW; float* SSQQ; float* SSQKV;
    __device__ __forceinline__ void operator()(const AccT& acc, const pg8::Unit& u, int wr, int wc, int fr, int fq) const {
        const int row0 = u.pm * 256 + wr * 64 + fr, col0 = u.pn * 256 + wc * 32 + 8 * fq;
#pragma unroll
        for (int ai = 0; ai < 2; ++ai)
#pragma unroll
            for (int m = 0; m < 4; ++m) {
                const int row = row0 + ai * 128 + m * 16;
                bf16_t* rowp = PROJ + (size_t)row * PROJ_N + col0;
#pragma unroll
                for (int bj = 0; bj < 2; ++bj) *(u32x4*)(rowp + bj * 128) = pack8(acc[ai][bj][m][0], acc[ai][bj][m][1]);
                if (u.pn == 0) {
                    float s = (sq4(acc[ai][0][m][0]) + sq4(acc[ai][0][m][1])) + (sq4(acc[ai][1][m][0]) + sq4(acc[ai][1][m][1]));
                    s += __shfl_xor(s, 16); s += __shfl_xor(s, 32);
                    if (fq == 0) SSQQ[row * 4 + wc] = s;
                } else if (u.pn == 1) {
                    float s = sq4(acc[ai][0][m][0]) + sq4(acc[ai][0][m][1]);
                    s += __shfl_xor(s, 16); s += __shfl_xor(s, 32);
                    if (fq == 0) SSQKV[row * 4 + wc] = s;
                    if (wc == 1 && fq < 2) { *(f32x4*)(DTRAW + row * 16 + 8 * fq) = acc[ai][1][m][0]; *(f32x4*)(DTRAW + row * 16 + 8 * fq + 4) = acc[ai][1][m][1]; }
                }
            }
    }
};
struct EpiQUp {
    static constexpr bool PERM = false;
    bf16_t* Q; const float* SSQQ; const float* COS; const float* SIN;
    __device__ __forceinline__ void operator()(const AccT& acc, const pg8::Unit& u, int wr, int wc, int fr, int fq) const {
#pragma unroll
        for (int ai = 0; ai < 2; ++ai)
#pragma unroll
            for (int m = 0; m < 4; ++m) {
                asm volatile("" ::: "memory");
                const int row = u.pm * 256 + ai * 128 + wr * 64 + m * 16 + fr, b = row / S, s = row % S;
                const f32x4 sv = *(const f32x4*)(SSQQ + row * 4);
                const float rs = 1.f / sqrtf(((sv.x + sv.y) + (sv.z + sv.w)) * (1.f / 256.f) + EPS);
                const f32x4 cs = *(const f32x4*)(COS + row * 16 + 4 * fq), sn = *(const f32x4*)(SIN + row * 16 + 4 * fq);
#pragma unroll
                for (int bj = 0; bj < 2; ++bj) {
                    const int g32 = 8 * u.pn + 4 * bj + wc, h = g32 / 3, part = g32 % 3;
                    f32x4 v0 = acc[ai][bj][m][0] * rs, v1 = acc[ai][bj][m][1] * rs;
                    if (part == 2) { const f32x4 o0 = v0 * cs - v1 * sn, o1 = v1 * cs + v0 * sn; v0 = o0; v1 = o1; }
                    bf16_t* qp = Q + ((size_t)(b * NH + h) * S + s) * DQK + part * 32 + 4 * fq;
                    *(u32x2*)qp = pack4(v0); *(u32x2*)(qp + 16) = pack4(v1);
                }
            }
    }
};
struct EpiKVUp {
    static constexpr bool PERM = true;
    bf16_t* Kb; bf16_t* Vb; const float* SSQKV;
    __device__ __forceinline__ void operator()(const AccT& acc, const pg8::Unit& u, int wr, int wc, int fr, int fq) const {
#pragma unroll
        for (int ai = 0; ai < 2; ++ai)
#pragma unroll
            for (int m = 0; m < 4; ++m) {
                asm volatile("" ::: "memory");
                const int row = u.pm * 256 + ai * 128 + wr * 64 + m * 16 + fr, b = row / S, s = row % S;
                const f32x4 sv = *(const f32x4*)(SSQKV + row * 4);
                const float rs = 1.f / sqrtf(((sv.x + sv.y) + (sv.z + sv.w)) * (1.f / 128.f) + EPS);
#pragma unroll
                for (int bj = 0; bj < 2; ++bj) {
                    const int h = 2 * u.pn + bj, d = 32 * wc + 8 * fq;
                    const u32x4 w = pack8(acc[ai][bj][m][0] * rs, acc[ai][bj][m][1] * rs);
                    if (wc < 2) *(u32x4*)(Kb + ((size_t)(b * NH + h) * S + s) * DQK + d) = w;
                    else *(u32x4*)(Vb + ((size_t)(b * NH + h) * S + s) * DV + (d - 64)) = w;
                }
            }
    }
};
struct EpiResid {
    static constexpr bool PERM = false;
    const float* base; float* out;
    __device__ __forceinline__ void operator()(const AccT& acc, const pg8::Unit& u, int wr, int wc, int fr, int fq) const {
#pragma unroll
        for (int ai = 0; ai < 2; ++ai)
#pragma unroll
            for (int m = 0; m < 4; ++m) {
                const size_t ro = (size_t)(u.pm * 256 + ai * 128 + wr * 64 + m * 16 + fr) * D + u.pn * 256 + wc * 32 + 4 * fq;
#pragma unroll
                for (int bj = 0; bj < 2; ++bj)
#pragma unroll
                    for (int n = 0; n < 2; ++n) { const size_t o = ro + bj * 128 + n * 16; *(f32x4*)(out + o) = *(const f32x4*)(base + o) + acc[ai][bj][m][n]; }
            }
    }
};
struct EpiPleProj {
    static constexpr bool PERM = true;
    bf16_t* O; float* SSQ;
    __device__ __forceinline__ void operator()(const AccT& acc, const pg8::Unit& u, int wr, int wc, int fr, int fq) const {
#pragma unroll
        for (int ai = 0; ai < 2; ++ai)
#pragma unroll
            for (int m = 0; m < 4; ++m) {
                const int row = u.pm * 256 + ai * 128 + wr * 64 + m * 16 + fr;
                bf16_t* rowp = O + (size_t)row * D + u.pn * 256 + wc * 32 + 8 * fq;
#pragma unroll
                for (int bj = 0; bj < 2; ++bj) *(u32x4*)(rowp + bj * 128) = pack8(acc[ai][bj][m][0], acc[ai][bj][m][1]);
                float s = (sq4(acc[ai][0][m][0]) + sq4(acc[ai][0][m][1])) + (sq4(acc[ai][1][m][0]) + sq4(acc[ai][1][m][1]));
                s += __shfl_xor(s, 16); s += __shfl_xor(s, 32);
                if (fq == 0) SSQ[row * 16 + u.pn * 4 + wc] = s;
            }
    }
};
struct EpiPleGate {
    static constexpr bool PERM = true;
    float* out; const bf16_t* PR; const float* SSQ; const float* bias; const float* wpost;
    __device__ __forceinline__ void operator()(const AccT& acc, const pg8::Unit& u, int wr, int wc, int fr, int fq) const {
#pragma unroll
        for (int ai = 0; ai < 2; ++ai)
#pragma unroll
            for (int m = 0; m < 4; ++m) {
                const int row = u.pm * 256 + ai * 128 + wr * 64 + m * 16 + fr;
                float ss = 0.f;
#pragma unroll
                for (int q = 0; q < 4; ++q) { const f32x4 sv = *(const f32x4*)(SSQ + row * 16 + 4 * q); ss += (sv.x + sv.y) + (sv.z + sv.w); }
                const float rs = 1.f / sqrtf(ss * (1.f / D) + EPS);
#pragma unroll
                for (int bj = 0; bj < 2; ++bj) {
                    const int col = u.pn * 256 + bj * 128 + wc * 32 + 8 * fq;
                    const u32x4 pr = *(const u32x4*)(PR + (size_t)row * D + col);
                    const unsigned pw[4] = {pr.x, pr.y, pr.z, pr.w};
#pragma unroll
                    for (int n = 0; n < 2; ++n) {
                        const f32x4 bv = *(const f32x4*)(bias + col + 4 * n), wv = *(const f32x4*)(wpost + col + 4 * n);
                        f32x4* op = (f32x4*)(out + (size_t)row * D + col + 4 * n); f32x4 o = *op; const f32x4 av = acc[ai][bj][m][n] + bv;
                        const f32x4 pl = (f32x4){bf2f(pw[2 * n] & 0xffffu), bf2f(pw[2 * n] >> 16), bf2f(pw[2 * n + 1] & 0xffffu), bf2f(pw[2 * n + 1] >> 16)} * rs * wv;
#pragma unroll
                        for (int j = 0; j < 4; ++j) o[j] += pl[j] / (1.f + __expf(-av[j]));
                        *op = o;
                    }
                }
            }
    }
};

struct GroupSched {
    const volatile LAS unsigned* ptile; int npn, G, c;
    __device__ __forceinline__ bool next(int i, pg8::Unit& u) const {
        const int L = i * G + c, total = (int)ptile[32] * npn; if (L >= total) return false;
        int e = 0;
        for (int q = 1; q < 32; ++q) e = (L >= (int)ptile[q] * npn) ? q : e;
        const int l = L - (int)ptile[e] * npn;
        u.pm = __builtin_amdgcn_readfirstlane((int)ptile[e] + l / npn); u.pn = __builtin_amdgcn_readfirstlane(e * npn + l % npn); return true;
    }
};
struct EpiMoeGU {
    static constexpr bool PERM = true;
    bf16_t* HE;
    __device__ __forceinline__ void operator()(const AccT& acc, const pg8::Unit& u, int wr, int wc, int fr, int fq) const {
        const int pn_l = u.pn & 1;
#pragma unroll
        for (int ai = 0; ai < 2; ++ai)
#pragma unroll
            for (int m = 0; m < 4; ++m) {
                const size_t row = (size_t)u.pm * 256 + ai * 128 + wr * 64 + m * 16 + fr;
                f32x4 h0, h1;
#pragma unroll
                for (int j = 0; j < 4; ++j) { const float g0 = acc[ai][0][m][0][j], g1 = acc[ai][0][m][1][j];
                    h0[j] = g0 / (1.f + __expf(-g0)) * acc[ai][1][m][0][j]; h1[j] = g1 / (1.f + __expf(-g1)) * acc[ai][1][m][1][j]; }
                *(u32x4*)(HE + row * 256 + pn_l * 128 + wc * 32 + 8 * fq) = pack8(h0, h1);
            }
    }
};
struct EpiMoeDown {
    static constexpr bool PERM = true;
    bf16_t* Y; const int* BUCKET; const float* ROUTE; const volatile LAS unsigned* ptile; const volatile LAS unsigned* cnt;
    __device__ __forceinline__ void operator()(const AccT& acc, const pg8::Unit& u, int wr, int wc, int fr, int fq) const {
        const int e = u.pn >> 2, pn_l = u.pn & 3, pm_l = u.pm - (int)ptile[e], n_e = (int)cnt[e];
#pragma unroll
        for (int ai = 0; ai < 2; ++ai)
#pragma unroll
            for (int m = 0; m < 4; ++m) {
                const int idx = pm_l * 256 + ai * 128 + wr * 64 + m * 16 + fr;
                if (idx < n_e) {
                    const int ent = BUCKET[(size_t)e * T + idx];
                    const float w = ROUTE[(ent >> 1) * 4 + 2 + (ent & 1)];
                    bf16_t* yp = Y + (size_t)ent * D + pn_l * 256 + wc * 32 + 8 * fq;
#pragma unroll
                    for (int bj = 0; bj < 2; ++bj) *(u32x4*)(yp + bj * 128) = pack8(acc[ai][bj][m][0] * w, acc[ai][bj][m][1] * w);
                }
            }
    }
};

template <class CM, class GN>
__device__ __forceinline__ void transpose_item(const float* W, int ldw, int K, bf16_t* WT, float* scr, int kb, int nb, int lane, CM cm, GN gain) {
    const int k0 = 64 * kb, n0 = 32 * nb;
    const int sc = cm(n0 + (lane & 31));
#pragma unroll 8
    for (int i = 0; i < 32; ++i) { const int kk = 2 * i + (lane >> 5); scr[kk * 33 + (lane & 31)] = sc >= 0 ? W[(size_t)(k0 + kk) * ldw + sc] * gain(k0 + kk) : 0.f; }
    asm volatile("s_waitcnt lgkmcnt(0)" ::: "memory");
    const int c = lane & 7;
#pragma unroll
    for (int j = 0; j < 4; ++j) { const int n = (lane >> 3) + 8 * j; const float* s = scr + (8 * c) * 33 + n;
        u32x4 o; o.x = pk2(s[0 * 33], s[1 * 33]); o.y = pk2(s[2 * 33], s[3 * 33]); o.z = pk2(s[4 * 33], s[5 * 33]); o.w = pk2(s[6 * 33], s[7 * 33]);
        *(u32x4*)(WT + (size_t)(n0 + n) * K + k0 + 8 * c) = o; }
    asm volatile("s_waitcnt lgkmcnt(0)" ::: "memory");
}


namespace att {
typedef short bf16x8 __attribute__((ext_vector_type(8)));
typedef short s16x4 __attribute__((ext_vector_type(4)));
typedef float f32x16 __attribute__((ext_vector_type(16)));
typedef short v4i16_t __attribute__((ext_vector_type(4)));
typedef float f32x2_t __attribute__((ext_vector_type(2))); typedef __bf16 bf16x2_t __attribute__((ext_vector_type(2)));
constexpr int KT = 64, NT = S / KT, KBYTES = KT * DQK * 2, VBYTES = KT * DV * 2, STAGE = KBYTES + VBYTES;
__device__ __forceinline__ unsigned cvtpk(float lo, float hi) { f32x2_t v = {lo, hi}; bf16x2_t b = __builtin_convertvector(v, bf16x2_t); return __builtin_bit_cast(unsigned, b); }
__device__ __forceinline__ s16x4 vtr(const LAS unsigned char* p) { return __builtin_bit_cast(s16x4, __builtin_amdgcn_ds_read_tr16_b64_v4i16((LAS v4i16_t*)p)); }
__device__ __forceinline__ float half_max(float m) { auto rr = __builtin_amdgcn_permlane32_swap(__float_as_uint(m), __float_as_uint(m), false, false); return fmaxf(__uint_as_float(rr[0]), __uint_as_float(rr[1])); }
__device__ __forceinline__ float half_sum(float m) { auto rr = __builtin_amdgcn_permlane32_swap(__float_as_uint(m), __float_as_uint(m), false, false); return __uint_as_float(rr[0]) + __uint_as_float(rr[1]); }

__device__ __forceinline__ void attn_unit(LAS unsigned char* lds, const bf16_t* Qg, const bf16_t* Kg, const bf16_t* Vg, bf16_t* MIXg, int bh, int qb) {
    int tid = threadIdx.x; asm volatile("" : "+v"(tid));
    const int lane = tid & 63, wid = __builtin_amdgcn_readfirstlane(tid >> 6), r32 = lane & 31, hi = lane >> 5;
    const size_t rowbase = (size_t)bh * S;
    const bf16_t* qrow = Qg + (rowbase + qb * 256 + wid * 32 + r32) * DQK + 8 * hi;
    bf16x8 qf[6];
#pragma unroll
    for (int ds = 0; ds < 6; ++ds) qf[ds] = *(const bf16x8*)(qrow + ds * 16);
    const char* ksrc0 = (const char*)(Kg + (rowbase + lane) * DQK + wid * 8);
    const char* ksrc1 = (const char*)(Kg + (rowbase + lane) * DQK + (wid + 8) * 8);
    const int sidx = 2 * wid + (lane >> 5), dvblk = sidx >> 3, kg = sidx & 7;
    const char* vsrc = (const char*)(Vg + (rowbase + kg * 8 + ((lane & 31) >> 2)) * DV + dvblk * 32 + (lane & 3) * 8);
    const unsigned kdst0 = wid * 1024, kdst1 = (wid + 8) * 1024, vdst = KBYTES + wid * 1024;
#define ATT_DMA(t, st) do { \
        __builtin_amdgcn_global_load_lds((const unsigned*)(ksrc0 + (size_t)(t) * (KT * DQK * 2)), (LAS unsigned*)(lds + (st) * STAGE + kdst0), 16, 0, 0); \
        __builtin_amdgcn_global_load_lds((const unsigned*)(vsrc + (size_t)(t) * (KT * DV * 2)), (LAS unsigned*)(lds + (st) * STAGE + vdst), 16, 0, 0); \
        if (wid < 4) __builtin_amdgcn_global_load_lds((const unsigned*)(ksrc1 + (size_t)(t) * (KT * DQK * 2)), (LAS unsigned*)(lds + (st) * STAGE + kdst1), 16, 0, 0); } while (0)
    const int koff = hi * 1024 + r32 * 16;
    const int voff = KBYTES + (4 * hi + ((lane & 15) >> 2)) * 64 + ((lane >> 4) & 1) * 32 + (lane & 3) * 8;
    f32x16 o0 = {}, o1 = {};
    float mrun = -1e30f, lpart = 0.f;
    ATT_DMA(0, 0);
    for (int t = 0; t < NT; ++t) {
        const int st = t & 1;
        if (t + 1 < NT) { ATT_DMA(t + 1, st ^ 1);
            if (wid < 4) asm volatile("s_waitcnt vmcnt(3)" ::: "memory"); else asm volatile("s_waitcnt vmcnt(2)" ::: "memory"); }
        else asm volatile("s_waitcnt vmcnt(0)" ::: "memory");
        __builtin_amdgcn_s_barrier();
        __builtin_amdgcn_sched_barrier(0);
        const LAS unsigned char* sb = lds + st * STAGE;
        f32x16 s0 = {}, s1 = {};
#pragma unroll
        for (int ds = 0; ds < 6; ++ds) {
            const bf16x8 k0 = *(const LAS bf16x8*)(sb + ds * 2048 + koff);
            const bf16x8 k1 = *(const LAS bf16x8*)(sb + ds * 2048 + koff + 512);
            s0 = __builtin_amdgcn_mfma_f32_32x32x16_bf16(k0, qf[ds], s0, 0, 0, 0);
            s1 = __builtin_amdgcn_mfma_f32_32x32x16_bf16(k1, qf[ds], s1, 0, 0, 0);
        }
        float mx = fmaxf(s0[0], s1[0]);
#pragma unroll
        for (int r = 1; r < 16; ++r) mx = fmaxf(mx, fmaxf(s0[r], s1[r]));
        mx = half_max(mx);
        const float mnew = fmaxf(mrun, mx), alpha = __builtin_amdgcn_exp2f(mrun - mnew);
        mrun = mnew;
        float ls = 0.f;
#pragma unroll
        for (int r = 0; r < 16; ++r) { s0[r] = __builtin_amdgcn_exp2f(s0[r] - mnew); s1[r] = __builtin_amdgcn_exp2f(s1[r] - mnew); ls += s0[r] + s1[r]; }
        lpart = lpart * alpha + ls;
#pragma unroll
        for (int r = 0; r < 16; ++r) { o0[r] *= alpha; o1[r] *= alpha; }
        u32x4 pw[4];
#pragma unroll
        for (int s = 0; s < 2; ++s) {
            pw[s] = (u32x4){cvtpk(s0[8 * s], s0[8 * s + 1]), cvtpk(s0[8 * s + 2], s0[8 * s + 3]), cvtpk(s0[8 * s + 4], s0[8 * s + 5]), cvtpk(s0[8 * s + 6], s0[8 * s + 7])};
            pw[2 + s] = (u32x4){cvtpk(s1[8 * s], s1[8 * s + 1]), cvtpk(s1[8 * s + 2], s1[8 * s + 3]), cvtpk(s1[8 * s + 4], s1[8 * s + 5]), cvtpk(s1[8 * s + 6], s1[8 * s + 7])};
        }
#pragma unroll
        for (int ks = 0; ks < 4; ++ks) {
            const bf16x8 pf = __builtin_bit_cast(bf16x8, pw[ks]);
            const s16x4 a0 = vtr(sb + voff + (2 * ks) * 512), a1 = vtr(sb + voff + (2 * ks + 1) * 512);
            const s16x4 b0 = vtr(sb + voff + (8 + 2 * ks) * 512), b1 = vtr(sb + voff + (8 + 2 * ks + 1) * 512);
            const bf16x8 v0 = (bf16x8){a0[0], a0[1], a0[2], a0[3], a1[0], a1[1], a1[2], a1[3]};
            const bf16x8 v1 = (bf16x8){b0[0], b0[1], b0[2], b0[3], b1[0], b1[1], b1[2], b1[3]};
            o0 = __builtin_amdgcn_mfma_f32_32x32x16_bf16(v0, pf, o0, 0, 0, 0);
            o1 = __builtin_amdgcn_mfma_f32_32x32x16_bf16(v1, pf, o1, 0, 0, 0);
        }
        asm volatile("s_waitcnt lgkmcnt(0)" ::: "memory");
        __builtin_amdgcn_s_barrier();
        __builtin_amdgcn_sched_barrier(0);
    }
    const float rl = 1.f / half_sum(lpart);
    const int b = bh >> 3, h = bh & 7;
    bf16_t* orow = MIXg + ((size_t)b * S + qb * 256 + wid * 32 + r32) * D + h * 64 + 4 * hi;
#pragma unroll
    for (int g4 = 0; g4 < 4; ++g4) {
        u32x2 w0, w1;
        w0.x = cvtpk(o0[4 * g4] * rl, o0[4 * g4 + 1] * rl); w0.y = cvtpk(o0[4 * g4 + 2] * rl, o0[4 * g4 + 3] * rl);
        w1.x = cvtpk(o1[4 * g4] * rl, o1[4 * g4 + 1] * rl); w1.y = cvtpk(o1[4 * g4 + 2] * rl, o1[4 * g4 + 3] * rl);
        *(u32x2*)(orow + 8 * g4) = w0; *(u32x2*)(orow + 32 + 8 * g4) = w1;
    }
#undef ATT_DMA
}
}

struct Args { const void* in[31]; float* out; unsigned char* ws; int ph_lo, ph_hi; };
#define IN_F(i) ((const float*)a.in[i])
enum { I_X = 0, I_P, I_POS, I_ATTN_NW, I_WIN, I_QNW, I_WUQ, I_KVNW, I_WUKV, I_AONW, I_CONVW, I_CONVB, I_DTB, I_ALOG, I_SSDD, I_SSDNW, I_WO, I_FFNNW,
       I_WRG, I_BRG, I_WRE, I_BRE, I_WEG, I_WEU, I_WED, I_PLENW, I_WPG, I_BPG, I_WPP, I_PPNW, I_FNW };

template <class FA, class FB, class FE>
__device__ __forceinline__ void naive_gemm(int M, int N, int K, FA fa, FB fb, FE fe, float* sm) {
    const int tid = threadIdx.x, tx = tid & 63, ty = tid >> 6;
    float* As = sm; float* Bs = sm + 64 * 17;
    const int ntm = M / 64, ntn = (N + 63) / 64;
    for (int tile = blockIdx.x; tile < ntm * ntn; tile += gridDim.x) {
        const int tm = tile / ntn, tn = tile % ntn;
        float acc[8];
#pragma unroll
        for (int j = 0; j < 8; ++j) acc[j] = 0.f;
        for (int k0 = 0; k0 < K; k0 += 16) {
            __syncthreads();
            for (int i = tid; i < 1024; i += 512) { const int r = i >> 4, c = i & 15; As[r * 17 + c] = fa(tm * 64 + r, k0 + c); }
            for (int i = tid; i < 1024; i += 512) { const int r = i >> 6, c = i & 63; const int n = tn * 64 + c; Bs[r * 64 + c] = (n < N) ? fb(k0 + r, n) : 0.f; }
            __syncthreads();
#pragma unroll
            for (int k = 0; k < 16; ++k) { const float b = Bs[k * 64 + tx];
#pragma unroll
                for (int j = 0; j < 8; ++j) acc[j] += As[(ty * 8 + j) * 17 + k] * b; }
        }
#pragma unroll
        for (int j = 0; j < 8; ++j) { const int m = tm * 64 + ty * 8 + j, n = tn * 64 + tx; if (n < N) fe(m, n, acc[j]); }
    }
    __syncthreads();
}

__device__ __forceinline__ int proj_src_col(int j) {
    if (j < 416) return j;
    if (j < 432) return 1696 + (j - 416);
    if (j < 512) return -1;
    if (j < 1024) return 416 + (j - 512);
    return 928 + (j - 1024);
}

__device__ __forceinline__ void rms_row_to_bf16(const float* xrow, const float* w, bf16_t* orow, int lane) {
    const f32x4* xr = (const f32x4*)xrow + lane; const f32x4* wr = (const f32x4*)w + lane;
    f32x4 v[4]; float s = 0.f;
#pragma unroll
    for (int j = 0; j < 4; ++j) { v[j] = xr[64 * j]; s += (v[j].x * v[j].x + v[j].y * v[j].y) + (v[j].z * v[j].z + v[j].w * v[j].w); }
    const float rstd = 1.f / sqrtf(wave_sum(s) * (1.f / D) + EPS);
    u32x2* o8 = (u32x2*)orow + lane;
#pragma unroll
    for (int j = 0; j < 4; ++j) { const f32x4 g = wr[64 * j]; u32x2 o; o.x = pk2(v[j].x * rstd * g.x, v[j].y * rstd * g.y); o.y = pk2(v[j].z * rstd * g.z, v[j].w * rstd * g.w); o8[64 * j] = o; }
}

constexpr int LDS_BYTES = 147456;
constexpr int MISC_OFF = 131072;

__global__ void __launch_bounds__(512, 2) fwd(Args a) {
    extern __shared__ __attribute__((aligned(16))) unsigned char lds_raw[];
    float* smf = (float*)lds_raw;
    const int G = gridDim.x, NGW = G * 8, NGT = G * 512;
#define FRESH_IDS() int tid = threadIdx.x; asm volatile("" : "+v"(tid)); const int lane = tid & 63, wave = __builtin_amdgcn_readfirstlane(tid >> 6); \
    const int gw = blockIdx.x * 8 + wave, gtid = blockIdx.x * 512 + tid; (void)lane; (void)gw; (void)gtid;
    unsigned char* ws = a.ws;
    unsigned* ctl = (unsigned*)(ws + WS_CTL);
    volatile LAS unsigned* MISC = (volatile LAS unsigned*)((LAS unsigned char*)lds_raw + MISC_OFF);
    if (threadIdx.x < 32) MISC[threadIdx.x] = 0u;
    __syncthreads();
#if !MK_PER_PHASE
    XcdBarrier bar = xcd_barrier_post(ctl + CW_BAR, MISC + 8);
#define GRID_BAR() xcd_barrier(bar)
#else
#define GRID_BAR() do {} while (0)
#endif
    const int lo = a.ph_lo, hi = a.ph_hi;
#ifndef PHMASK
#define PHMASK 0xFFFF
#endif
#define IN(k) (((PHMASK >> (k)) & 1) && lo <= (k) && (k) < hi)
#define SEAM(k) do { if (IN(k) && IN((k) + 1)) GRID_BAR(); } while (0)

    const float* x = IN_F(I_X);
    float* out = a.out;
    bf16_t* H = (bf16_t*)(ws + WS_H);
    bf16_t* PROJ = (bf16_t*)(ws + WS_PROJ);
    bf16_t* PLERAW = (bf16_t*)(ws + WS_PROJ);
    bf16_t* Qb = (bf16_t*)(ws + WS_Q); bf16_t* Kb = (bf16_t*)(ws + WS_K); bf16_t* Vb = (bf16_t*)(ws + WS_V);
    bf16_t* MIX = (bf16_t*)(ws + WS_MIX);
    bf16_t* XBCC = (bf16_t*)(ws + WS_XBCC);
    float* YSSD = (float*)(ws + WS_H);
    float* COS = (float*)(ws + WS_COS); float* SIN = (float*)(ws + WS_SIN);
    float* DT = (float*)(ws + WS_DT); float* DTRAW = (float*)(ws + WS_DTRAW);
    float* ROUTE = (float*)(ws + WS_ROUTE);
    int* BUCKET = (int*)(ws + WS_BUCKET);
    const int* pos = (const int*)a.in[I_POS];

    bf16_t* WT_IN = (bf16_t*)(ws + WS_WEIGHTS);
    bf16_t* WT_UQ = WT_IN + (size_t)PROJ_N * D;
    bf16_t* WT_UKV = WT_UQ + 768 * 256;
    bf16_t* WT_O = WT_UKV + 1024 * 128;
    bf16_t* WT_PG = WT_O + (size_t)D * D;
    bf16_t* WT_PP = WT_PG + (size_t)D * D;
    bf16_t* WT_GU = WT_PP + (size_t)D * 256;
    bf16_t* WT_DN = WT_GU + (size_t)32 * 512 * 1024;
    bf16_t* PB = (bf16_t*)(ws + WS_PB);
    float* SSQQ = (float*)(ws + WS_SSQQ); float* SSQKV = (float*)(ws + WS_SSQKV); float* SSQPLE = (float*)(ws + WS_SSQPLE);
    LAS unsigned char* ldsb = (LAS unsigned char*)lds_raw;
    float* WR = (float*)(ws + WS_WR);

    if (IN(0)) {
        FRESH_IDS();
        float* scr = smf + wave * 4096;
        constexpr int I_IN = 16 * 56, I_UQ = 4 * 24, I_UKV = 2 * 32, I_O = 16 * 32, I_PG = 16 * 32, I_PP = 4 * 32, I_GU = 32 * 16 * 16, I_DN = 32 * 4 * 32;
        constexpr int NITEMS = I_IN + I_UQ + I_UKV + I_O + I_PG + I_PP + I_GU + I_DN;
        const float* qnw = IN_F(I_QNW); const float* kvnw = IN_F(I_KVNW);
        const float qscale = 0.10206207261596575f * 1.4426950408889634f;
        auto one = [](int) { return 1.f; };
        auto ident = [](int n) { return n; };
        for (int it = gw; it < NITEMS; it += NGW) {
            int r = it;
            if (r < I_IN) { transpose_item(IN_F(I_WIN), IN_COLS, D, WT_IN, scr, r / 56, r % 56, lane, [](int n) { return proj_src_col(n); }, one); continue; } r -= I_IN;
            if (r < I_UQ) { transpose_item(IN_F(I_WUQ), 768, 256, WT_UQ, scr, r / 24, r % 24, lane, ident, [&](int k) { return qnw[k] * qscale; }); continue; } r -= I_UQ;
            if (r < I_UKV) { transpose_item(IN_F(I_WUKV), 1024, 128, WT_UKV, scr, r / 32, r % 32, lane, ident, [&](int k) { return kvnw[k]; }); continue; } r -= I_UKV;
            if (r < I_O) { transpose_item(IN_F(I_WO), D, D, WT_O, scr, r / 32, r % 32, lane, ident, one); continue; } r -= I_O;
            if (r < I_PG) { transpose_item(IN_F(I_WPG), D, D, WT_PG, scr, r / 32, r % 32, lane, ident, one); continue; } r -= I_PG;
            if (r < I_PP) { transpose_item(IN_F(I_WPP), D, 256, WT_PP, scr, r / 32, r % 32, lane, ident, one); continue; } r -= I_PP;
            if (r < I_GU) { const int e = r / 256, q = r % 256, kb = q / 16, nb = q % 16;
                const float* W = ((nb & 7) < 4 ? IN_F(I_WEG) : IN_F(I_WEU)) + (size_t)e * 1024 * 256;
                transpose_item(W, 256, D, WT_GU + (size_t)e * 512 * 1024, scr, kb, nb, lane, [](int n) { return (n >> 8) * 128 + (n & 127); }, one); continue; } r -= I_GU;
            { const int e = r / 128, q = r % 128; transpose_item(IN_F(I_WED) + (size_t)e * 256 * 1024, D, 256, WT_DN + (size_t)e * 1024 * 256, scr, q / 32, q % 32, lane, ident, one); }
        }
        for (int m = gw; m < T; m += NGW) rms_row_to_bf16(x + (size_t)m * D, IN_F(I_ATTN_NW), H + (size_t)m * D, lane);
        { const f32x4* pp = (const f32x4*)IN_F(I_P); u32x2* po = (u32x2*)PB;
          for (int i = gtid; i < T * 256 / 4; i += NGT) { const f32x4 v = pp[i]; u32x2 o; o.x = pk2(v.x, v.y); o.y = pk2(v.z, v.w); po[i] = o; } }
        { const float* wrg = IN_F(I_WRG); const float* wre = IN_F(I_WRE);
          for (int i = gtid; i < 36 * 1024; i += NGT) { const int j = i >> 10, c = i & 1023; WR[i] = j < 4 ? wrg[c * 4 + j] : wre[c * 32 + (j - 4)]; } }
        for (int i = gtid; i < T * 16; i += NGT) {
            const int t = i >> 4, f = i & 15;
            const float inv = 1.0f / powf(10000.0f, (float)(2 * f) / 32.0f);
            const float ang = (float)pos[t] * inv;
            COS[i] = cosf(ang); SIN[i] = sinf(ang);
        }
    }
    SEAM(0);
    if (IN(1)) {
        FRESH_IDS();
        pg8::Gemm g{H, WT_IN, T, PROJ_N, D, D, D}; pg8::StaticOrder So; So.init(T, PROJ_N, G, (int)blockIdx.x);
        EpiInProj E{PROJ, DTRAW, SSQQ, SSQKV};
        pg8::gemm_phase(ldsb, g, So, E);
    }
    SEAM(1);
    if (IN(2)) {
        FRESH_IDS();
        const float* cw = IN_F(I_CONVW); const float* cb = IN_F(I_CONVB);
        for (size_t i = gtid; i < (size_t)T * XBC; i += NGT) {
            const int t = (int)(i / XBC), c = (int)(i % XBC), s = t & (S - 1);
            float acc = cb[c];
#pragma unroll
            for (int k = 0; k < 5; ++k) { const int ss = s + k - 2; if (ss >= 0 && ss < S) acc += cw[k * XBC + c] * bf2f(PROJ[(size_t)(t + k - 2) * PROJ_N + PC_XBC + c]); }
            XBCC[i] = (bf16_t)f2bf(silu_f(acc));
        }
        const float* dtb = IN_F(I_DTB);
        for (int i = gtid; i < T * 16; i += NGT) { const float v = DTRAW[i] + dtb[i & 15]; DT[i] = v > 20.f ? v : log1pf(expf(v)); }
        for (int i = gtid; i < T * 16; i += NGT) {
            const int t = i >> 4, f = i & 15, b = t / S, s = t % S;
            const float c = COS[i], sn = SIN[i];
            const float t1 = bf2f(PROJ[(size_t)t * PROJ_N + PC_KR + f]), t2 = bf2f(PROJ[(size_t)t * PROJ_N + PC_KR + 16 + f]);
            const bf16_t o1 = (bf16_t)f2bf(t1 * c - t2 * sn), o2 = (bf16_t)f2bf(t2 * c + t1 * sn);
            for (int h = 0; h < NH; ++h) { bf16_t* kr = Kb + ((size_t)(b * NH + h) * S + s) * DQK + 64; kr[f] = o1; kr[16 + f] = o2; }
        }
        __syncthreads();
        { pg8::Gemm g{PROJ + PC_CQ, WT_UQ, T, 768, 256, PROJ_N, 256}; pg8::StaticOrder So; So.init(T, 768, G, (int)blockIdx.x);
          EpiQUp E{Qb, SSQQ, COS, SIN}; pg8::gemm_phase(ldsb, g, So, E); }
        { pg8::Gemm g{PROJ + PC_CKV, WT_UKV, T, 1024, 128, PROJ_N, 128}; pg8::StaticOrder So; So.init(T, 1024, G, (int)blockIdx.x);
          EpiKVUp E{Kb, Vb, SSQKV}; pg8::gemm_phase(ldsb, g, So, E); }
    }
    SEAM(2);
    if (IN(3)) {
        FRESH_IDS();
        if (blockIdx.x < 64) {
            const int b = blockIdx.x >> 3, hd = blockIdx.x & 7, g = hd >> 2;
            const int p = tid >> 3, ng = tid & 7;
            float* Xs = smf; float* Bs = smf + 4096; float* Cs = smf + 8192; float* dts = smf + 12288;
            const float* alog = IN_F(I_ALOG);
            for (int dir = 0; dir < 2; ++dir) {
                const float av = -expf(alog[dir * 8 + hd]);
                float hst[8];
#pragma unroll
                for (int j = 0; j < 8; ++j) hst[j] = 0.f;
                for (int tile = 0; tile < S / 64; ++tile) {
                    const int s0 = dir == 0 ? tile * 64 : S - 64 - tile * 64;
                    __syncthreads();
                    for (int i = tid; i < 4096; i += 512) { const int r = i >> 6, c = i & 63; const bf16_t* row = XBCC + (size_t)(b * S + s0 + r) * XBC;
                        Xs[i] = bf2f(row[hd * 64 + c]); Bs[i] = bf2f(row[512 + g * 64 + c]); Cs[i] = bf2f(row[640 + g * 64 + c]); }
                    if (tid < 64) dts[tid] = DT[(size_t)(b * S + s0 + tid) * 16 + dir * 8 + hd];
                    __syncthreads();
                    for (int st = 0; st < 64; ++st) {
                        const int r = dir == 0 ? st : 63 - st;
                        const float dt = dts[r], dA = __expf(dt * av), coef = dt * Xs[r * 64 + p];
                        float part = 0.f;
#pragma unroll
                        for (int j = 0; j < 8; ++j) { hst[j] = hst[j] * dA + coef * Bs[r * 64 + ng * 8 + j]; part += hst[j] * Cs[r * 64 + ng * 8 + j]; }
                        part += __shfl_xor(part, 1); part += __shfl_xor(part, 2); part += __shfl_xor(part, 4);
                        if (ng == 0) { float* yp = YSSD + (size_t)(b * S + s0 + r) * 512 + hd * 64 + p; if (dir == 0) *yp = part; else *yp += part; }
                    }
                }
            }
            __syncthreads();
        }
        {
            const int vcu = (G % 8 == 0) ? ((int)blockIdx.x % 8) * (G / 8) + (int)blockIdx.x / 8 : (int)blockIdx.x;
            for (int u = vcu; u < NB * NH * 16; u += G) att::attn_unit(ldsb, Qb, Kb, Vb, MIX, u >> 4, u & 15);
        }
    }
    SEAM(3);
    if (IN(4)) {
        FRESH_IDS();
        const float* aonw = IN_F(I_AONW); const float* ssdd = IN_F(I_SSDD); const float* ssdnw = IN_F(I_SSDNW);
        for (int m = gw; m < T; m += NGW) {
            bf16_t* mr = MIX + (size_t)m * D;
            float v[8]; float ss = 0.f;
#pragma unroll
            for (int j = 0; j < 8; ++j) { v[j] = bf2f(mr[lane * 8 + j]); ss += v[j] * v[j]; }
            float rstd = 1.f / sqrtf(wave_sum(ss) * (1.f / 512.f) + EPS);
#pragma unroll
            for (int j = 0; j < 8; ++j) mr[lane * 8 + j] = (bf16_t)f2bf(v[j] * rstd * aonw[lane * 8 + j]);
            ss = 0.f;
#pragma unroll
            for (int j = 0; j < 8; ++j) { const int c = lane * 8 + j;
                const float y = YSSD[(size_t)m * 512 + c] + bf2f(XBCC[(size_t)m * XBC + c]) * ssdd[c >> 6];
                const float z = bf2f(PROJ[(size_t)m * PROJ_N + PC_Z + c]);
                v[j] = y * silu_f(z); ss += v[j] * v[j]; }
            rstd = 1.f / sqrtf(wave_sum(ss) * (1.f / 512.f) + EPS);
#pragma unroll
            for (int j = 0; j < 8; ++j) mr[512 + lane * 8 + j] = (bf16_t)f2bf(v[j] * rstd * ssdnw[lane * 8 + j]);
        }
    }
    SEAM(4);
    if (IN(5)) {
        FRESH_IDS();
        pg8::Gemm g{MIX, WT_O, T, D, D, D, D}; pg8::StaticOrder So; So.init(T, D, G, (int)blockIdx.x);
        EpiResid E{x, out}; pg8::gemm_phase(ldsb, g, So, E);
    }
    SEAM(5);
    if (IN(6)) {
        FRESH_IDS();
        const float* fw = IN_F(I_FFNNW); const float* brg = IN_F(I_BRG); const float* bre = IN_F(I_BRE);
        for (int m = gw; m < T; m += NGW) {
            const f32x4* xr = (const f32x4*)(out + (size_t)m * D) + lane; const f32x4* wr = (const f32x4*)fw + lane;
            f32x4 v[4]; float s = 0.f;
#pragma unroll
            for (int j = 0; j < 4; ++j) { v[j] = xr[64 * j]; s += (v[j].x * v[j].x + v[j].y * v[j].y) + (v[j].z * v[j].z + v[j].w * v[j].w); }
            const float rstd = 1.f / sqrtf(wave_sum(s) * (1.f / D) + EPS);
            u32x2* o8 = (u32x2*)(H + (size_t)m * D) + lane;
            f32x4 hn[4];
#pragma unroll
            for (int j = 0; j < 4; ++j) { hn[j] = v[j] * rstd * wr[64 * j]; u32x2 o; o.x = pk2(hn[j].x, hn[j].y); o.y = pk2(hn[j].z, hn[j].w); o8[64 * j] = o; }
            float mylog = 0.f;
#pragma unroll 2
            for (int j = 0; j < 36; ++j) {
                const f32x4* wj = (const f32x4*)(WR + j * 1024) + lane; float pdot = 0.f;
#pragma unroll
                for (int jj = 0; jj < 4; ++jj) { const f32x4 w = wj[64 * jj]; pdot += (hn[jj].x * w.x + hn[jj].y * w.y) + (hn[jj].z * w.z + hn[jj].w * w.w); }
                pdot = wave_sum(pdot);
                mylog = (lane == j) ? pdot : mylog;
            }
            float acc[36];
#pragma unroll
            for (int j = 0; j < 36; ++j) acc[j] = __shfl(mylog, j);
            if (lane == 0) {
                float gl[4]; int gi = 0;
#pragma unroll
                for (int q = 0; q < 4; ++q) gl[q] = acc[q] + brg[q];
                float gmax = gl[0];
#pragma unroll
                for (int q = 1; q < 4; ++q) if (gl[q] > gmax) { gmax = gl[q]; gi = q; }
                float gs = 0.f;
#pragma unroll
                for (int q = 0; q < 4; ++q) gs += expf(gl[q] - gmax);
                const float gwt = 1.f / gs;
                float el[8];
#pragma unroll
                for (int q = 0; q < 8; ++q) { float vv = 0.f;
#pragma unroll
                    for (int g2 = 0; g2 < 4; ++g2) vv = (g2 == gi) ? acc[4 + g2 * 8 + q] + bre[g2 * 8 + q] : vv;
                    el[q] = vv; }
                int i0 = 0; float v0 = el[0];
#pragma unroll
                for (int q = 1; q < 8; ++q) if (el[q] > v0) { v0 = el[q]; i0 = q; }
                int i1 = -1; float v1 = -3.4e38f;
#pragma unroll
                for (int q = 0; q < 8; ++q) if (q != i0 && el[q] > v1) { v1 = el[q]; i1 = q; }
                const float e1 = expf(v1 - v0), w0 = gwt / (1.f + e1), w1 = gwt * e1 / (1.f + e1);
                const int ex0 = gi * 8 + i0, ex1 = gi * 8 + i1;
                ROUTE[m * 4 + 0] = __int_as_float(ex0); ROUTE[m * 4 + 1] = __int_as_float(ex1); ROUTE[m * 4 + 2] = w0; ROUTE[m * 4 + 3] = w1;
                const unsigned p0 = atomicAdd(ctl + CW_ECNT + 64 * ex0, 1u); BUCKET[(size_t)ex0 * T + p0] = m * 2;
                const unsigned p1 = atomicAdd(ctl + CW_ECNT + 64 * ex1, 1u); BUCKET[(size_t)ex1 * T + p1] = m * 2 + 1;
            }
        }
        __syncthreads();
        { pg8::Gemm g{PB, WT_PP, T, D, 256, 256, 256}; pg8::StaticOrder So; So.init(T, D, G, (int)blockIdx.x);
          EpiPleProj E{PLERAW, SSQPLE}; pg8::gemm_phase(ldsb, g, So, E); }
    }
    SEAM(6);
    volatile LAS unsigned* CNT_L = MISC + 64; volatile LAS unsigned* PTILE_L = MISC + 96;
    LAS unsigned* ROWTAB = (LAS unsigned*)(ldsb + MISC_OFF + 1024);
    bf16_t* HE = (bf16_t*)(ws + WS_HE); bf16_t* YPAIR = (bf16_t*)(ws + WS_Q);
    if (IN(7) || IN(8)) {
        if (threadIdx.x == 0) { unsigned acc = 0;
            for (int e2 = 0; e2 < 32; ++e2) { const unsigned c = __hip_atomic_load(ctl + CW_ECNT + 64 * e2, __ATOMIC_RELAXED, __HIP_MEMORY_SCOPE_AGENT); CNT_L[e2] = c; PTILE_L[e2] = acc; acc += (c + 255u) >> 8; }
            PTILE_L[32] = acc; }
        __syncthreads();
    }
    if (IN(7)) {
        FRESH_IDS();
        GroupSched Sg{PTILE_L, 2, G, (int)blockIdx.x};
        { pg8::Unit u;
          for (int i = 0; i < 8 && Sg.next(i, u); ++i) { const int e2 = u.pn >> 1, pm_l = u.pm - (int)PTILE_L[e2];
              if (tid < 256) { const int idx = pm_l * 256 + tid; const int tok = idx < (int)CNT_L[e2] ? (BUCKET[(size_t)e2 * T + idx] >> 1) : 0; ROWTAB[i * 256 + tid] = (unsigned)tok * 2048u; } } }
        __syncthreads();
        pg8::Gemm g{H, WT_GU, T, 32 * 512, D, D, D};
        EpiMoeGU E{HE};
        pg8::gemm_phase<EpiMoeGU, GroupSched, true>(ldsb, g, Sg, E, ROWTAB);
    }
    SEAM(7);
    if (IN(8)) {
        GroupSched Sg{PTILE_L, 4, G, (int)blockIdx.x};
        pg8::Gemm g{HE, WT_DN, 0, 32 * 1024, 256, 256, 256};
        EpiMoeDown E{YPAIR, BUCKET, ROUTE, PTILE_L, CNT_L};
        pg8::gemm_phase(ldsb, g, Sg, E);
    }
    SEAM(8);
    if (IN(9)) {
        FRESH_IDS();
        const f32x4* wr4 = (const f32x4*)IN_F(I_PLENW) + lane;
        for (int m = gw; m < T; m += NGW) {
            f32x4* xr = (f32x4*)(out + (size_t)m * D) + lane;
            const u32x2* y0 = (const u32x2*)(YPAIR + (size_t)(2 * m) * D) + lane; const u32x2* y1 = (const u32x2*)(YPAIR + (size_t)(2 * m + 1) * D) + lane;
            f32x4 v[4]; float s = 0.f;
#pragma unroll
            for (int j = 0; j < 4; ++j) { const u32x2 a0 = y0[64 * j], a1 = y1[64 * j];
                v[j] = xr[64 * j] + (f32x4){bf2f(a0.x & 0xffffu) + bf2f(a1.x & 0xffffu), bf2f(a0.x >> 16) + bf2f(a1.x >> 16), bf2f(a0.y & 0xffffu) + bf2f(a1.y & 0xffffu), bf2f(a0.y >> 16) + bf2f(a1.y >> 16)};
                xr[64 * j] = v[j]; s += (v[j].x * v[j].x + v[j].y * v[j].y) + (v[j].z * v[j].z + v[j].w * v[j].w); }
            const float rstd = 1.f / sqrtf(wave_sum(s) * (1.f / D) + EPS);
            u32x2* o8 = (u32x2*)(H + (size_t)m * D) + lane;
#pragma unroll
            for (int j = 0; j < 4; ++j) { const f32x4 g4 = wr4[64 * j]; u32x2 o; o.x = pk2(v[j].x * rstd * g4.x, v[j].y * rstd * g4.y); o.y = pk2(v[j].z * rstd * g4.z, v[j].w * rstd * g4.w); o8[64 * j] = o; }
        }
    }
    SEAM(9);
    if (IN(10)) {
        pg8::Gemm g{H, WT_PG, T, D, D, D, D}; pg8::StaticOrder So; So.init(T, D, G, (int)blockIdx.x);
        EpiPleGate E{out, PLERAW, SSQPLE, IN_F(I_BPG), IN_F(I_PPNW)}; pg8::gemm_phase(ldsb, g, So, E);
    }
    SEAM(10);
    if (IN(11)) {
        FRESH_IDS();
        const float* fnw = IN_F(I_FNW);
        for (int m = gw; m < T; m += NGW) {
            f32x4* xr = (f32x4*)(out + (size_t)m * D) + lane; const f32x4* wr = (const f32x4*)fnw + lane;
            f32x4 v[4]; float s = 0.f;
#pragma unroll
            for (int j = 0; j < 4; ++j) { v[j] = xr[64 * j]; s += (v[j].x * v[j].x + v[j].y * v[j].y) + (v[j].z * v[j].z + v[j].w * v[j].w); }
            const float rstd = 1.f / sqrtf(wave_sum(s) * (1.f / D) + EPS);
#pragma unroll
            for (int j = 0; j < 4; ++j) xr[64 * j] = v[j] * rstd * wr[64 * j];
        }
    }
#undef IN
#undef SEAM
}

extern "C" void kernel_launch(void* const* d_in, const int* in_sizes, int n_in, void* d_out, int out_size, void* d_ws, size_t ws_size, hipStream_t stream) {
    static int grid = 0;
    if (grid == 0) {
        if (n_in != 31 || out_size != T * D || ws_size < WS_END) { fprintf(stderr, "kernel_launch: unexpected shapes (n_in %d out %d ws %zu)\n", n_in, out_size, ws_size); grid = -1; return; }
        int dev = 0, cus = 0, per_cu = 0;
        if (hipGetDevice(&dev) != hipSuccess || hipDeviceGetAttribute(&cus, hipDeviceAttributeMultiprocessorCount, dev) != hipSuccess) { grid = -1; return; }
        if (hipFuncSetAttribute((const void*)fwd, hipFuncAttributeMaxDynamicSharedMemorySize, LDS_BYTES) != hipSuccess) { fprintf(stderr, "kernel_launch: hipFuncSetAttribute failed\n"); grid = -1; return; }
        if (hipOccupancyMaxActiveBlocksPerMultiprocessor(&per_cu, (const void*)fwd, 512, LDS_BYTES) != hipSuccess || per_cu < 1) { fprintf(stderr, "kernel_launch: occupancy query says %d\n", per_cu); }
        (void)hipGetLastError();
        grid = cus;
    }
    if (grid < 0) return;
    (void)hipMemsetAsync((char*)d_ws + WS_CTL, 0, CTL_ZERO_BYTES, stream);
    Args a{};
    for (int i = 0; i < 31; ++i) a.in[i] = d_in[i];
    a.out = (float*)d_out; a.ws = (unsigned char*)d_ws;
#if MK_PER_PHASE
    for (int p = 0; p < NPHASES; ++p) { a.ph_lo = p; a.ph_hi = p + 1; hipLaunchKernelGGL(fwd, dim3(grid), dim3(512), LDS_BYTES, stream, a); }
#else
    a.ph_lo = 0; a.ph_hi = NPHASES;
    hipLaunchKernelGGL(fwd, dim3(grid), dim3(512), LDS_BYTES, stream, a);
#endif
}
```

```cpp
#include <hip/hip_runtime.h>
#include <cstdio>
#include <cstdint>

#ifndef MK_PER_PHASE
#define MK_PER_PHASE 0
#endif

#define LAS __attribute__((address_space(3)))
#define GAS __attribute__((address_space(1)))
typedef unsigned short bf16_t;
typedef float f32x4 __attribute__((ext_vector_type(4)));
typedef unsigned u32x4 __attribute__((ext_vector_type(4)));
typedef unsigned u32x2 __attribute__((ext_vector_type(2)));

constexpr int NB = 8, S = 4096, T = NB * S, D = 1024;
constexpr int NH = 8, DQK = 96, DV = 64;
constexpr int PROJ_N = 1792, IN_COLS = 1712;
constexpr int PC_CQ = 0, PC_CKV = 256, PC_KR = 384, PC_DT = 416, PC_Z = 512, PC_XBC = 1024;
constexpr int XBC = 768;
constexpr float EPS = 1e-6f;
constexpr int NPHASES = 12;

constexpr size_t MiB = 1u << 20;
constexpr size_t WS_CTL = 0, CTL_ZERO_BYTES = 1 * MiB;
constexpr size_t WS_COS = 1 * MiB, WS_SIN = 3 * MiB, WS_DT = 5 * MiB, WS_ROUTE = 7 * MiB, WS_BUCKET = 8 * MiB;
constexpr size_t WS_SSQQ = 12 * MiB, WS_SSQKV = 12 * MiB + 512 * 1024, WS_DTRAW = 13 * MiB, WS_SSQPLE = 15 * MiB;
constexpr size_t WS_WR = 7 * MiB + 512 * 1024;
constexpr size_t WS_CDEC = 7 * MiB + 768 * 1024;
constexpr size_t WS_WEIGHTS = 18 * MiB;
constexpr size_t WS_H = 80 * MiB;
constexpr size_t WS_PROJ = 144 * MiB;
constexpr size_t WS_HE = 208 * MiB;
constexpr size_t WS_Q = 256 * MiB, WS_K = 304 * MiB, WS_V = 352 * MiB;
constexpr size_t WS_MIX = 384 * MiB;
constexpr size_t WS_XBCC = 448 * MiB;
constexpr size_t WS_PB = 496 * MiB;
constexpr size_t WS_END = 512 * MiB;
constexpr int CW_BAR = 4096, CW_ECNT = 8192;

__device__ __forceinline__ unsigned f2bf(float f) { unsigned u = __builtin_bit_cast(unsigned, f); return (u + 0x7fffu + ((u >> 16) & 1u)) >> 16; }
__device__ __forceinline__ float bf2f(unsigned h) { return __builtin_bit_cast(float, h << 16); }
__device__ __forceinline__ unsigned pk2(float lo, float hi) { return f2bf(lo) | (f2bf(hi) << 16); }
__device__ __forceinline__ float wave_sum(float v) {
#pragma unroll
    for (int o = 1; o < 64; o <<= 1) v += __shfl_xor(v, o);
    return v;
}
__device__ __forceinline__ float silu_f(float v) { return v / (1.f + __expf(-v)); }

#define XB_TMO      128
#define XB_XCNT(j)  (256  + 64 * (j))
#define XB_XSUB(j)  (1280 + 64 * (j))
#define XB_XGEN(j)  (2304 + 64 * (j))
#define XB_TOP      3328
#define XB_TOPGEN   3392
#define XCD_BAR_WORDS 3456
#define XB_SPIN_CAP (1u << 22)

__device__ __forceinline__ unsigned xb_ld(unsigned* p)              { return __hip_atomic_load(p, __ATOMIC_RELAXED, __HIP_MEMORY_SCOPE_AGENT); }
__device__ __forceinline__ unsigned xb_add(unsigned* p, unsigned v) { return __hip_atomic_fetch_add(p, v, __ATOMIC_RELAXED, __HIP_MEMORY_SCOPE_AGENT); }
__device__ __forceinline__ unsigned xb_xcc_id() { return (unsigned)__builtin_amdgcn_s_getreg((3 << 11) | 20) & 0xFu; }
#define XB_SPIN(cond, bar) do { unsigned _sp = 0; while (cond) { __builtin_amdgcn_s_sleep(1); \
    if ((++_sp & 255u) == 0u) { if (xb_ld(&(bar)[XB_TMO])) break; if (_sp > XB_SPIN_CAP) { atomicAdd(&(bar)[XB_TMO], 1u); break; } } } } while (0)

struct XcdBarrier { unsigned* bar; unsigned x; volatile LAS unsigned* st; };
__device__ __forceinline__ XcdBarrier xcd_barrier_post(unsigned* bar, volatile LAS unsigned* st) {
    XcdBarrier b; b.bar = bar; b.x = xb_xcc_id(); b.st = st;
    if (threadIdx.x == 0) (void)xb_add(&bar[XB_XCNT(b.x)], 1u);
    return b;
}
__device__ __forceinline__ void xcd_barrier_complete(unsigned* bar, unsigned x, unsigned& nloc, unsigned& nx) {
    const unsigned G = gridDim.x * gridDim.y * gridDim.z;
    unsigned sum, cnt, mine, sp = 0u;
    for (;;) {
        sum = 0u; cnt = 0u; mine = 0u;
#pragma unroll
        for (unsigned j = 0; j < 16; ++j) { const unsigned c = xb_ld(&bar[XB_XCNT(j)]); sum += c; cnt += (c > 0u) ? 1u : 0u; mine = (j == x) ? c : mine; }
        if (sum == G) break;
        __builtin_amdgcn_s_sleep(1);
        if ((++sp & 255u) == 0u) { if (xb_ld(&bar[XB_TMO])) break; if (sp > XB_SPIN_CAP) { atomicAdd(&bar[XB_TMO], 1u); break; } }
    }
    nloc = mine > 0u ? mine : 1u; nx = cnt > 0u ? cnt : 1u;
}
__device__ __forceinline__ void xcd_barrier(const XcdBarrier& b) {
    asm volatile("s_waitcnt vmcnt(0)" ::: "memory");
    __syncthreads();
    if (threadIdx.x == 0) {
        unsigned* bar = b.bar;
        __builtin_amdgcn_s_waitcnt(0);
        unsigned nloc = b.st[0], nx = b.st[1];
        if (nloc == 0u) { xcd_barrier_complete(bar, b.x, nloc, nx); b.st[0] = nloc; b.st[1] = nx; }
        const unsigned old = xb_add(&bar[XB_XSUB(b.x)], 1u);
        const unsigned gen = old / nloc;
        if (old + 1u == (gen + 1u) * nloc) {
            __builtin_amdgcn_fence(__ATOMIC_RELEASE, "agent");
            asm volatile("s_waitcnt vmcnt(0)" ::: "memory");
            const unsigned og = xb_add(&bar[XB_TOP], 1u);
            const unsigned tg = og / nx;
            if (og + 1u == (tg + 1u) * nx) xb_add(&bar[XB_TOPGEN], 1u);
            else XB_SPIN(xb_ld(&bar[XB_TOPGEN]) == tg, bar);
            __builtin_amdgcn_fence(__ATOMIC_ACQUIRE, "agent");
            xb_add(&bar[XB_XGEN(b.x)], 1u);
            asm volatile("s_waitcnt vmcnt(0)" ::: "memory");
        } else {
            XB_SPIN(xb_ld(&bar[XB_XGEN(b.x)]) == gen, bar);
            __builtin_amdgcn_fence(__ATOMIC_ACQUIRE, "agent");
            asm volatile("s_waitcnt vmcnt(0)" ::: "memory");
        }
    }
    __syncthreads();
}


namespace pg8 {
typedef short bf16x8 __attribute__((ext_vector_type(8)));
constexpr int BM = 256, BK = 64, HALF = 128, HTB = HALF * BK * 2, STAGE_BYTES = 8 * HTB, NXCD = 8, WGM = 8;
__host__ __device__ __forceinline__ int lds_byte(int r, int c) { const int st = (r >> 4) * 2 + (c >> 5), rr = r & 15, cc = c & 31, ob = rr * 64 + cc * 2; return st * 1024 + (ob ^ (((ob >> 9) & 1) << 5)); }
__host__ __device__ __forceinline__ void stage_rc(int b, int& R, int& C) { const int st = b / 1024, sb = b % 1024, swz = sb ^ (((sb >> 9) & 1) << 5); R = (st >> 1) * 16 + swz / 64; C = (st & 1) * 32 + (swz % 64) / 2; }
__host__ __device__ __forceinline__ int perm32(int rho) { const int n = rho >> 4, i = rho & 15; return 8 * (i >> 2) + 4 * n + (i & 3); }
struct Unit { int pm, pn; };
struct Gemm { const bf16_t* A; const bf16_t* Bt; int M, N, K, lda, ldb; };
struct StaticOrder {
    int nM, nN, nwg, G, c;
    __host__ __device__ void init(int M, int N, int G_, int c_) { nM = M / BM; nN = N / BM; nwg = nM * nN; G = G_; c = c_; }
    __host__ __device__ bool next(int i, Unit& u) const {
        const long L = (long)i * G + c; if (L >= nwg) return false;
        int wgid = (int)L; { const int q = nwg / NXCD, r = nwg % NXCD, xcd = wgid % NXCD, off = wgid / NXCD; wgid = (xcd < r ? xcd * (q + 1) : r * (q + 1) + (xcd - r) * q) + off; }
        const int nig = WGM * nN, gid = wgid / nig, fm = gid * WGM, gsz = (nM - fm) < WGM ? (nM - fm) : WGM;
        u.pm = fm + ((wgid % nig) % gsz); u.pn = (wgid % nig) / gsz; return true;
    }
};
__device__ __forceinline__ unsigned cvt_pk_bf16(float lo, float hi) { unsigned r; asm volatile("v_cvt_pk_bf16_f32 %0, %1, %2" : "=v"(r) : "v"(lo), "v"(hi)); return r; }

template <class Epi, class Sched, bool GATHER = false>
__device__ __forceinline__ void gemm_phase(LAS unsigned char* lds, const Gemm g, const Sched& S, const Epi& E, const LAS unsigned* rowtab = nullptr) {
    int tid = threadIdx.x; asm volatile("" : "+v"(tid));
    const int wid = __builtin_amdgcn_readfirstlane(tid >> 6), lane = tid & 63, wr = wid >> 2, wc = wid & 3, fr = lane & 15, fq = lane >> 4;
    int nt = g.K / BK; asm volatile("" : "+s"(nt));
    unsigned vAc[2][2], vAn[2][2], voffB[2]; int RA[2], CA[2];
#pragma unroll
    for (int i = 0; i < 2; ++i) { int R, C; stage_rc(tid * 16 + i * 8192, R, C); const int Rb = Epi::PERM ? ((R & ~31) + perm32(R & 31)) : R; RA[i] = R; CA[i] = C;
        voffB[i] = (unsigned)(Rb * g.ldb + C) * 2u;
#pragma unroll
        for (int h = 0; h < 2; ++h) { vAc[h][i] = GATHER ? rowtab[h * HALF + R] + (unsigned)C * 2u : (unsigned)((h * HALF + R) * g.lda + C) * 2u; vAn[h][i] = vAc[h][i]; } }
    const size_t kstep = (size_t)(BK * 2);
    const size_t hstepB = (size_t)HALF * g.ldb * 2;
    const size_t tstepA = GATHER ? 0 : (size_t)BM * g.lda * 2, tstepB = 2 * hstepB;
    const unsigned ldsw = (unsigned)wid * 1024u;
    const int aoff = lds_byte(wr * 64 + fr, fq * 8), boff = lds_byte(wc * 32 + fr, fq * 8);
#define PG8_SA(b, h) (((b) * 2 + (h)) * HTB)
#define PG8_SB(b, h) ((4 + (b) * 2 + (h)) * HTB)
#define PG8_STAGE(bufoff, gbase, voff) do { _Pragma("unroll") for (int _i = 0; _i < 2; ++_i) \
        __builtin_amdgcn_global_load_lds((const unsigned*)((const char*)(gbase) + (voff)[_i]), (LAS unsigned*)(lds + (bufoff) + ldsw + _i * 8192), 16, 0, 0); } while (0)
#define PG8_LDA(dst, b, h) do { _Pragma("unroll") for (int m = 0; m < 4; ++m) _Pragma("unroll") for (int k = 0; k < 2; ++k) dst[m][k] = *(const LAS bf16x8*)(lds + PG8_SA(b, h) + aoff + m * 2048 + k * 1024); } while (0)
#define PG8_LDB(dst, b, h) do { _Pragma("unroll") for (int n = 0; n < 2; ++n) _Pragma("unroll") for (int k = 0; k < 2; ++k) dst[n][k] = *(const LAS bf16x8*)(lds + PG8_SB(b, h) + boff + n * 2048 + k * 1024); } while (0)
#define PG8_MMA(ai, bj, At, Bt) do { __builtin_amdgcn_s_setprio(1); _Pragma("unroll") for (int m = 0; m < 4; ++m) _Pragma("unroll") for (int n = 0; n < 2; ++n) _Pragma("unroll") for (int k = 0; k < 2; ++k) \
        acc[ai][bj][m][n] = __builtin_amdgcn_mfma_f32_16x16x32_bf16(Bt[n][k], At[m][k], acc[ai][bj][m][n], 0, 0, 0); __builtin_amdgcn_s_setprio(0); } while (0)
#define PG8_WAIT_V(n) asm volatile("s_waitcnt vmcnt(" #n ")" ::: "memory")
#define PG8_WAIT_L(n) asm volatile("s_waitcnt lgkmcnt(" #n ")" ::: "memory")
#define PG8_BAR __builtin_amdgcn_s_barrier()
#define PG8_SCHED __builtin_amdgcn_sched_barrier(0)
    Unit cur, nxt; int ui = 0;
    if (!S.next(0, cur)) return;
    f32x4 acc[2][2][4][2];
#pragma unroll
    for (int a = 0; a < 2; ++a)
#pragma unroll
        for (int b = 0; b < 2; ++b)
#pragma unroll
            for (int m = 0; m < 4; ++m)
#pragma unroll
                for (int n = 0; n < 2; ++n) acc[a][b][m][n] = (f32x4){0.f, 0.f, 0.f, 0.f};
    bf16x8 At[4][2], B0[2][2], B1[2][2];
    const char* cA = (const char*)g.A + (size_t)cur.pm * tstepA; const char* cB = (const char*)g.Bt + (size_t)cur.pn * tstepB;
    PG8_STAGE(PG8_SB(0, 0), cB, voffB); PG8_STAGE(PG8_SB(0, 1), cB + hstepB, voffB); PG8_STAGE(PG8_SA(0, 0), cA, vAc[0]); PG8_STAGE(PG8_SA(0, 1), cA, vAc[1]);
    if (wr == 1) PG8_BAR;
    PG8_WAIT_V(2); PG8_BAR;
    PG8_STAGE(PG8_SB(1, 0), cB + kstep, voffB); PG8_STAGE(PG8_SA(1, 0), cA + kstep, vAc[0]); PG8_STAGE(PG8_SB(1, 1), cB + hstepB + kstep, voffB);
    PG8_WAIT_V(6); PG8_BAR;
    for (;;) {
        const bool has_next = S.next(ui + 1, nxt);
        const char* nA = has_next ? (const char*)g.A + (size_t)nxt.pm * tstepA : cA; const char* nB = has_next ? (const char*)g.Bt + (size_t)nxt.pn * tstepB : cB;
        if (GATHER && has_next) {
#pragma unroll
            for (int i = 0; i < 2; ++i)
#pragma unroll
                for (int h = 0; h < 2; ++h) vAn[h][i] = rowtab[(ui + 1) * BM + h * HALF + RA[i]] + (unsigned)CA[i] * 2u;
        }
        for (int t = 0; t < nt; t += 2) {
            const bool last = (t == nt - 2);
            const char* a1 = cA + (size_t)(t + 1) * kstep;
            const char* a2 = last ? nA : cA + (size_t)(t + 2) * kstep; const char* b2 = last ? nB : cB + (size_t)(t + 2) * kstep;
            const char* a3 = a2 + kstep; const char* b3 = b2 + kstep;
            unsigned v2[2][2];
#pragma unroll
            for (int i = 0; i < 2; ++i)
#pragma unroll
                for (int h = 0; h < 2; ++h) v2[h][i] = (GATHER && last) ? vAn[h][i] : vAc[h][i];
            PG8_LDB(B0, 0, 0); PG8_LDB(B1, 0, 1); PG8_SCHED; PG8_LDA(At, 0, 0); PG8_STAGE(PG8_SA(1, 1), a1, vAc[1]);
            PG8_WAIT_V(8); PG8_WAIT_L(0); PG8_BAR; PG8_MMA(0, 0, At, B0); PG8_MMA(0, 1, At, B1); PG8_BAR; PG8_SCHED;
            PG8_LDA(At, 0, 1); PG8_STAGE(PG8_SB(0, 0), b2, voffB); PG8_STAGE(PG8_SB(0, 1), b2 + hstepB, voffB); PG8_STAGE(PG8_SA(0, 0), a2, v2[0]);
            PG8_WAIT_V(8); PG8_WAIT_L(0); PG8_BAR; PG8_MMA(1, 0, At, B0); PG8_MMA(1, 1, At, B1); PG8_BAR; PG8_SCHED;
            PG8_LDB(B0, 1, 0); PG8_LDB(B1, 1, 1); PG8_SCHED; PG8_LDA(At, 1, 0); PG8_STAGE(PG8_SA(0, 1), a2, v2[1]);
            PG8_WAIT_V(8); PG8_WAIT_L(0); PG8_BAR; PG8_MMA(0, 0, At, B0); PG8_MMA(0, 1, At, B1); PG8_BAR; PG8_SCHED;
            PG8_LDA(At, 1, 1); PG8_STAGE(PG8_SB(1, 0), b3, voffB); PG8_STAGE(PG8_SB(1, 1), b3 + hstepB, voffB); PG8_STAGE(PG8_SA(1, 0), a3, v2[0]);
            PG8_WAIT_V(8); PG8_WAIT_L(0); PG8_BAR; PG8_MMA(1, 0, At, B0); PG8_MMA(1, 1, At, B1); PG8_BAR; PG8_SCHED;
        }
        if (wr == 0) PG8_BAR;
        E(acc, cur, wr, wc, fr, fq);
        if (!has_next) break;
#pragma unroll
        for (int a = 0; a < 2; ++a)
#pragma unroll
            for (int b = 0; b < 2; ++b)
#pragma unroll
                for (int m = 0; m < 4; ++m)
#pragma unroll
                    for (int n = 0; n < 2; ++n) acc[a][b][m][n] = (f32x4){0.f, 0.f, 0.f, 0.f};
        cur = nxt; cA = nA; cB = nB; ++ui;
        if (GATHER) {
#pragma unroll
            for (int i = 0; i < 2; ++i)
#pragma unroll
                for (int h = 0; h < 2; ++h) vAc[h][i] = vAn[h][i];
        }
        if (wr == 1) PG8_BAR;
    }
    PG8_WAIT_V(0);
    PG8_BAR;
#undef PG8_SA
#undef PG8_SB
#undef PG8_STAGE
#undef PG8_LDA
#undef PG8_LDB
#undef PG8_MMA
#undef PG8_WAIT_V
#undef PG8_WAIT_L
#undef PG8_BAR
#undef PG8_SCHED
}
}

typedef f32x4 AccT[2][2][4][2];
__device__ __forceinline__ float sq4(const f32x4 v) { return (v.x * v.x + v.y * v.y) + (v.z * v.z + v.w * v.w); }
__device__ __forceinline__ u32x4 pack8(const f32x4 a, const f32x4 b) { u32x4 w; w.x = pg8::cvt_pk_bf16(a.x, a.y); w.y = pg8::cvt_pk_bf16(a.z, a.w); w.z = pg8::cvt_pk_bf16(b.x, b.y); w.w = pg8::cvt_pk_bf16(b.z, b.w); return w; }
__device__ __forceinline__ u32x2 pack4(const f32x4 a) { u32x2 w; w.x = pg8::cvt_pk_bf16(a.x, a.y); w.y = pg8::cvt_pk_bf16(a.z, a.w); return w; }

struct EpiInProj {
    static constexpr bool PERM = true;
    bf16_t* PROJ; float* DTRAW; float* SSQQ; float* SSQKV;
    __device__ __forceinline__ void operator()(const AccT& acc, const pg8::Unit& u, int wr, int wc, int fr, int fq) const {
        const int row0 = u.pm * 256 + wr * 64 + fr, col0 = u.pn * 256 + wc * 32 + 8 * fq;
#pragma unroll
        for (int ai = 0; ai < 2; ++ai)
#pragma unroll
            for (int m = 0; m < 4; ++m) {
                const int row = row0 + ai * 128 + m * 16;
                bf16_t* rowp = PROJ + (size_t)row * PROJ_N + col0;
#pragma unroll
                for (int bj = 0; bj < 2; ++bj) *(u32x4*)(rowp + bj * 128) = pack8(acc[ai][bj][m][0], acc[ai][bj][m][1]);
                if (u.pn == 0) {
                    float s = (sq4(acc[ai][0][m][0]) + sq4(acc[ai][0][m][1])) + (sq4(acc[ai][1][m][0]) + sq4(acc[ai][1][m][1]));
                    s += __shfl_xor(s, 16); s += __shfl_xor(s, 32);
                    if (fq == 0) SSQQ[row * 4 + wc] = s;
                } else if (u.pn == 1) {
                    float s = sq4(acc[ai][0][m][0]) + sq4(acc[ai][0][m][1]);
                    s += __shfl_xor(s, 16); s += __shfl_xor(s, 32);
                    if (fq == 0) SSQKV[row * 4 + wc] = s;
                    if (wc == 1 && fq < 2) { *(f32x4*)(DTRAW + row * 16 + 8 * fq) = acc[ai][1][m][0]; *(f32x4*)(DTRAW + row * 16 + 8 * fq + 4) = acc[ai][1][m][1]; }
                }
            }
    }
};
struct EpiQUp {
    static constexpr bool PERM = false;
    bf16_t* Q; const float* SSQQ; const float* COS; const float* SIN;
    __device__ __forceinline__ void operator()(const AccT& acc, const pg8::Unit& u, int wr, int wc, int fr, int fq) const {
#pragma unroll
        for (int ai = 0; ai < 2; ++ai)
#pragma unroll
            for (int m = 0; m < 4; ++m) {
                asm volatile("" ::: "memory");
                const int row = u.pm * 256 + ai * 128 + wr * 64 + m * 16 + fr, b = row / S, s = row % S;
                const f32x4 sv = *(const f32x4*)(SSQQ + row * 4);
                const float rs = 1.f / sqrtf(((sv.x + sv.y) + (sv.z + sv.w)) * (1.f / 256.f) + EPS);
                const f32x4 cs = *(const f32x4*)(COS + row * 16 + 4 * fq), sn = *(const f32x4*)(SIN + row * 16 + 4 * fq);
#pragma unroll
                for (int bj = 0; bj < 2; ++bj) {
                    const int g32 = 8 * u.pn + 4 * bj + wc, h = g32 / 3, part = g32 % 3;
                    f32x4 v0 = acc[ai][bj][m][0] * rs, v1 = acc[ai][bj][m][1] * rs;
                    if (part == 2) { const f32x4 o0 = v0 * cs - v1 * sn, o1 = v1 * cs + v0 * sn; v0 = o0; v1 = o1; }
                    bf16_t* qp = Q + ((size_t)(b * NH + h) * S + s) * DQK + part * 32 + 4 * fq;
                    *(u32x2*)qp = pack4(v0); *(u32x2*)(qp + 16) = pack4(v1);
                }
            }
    }
};
struct EpiKVUp {
    static constexpr bool PERM = true;
    bf16_t* Kb; bf16_t* Vb; const float* SSQKV;
    __device__ __forceinline__ void operator()(const AccT& acc, const pg8::Unit& u, int wr, int wc, int fr, int fq) const {
#pragma unroll
        for (int ai = 0; ai < 2; ++ai)
#pragma unroll
            for (int m = 0; m < 4; ++m) {
                asm volatile("" ::: "memory");
                const int row = u.pm * 256 + ai * 128 + wr * 64 + m * 16 + fr, b = row / S, s = row % S;
                const f32x4 sv = *(const f32x4*)(SSQKV + row * 4);
                const float rs = 1.f / sqrtf(((sv.x + sv.y) + (sv.z + sv.w)) * (1.f / 128.f) + EPS);
#pragma unroll
                for (int bj = 0; bj < 2; ++bj) {
                    const int h = 2 * u.pn + bj, d = 32 * wc + 8 * fq;
                    const u32x4 w = pack8(acc[ai][bj][m][0] * rs, acc[ai][bj][m][1] * rs);
                    if (wc < 2) *(u32x4*)(Kb + ((size_t)(b * NH + h) * S + s) * DQK + d) = w;
                    else *(u32x4*)(Vb + ((size_t)(b * NH + h) * S + s) * DV + (d - 64)) = w;
                }
            }
    }
};
struct EpiResid {
    static constexpr bool PERM = false;
    const float* base; float* out;
    __device__ __forceinline__ void operator()(const AccT& acc, const pg8::Unit& u, int wr, int wc, int fr, int fq) const {
#pragma unroll
        for (int ai = 0; ai < 2; ++ai)
#pragma unroll
            for (int m = 0; m < 4; ++m) {
                const size_t ro = (size_t)(u.pm * 256 + ai * 128 + wr * 64 + m * 16 + fr) * D + u.pn * 256 + wc * 32 + 4 * fq;
#pragma unroll
                for (int bj = 0; bj < 2; ++bj)
#pragma unroll
                    for (int n = 0; n < 2; ++n) { const size_t o = ro + bj * 128 + n * 16; *(f32x4*)(out + o) = *(const f32x4*)(base + o) + acc[ai][bj][m][n]; }
            }
    }
};
struct EpiPleProj {
    static constexpr bool PERM = true;
    bf16_t* O; float* SSQ;
    __device__ __forceinline__ void operator()(const AccT& acc, const pg8::Unit& u, int wr, int wc, int fr, int fq) const {
#pragma unroll
        for (int ai = 0; ai < 2; ++ai)
#pragma unroll
            for (int m = 0; m < 4; ++m) {
                const int row = u.pm * 256 + ai * 128 + wr * 64 + m * 16 + fr;
                bf16_t* rowp = O + (size_t)row * D + u.pn * 256 + wc * 32 + 8 * fq;
#pragma unroll
                for (int bj = 0; bj < 2; ++bj) *(u32x4*)(rowp + bj * 128) = pack8(acc[ai][bj][m][0], acc[ai][bj][m][1]);
                float s = (sq4(acc[ai][0][m][0]) + sq4(acc[ai][0][m][1])) + (sq4(acc[ai][1][m][0]) + sq4(acc[ai][1][m][1]));
                s += __shfl_xor(s, 16); s += __shfl_xor(s, 32);
                if (fq == 0) SSQ[row * 16 + u.pn * 4 + wc] = s;
            }
    }
};
struct EpiPleGate {
    static constexpr bool PERM = true;
    float* out; const bf16_t* PR; const float* SSQ; const float* bias; const float* wpost;
    __device__ __forceinline__ void operator()(const AccT& acc, const pg8::Unit& u, int wr, int wc, int fr, int fq) const {
#pragma unroll
        for (int ai = 0; ai < 2; ++ai)
#pragma unroll
            for (int m = 0; m < 4; ++m) {
                const int row = u.pm * 256 + ai * 128 + wr * 64 + m * 16 + fr;
                float ss = 0.f;
#pragma unroll
                for (int q = 0; q < 4; ++q) { const f32x4 sv = *(const f32x4*)(SSQ + row * 16 + 4 * q); ss += (sv.x + sv.y) + (sv.z + sv.w); }
                const float rs = 1.f / sqrtf(ss * (1.f / D) + EPS);
#pragma unroll
                for (int bj = 0; bj < 2; ++bj) {
                    const int col = u.pn * 256 + bj * 128 + wc * 32 + 8 * fq;
                    const u32x4 pr = *(const u32x4*)(PR + (size_t)row * D + col);
                    const unsigned pw[4] = {pr.x, pr.y, pr.z, pr.w};
#pragma unroll
                    for (int n = 0; n < 2; ++n) {
                        const f32x4 bv = *(const f32x4*)(bias + col + 4 * n), wv = *(const f32x4*)(wpost + col + 4 * n);
                        f32x4* op = (f32x4*)(out + (size_t)row * D + col + 4 * n); f32x4 o = *op; const f32x4 av = acc[ai][bj][m][n] + bv;
                        const f32x4 pl = (f32x4){bf2f(pw[2 * n] & 0xffffu), bf2f(pw[2 * n] >> 16), bf2f(pw[2 * n + 1] & 0xffffu), bf2f(pw[2 * n + 1] >> 16)} * rs * wv;
#pragma unroll
                        for (int j = 0; j < 4; ++j) o[j] += pl[j] / (1.f + __expf(-av[j]));
                        *op = o;
                    }
                }
            }
    }
};

struct GroupSched {
    const volatile LAS unsigned* ptile; int npn, G, c;
    __device__ __forceinline__ bool next(int i, pg8::Unit& u) const {
        const int L = i * G + c, total = (int)ptile[32] * npn; if (L >= total) return false;
        int e = 0;
        for (int q = 1; q < 32; ++q) e = (L >= (int)ptile[q] * npn) ? q : e;
        const int l = L - (int)ptile[e] * npn;
        u.pm = __builtin_amdgcn_readfirstlane((int)ptile[e] + l / npn); u.pn = __builtin_amdgcn_readfirstlane(e * npn + l % npn); return true;
    }
};
struct EpiMoeGU {
    static constexpr bool PERM = true;
    bf16_t* HE;
    __device__ __forceinline__ void operator()(const AccT& acc, const pg8::Unit& u, int wr, int wc, int fr, int fq) const {
        const int pn_l = u.pn & 1;
#pragma unroll
        for (int ai = 0; ai < 2; ++ai)
#pragma unroll
            for (int m = 0; m < 4; ++m) {
                const size_t row = (size_t)u.pm * 256 + ai * 128 + wr * 64 + m * 16 + fr;
                f32x4 h0, h1;
#pragma unroll
                for (int j = 0; j < 4; ++j) { const float g0 = acc[ai][0][m][0][j], g1 = acc[ai][0][m][1][j];
                    h0[j] = g0 / (1.f + __expf(-g0)) * acc[ai][1][m][0][j]; h1[j] = g1 / (1.f + __expf(-g1)) * acc[ai][1][m][1][j]; }
                *(u32x4*)(HE + row * 256 + pn_l * 128 + wc * 32 + 8 * fq) = pack8(h0, h1);
            }
    }
};
struct EpiMoeDown {
    static constexpr bool PERM = true;
    bf16_t* Y; const int* BUCKET; const float* ROUTE; const volatile LAS unsigned* ptile; const volatile LAS unsigned* cnt;
    __device__ __forceinline__ void operator()(const AccT& acc, const pg8::Unit& u, int wr, int wc, int fr, int fq) const {
        const int e = u.pn >> 2, pn_l = u.pn & 3, pm_l = u.pm - (int)ptile[e], n_e = (int)cnt[e];
#pragma unroll
        for (int ai = 0; ai < 2; ++ai)
#pragma unroll
            for (int m = 0; m < 4; ++m) {
                const int idx = pm_l * 256 + ai * 128 + wr * 64 + m * 16 + fr;
                if (idx < n_e) {
                    const int ent = BUCKET[(size_t)e * T + idx];
                    const float w = ROUTE[(ent >> 1) * 4 + 2 + (ent & 1)];
                    bf16_t* yp = Y + (size_t)ent * D + pn_l * 256 + wc * 32 + 8 * fq;
#pragma unroll
                    for (int bj = 0; bj < 2; ++bj) *(u32x4*)(yp + bj * 128) = pack8(acc[ai][bj][m][0] * w, acc[ai][bj][m][1] * w);
                }
            }
    }
};

template <class CM, class GN>
__device__ __forceinline__ void transpose_item(const float* W, int ldw, int K, bf16_t* WT, float* scr, int kb, int nb, int lane, CM cm, GN gain) {
    const int k0 = 64 * kb, n0 = 32 * nb;
    const int sc = cm(n0 + (lane & 31));
#pragma unroll 8
    for (int i = 0; i < 32; ++i) { const int kk = 2 * i + (lane >> 5); scr[kk * 33 + (lane & 31)] = sc >= 0 ? W[(size_t)(k0 + kk) * ldw + sc] * gain(k0 + kk) : 0.f; }
    asm volatile("s_waitcnt lgkmcnt(0)" ::: "memory");
    const int c = lane & 7;
#pragma unroll
    for (int j = 0; j < 4; ++j) { const int n = (lane >> 3) + 8 * j; const float* s = scr + (8 * c) * 33 + n;
        u32x4 o; o.x = pk2(s[0 * 33], s[1 * 33]); o.y = pk2(s[2 * 33], s[3 * 33]); o.z = pk2(s[4 * 33], s[5 * 33]); o.w = pk2(s[6 * 33], s[7 * 33]);
        *(u32x4*)(WT + (size_t)(n0 + n) * K + k0 + 8 * c) = o; }
    asm volatile("s_waitcnt lgkmcnt(0)" ::: "memory");
}


namespace att {
typedef short bf16x8 __attribute__((ext_vector_type(8)));
typedef short s16x4 __attribute__((ext_vector_type(4)));
typedef float f32x16 __attribute__((ext_vector_type(16)));
typedef short v4i16_t __attribute__((ext_vector_type(4)));
typedef float f32x2_t __attribute__((ext_vector_type(2))); typedef __bf16 bf16x2_t __attribute__((ext_vector_type(2)));
constexpr int KT = 64, NT = S / KT, KBYTES = KT * DQK * 2, VBYTES = KT * DV * 2, STAGE = KBYTES + VBYTES;
__device__ __forceinline__ unsigned cvtpk(float lo, float hi) { f32x2_t v = {lo, hi}; bf16x2_t b = __builtin_convertvector(v, bf16x2_t); return __builtin_bit_cast(unsigned, b); }
__device__ __forceinline__ s16x4 vtr(const LAS unsigned char* p) { return __builtin_bit_cast(s16x4, __builtin_amdgcn_ds_read_tr16_b64_v4i16((LAS v4i16_t*)p)); }
__device__ __forceinline__ float half_max(float m) { auto rr = __builtin_amdgcn_permlane32_swap(__float_as_uint(m), __float_as_uint(m), false, false); return fmaxf(__uint_as_float(rr[0]), __uint_as_float(rr[1])); }
__device__ __forceinline__ float half_sum(float m) { auto rr = __builtin_amdgcn_permlane32_swap(__float_as_uint(m), __float_as_uint(m), false, false); return __uint_as_float(rr[0]) + __uint_as_float(rr[1]); }

__device__ __forceinline__ void attn_unit(LAS unsigned char* lds, const bf16_t* Qg, const bf16_t* Kg, const bf16_t* Vg, bf16_t* MIXg, int bh, int qb) {
    int tid = threadIdx.x; asm volatile("" : "+v"(tid));
    const int lane = tid & 63, wid = __builtin_amdgcn_readfirstlane(tid >> 6), r32 = lane & 31, hi = lane >> 5;
    const size_t rowbase = (size_t)bh * S;
    const bf16_t* qrow = Qg + (rowbase + qb * 256 + wid * 32 + r32) * DQK + 8 * hi;
    bf16x8 qf[6];
#pragma unroll
    for (int ds = 0; ds < 6; ++ds) qf[ds] = *(const bf16x8*)(qrow + ds * 16);
    const char* ksrc0 = (const char*)(Kg + (rowbase + lane) * DQK + wid * 8);
    const char* ksrc1 = (const char*)(Kg + (rowbase + lane) * DQK + (wid + 8) * 8);
    const int sidx = 2 * wid + (lane >> 5), dvblk = sidx >> 3, kg = sidx & 7;
    const char* vsrc = (const char*)(Vg + (rowbase + kg * 8 + ((lane & 31) >> 2)) * DV + dvblk * 32 + (lane & 3) * 8);
    const unsigned kdst0 = wid * 1024, kdst1 = (wid + 8) * 1024, vdst = KBYTES + wid * 1024;
#define ATT_DMA(t, st) do { \
        __builtin_amdgcn_global_load_lds((const unsigned*)(ksrc0 + (size_t)(t) * (KT * DQK * 2)), (LAS unsigned*)(lds + (st) * STAGE + kdst0), 16, 0, 0); \
        __builtin_amdgcn_global_load_lds((const unsigned*)(vsrc + (size_t)(t) * (KT * DV * 2)), (LAS unsigned*)(lds + (st) * STAGE + vdst), 16, 0, 0); \
        if (wid < 4) __builtin_amdgcn_global_load_lds((const unsigned*)(ksrc1 + (size_t)(t) * (KT * DQK * 2)), (LAS unsigned*)(lds + (st) * STAGE + kdst1), 16, 0, 0); } while (0)
    const int koff = hi * 1024 + r32 * 16;
    const int voff = KBYTES + (4 * hi + ((lane & 15) >> 2)) * 64 + ((lane >> 4) & 1) * 32 + (lane & 3) * 8;
    f32x16 o0 = {}, o1 = {};
    float mrun = -1e30f, lpart = 0.f;
    ATT_DMA(0, 0);
    for (int t = 0; t < NT; ++t) {
        const int st = t & 1;
        if (t + 1 < NT) { ATT_DMA(t + 1, st ^ 1);
            if (wid < 4) asm volatile("s_waitcnt vmcnt(3)" ::: "memory"); else asm volatile("s_waitcnt vmcnt(2)" ::: "memory"); }
        else asm volatile("s_waitcnt vmcnt(0)" ::: "memory");
        __builtin_amdgcn_s_barrier();
        __builtin_amdgcn_sched_barrier(0);
        const LAS unsigned char* sb = lds + st * STAGE;
        f32x16 s0 = {}, s1 = {};
#pragma unroll
        for (int ds = 0; ds < 6; ++ds) {
            const bf16x8 k0 = *(const LAS bf16x8*)(sb + ds * 2048 + koff);
            const bf16x8 k1 = *(const LAS bf16x8*)(sb + ds * 2048 + koff + 512);
            s0 = __builtin_amdgcn_mfma_f32_32x32x16_bf16(k0, qf[ds], s0, 0, 0, 0);
            s1 = __builtin_amdgcn_mfma_f32_32x32x16_bf16(k1, qf[ds], s1, 0, 0, 0);
        }
        float mx = fmaxf(s0[0], s1[0]);
#pragma unroll
        for (int r = 1; r < 16; ++r) mx = fmaxf(mx, fmaxf(s0[r], s1[r]));
        mx = half_max(mx);
        const float mnew = fmaxf(mrun, mx), alpha = __builtin_amdgcn_exp2f(mrun - mnew);
        mrun = mnew;
        float ls = 0.f;
#pragma unroll
        for (int r = 0; r < 16; ++r) { s0[r] = __builtin_amdgcn_exp2f(s0[r] - mnew); s1[r] = __builtin_amdgcn_exp2f(s1[r] - mnew); ls += s0[r] + s1[r]; }
        lpart = lpart * alpha + ls;
#pragma unroll
        for (int r = 0; r < 16; ++r) { o0[r] *= alpha; o1[r] *= alpha; }
        u32x4 pw[4];
#pragma unroll
        for (int s = 0; s < 2; ++s) {
            pw[s] = (u32x4){cvtpk(s0[8 * s], s0[8 * s + 1]), cvtpk(s0[8 * s + 2], s0[8 * s + 3]), cvtpk(s0[8 * s + 4], s0[8 * s + 5]), cvtpk(s0[8 * s + 6], s0[8 * s + 7])};
            pw[2 + s] = (u32x4){cvtpk(s1[8 * s], s1[8 * s + 1]), cvtpk(s1[8 * s + 2], s1[8 * s + 3]), cvtpk(s1[8 * s + 4], s1[8 * s + 5]), cvtpk(s1[8 * s + 6], s1[8 * s + 7])};
        }
#pragma unroll
        for (int ks = 0; ks < 4; ++ks) {
            const bf16x8 pf = __builtin_bit_cast(bf16x8, pw[ks]);
            const s16x4 a0 = vtr(sb + voff + (2 * ks) * 512), a1 = vtr(sb + voff + (2 * ks + 1) * 512);
            const s16x4 b0 = vtr(sb + voff + (8 + 2 * ks) * 512), b1 = vtr(sb + voff + (8 + 2 * ks + 1) * 512);
            const bf16x8 v0 = (bf16x8){a0[0], a0[1], a0[2], a0[3], a1[0], a1[1], a1[2], a1[3]};
            const bf16x8 v1 = (bf16x8){b0[0], b0[1], b0[2], b0[3], b1[0], b1[1], b1[2], b1[3]};
            o0 = __builtin_amdgcn_mfma_f32_32x32x16_bf16(v0, pf, o0, 0, 0, 0);
            o1 = __builtin_amdgcn_mfma_f32_32x32x16_bf16(v1, pf, o1, 0, 0, 0);
        }
        asm volatile("s_waitcnt lgkmcnt(0)" ::: "memory");
        __builtin_amdgcn_s_barrier();
        __builtin_amdgcn_sched_barrier(0);
    }
    const float rl = 1.f / half_sum(lpart);
    const int b = bh >> 3, h = bh & 7;
    bf16_t* orow = MIXg + ((size_t)b * S + qb * 256 + wid * 32 + r32) * D + h * 64 + 4 * hi;
#pragma unroll
    for (int g4 = 0; g4 < 4; ++g4) {
        u32x2 w0, w1;
        w0.x = cvtpk(o0[4 * g4] * rl, o0[4 * g4 + 1] * rl); w0.y = cvtpk(o0[4 * g4 + 2] * rl, o0[4 * g4 + 3] * rl);
        w1.x = cvtpk(o1[4 * g4] * rl, o1[4 * g4 + 1] * rl); w1.y = cvtpk(o1[4 * g4 + 2] * rl, o1[4 * g4 + 3] * rl);
        *(u32x2*)(orow + 8 * g4) = w0; *(u32x2*)(orow + 32 + 8 * g4) = w1;
    }
#undef ATT_DMA
}
}


namespace ssd {
typedef short bf16x8 __attribute__((ext_vector_type(8)));
typedef short bf16x4 __attribute__((ext_vector_type(4)));
typedef float f32x16 __attribute__((ext_vector_type(16)));
constexpr int CH = 128, NCH = S / CH;
constexpr float LOG2E = 1.4426950408889634f;
__device__ __forceinline__ int crow(int r, int hi) { return (r & 3) + 8 * (r >> 2) + 4 * hi; }
__device__ __forceinline__ unsigned cvtpk(float lo, float hi) { return att::cvtpk(lo, hi); }
__device__ __forceinline__ void scan128(float a0, float a1, int lane, float& p0, float& p1, float& tot) {
    float s = a0 + a1;
#pragma unroll
    for (int o = 1; o < 64; o <<= 1) { const float t = __shfl_up(s, o); if (lane >= o) s += t; }
    tot = __shfl(s, 63); p1 = s; p0 = s - a1;
}
__device__ __forceinline__ void conv_chunk(float* smf, const bf16_t* PROJ, const float* cw, const float* cb, bf16_t* XBCC, bf16_t* XT, bf16_t* BT,
                                           const float* DTRAW, const float* dtb, float* DT, int b, int c) {
    int tid = threadIdx.x; asm volatile("" : "+v"(tid));
    const int t0 = b * S + c * CH, s0 = c * CH;
    if (tid < 2048 / 4) {
        const f32x4 raw = *(const f32x4*)(DTRAW + (size_t)t0 * 16 + tid * 4); const f32x4 bb = *(const f32x4*)(dtb + ((tid * 4) & 15)); f32x4 o;
#pragma unroll
        for (int j = 0; j < 4; ++j) { const float v = raw[j] + bb[j]; o[j] = v > 20.f ? v : log1pf(expf(v)); }
        *(f32x4*)(DT + (size_t)t0 * 16 + tid * 4) = o;
    }
    const int ch = tid & 127, lq = tid >> 7;
    for (int cbk = 0; cbk < 6; ++cbk) {
        __syncthreads();
        for (int i = tid; i < 132 * 16; i += 512) {
            const int r = i >> 4, c8 = (i & 15) * 8, ss = s0 - 2 + r;
            u32x4 v = (u32x4){0u, 0u, 0u, 0u};
            if (ss >= 0 && ss < S) v = *(const u32x4*)(PROJ + (size_t)(b * S + ss) * PROJ_N + PC_XBC + cbk * 128 + c8);
            float* d = smf + r * 128 + c8;
            d[0] = bf2f(v.x & 0xffffu); d[1] = bf2f(v.x >> 16); d[2] = bf2f(v.y & 0xffffu); d[3] = bf2f(v.y >> 16);
            d[4] = bf2f(v.z & 0xffffu); d[5] = bf2f(v.z >> 16); d[6] = bf2f(v.w & 0xffffu); d[7] = bf2f(v.w >> 16);
        }
        __syncthreads();
        const int gch = cbk * 128 + ch;
        float w[5];
#pragma unroll
        for (int k = 0; k < 5; ++k) w[k] = cw[k * XBC + gch];
        const float bias = cb[gch];
        unsigned pk[16];
        float x0 = smf[(lq * 32 + 0) * 128 + ch], x1 = smf[(lq * 32 + 1) * 128 + ch], x2 = smf[(lq * 32 + 2) * 128 + ch], x3 = smf[(lq * 32 + 3) * 128 + ch];
        float prev = 0.f;
#pragma unroll
        for (int l = 0; l < 32; ++l) {
            const float x4 = smf[(lq * 32 + l + 4) * 128 + ch];
            const float acc = bias + w[0] * x0 + w[1] * x1 + w[2] * x2 + w[3] * x3 + w[4] * x4;
            const float v = acc / (1.f + __expf(-acc));
            XBCC[(size_t)(t0 + lq * 32 + l) * XBC + gch] = (bf16_t)f2bf(v);
            if (l & 1) pk[l >> 1] = pk2(prev, v); else prev = v;
            x0 = x1; x1 = x2; x2 = x3; x3 = x4;
        }
        if (cbk < 5) {
            bf16_t* dst = cbk < 4 ? XT + ((size_t)(b * NCH + c) * 512 + gch) * CH + lq * 32 : BT + ((size_t)(b * NCH + c) * 128 + ch) * CH + lq * 32;
#pragma unroll
            for (int q = 0; q < 4; ++q) *(u32x4*)(dst + q * 8) = (u32x4){pk[4 * q], pk[4 * q + 1], pk[4 * q + 2], pk[4 * q + 3]};
        }
    }
    __syncthreads();
}
__device__ __forceinline__ void states_chunk(float* wtab_all, const bf16_t* XT, const bf16_t* BT, const float* DT, const float* alog, float* STATES, float* CDEC, int b, int c) {
    int tid = threadIdx.x; asm volatile("" : "+v"(tid));
    const int lane = tid & 63, hd = __builtin_amdgcn_readfirstlane(tid >> 6), g = hd >> 2, r32 = lane & 31, hi = lane >> 5;
    float* wtab = wtab_all + hd * 128;
    const size_t t0 = (size_t)b * S + c * CH;
    const bf16_t* xt = XT + ((size_t)(b * NCH + c) * 512 + hd * 64) * CH; const bf16_t* bt = BT + ((size_t)(b * NCH + c) * 128 + g * 64) * CH;
    for (int dir = 0; dir < 2; ++dir) {
        const float av = -expf(alog[dir * 8 + hd]);
        const float d0 = DT[(t0 + 2 * lane) * 16 + dir * 8 + hd], d1 = DT[(t0 + 2 * lane + 1) * 16 + dir * 8 + hd];
        float p0, p1, tot; scan128(d0 * av, d1 * av, lane, p0, p1, tot);
        const float w0 = dir == 0 ? __expf(tot - p0) * d0 : __expf(p0 - d0 * av) * d0;
        const float w1 = dir == 0 ? __expf(tot - p1) * d1 : __expf(p1 - d1 * av) * d1;
        wtab[2 * lane] = w0; wtab[2 * lane + 1] = w1;
        if (lane == 0) CDEC[((b * NCH + c) * 2 + dir) * 8 + hd] = __expf(tot);
        asm volatile("s_waitcnt lgkmcnt(0)" ::: "memory");
        f32x16 acc[2][2];
#pragma unroll
        for (int i = 0; i < 2; ++i)
#pragma unroll
            for (int j = 0; j < 2; ++j) acc[i][j] = (f32x16){};
#pragma unroll 2
        for (int ks = 0; ks < 8; ++ks) {
            const f32x4 wa = *(const f32x4*)(wtab + 16 * ks + 8 * hi), wb = *(const f32x4*)(wtab + 16 * ks + 8 * hi + 4);
            bf16x8 xb[2], bb[2];
#pragma unroll
            for (int pb = 0; pb < 2; ++pb) {
                const u32x4 v = *(const u32x4*)(xt + (size_t)(32 * pb + r32) * CH + 16 * ks + 8 * hi);
                u32x4 o; o.x = cvtpk(bf2f(v.x & 0xffffu) * wa.x, bf2f(v.x >> 16) * wa.y); o.y = cvtpk(bf2f(v.y & 0xffffu) * wa.z, bf2f(v.y >> 16) * wa.w);
                o.z = cvtpk(bf2f(v.z & 0xffffu) * wb.x, bf2f(v.z >> 16) * wb.y); o.w = cvtpk(bf2f(v.w & 0xffffu) * wb.z, bf2f(v.w >> 16) * wb.w);
                xb[pb] = __builtin_bit_cast(bf16x8, o);
            }
#pragma unroll
            for (int nb = 0; nb < 2; ++nb) bb[nb] = *(const bf16x8*)(bt + (size_t)(32 * nb + r32) * CH + 16 * ks + 8 * hi);
#pragma unroll
            for (int nb = 0; nb < 2; ++nb)
#pragma unroll
                for (int pb = 0; pb < 2; ++pb) acc[nb][pb] = __builtin_amdgcn_mfma_f32_32x32x16_bf16(bb[nb], xb[pb], acc[nb][pb], 0, 0, 0);
        }
        float* st = STATES + ((size_t)((b * NCH + c) * 2 + dir) * 8 + hd) * 4096;
#pragma unroll
        for (int nb = 0; nb < 2; ++nb)
#pragma unroll
            for (int pb = 0; pb < 2; ++pb)
#pragma unroll
                for (int q = 0; q < 4; ++q)
                    *(f32x4*)(st + (32 * pb + r32) * 64 + 32 * nb + 8 * q + 4 * hi) = (f32x4){acc[nb][pb][4 * q], acc[nb][pb][4 * q + 1], acc[nb][pb][4 * q + 2], acc[nb][pb][4 * q + 3]};
    }
}
__device__ __forceinline__ void finalize_chunk(float* smf, const bf16_t* XBCC, const bf16_t* XT, const bf16_t* PROJ, const float* DT, const float* alog, const float* STATES,
                                               const float* ssdd, const float* ssdnw, bf16_t* MIX, int b, int c) {
    int tid = threadIdx.x; asm volatile("" : "+v"(tid));
    const int lane = tid & 63, hd = __builtin_amdgcn_readfirstlane(tid >> 6), g = hd >> 2, r32 = lane & 31, hi = lane >> 5;
    f32x4* tab = (f32x4*)smf + hd * 128;
    float* red = smf + 8 * 128 * 4;
    const size_t t0 = (size_t)b * S + c * CH;
    {
        const float af = -expf(alog[hd]), ab = -expf(alog[8 + hd]);
        const float f0 = DT[(t0 + 2 * lane) * 16 + hd], f1 = DT[(t0 + 2 * lane + 1) * 16 + hd];
        const float b0 = DT[(t0 + 2 * lane) * 16 + 8 + hd], b1 = DT[(t0 + 2 * lane + 1) * 16 + 8 + hd];
        float pf0, pf1, tf, pb0, pb1, tb;
        scan128(f0 * af, f1 * af, lane, pf0, pf1, tf); scan128(b0 * ab, b1 * ab, lane, pb0, pb1, tb);
        tab[2 * lane] = (f32x4){pf0, f0, tb - (pb0 - b0 * ab), b0}; tab[2 * lane + 1] = (f32x4){pf1, f1, tb - (pb1 - b1 * ab), b1};
        asm volatile("s_waitcnt lgkmcnt(0)" ::: "memory");
    }
    const bf16_t* xt = XT + ((size_t)(b * NCH + c) * 512 + hd * 64) * CH;
    const float dsk = ssdd[hd];
    for (int ib = 0; ib < 4; ++ib) {
        const int i = 32 * ib + r32;
        const f32x4 ti = tab[i];
        bf16x8 cf[4];
#pragma unroll
        for (int ks = 0; ks < 4; ++ks) cf[ks] = *(const bf16x8*)(XBCC + (t0 + i) * XBC + 640 + g * 64 + 16 * ks + 8 * hi);
        f32x16 yT[2]; yT[0] = (f32x16){}; yT[1] = (f32x16){};
#pragma unroll 1
        for (int jb = 0; jb < 4; ++jb) {
            f32x16 gt = (f32x16){};
#pragma unroll
            for (int ks = 0; ks < 4; ++ks) { const bf16x8 bfr = *(const bf16x8*)(XBCC + (t0 + 32 * jb + r32) * XBC + 512 + g * 64 + 16 * ks + 8 * hi);
                gt = __builtin_amdgcn_mfma_f32_32x32x16_bf16(bfr, cf[ks], gt, 0, 0, 0); }
#pragma unroll
            for (int r = 0; r < 16; ++r) {
                const int j = 32 * jb + crow(r, hi);
                const f32x4 tj = tab[j];
                const bool lt = j < i, gtj = j > i;
                const float arg = lt ? ti.x - tj.x : (gtj ? ti.z - tj.z : 0.f);
                const float dj = lt ? tj.y : (gtj ? tj.w : ti.y + ti.w);
                gt[r] = gt[r] * __builtin_amdgcn_exp2f(arg * LOG2E) * dj;
            }
            u32x4 pw[2];
#pragma unroll
            for (int s = 0; s < 2; ++s) pw[s] = (u32x4){cvtpk(gt[8 * s], gt[8 * s + 1]), cvtpk(gt[8 * s + 2], gt[8 * s + 3]), cvtpk(gt[8 * s + 4], gt[8 * s + 5]), cvtpk(gt[8 * s + 6], gt[8 * s + 7])};
#pragma unroll
            for (int s = 0; s < 2; ++s)
#pragma unroll
                for (int pb = 0; pb < 2; ++pb) {
                    const bf16_t* xp = xt + (size_t)(32 * pb + r32) * CH + 32 * jb + 16 * s + 4 * hi;
                    const u32x2 lo = *(const u32x2*)xp, hi2 = *(const u32x2*)(xp + 8);
                    const bf16x8 xf = __builtin_bit_cast(bf16x8, (u32x4){lo.x, lo.y, hi2.x, hi2.y});
                    yT[pb] = __builtin_amdgcn_mfma_f32_32x32x16_bf16(xf, __builtin_bit_cast(bf16x8, pw[s]), yT[pb], 0, 0, 0);
                }
        }
#pragma unroll 1
        for (int dir = 0; dir < 2; ++dir) {
            const float ei = __builtin_amdgcn_exp2f((dir == 0 ? ti.x : ti.z) * LOG2E);
            const float* st = STATES + ((size_t)((b * NCH + c) * 2 + dir) * 8 + hd) * 4096;
#pragma unroll
            for (int ks = 0; ks < 4; ++ks) {
                const u32x4 cv = __builtin_bit_cast(u32x4, cf[ks]);
                u32x4 cs; cs.x = cvtpk(bf2f(cv.x & 0xffffu) * ei, bf2f(cv.x >> 16) * ei); cs.y = cvtpk(bf2f(cv.y & 0xffffu) * ei, bf2f(cv.y >> 16) * ei);
                cs.z = cvtpk(bf2f(cv.z & 0xffffu) * ei, bf2f(cv.z >> 16) * ei); cs.w = cvtpk(bf2f(cv.w & 0xffffu) * ei, bf2f(cv.w >> 16) * ei);
#pragma unroll
                for (int pb = 0; pb < 2; ++pb) {
                    const float* hp = st + (32 * pb + r32) * 64 + 16 * ks + 8 * hi;
                    const f32x4 h0 = *(const f32x4*)hp, h1 = *(const f32x4*)(hp + 4);
                    const u32x4 hw = (u32x4){cvtpk(h0.x, h0.y), cvtpk(h0.z, h0.w), cvtpk(h1.x, h1.y), cvtpk(h1.z, h1.w)};
                    yT[pb] = __builtin_amdgcn_mfma_f32_32x32x16_bf16(__builtin_bit_cast(bf16x8, hw), __builtin_bit_cast(bf16x8, cs), yT[pb], 0, 0, 0);
                }
            }
        }
        float ss = 0.f;
#pragma unroll
        for (int pb = 0; pb < 2; ++pb)
#pragma unroll
            for (int q = 0; q < 4; ++q) {
                const int p = 32 * pb + 8 * q + 4 * hi;
                const u32x2 xv = *(const u32x2*)(XBCC + (t0 + i) * XBC + hd * 64 + p);
                const u32x2 zv = *(const u32x2*)(PROJ + (t0 + i) * PROJ_N + PC_Z + hd * 64 + p);
                const float xs[4] = {bf2f(xv.x & 0xffffu), bf2f(xv.x >> 16), bf2f(xv.y & 0xffffu), bf2f(xv.y >> 16)};
                const float zs[4] = {bf2f(zv.x & 0xffffu), bf2f(zv.x >> 16), bf2f(zv.y & 0xffffu), bf2f(zv.y >> 16)};
#pragma unroll
                for (int e = 0; e < 4; ++e) { const float y = yT[pb][4 * q + e] + dsk * xs[e]; const float gv = y * (zs[e] / (1.f + __expf(-zs[e]))); yT[pb][4 * q + e] = gv; ss += gv * gv; }
            }
        ss = att::half_sum(ss);
        __syncthreads();
        if (hi == 0) red[hd * 32 + r32] = ss;
        __syncthreads();
        float tot = 0.f;
#pragma unroll
        for (int w8 = 0; w8 < 8; ++w8) tot += red[w8 * 32 + r32];
        const float rstd = 1.f / sqrtf(tot * (1.f / 512.f) + EPS);
#pragma unroll
        for (int pb = 0; pb < 2; ++pb)
#pragma unroll
            for (int q = 0; q < 4; ++q) {
                const int p = 32 * pb + 8 * q + 4 * hi;
                const f32x4 wv = *(const f32x4*)(ssdnw + hd * 64 + p);
                u32x2 o; o.x = cvtpk(yT[pb][4 * q] * rstd * wv.x, yT[pb][4 * q + 1] * rstd * wv.y); o.y = cvtpk(yT[pb][4 * q + 2] * rstd * wv.z, yT[pb][4 * q + 3] * rstd * wv.w);
                *(u32x2*)(MIX + (t0 + i) * D + 512 + hd * 64 + p) = o;
            }
    }
    __syncthreads();
}
}

struct Args { const void* in[31]; float* out; unsigned char* ws; int ph_lo, ph_hi; };
#define IN_F(i) ((const float*)a.in[i])
enum { I_X = 0, I_P, I_POS, I_ATTN_NW, I_WIN, I_QNW, I_WUQ, I_KVNW, I_WUKV, I_AONW, I_CONVW, I_CONVB, I_DTB, I_ALOG, I_SSDD, I_SSDNW, I_WO, I_FFNNW,
       I_WRG, I_BRG, I_WRE, I_BRE, I_WEG, I_WEU, I_WED, I_PLENW, I_WPG, I_BPG, I_WPP, I_PPNW, I_FNW };

template <class FA, class FB, class FE>
__device__ __forceinline__ void naive_gemm(int M, int N, int K, FA fa, FB fb, FE fe, float* sm) {
    const int tid = threadIdx.x, tx = tid & 63, ty = tid >> 6;
    float* As = sm; float* Bs = sm + 64 * 17;
    const int ntm = M / 64, ntn = (N + 63) / 64;
    for (int tile = blockIdx.x; tile < ntm * ntn; tile += gridDim.x) {
        const int tm = tile / ntn, tn = tile % ntn;
        float acc[8];
#pragma unroll
        for (int j = 0; j < 8; ++j) acc[j] = 0.f;
        for (int k0 = 0; k0 < K; k0 += 16) {
            __syncthreads();
            for (int i = tid; i < 1024; i += 512) { const int r = i >> 4, c = i & 15; As[r * 17 + c] = fa(tm * 64 + r, k0 + c); }
            for (int i = tid; i < 1024; i += 512) { const int r = i >> 6, c = i & 63; const int n = tn * 64 + c; Bs[r * 64 + c] = (n < N) ? fb(k0 + r, n) : 0.f; }
            __syncthreads();
#pragma unroll
            for (int k = 0; k < 16; ++k) { const float b = Bs[k * 64 + tx];
#pragma unroll
                for (int j = 0; j < 8; ++j) acc[j] += As[(ty * 8 + j) * 17 + k] * b; }
        }
#pragma unroll
        for (int j = 0; j < 8; ++j) { const int m = tm * 64 + ty * 8 + j, n = tn * 64 + tx; if (n < N) fe(m, n, acc[j]); }
    }
    __syncthreads();
}

__device__ __forceinline__ int proj_src_col(int j) {
    if (j < 416) return j;
    if (j < 432) return 1696 + (j - 416);
    if (j < 512) return -1;
    if (j < 1024) return 416 + (j - 512);
    return 928 + (j - 1024);
}

__device__ __forceinline__ void rms_row_to_bf16(const float* xrow, const float* w, bf16_t* orow, int lane) {
    const f32x4* xr = (const f32x4*)xrow + lane; const f32x4* wr = (const f32x4*)w + lane;
    f32x4 v[4]; float s = 0.f;
#pragma unroll
    for (int j = 0; j < 4; ++j) { v[j] = xr[64 * j]; s += (v[j].x * v[j].x + v[j].y * v[j].y) + (v[j].z * v[j].z + v[j].w * v[j].w); }
    const float rstd = 1.f / sqrtf(wave_sum(s) * (1.f / D) + EPS);
    u32x2* o8 = (u32x2*)orow + lane;
#pragma unroll
    for (int j = 0; j < 4; ++j) { const f32x4 g = wr[64 * j]; u32x2 o; o.x = pk2(v[j].x * rstd * g.x, v[j].y * rstd * g.y); o.y = pk2(v[j].z * rstd * g.z, v[j].w * rstd * g.w); o8[64 * j] = o; }
}

constexpr int LDS_BYTES = 147456;
constexpr int MISC_OFF = 131072;

__global__ void __launch_bounds__(512, 2) fwd(Args a) {
    extern __shared__ __attribute__((aligned(16))) unsigned char lds_raw[];
    float* smf = (float*)lds_raw;
    const int G = gridDim.x, NGW = G * 8, NGT = G * 512;
#define FRESH_IDS() int tid = threadIdx.x; asm volatile("" : "+v"(tid)); const int lane = tid & 63, wave = __builtin_amdgcn_readfirstlane(tid >> 6); \
    const int gw = blockIdx.x * 8 + wave, gtid = blockIdx.x * 512 + tid; (void)lane; (void)gw; (void)gtid;
    unsigned char* ws = a.ws;
    unsigned* ctl = (unsigned*)(ws + WS_CTL);
    volatile LAS unsigned* MISC = (volatile LAS unsigned*)((LAS unsigned char*)lds_raw + MISC_OFF);
    if (threadIdx.x < 32) MISC[threadIdx.x] = 0u;
    __syncthreads();
#if !MK_PER_PHASE
    XcdBarrier bar = xcd_barrier_post(ctl + CW_BAR, MISC + 8);
#define GRID_BAR() xcd_barrier(bar)
#else
#define GRID_BAR() do {} while (0)
#endif
    const int lo = a.ph_lo, hi = a.ph_hi;
#ifndef PHMASK
#define PHMASK 0xFFFF
#endif
#define IN(k) (((PHMASK >> (k)) & 1) && lo <= (k) && (k) < hi)
#define SEAM(k) do { if (IN(k) && IN((k) + 1)) GRID_BAR(); } while (0)

    const float* x = IN_F(I_X);
    float* out = a.out;
    bf16_t* H = (bf16_t*)(ws + WS_H);
    bf16_t* PROJ = (bf16_t*)(ws + WS_PROJ);
    bf16_t* PLERAW = (bf16_t*)(ws + WS_PROJ);
    bf16_t* Qb = (bf16_t*)(ws + WS_Q); bf16_t* Kb = (bf16_t*)(ws + WS_K); bf16_t* Vb = (bf16_t*)(ws + WS_V);
    bf16_t* MIX = (bf16_t*)(ws + WS_MIX);
    bf16_t* XBCC = (bf16_t*)(ws + WS_XBCC);
    float* STATES = out;
    bf16_t* XT = (bf16_t*)((char*)out + 64 * MiB);
    bf16_t* BT = (bf16_t*)((char*)out + 96 * MiB);
    float* CDEC = (float*)(ws + WS_CDEC);
    float* COS = (float*)(ws + WS_COS); float* SIN = (float*)(ws + WS_SIN);
    float* DT = (float*)(ws + WS_DT); float* DTRAW = (float*)(ws + WS_DTRAW);
    float* ROUTE = (float*)(ws + WS_ROUTE);
    int* BUCKET = (int*)(ws + WS_BUCKET);
    const int* pos = (const int*)a.in[I_POS];

    bf16_t* WT_IN = (bf16_t*)(ws + WS_WEIGHTS);
    bf16_t* WT_UQ = WT_IN + (size_t)PROJ_N * D;
    bf16_t* WT_UKV = WT_UQ + 768 * 256;
    bf16_t* WT_O = WT_UKV + 1024 * 128;
    bf16_t* WT_PG = WT_O + (size_t)D * D;
    bf16_t* WT_PP = WT_PG + (size_t)D * D;
    bf16_t* WT_GU = WT_PP + (size_t)D * 256;
    bf16_t* WT_DN = WT_GU + (size_t)32 * 512 * 1024;
    bf16_t* PB = (bf16_t*)(ws + WS_PB);
    float* SSQQ = (float*)(ws + WS_SSQQ); float* SSQKV = (float*)(ws + WS_SSQKV); float* SSQPLE = (float*)(ws + WS_SSQPLE);
    LAS unsigned char* ldsb = (LAS unsigned char*)lds_raw;
    float* WR = (float*)(ws + WS_WR);

    if (IN(0)) {
        FRESH_IDS();
        float* scr = smf + wave * 4096;
        constexpr int I_IN = 16 * 56, I_UQ = 4 * 24, I_UKV = 2 * 32, I_O = 16 * 32, I_PG = 16 * 32, I_PP = 4 * 32, I_GU = 32 * 16 * 16, I_DN = 32 * 4 * 32;
        constexpr int NITEMS = I_IN + I_UQ + I_UKV + I_O + I_PG + I_PP + I_GU + I_DN;
        const float* qnw = IN_F(I_QNW); const float* kvnw = IN_F(I_KVNW);
        const float qscale = 0.10206207261596575f * 1.4426950408889634f;
        auto one = [](int) { return 1.f; };
        auto ident = [](int n) { return n; };
        for (int it = gw; it < NITEMS; it += NGW) {
            int r = it;
            if (r < I_IN) { transpose_item(IN_F(I_WIN), IN_COLS, D, WT_IN, scr, r / 56, r % 56, lane, [](int n) { return proj_src_col(n); }, one); continue; } r -= I_IN;
            if (r < I_UQ) { transpose_item(IN_F(I_WUQ), 768, 256, WT_UQ, scr, r / 24, r % 24, lane, ident, [&](int k) { return qnw[k] * qscale; }); continue; } r -= I_UQ;
            if (r < I_UKV) { transpose_item(IN_F(I_WUKV), 1024, 128, WT_UKV, scr, r / 32, r % 32, lane, ident, [&](int k) { return kvnw[k]; }); continue; } r -= I_UKV;
            if (r < I_O) { transpose_item(IN_F(I_WO), D, D, WT_O, scr, r / 32, r % 32, lane, ident, one); continue; } r -= I_O;
            if (r < I_PG) { transpose_item(IN_F(I_WPG), D, D, WT_PG, scr, r / 32, r % 32, lane, ident, one); continue; } r -= I_PG;
            if (r < I_PP) { transpose_item(IN_F(I_WPP), D, 256, WT_PP, scr, r / 32, r % 32, lane, ident, one); continue; } r -= I_PP;
            if (r < I_GU) { const int e = r / 256, q = r % 256, kb = q / 16, nb = q % 16;
                const float* W = ((nb & 7) < 4 ? IN_F(I_WEG) : IN_F(I_WEU)) + (size_t)e * 1024 * 256;
                transpose_item(W, 256, D, WT_GU + (size_t)e * 512 * 1024, scr, kb, nb, lane, [](int n) { return (n >> 8) * 128 + (n & 127); }, one); continue; } r -= I_GU;
            { const int e = r / 128, q = r % 128; transpose_item(IN_F(I_WED) + (size_t)e * 256 * 1024, D, 256, WT_DN + (size_t)e * 1024 * 256, scr, q / 32, q % 32, lane, ident, one); }
        }
        for (int m = gw; m < T; m += NGW) rms_row_to_bf16(x + (size_t)m * D, IN_F(I_ATTN_NW), H + (size_t)m * D, lane);
        { const f32x4* pp = (const f32x4*)IN_F(I_P); u32x2* po = (u32x2*)PB;
          for (int i = gtid; i < T * 256 / 4; i += NGT) { const f32x4 v = pp[i]; u32x2 o; o.x = pk2(v.x, v.y); o.y = pk2(v.z, v.w); po[i] = o; } }
        { const float* wrg = IN_F(I_WRG); const float* wre = IN_F(I_WRE);
          for (int i = gtid; i < 36 * 1024; i += NGT) { const int j = i >> 10, c = i & 1023; WR[i] = j < 4 ? wrg[c * 4 + j] : wre[c * 32 + (j - 4)]; } }
        for (int i = gtid; i < T * 16; i += NGT) {
            const int t = i >> 4, f = i & 15;
            const float inv = 1.0f / powf(10000.0f, (float)(2 * f) / 32.0f);
            const float ang = (float)pos[t] * inv;
            COS[i] = cosf(ang); SIN[i] = sinf(ang);
        }
    }
    SEAM(0);
    if (IN(1)) {
        FRESH_IDS();
        pg8::Gemm g{H, WT_IN, T, PROJ_N, D, D, D}; pg8::StaticOrder So; So.init(T, PROJ_N, G, (int)blockIdx.x);
        EpiInProj E{PROJ, DTRAW, SSQQ, SSQKV};
        pg8::gemm_phase(ldsb, g, So, E);
    }
    SEAM(1);
    if (IN(2)) {
        FRESH_IDS();
        for (int u = blockIdx.x; u < NB * ssd::NCH; u += G) {
            ssd::conv_chunk(smf, PROJ, IN_F(I_CONVW), IN_F(I_CONVB), XBCC, XT, BT, DTRAW, IN_F(I_DTB), DT, u >> 5, u & 31);
            ssd::states_chunk(smf + 20480, XT, BT, DT, IN_F(I_ALOG), STATES, CDEC, u >> 5, u & 31);
            __syncthreads();
        }
        for (int i = gtid; i < T * 16; i += NGT) {
            const int t = i >> 4, f = i & 15, b = t / S, s = t % S;
            const float c = COS[i], sn = SIN[i];
            const float t1 = bf2f(PROJ[(size_t)t * PROJ_N + PC_KR + f]), t2 = bf2f(PROJ[(size_t)t * PROJ_N + PC_KR + 16 + f]);
            const bf16_t o1 = (bf16_t)f2bf(t1 * c - t2 * sn), o2 = (bf16_t)f2bf(t2 * c + t1 * sn);
            for (int h = 0; h < NH; ++h) { bf16_t* kr = Kb + ((size_t)(b * NH + h) * S + s) * DQK + 64; kr[f] = o1; kr[16 + f] = o2; }
        }
        __syncthreads();
        { pg8::Gemm g{PROJ + PC_CQ, WT_UQ, T, 768, 256, PROJ_N, 256}; pg8::StaticOrder So; So.init(T, 768, G, (int)blockIdx.x);
          EpiQUp E{Qb, SSQQ, COS, SIN}; pg8::gemm_phase(ldsb, g, So, E); }
        { pg8::Gemm g{PROJ + PC_CKV, WT_UKV, T, 1024, 128, PROJ_N, 128}; pg8::StaticOrder So; So.init(T, 1024, G, (int)blockIdx.x);
          EpiKVUp E{Kb, Vb, SSQKV}; pg8::gemm_phase(ldsb, g, So, E); }
    }
    SEAM(2);
    if (IN(3)) {
        FRESH_IDS();
        for (int idx = gtid; idx < 128 * 1024; idx += NGT) {
            const int chain = idx >> 10, e4 = (idx & 1023) * 4, b = chain >> 4, dir = (chain >> 3) & 1, hd = chain & 7;
            f32x4 h4 = (f32x4){0.f, 0.f, 0.f, 0.f};
#pragma unroll 8
            for (int step = 0; step < ssd::NCH; ++step) {
                const int c = dir == 0 ? step : ssd::NCH - 1 - step;
                const int sidx = ((b * ssd::NCH + c) * 2 + dir) * 8 + hd;
                f32x4* ptr = (f32x4*)(STATES + (size_t)sidx * 4096 + e4);
                const f32x4 s4 = *ptr; *ptr = h4; h4 = h4 * CDEC[sidx] + s4;
            }
        }
        __syncthreads();
        {
            const int vcu = (G % 8 == 0) ? ((int)blockIdx.x % 8) * (G / 8) + (int)blockIdx.x / 8 : (int)blockIdx.x;
            for (int u = vcu; u < NB * NH * 16; u += G) att::attn_unit(ldsb, Qb, Kb, Vb, MIX, u >> 4, u & 15);
        }
    }
    SEAM(3);
    if (IN(4)) {
        FRESH_IDS();
        const float* aonw = IN_F(I_AONW);
        for (int u = blockIdx.x; u < NB * ssd::NCH; u += G) {
            ssd::finalize_chunk(smf, XBCC, XT, PROJ, DT, IN_F(I_ALOG), STATES, IN_F(I_SSDD), IN_F(I_SSDNW), MIX, u >> 5, u & 31);
            for (int r = wave; r < ssd::CH; r += 8) {
                bf16_t* mr = MIX + ((size_t)(u >> 5) * S + (u & 31) * ssd::CH + r) * D + lane * 8;
                const u32x4 raw = *(const u32x4*)mr;
                float v[8] = {bf2f(raw.x & 0xffffu), bf2f(raw.x >> 16), bf2f(raw.y & 0xffffu), bf2f(raw.y >> 16), bf2f(raw.z & 0xffffu), bf2f(raw.z >> 16), bf2f(raw.w & 0xffffu), bf2f(raw.w >> 16)};
                float ss = 0.f;
#pragma unroll
                for (int j = 0; j < 8; ++j) ss += v[j] * v[j];
                const float rstd = 1.f / sqrtf(wave_sum(ss) * (1.f / 512.f) + EPS);
                const f32x4 w0 = *(const f32x4*)(aonw + lane * 8), w1 = *(const f32x4*)(aonw + lane * 8 + 4);
                u32x4 o; o.x = pk2(v[0] * rstd * w0.x, v[1] * rstd * w0.y); o.y = pk2(v[2] * rstd * w0.z, v[3] * rstd * w0.w);
                o.z = pk2(v[4] * rstd * w1.x, v[5] * rstd * w1.y); o.w = pk2(v[6] * rstd * w1.z, v[7] * rstd * w1.w);
                *(u32x4*)mr = o;
            }
        }
    }
    SEAM(4);
    if (IN(5)) {
        FRESH_IDS();
        pg8::Gemm g{MIX, WT_O, T, D, D, D, D}; pg8::StaticOrder So; So.init(T, D, G, (int)blockIdx.x);
        EpiResid E{x, out}; pg8::gemm_phase(ldsb, g, So, E);
    }
    SEAM(5);
    if (IN(6)) {
        FRESH_IDS();
        const float* fw = IN_F(I_FFNNW); const float* brg = IN_F(I_BRG); const float* bre = IN_F(I_BRE);
        for (int m = gw; m < T; m += NGW) {
            const f32x4* xr = (const f32x4*)(out + (size_t)m * D) + lane; const f32x4* wr = (const f32x4*)fw + lane;
            f32x4 v[4]; float s = 0.f;
#pragma unroll
            for (int j = 0; j < 4; ++j) { v[j] = xr[64 * j]; s += (v[j].x * v[j].x + v[j].y * v[j].y) + (v[j].z * v[j].z + v[j].w * v[j].w); }
            const float rstd = 1.f / sqrtf(wave_sum(s) * (1.f / D) + EPS);
            u32x2* o8 = (u32x2*)(H + (size_t)m * D) + lane;
            f32x4 hn[4];
#pragma unroll
            for (int j = 0; j < 4; ++j) { hn[j] = v[j] * rstd * wr[64 * j]; u32x2 o; o.x = pk2(hn[j].x, hn[j].y); o.y = pk2(hn[j].z, hn[j].w); o8[64 * j] = o; }
            float mylog = 0.f;
#pragma unroll 2
            for (int j = 0; j < 36; ++j) {
                const f32x4* wj = (const f32x4*)(WR + j * 1024) + lane; float pdot = 0.f;
#pragma unroll
                for (int jj = 0; jj < 4; ++jj) { const f32x4 w = wj[64 * jj]; pdot += (hn[jj].x * w.x + hn[jj].y * w.y) + (hn[jj].z * w.z + hn[jj].w * w.w); }
                pdot = wave_sum(pdot);
                mylog = (lane == j) ? pdot : mylog;
            }
            float acc[36];
#pragma unroll
            for (int j = 0; j < 36; ++j) acc[j] = __shfl(mylog, j);
            if (lane == 0) {
                float gl[4]; int gi = 0;
#pragma unroll
                for (int q = 0; q < 4; ++q) gl[q] = acc[q] + brg[q];
                float gmax = gl[0];
#pragma unroll
                for (int q = 1; q < 4; ++q) if (gl[q] > gmax) { gmax = gl[q]; gi = q; }
                float gs = 0.f;
#pragma unroll
                for (int q = 0; q < 4; ++q) gs += expf(gl[q] - gmax);
                const float gwt = 1.f / gs;
                float el[8];
#pragma unroll
                for (int q = 0; q < 8; ++q) { float vv = 0.f;
#pragma unroll
                    for (int g2 = 0; g2 < 4; ++g2) vv = (g2 == gi) ? acc[4 + g2 * 8 + q] + bre[g2 * 8 + q] : vv;
                    el[q] = vv; }
                int i0 = 0; float v0 = el[0];
#pragma unroll
                for (int q = 1; q < 8; ++q) if (el[q] > v0) { v0 = el[q]; i0 = q; }
                int i1 = -1; float v1 = -3.4e38f;
#pragma unroll
                for (int q = 0; q < 8; ++q) if (q != i0 && el[q] > v1) { v1 = el[q]; i1 = q; }
                const float e1 = expf(v1 - v0), w0 = gwt / (1.f + e1), w1 = gwt * e1 / (1.f + e1);
                const int ex0 = gi * 8 + i0, ex1 = gi * 8 + i1;
                ROUTE[m * 4 + 0] = __int_as_float(ex0); ROUTE[m * 4 + 1] = __int_as_float(ex1); ROUTE[m * 4 + 2] = w0; ROUTE[m * 4 + 3] = w1;
                const unsigned p0 = atomicAdd(ctl + CW_ECNT + 64 * ex0, 1u); BUCKET[(size_t)ex0 * T + p0] = m * 2;
                const unsigned p1 = atomicAdd(ctl + CW_ECNT + 64 * ex1, 1u); BUCKET[(size_t)ex1 * T + p1] = m * 2 + 1;
            }
        }
        __syncthreads();
        { pg8::Gemm g{PB, WT_PP, T, D, 256, 256, 256}; pg8::StaticOrder So; So.init(T, D, G, (int)blockIdx.x);
          EpiPleProj E{PLERAW, SSQPLE}; pg8::gemm_phase(ldsb, g, So, E); }
    }
    SEAM(6);
    volatile LAS unsigned* CNT_L = MISC + 64; volatile LAS unsigned* PTILE_L = MISC + 96;
    LAS unsigned* ROWTAB = (LAS unsigned*)(ldsb + MISC_OFF + 1024);
    bf16_t* HE = (bf16_t*)(ws + WS_HE); bf16_t* YPAIR = (bf16_t*)(ws + WS_Q);
    if (IN(7) || IN(8)) {
        if (threadIdx.x == 0) { unsigned acc = 0;
            for (int e2 = 0; e2 < 32; ++e2) { const unsigned c = __hip_atomic_load(ctl + CW_ECNT + 64 * e2, __ATOMIC_RELAXED, __HIP_MEMORY_SCOPE_AGENT); CNT_L[e2] = c; PTILE_L[e2] = acc; acc += (c + 255u) >> 8; }
            PTILE_L[32] = acc; }
        __syncthreads();
    }
    if (IN(7)) {
        FRESH_IDS();
        GroupSched Sg{PTILE_L, 2, G, (int)blockIdx.x};
        { pg8::Unit u;
          for (int i = 0; i < 8 && Sg.next(i, u); ++i) { const int e2 = u.pn >> 1, pm_l = u.pm - (int)PTILE_L[e2];
              if (tid < 256) { const int idx = pm_l * 256 + tid; const int tok = idx < (int)CNT_L[e2] ? (BUCKET[(size_t)e2 * T + idx] >> 1) : 0; ROWTAB[i * 256 + tid] = (unsigned)tok * 2048u; } } }
        __syncthreads();
        pg8::Gemm g{H, WT_GU, T, 32 * 512, D, D, D};
        EpiMoeGU E{HE};
        pg8::gemm_phase<EpiMoeGU, GroupSched, true>(ldsb, g, Sg, E, ROWTAB);
    }
    SEAM(7);
    if (IN(8)) {
        GroupSched Sg{PTILE_L, 4, G, (int)blockIdx.x};
        pg8::Gemm g{HE, WT_DN, 0, 32 * 1024, 256, 256, 256};
        EpiMoeDown E{YPAIR, BUCKET, ROUTE, PTILE_L, CNT_L};
        pg8::gemm_phase(ldsb, g, Sg, E);
    }
    SEAM(8);
    if (IN(9)) {
        FRESH_IDS();
        const f32x4* wr4 = (const f32x4*)IN_F(I_PLENW) + lane;
        for (int m = gw; m < T; m += NGW) {
            f32x4* xr = (f32x4*)(out + (size_t)m * D) + lane;
            const u32x2* y0 = (const u32x2*)(YPAIR + (size_t)(2 * m) * D) + lane; const u32x2* y1 = (const u32x2*)(YPAIR + (size_t)(2 * m + 1) * D) + lane;
            f32x4 v[4]; float s = 0.f;
#pragma unroll
            for (int j = 0; j < 4; ++j) { const u32x2 a0 = y0[64 * j], a1 = y1[64 * j];
                v[j] = xr[64 * j] + (f32x4){bf2f(a0.x & 0xffffu) + bf2f(a1.x & 0xffffu), bf2f(a0.x >> 16) + bf2f(a1.x >> 16), bf2f(a0.y & 0xffffu) + bf2f(a1.y & 0xffffu), bf2f(a0.y >> 16) + bf2f(a1.y >> 16)};
                xr[64 * j] = v[j]; s += (v[j].x * v[j].x + v[j].y * v[j].y) + (v[j].z * v[j].z + v[j].w * v[j].w); }
            const float rstd = 1.f / sqrtf(wave_sum(s) * (1.f / D) + EPS);
            u32x2* o8 = (u32x2*)(H + (size_t)m * D) + lane;
#pragma unroll
            for (int j = 0; j < 4; ++j) { const f32x4 g4 = wr4[64 * j]; u32x2 o; o.x = pk2(v[j].x * rstd * g4.x, v[j].y * rstd * g4.y); o.y = pk2(v[j].z * rstd * g4.z, v[j].w * rstd * g4.w); o8[64 * j] = o; }
        }
    }
    SEAM(9);
    if (IN(10)) {
        pg8::Gemm g{H, WT_PG, T, D, D, D, D}; pg8::StaticOrder So; So.init(T, D, G, (int)blockIdx.x);
        EpiPleGate E{out, PLERAW, SSQPLE, IN_F(I_BPG), IN_F(I_PPNW)}; pg8::gemm_phase(ldsb, g, So, E);
    }
    SEAM(10);
    if (IN(11)) {
        FRESH_IDS();
        const float* fnw = IN_F(I_FNW);
        for (int m = gw; m < T; m += NGW) {
            f32x4* xr = (f32x4*)(out + (size_t)m * D) + lane; const f32x4* wr = (const f32x4*)fnw + lane;
            f32x4 v[4]; float s = 0.f;
#pragma unroll
            for (int j = 0; j < 4; ++j) { v[j] = xr[64 * j]; s += (v[j].x * v[j].x + v[j].y * v[j].y) + (v[j].z * v[j].z + v[j].w * v[j].w); }
            const float rstd = 1.f / sqrtf(wave_sum(s) * (1.f / D) + EPS);
#pragma unroll
            for (int j = 0; j < 4; ++j) xr[64 * j] = v[j] * rstd * wr[64 * j];
        }
    }
#undef IN
#undef SEAM
}

extern "C" void kernel_launch(void* const* d_in, const int* in_sizes, int n_in, void* d_out, int out_size, void* d_ws, size_t ws_size, hipStream_t stream) {
    static int grid = 0;
    if (grid == 0) {
        if (n_in != 31 || out_size != T * D || ws_size < WS_END) { fprintf(stderr, "kernel_launch: unexpected shapes (n_in %d out %d ws %zu)\n", n_in, out_size, ws_size); grid = -1; return; }
        int dev = 0, cus = 0, per_cu = 0;
        if (hipGetDevice(&dev) != hipSuccess || hipDeviceGetAttribute(&cus, hipDeviceAttributeMultiprocessorCount, dev) != hipSuccess) { grid = -1; return; }
        if (hipFuncSetAttribute((const void*)fwd, hipFuncAttributeMaxDynamicSharedMemorySize, LDS_BYTES) != hipSuccess) { fprintf(stderr, "kernel_launch: hipFuncSetAttribute failed\n"); grid = -1; return; }
        if (hipOccupancyMaxActiveBlocksPerMultiprocessor(&per_cu, (const void*)fwd, 512, LDS_BYTES) != hipSuccess || per_cu < 1) { fprintf(stderr, "kernel_launch: occupancy query says %d\n", per_cu); }
        (void)hipGetLastError();
        grid = cus;
    }
    if (grid < 0) return;
    (void)hipMemsetAsync((char*)d_ws + WS_CTL, 0, CTL_ZERO_BYTES, stream);
    Args a{};
    for (int i = 0; i < 31; ++i) a.in[i] = d_in[i];
    a.out = (float*)d_out; a.ws = (unsigned char*)d_ws;
#if MK_PER_PHASE
    for (int p = 0; p < NPHASES; ++p) { a.ph_lo = p; a.ph_hi = p + 1; hipLaunchKernelGGL(fwd, dim3(grid), dim3(512), LDS_BYTES, stream, a); }
#else
    a.ph_lo = 0; a.ph_hi = NPHASES;
    hipLaunchKernelGGL(fwd, dim3(grid), dim3(512), LDS_BYTES, stream, a);
#endif
}
```

```cpp
#include <hip/hip_runtime.h>
#include <cstdio>
#include <cstdint>

#ifndef MK_PER_PHASE
#define MK_PER_PHASE 0
#endif

#define LAS __attribute__((address_space(3)))
#define GAS __attribute__((address_space(1)))
typedef unsigned short bf16_t;
typedef float f32x4 __attribute__((ext_vector_type(4)));
typedef unsigned u32x4 __attribute__((ext_vector_type(4)));
typedef unsigned u32x2 __attribute__((ext_vector_type(2)));

constexpr int NB = 8, S = 4096, T = NB * S, D = 1024;
constexpr int NH = 8, DQK = 96, DV = 64;
constexpr int PROJ_N = 1792, IN_COLS = 1712;
constexpr int PC_CQ = 0, PC_CKV = 256, PC_KR = 384, PC_DT = 416, PC_Z = 512, PC_XBC = 1024;
constexpr int XBC = 768;
constexpr float EPS = 1e-6f;
constexpr int NPHASES = 12;

constexpr size_t MiB = 1u << 20;
constexpr size_t WS_CTL = 0, CTL_ZERO_BYTES = 1 * MiB;
constexpr size_t WS_COS = 1 * MiB, WS_SIN = 3 * MiB, WS_DT = 5 * MiB, WS_ROUTE = 7 * MiB, WS_BUCKET = 8 * MiB;
constexpr size_t WS_SSQQ = 12 * MiB, WS_SSQKV = 12 * MiB + 512 * 1024, WS_DTRAW = 13 * MiB, WS_SSQPLE = 15 * MiB;
constexpr size_t WS_WR = 7 * MiB + 512 * 1024;
constexpr size_t WS_CDEC = 7 * MiB + 768 * 1024;
constexpr size_t WS_WRF = 7 * MiB + 512 * 1024;
constexpr size_t WS_SSQX1 = 17 * MiB;
constexpr size_t WS_WEIGHTS = 19 * MiB;
constexpr size_t WS_H = 80 * MiB;
constexpr size_t WS_PROJ = 144 * MiB;
constexpr size_t WS_HE = 208 * MiB;
constexpr size_t WS_Q = 256 * MiB, WS_K = 304 * MiB, WS_V = 352 * MiB;
constexpr size_t WS_MIX = 384 * MiB;
constexpr size_t WS_XBCC = 448 * MiB;
constexpr size_t WS_PB = 496 * MiB;
constexpr size_t WS_END = 512 * MiB;
constexpr int CW_BAR = 4096, CW_ECNT = 8192;

__device__ __forceinline__ unsigned f2bf(float f) { unsigned u = __builtin_bit_cast(unsigned, f); return (u + 0x7fffu + ((u >> 16) & 1u)) >> 16; }
__device__ __forceinline__ float bf2f(unsigned h) { return __builtin_bit_cast(float, h << 16); }
__device__ __forceinline__ unsigned pk2(float lo, float hi) { return f2bf(lo) | (f2bf(hi) << 16); }
__device__ __forceinline__ float wave_sum(float v) {
#pragma unroll
    for (int o = 1; o < 64; o <<= 1) v += __shfl_xor(v, o);
    return v;
}
__device__ __forceinline__ float silu_f(float v) { return v / (1.f + __expf(-v)); }

#define XB_TMO      128
#define XB_XCNT(j)  (256  + 64 * (j))
#define XB_XSUB(j)  (1280 + 64 * (j))
#define XB_XGEN(j)  (2304 + 64 * (j))
#define XB_TOP      3328
#define XB_TOPGEN   3392
#define XCD_BAR_WORDS 3456
#define XB_SPIN_CAP (1u << 22)

__device__ __forceinline__ unsigned xb_ld(unsigned* p)              { return __hip_atomic_load(p, __ATOMIC_RELAXED, __HIP_MEMORY_SCOPE_AGENT); }
__device__ __forceinline__ unsigned xb_add(unsigned* p, unsigned v) { return __hip_atomic_fetch_add(p, v, __ATOMIC_RELAXED, __HIP_MEMORY_SCOPE_AGENT); }
__device__ __forceinline__ unsigned xb_xcc_id() { return (unsigned)__builtin_amdgcn_s_getreg((3 << 11) | 20) & 0xFu; }
#define XB_SPIN(cond, bar) do { unsigned _sp = 0; while (cond) { __builtin_amdgcn_s_sleep(1); \
    if ((++_sp & 255u) == 0u) { if (xb_ld(&(bar)[XB_TMO])) break; if (_sp > XB_SPIN_CAP) { atomicAdd(&(bar)[XB_TMO], 1u); break; } } } } while (0)

struct XcdBarrier { unsigned* bar; unsigned x; volatile LAS unsigned* st; };
__device__ __forceinline__ XcdBarrier xcd_barrier_post(unsigned* bar, volatile LAS unsigned* st) {
    XcdBarrier b; b.bar = bar; b.x = xb_xcc_id(); b.st = st;
    if (threadIdx.x == 0) (void)xb_add(&bar[XB_XCNT(b.x)], 1u);
    return b;
}
__device__ __forceinline__ void xcd_barrier_complete(unsigned* bar, unsigned x, unsigned& nloc, unsigned& nx) {
    const unsigned G = gridDim.x * gridDim.y * gridDim.z;
    unsigned sum, cnt, mine, sp = 0u;
    for (;;) {
        sum = 0u; cnt = 0u; mine = 0u;
#pragma unroll
        for (unsigned j = 0; j < 16; ++j) { const unsigned c = xb_ld(&bar[XB_XCNT(j)]); sum += c; cnt += (c > 0u) ? 1u : 0u; mine = (j == x) ? c : mine; }
        if (sum == G) break;
        __builtin_amdgcn_s_sleep(1);
        if ((++sp & 255u) == 0u) { if (xb_ld(&bar[XB_TMO])) break; if (sp > XB_SPIN_CAP) { atomicAdd(&bar[XB_TMO], 1u); break; } }
    }
    nloc = mine > 0u ? mine : 1u; nx = cnt > 0u ? cnt : 1u;
}
__device__ __forceinline__ void xcd_barrier(const XcdBarrier& b) {
    asm volatile("s_waitcnt vmcnt(0)" ::: "memory");
    __syncthreads();
    if (threadIdx.x == 0) {
        unsigned* bar = b.bar;
        __builtin_amdgcn_s_waitcnt(0);
        unsigned nloc = b.st[0], nx = b.st[1];
        if (nloc == 0u) { xcd_barrier_complete(bar, b.x, nloc, nx); b.st[0] = nloc; b.st[1] = nx; }
        const unsigned old = xb_add(&bar[XB_XSUB(b.x)], 1u);
        const unsigned gen = old / nloc;
        if (old + 1u == (gen + 1u) * nloc) {
            __builtin_amdgcn_fence(__ATOMIC_RELEASE, "agent");
            asm volatile("s_waitcnt vmcnt(0)" ::: "memory");
            const unsigned og = xb_add(&bar[XB_TOP], 1u);
            const unsigned tg = og / nx;
            if (og + 1u == (tg + 1u) * nx) xb_add(&bar[XB_TOPGEN], 1u);
            else XB_SPIN(xb_ld(&bar[XB_TOPGEN]) == tg, bar);
            __builtin_amdgcn_fence(__ATOMIC_ACQUIRE, "agent");
            xb_add(&bar[XB_XGEN(b.x)], 1u);
            asm volatile("s_waitcnt vmcnt(0)" ::: "memory");
        } else {
            XB_SPIN(xb_ld(&bar[XB_XGEN(b.x)]) == gen, bar);
            __builtin_amdgcn_fence(__ATOMIC_ACQUIRE, "agent");
            asm volatile("s_waitcnt vmcnt(0)" ::: "memory");
        }
    }
    __syncthreads();
}


namespace pg8 {
typedef short bf16x8 __attribute__((ext_vector_type(8)));
constexpr int BM = 256, BK = 64, HALF = 128, HTB = HALF * BK * 2, STAGE_BYTES = 8 * HTB, NXCD = 8, WGM = 8;
__host__ __device__ __forceinline__ int lds_byte(int r, int c) { const int st = (r >> 4) * 2 + (c >> 5), rr = r & 15, cc = c & 31, ob = rr * 64 + cc * 2; return st * 1024 + (ob ^ (((ob >> 9) & 1) << 5)); }
__host__ __device__ __forceinline__ void stage_rc(int b, int& R, int& C) { const int st = b / 1024, sb = b % 1024, swz = sb ^ (((sb >> 9) & 1) << 5); R = (st >> 1) * 16 + swz / 64; C = (st & 1) * 32 + (swz % 64) / 2; }
__host__ __device__ __forceinline__ int perm32(int rho) { const int n = rho >> 4, i = rho & 15; return 8 * (i >> 2) + 4 * n + (i & 3); }
struct Unit { int pm, pn; };
struct Gemm { const bf16_t* A; const bf16_t* Bt; int M, N, K, lda, ldb; };
struct StaticOrder {
    int nM, nN, nwg, G, c;
    __host__ __device__ void init(int M, int N, int G_, int c_) { nM = M / BM; nN = N / BM; nwg = nM * nN; G = G_; c = c_; }
    __host__ __device__ bool next(int i, Unit& u) const {
        const long L = (long)i * G + c; if (L >= nwg) return false;
        int wgid = (int)L; { const int q = nwg / NXCD, r = nwg % NXCD, xcd = wgid % NXCD, off = wgid / NXCD; wgid = (xcd < r ? xcd * (q + 1) : r * (q + 1) + (xcd - r) * q) + off; }
        const int nig = WGM * nN, gid = wgid / nig, fm = gid * WGM, gsz = (nM - fm) < WGM ? (nM - fm) : WGM;
        u.pm = fm + ((wgid % nig) % gsz); u.pn = (wgid % nig) / gsz; return true;
    }
};
__device__ __forceinline__ unsigned cvt_pk_bf16(float lo, float hi) { unsigned r; asm volatile("v_cvt_pk_bf16_f32 %0, %1, %2" : "=v"(r) : "v"(lo), "v"(hi)); return r; }

template <class Epi, class Sched, bool GATHER = false>
__device__ __forceinline__ void gemm_phase(LAS unsigned char* lds, const Gemm g, const Sched& S, const Epi& E, const LAS unsigned* rowtab = nullptr) {
    int tid = threadIdx.x; asm volatile("" : "+v"(tid));
    const int wid = __builtin_amdgcn_readfirstlane(tid >> 6), lane = tid & 63, wr = wid >> 2, wc = wid & 3, fr = lane & 15, fq = lane >> 4;
    int nt = g.K / BK; asm volatile("" : "+s"(nt));
    unsigned vAc[2][2], vAn[2][2], voffB[2]; int RA[2], CA[2];
#pragma unroll
    for (int i = 0; i < 2; ++i) { int R, C; stage_rc(tid * 16 + i * 8192, R, C); const int Rb = Epi::PERM ? ((R & ~31) + perm32(R & 31)) : R; RA[i] = R; CA[i] = C;
        voffB[i] = (unsigned)(Rb * g.ldb + C) * 2u;
#pragma unroll
        for (int h = 0; h < 2; ++h) { vAc[h][i] = GATHER ? rowtab[h * HALF + R] + (unsigned)C * 2u : (unsigned)((h * HALF + R) * g.lda + C) * 2u; vAn[h][i] = vAc[h][i]; } }
    const size_t kstep = (size_t)(BK * 2);
    const size_t hstepB = (size_t)HALF * g.ldb * 2;
    const size_t tstepA = GATHER ? 0 : (size_t)BM * g.lda * 2, tstepB = 2 * hstepB;
    const unsigned ldsw = (unsigned)wid * 1024u;
    const int aoff = lds_byte(wr * 64 + fr, fq * 8), boff = lds_byte(wc * 32 + fr, fq * 8);
#define PG8_SA(b, h) (((b) * 2 + (h)) * HTB)
#define PG8_SB(b, h) ((4 + (b) * 2 + (h)) * HTB)
#define PG8_STAGE(bufoff, gbase, voff) do { _Pragma("unroll") for (int _i = 0; _i < 2; ++_i) \
        __builtin_amdgcn_global_load_lds((const unsigned*)((const char*)(gbase) + (voff)[_i]), (LAS unsigned*)(lds + (bufoff) + ldsw + _i * 8192), 16, 0, 0); } while (0)
#define PG8_LDA(dst, b, h) do { _Pragma("unroll") for (int m = 0; m < 4; ++m) _Pragma("unroll") for (int k = 0; k < 2; ++k) dst[m][k] = *(const LAS bf16x8*)(lds + PG8_SA(b, h) + aoff + m * 2048 + k * 1024); } while (0)
#define PG8_LDB(dst, b, h) do { _Pragma("unroll") for (int n = 0; n < 2; ++n) _Pragma("unroll") for (int k = 0; k < 2; ++k) dst[n][k] = *(const LAS bf16x8*)(lds + PG8_SB(b, h) + boff + n * 2048 + k * 1024); } while (0)
#define PG8_MMA(ai, bj, At, Bt) do { __builtin_amdgcn_s_setprio(1); _Pragma("unroll") for (int m = 0; m < 4; ++m) _Pragma("unroll") for (int n = 0; n < 2; ++n) _Pragma("unroll") for (int k = 0; k < 2; ++k) \
        acc[ai][bj][m][n] = __builtin_amdgcn_mfma_f32_16x16x32_bf16(Bt[n][k], At[m][k], acc[ai][bj][m][n], 0, 0, 0); __builtin_amdgcn_s_setprio(0); } while (0)
#define PG8_WAIT_V(n) asm volatile("s_waitcnt vmcnt(" #n ")" ::: "memory")
#define PG8_WAIT_L(n) asm volatile("s_waitcnt lgkmcnt(" #n ")" ::: "memory")
#define PG8_BAR __builtin_amdgcn_s_barrier()
#define PG8_SCHED __builtin_amdgcn_sched_barrier(0)
    Unit cur, nxt; int ui = 0;
    if (!S.next(0, cur)) return;
    f32x4 acc[2][2][4][2];
#pragma unroll
    for (int a = 0; a < 2; ++a)
#pragma unroll
        for (int b = 0; b < 2; ++b)
#pragma unroll
            for (int m = 0; m < 4; ++m)
#pragma unroll
                for (int n = 0; n < 2; ++n) acc[a][b][m][n] = (f32x4){0.f, 0.f, 0.f, 0.f};
    bf16x8 At[4][2], B0[2][2], B1[2][2];
    const char* cA = (const char*)g.A + (size_t)cur.pm * tstepA; const char* cB = (const char*)g.Bt + (size_t)cur.pn * tstepB;
    PG8_STAGE(PG8_SB(0, 0), cB, voffB); PG8_STAGE(PG8_SB(0, 1), cB + hstepB, voffB); PG8_STAGE(PG8_SA(0, 0), cA, vAc[0]); PG8_STAGE(PG8_SA(0, 1), cA, vAc[1]);
    if (wr == 1) PG8_BAR;
    PG8_WAIT_V(2); PG8_BAR;
    PG8_STAGE(PG8_SB(1, 0), cB + kstep, voffB); PG8_STAGE(PG8_SA(1, 0), cA + kstep, vAc[0]); PG8_STAGE(PG8_SB(1, 1), cB + hstepB + kstep, voffB);
    PG8_WAIT_V(6); PG8_BAR;
    for (;;) {
        const bool has_next = S.next(ui + 1, nxt);
        const char* nA = has_next ? (const char*)g.A + (size_t)nxt.pm * tstepA : cA; const char* nB = has_next ? (const char*)g.Bt + (size_t)nxt.pn * tstepB : cB;
        if (GATHER && has_next) {
#pragma unroll
            for (int i = 0; i < 2; ++i)
#pragma unroll
                for (int h = 0; h < 2; ++h) vAn[h][i] = rowtab[(ui + 1) * BM + h * HALF + RA[i]] + (unsigned)CA[i] * 2u;
        }
        for (int t = 0; t < nt; t += 2) {
            const bool last = (t == nt - 2);
            const char* a1 = cA + (size_t)(t + 1) * kstep;
            const char* a2 = last ? nA : cA + (size_t)(t + 2) * kstep; const char* b2 = last ? nB : cB + (size_t)(t + 2) * kstep;
            const char* a3 = a2 + kstep; const char* b3 = b2 + kstep;
            unsigned v2[2][2];
#pragma unroll
            for (int i = 0; i < 2; ++i)
#pragma unroll
                for (int h = 0; h < 2; ++h) v2[h][i] = (GATHER && last) ? vAn[h][i] : vAc[h][i];
            PG8_LDB(B0, 0, 0); PG8_LDB(B1, 0, 1); PG8_SCHED; PG8_LDA(At, 0, 0); PG8_STAGE(PG8_SA(1, 1), a1, vAc[1]);
            PG8_WAIT_V(8); PG8_WAIT_L(0); PG8_BAR; PG8_MMA(0, 0, At, B0); PG8_MMA(0, 1, At, B1); PG8_BAR; PG8_SCHED;
            PG8_LDA(At, 0, 1); PG8_STAGE(PG8_SB(0, 0), b2, voffB); PG8_STAGE(PG8_SB(0, 1), b2 + hstepB, voffB); PG8_STAGE(PG8_SA(0, 0), a2, v2[0]);
            PG8_WAIT_V(8); PG8_WAIT_L(0); PG8_BAR; PG8_MMA(1, 0, At, B0); PG8_MMA(1, 1, At, B1); PG8_BAR; PG8_SCHED;
            PG8_LDB(B0, 1, 0); PG8_LDB(B1, 1, 1); PG8_SCHED; PG8_LDA(At, 1, 0); PG8_STAGE(PG8_SA(0, 1), a2, v2[1]);
            PG8_WAIT_V(8); PG8_WAIT_L(0); PG8_BAR; PG8_MMA(0, 0, At, B0); PG8_MMA(0, 1, At, B1); PG8_BAR; PG8_SCHED;
            PG8_LDA(At, 1, 1); PG8_STAGE(PG8_SB(1, 0), b3, voffB); PG8_STAGE(PG8_SB(1, 1), b3 + hstepB, voffB); PG8_STAGE(PG8_SA(1, 0), a3, v2[0]);
            PG8_WAIT_V(8); PG8_WAIT_L(0); PG8_BAR; PG8_MMA(1, 0, At, B0); PG8_MMA(1, 1, At, B1); PG8_BAR; PG8_SCHED;
        }
        if (wr == 0) PG8_BAR;
        E(acc, cur, wr, wc, fr, fq);
        if (!has_next) break;
#pragma unroll
        for (int a = 0; a < 2; ++a)
#pragma unroll
            for (int b = 0; b < 2; ++b)
#pragma unroll
                for (int m = 0; m < 4; ++m)
#pragma unroll
                    for (int n = 0; n < 2; ++n) acc[a][b][m][n] = (f32x4){0.f, 0.f, 0.f, 0.f};
        cur = nxt; cA = nA; cB = nB; ++ui;
        if (GATHER) {
#pragma unroll
            for (int i = 0; i < 2; ++i)
#pragma unroll
                for (int h = 0; h < 2; ++h) vAc[h][i] = vAn[h][i];
        }
        if (wr == 1) PG8_BAR;
    }
    PG8_WAIT_V(0);
    PG8_BAR;
#undef PG8_SA
#undef PG8_SB
#undef PG8_STAGE
#undef PG8_LDA
#undef PG8_LDB
#undef PG8_MMA
#undef PG8_WAIT_V
#undef PG8_WAIT_L
#undef PG8_BAR
#undef PG8_SCHED
}
}

typedef f32x4 AccT[2][2][4][2];
__device__ __forceinline__ float sq4(const f32x4 v) { return (v.x * v.x + v.y * v.y) + (v.z * v.z + v.w * v.w); }
__device__ __forceinline__ u32x4 pack8(const f32x4 a, const f32x4 b) { u32x4 w; w.x = pg8::cvt_pk_bf16(a.x, a.y); w.y = pg8::cvt_pk_bf16(a.z, a.w); w.z = pg8::cvt_pk_bf16(b.x, b.y); w.w = pg8::cvt_pk_bf16(b.z, b.w); return w; }
__device__ __forceinline__ u32x2 pack4(const f32x4 a) { u32x2 w; w.x = pg8::cvt_pk_bf16(a.x, a.y); w.y = pg8::cvt_pk_bf16(a.z, a.w); return w; }

struct EpiInProj {
    static constexpr bool PERM = true;
    bf16_t* PROJ; float* DTRAW; float* SSQQ; float* SSQKV;
    __device__ __forceinline__ void operator()(const AccT& acc, const pg8::Unit& u, int wr, int wc, int fr, int fq) const {
        const int row0 = u.pm * 256 + wr * 64 + fr, col0 = u.pn * 256 + wc * 32 + 8 * fq;
#pragma unroll
        for (int ai = 0; ai < 2; ++ai)
#pragma unroll
            for (int m = 0; m < 4; ++m) {
                const int row = row0 + ai * 128 + m * 16;
                bf16_t* rowp = PROJ + (size_t)row * PROJ_N + col0;
#pragma unroll
                for (int bj = 0; bj < 2; ++bj) *(u32x4*)(rowp + bj * 128) = pack8(acc[ai][bj][m][0], acc[ai][bj][m][1]);
                if (u.pn == 0) {
                    float s = (sq4(acc[ai][0][m][0]) + sq4(acc[ai][0][m][1])) + (sq4(acc[ai][1][m][0]) + sq4(acc[ai][1][m][1]));
                    s += __shfl_xor(s, 16); s += __shfl_xor(s, 32);
                    if (fq == 0) SSQQ[row * 4 + wc] = s;
                } else if (u.pn == 1) {
                    float s = sq4(acc[ai][0][m][0]) + sq4(acc[ai][0][m][1]);
                    s += __shfl_xor(s, 16); s += __shfl_xor(s, 32);
                    if (fq == 0) SSQKV[row * 4 + wc] = s;
                    if (wc == 1 && fq < 2) { *(f32x4*)(DTRAW + row * 16 + 8 * fq) = acc[ai][1][m][0]; *(f32x4*)(DTRAW + row * 16 + 8 * fq + 4) = acc[ai][1][m][1]; }
                }
            }
    }
};
struct EpiQUp {
    static constexpr bool PERM = false;
    bf16_t* Q; const float* SSQQ; const float* COS; const float* SIN;
    __device__ __forceinline__ void operator()(const AccT& acc, const pg8::Unit& u, int wr, int wc, int fr, int fq) const {
#pragma unroll
        for (int ai = 0; ai < 2; ++ai)
#pragma unroll
            for (int m = 0; m < 4; ++m) {
                asm volatile("" ::: "memory");
                const int row = u.pm * 256 + ai * 128 + wr * 64 + m * 16 + fr, b = row / S, s = row % S;
                const f32x4 sv = *(const f32x4*)(SSQQ + row * 4);
                const float rs = 1.f / sqrtf(((sv.x + sv.y) + (sv.z + sv.w)) * (1.f / 256.f) + EPS);
                const f32x4 cs = *(const f32x4*)(COS + row * 16 + 4 * fq), sn = *(const f32x4*)(SIN + row * 16 + 4 * fq);
#pragma unroll
                for (int bj = 0; bj < 2; ++bj) {
                    const int g32 = 8 * u.pn + 4 * bj + wc, h = g32 / 3, part = g32 % 3;
                    f32x4 v0 = acc[ai][bj][m][0] * rs, v1 = acc[ai][bj][m][1] * rs;
                    if (part == 2) { const f32x4 o0 = v0 * cs - v1 * sn, o1 = v1 * cs + v0 * sn; v0 = o0; v1 = o1; }
                    bf16_t* qp = Q + ((size_t)(b * NH + h) * S + s) * DQK + part * 32 + 4 * fq;
                    *(u32x2*)qp = pack4(v0); *(u32x2*)(qp + 16) = pack4(v1);
                }
            }
    }
};
struct EpiKVUp {
    static constexpr bool PERM = true;
    bf16_t* Kb; bf16_t* Vb; const float* SSQKV;
    __device__ __forceinline__ void operator()(const AccT& acc, const pg8::Unit& u, int wr, int wc, int fr, int fq) const {
#pragma unroll
        for (int ai = 0; ai < 2; ++ai)
#pragma unroll
            for (int m = 0; m < 4; ++m) {
                asm volatile("" ::: "memory");
                const int row = u.pm * 256 + ai * 128 + wr * 64 + m * 16 + fr, b = row / S, s = row % S;
                const f32x4 sv = *(const f32x4*)(SSQKV + row * 4);
                const float rs = 1.f / sqrtf(((sv.x + sv.y) + (sv.z + sv.w)) * (1.f / 128.f) + EPS);
#pragma unroll
                for (int bj = 0; bj < 2; ++bj) {
                    const int h = 2 * u.pn + bj; const size_t tile = (size_t)(b * NH + h) * (S / 64) + (s >> 6);
                    const u32x4 w = pack8(acc[ai][bj][m][0] * rs, acc[ai][bj][m][1] * rs);
                    if (wc < 2) *(u32x4*)(Kb + (tile * 12 + 4 * wc + fq) * 512 + (s & 63) * 8) = w;
                    else *(u32x4*)(Vb + (tile * 16 + (wc - 2) * 8 + ((s & 63) >> 3)) * 256 + (s & 7) * 32 + 8 * fq) = w;
                }
            }
    }
};
struct EpiResid {
    static constexpr bool PERM = false;
    const float* base; float* out; float* SSQ;
    __device__ __forceinline__ void operator()(const AccT& acc, const pg8::Unit& u, int wr, int wc, int fr, int fq) const {
#pragma unroll
        for (int ai = 0; ai < 2; ++ai)
#pragma unroll
            for (int m = 0; m < 4; ++m) {
                const int row = u.pm * 256 + ai * 128 + wr * 64 + m * 16 + fr;
                const size_t ro = (size_t)row * D + u.pn * 256 + wc * 32 + 4 * fq;
                float s = 0.f;
#pragma unroll
                for (int bj = 0; bj < 2; ++bj)
#pragma unroll
                    for (int n = 0; n < 2; ++n) { const size_t o = ro + bj * 128 + n * 16; const f32x4 v = *(const f32x4*)(base + o) + acc[ai][bj][m][n]; *(f32x4*)(out + o) = v; s += sq4(v); }
                s += __shfl_xor(s, 16); s += __shfl_xor(s, 32);
                if (fq == 0) SSQ[row * 16 + u.pn * 4 + wc] = s;
            }
    }
};
struct EpiPleProj {
    static constexpr bool PERM = true;
    bf16_t* O; float* SSQ;
    __device__ __forceinline__ void operator()(const AccT& acc, const pg8::Unit& u, int wr, int wc, int fr, int fq) const {
#pragma unroll
        for (int ai = 0; ai < 2; ++ai)
#pragma unroll
            for (int m = 0; m < 4; ++m) {
                const int row = u.pm * 256 + ai * 128 + wr * 64 + m * 16 + fr;
                bf16_t* rowp = O + (size_t)row * D + u.pn * 256 + wc * 32 + 8 * fq;
#pragma unroll
                for (int bj = 0; bj < 2; ++bj) *(u32x4*)(rowp + bj * 128) = pack8(acc[ai][bj][m][0], acc[ai][bj][m][1]);
                float s = (sq4(acc[ai][0][m][0]) + sq4(acc[ai][0][m][1])) + (sq4(acc[ai][1][m][0]) + sq4(acc[ai][1][m][1]));
                s += __shfl_xor(s, 16); s += __shfl_xor(s, 32);
                if (fq == 0) SSQ[row * 16 + u.pn * 4 + wc] = s;
            }
    }
};
struct EpiPleGate {
    static constexpr bool PERM = true;
    float* out; const bf16_t* PR; const float* SSQ; const float* bias; const float* wpost;
    __device__ __forceinline__ void operator()(const AccT& acc, const pg8::Unit& u, int wr, int wc, int fr, int fq) const {
#pragma unroll
        for (int ai = 0; ai < 2; ++ai)
#pragma unroll
            for (int m = 0; m < 4; ++m) {
                const int row = u.pm * 256 + ai * 128 + wr * 64 + m * 16 + fr;
                float ss = 0.f;
#pragma unroll
                for (int q = 0; q < 4; ++q) { const f32x4 sv = *(const f32x4*)(SSQ + row * 16 + 4 * q); ss += (sv.x + sv.y) + (sv.z + sv.w); }
                const float rs = 1.f / sqrtf(ss * (1.f / D) + EPS);
#pragma unroll
                for (int bj = 0; bj < 2; ++bj) {
                    const int col = u.pn * 256 + bj * 128 + wc * 32 + 8 * fq;
                    const u32x4 pr = *(const u32x4*)(PR + (size_t)row * D + col);
                    const unsigned pw[4] = {pr.x, pr.y, pr.z, pr.w};
#pragma unroll
                    for (int n = 0; n < 2; ++n) {
                        const f32x4 bv = *(const f32x4*)(bias + col + 4 * n), wv = *(const f32x4*)(wpost + col + 4 * n);
                        f32x4* op = (f32x4*)(out + (size_t)row * D + col + 4 * n); f32x4 o = *op; const f32x4 av = acc[ai][bj][m][n] + bv;
                        const f32x4 pl = (f32x4){bf2f(pw[2 * n] & 0xffffu), bf2f(pw[2 * n] >> 16), bf2f(pw[2 * n + 1] & 0xffffu), bf2f(pw[2 * n + 1] >> 16)} * rs * wv;
#pragma unroll
                        for (int j = 0; j < 4; ++j) o[j] += pl[j] / (1.f + __expf(-av[j]));
                        *op = o;
                    }
                }
            }
    }
};

struct GroupSched {
    const volatile LAS unsigned* ptile; int npn, G, c;
    __device__ __forceinline__ bool next(int i, pg8::Unit& u) const {
        const int L = i * G + c, total = (int)ptile[32] * npn; if (L >= total) return false;
        int e = 0;
        for (int q = 1; q < 32; ++q) e = (L >= (int)ptile[q] * npn) ? q : e;
        const int l = L - (int)ptile[e] * npn;
        u.pm = __builtin_amdgcn_readfirstlane((int)ptile[e] + l / npn); u.pn = __builtin_amdgcn_readfirstlane(e * npn + l % npn); return true;
    }
};
struct EpiMoeGU {
    static constexpr bool PERM = true;
    bf16_t* HE;
    __device__ __forceinline__ void operator()(const AccT& acc, const pg8::Unit& u, int wr, int wc, int fr, int fq) const {
        const int pn_l = u.pn & 1;
#pragma unroll
        for (int ai = 0; ai < 2; ++ai)
#pragma unroll
            for (int m = 0; m < 4; ++m) {
                const size_t row = (size_t)u.pm * 256 + ai * 128 + wr * 64 + m * 16 + fr;
                f32x4 h0, h1;
#pragma unroll
                for (int j = 0; j < 4; ++j) { const float g0 = acc[ai][0][m][0][j], g1 = acc[ai][0][m][1][j];
                    h0[j] = g0 / (1.f + __expf(-g0)) * acc[ai][1][m][0][j]; h1[j] = g1 / (1.f + __expf(-g1)) * acc[ai][1][m][1][j]; }
                *(u32x4*)(HE + row * 256 + pn_l * 128 + wc * 32 + 8 * fq) = pack8(h0, h1);
            }
    }
};
struct EpiMoeDown {
    static constexpr bool PERM = true;
    bf16_t* Y; const int* BUCKET; const float* ROUTE; const volatile LAS unsigned* ptile; const volatile LAS unsigned* cnt;
    __device__ __forceinline__ void operator()(const AccT& acc, const pg8::Unit& u, int wr, int wc, int fr, int fq) const {
        const int e = u.pn >> 2, pn_l = u.pn & 3, pm_l = u.pm - (int)ptile[e], n_e = (int)cnt[e];
#pragma unroll
        for (int ai = 0; ai < 2; ++ai)
#pragma unroll
            for (int m = 0; m < 4; ++m) {
                const int idx = pm_l * 256 + ai * 128 + wr * 64 + m * 16 + fr;
                if (idx < n_e) {
                    const int ent = BUCKET[(size_t)e * T + idx];
                    const float w = ROUTE[(ent >> 1) * 4 + 2 + (ent & 1)];
                    bf16_t* yp = Y + (size_t)ent * D + pn_l * 256 + wc * 32 + 8 * fq;
#pragma unroll
                    for (int bj = 0; bj < 2; ++bj) *(u32x4*)(yp + bj * 128) = pack8(acc[ai][bj][m][0] * w, acc[ai][bj][m][1] * w);
                }
            }
    }
};

template <class CM, class GN>
__device__ __forceinline__ void transpose_item(const float* W, int ldw, int K, bf16_t* WT, float* scr, int kb, int nb, int lane, CM cm, GN gain) {
    const int k0 = 64 * kb, n0 = 32 * nb;
    const int sc = cm(n0 + (lane & 31));
#pragma unroll 8
    for (int i = 0; i < 32; ++i) { const int kk = 2 * i + (lane >> 5); scr[kk * 33 + (lane & 31)] = sc >= 0 ? W[(size_t)(k0 + kk) * ldw + sc] * gain(k0 + kk) : 0.f; }
    asm volatile("s_waitcnt lgkmcnt(0)" ::: "memory");
    const int c = lane & 7;
#pragma unroll
    for (int j = 0; j < 4; ++j) { const int n = (lane >> 3) + 8 * j; const float* s = scr + (8 * c) * 33 + n;
        u32x4 o; o.x = pk2(s[0 * 33], s[1 * 33]); o.y = pk2(s[2 * 33], s[3 * 33]); o.z = pk2(s[4 * 33], s[5 * 33]); o.w = pk2(s[6 * 33], s[7 * 33]);
        *(u32x4*)(WT + (size_t)(n0 + n) * K + k0 + 8 * c) = o; }
    asm volatile("s_waitcnt lgkmcnt(0)" ::: "memory");
}


namespace att {
typedef short bf16x8 __attribute__((ext_vector_type(8)));
typedef short s16x4 __attribute__((ext_vector_type(4)));
typedef float f32x16 __attribute__((ext_vector_type(16)));
typedef short v4i16_t __attribute__((ext_vector_type(4)));
typedef float f32x2_t __attribute__((ext_vector_type(2))); typedef __bf16 bf16x2_t __attribute__((ext_vector_type(2)));
constexpr int KT = 64, NT = S / KT, KBYTES = KT * DQK * 2, VBYTES = KT * DV * 2, STAGE = KBYTES + VBYTES;
__device__ __forceinline__ unsigned cvtpk(float lo, float hi) { f32x2_t v = {lo, hi}; bf16x2_t b = __builtin_convertvector(v, bf16x2_t); return __builtin_bit_cast(unsigned, b); }
__device__ __forceinline__ s16x4 vtr(const LAS unsigned char* p) { return __builtin_bit_cast(s16x4, __builtin_amdgcn_ds_read_tr16_b64_v4i16((LAS v4i16_t*)p)); }
__device__ __forceinline__ float half_max(float m) { auto rr = __builtin_amdgcn_permlane32_swap(__float_as_uint(m), __float_as_uint(m), false, false); return fmaxf(__uint_as_float(rr[0]), __uint_as_float(rr[1])); }
__device__ __forceinline__ float half_sum(float m) { auto rr = __builtin_amdgcn_permlane32_swap(__float_as_uint(m), __float_as_uint(m), false, false); return __uint_as_float(rr[0]) + __uint_as_float(rr[1]); }

constexpr int KRING = 0, VRING = 4 * KBYTES, ATT_THR = 8;
__device__ __forceinline__ void attn_unit(LAS unsigned char* lds, const bf16_t* Qg, const bf16_t* Kg, const bf16_t* Vg, bf16_t* MIXg, int bh, int qb) {
    int tid = threadIdx.x; asm volatile("" : "+v"(tid));
    const int lane = tid & 63, wid = __builtin_amdgcn_readfirstlane(tid >> 6), r32 = lane & 31, hi = lane >> 5;
    const size_t rowbase = (size_t)bh * S;
    const bf16_t* qrow = Qg + (rowbase + qb * 256 + wid * 32 + r32) * DQK + 8 * hi;
    bf16x8 qf[6];
#pragma unroll
    for (int ds = 0; ds < 6; ++ds) qf[ds] = *(const bf16x8*)(qrow + ds * 16);
    const char* ksrc0 = (const char*)(Kg + rowbase * DQK) + wid * 1024 + lane * 16;
    const char* ksrc1 = ksrc0 + 8 * 1024;
    const char* vsrc = (const char*)(Vg + rowbase * DV) + wid * 1024 + lane * 16;
#define ATT_DMA_K(t, slot) do { \
        __builtin_amdgcn_global_load_lds((const unsigned*)(ksrc0 + (size_t)(t) * (KT * DQK * 2)), (LAS unsigned*)(lds + KRING + (slot) * KBYTES + wid * 1024), 16, 0, 0); \
        if (wid < 4) __builtin_amdgcn_global_load_lds((const unsigned*)(ksrc1 + (size_t)(t) * (KT * DQK * 2)), (LAS unsigned*)(lds + KRING + (slot) * KBYTES + (wid + 8) * 1024), 16, 0, 0); } while (0)
#define ATT_DMA_V(t, slot) __builtin_amdgcn_global_load_lds((const unsigned*)(vsrc + (size_t)(t) * (KT * DV * 2)), (LAS unsigned*)(lds + VRING + (slot) * VBYTES + wid * 1024), 16, 0, 0)
#define ATT_SYNC() do { asm volatile("s_waitcnt vmcnt(0) lgkmcnt(0)" ::: "memory"); __builtin_amdgcn_s_barrier(); __builtin_amdgcn_sched_barrier(0); } while (0)
#define ATT_SYNCN(tau) do { if ((tau) + 2 < NT) { if (g0) asm volatile("s_waitcnt vmcnt(3) lgkmcnt(0)" ::: "memory"); else asm volatile("s_waitcnt vmcnt(2) lgkmcnt(0)" ::: "memory"); } \
        else asm volatile("s_waitcnt vmcnt(0) lgkmcnt(0)" ::: "memory"); __builtin_amdgcn_s_barrier(); __builtin_amdgcn_sched_barrier(0); } while (0)
    const int koff = KRING + hi * 1024 + r32 * 16;
    const int voff = VRING + (4 * hi + ((lane & 15) >> 2)) * 64 + ((lane >> 4) & 1) * 32 + (lane & 3) * 8;
    f32x16 o0 = {}, o1 = {}, negm = {};
    float mref = 0.f, lpart = 0.f;
    f32x16 sA0, sA1, sB0, sB1;
    u32x4 pw[4];
    bf16x8 kf[12], vf[8];
#define ATT_SB() __builtin_amdgcn_sched_barrier(0)
#define ATT_LOADK(kslot) do { const LAS unsigned char* kb_ = lds + koff + (kslot) * KBYTES; \
        _Pragma("unroll") for (int ds = 0; ds < 6; ++ds) { kf[2 * ds] = *(const LAS bf16x8*)(kb_ + ds * 2048); kf[2 * ds + 1] = *(const LAS bf16x8*)(kb_ + ds * 2048 + 512); } } while (0)
#define ATT_LOADV(vslot) do { const LAS unsigned char* vb_ = lds + voff + (vslot) * VBYTES; \
        _Pragma("unroll") for (int ks = 0; ks < 4; ++ks) { \
            const s16x4 a0_ = vtr(vb_ + (2 * ks) * 512), a1_ = vtr(vb_ + (2 * ks + 1) * 512), b0_ = vtr(vb_ + (8 + 2 * ks) * 512), b1_ = vtr(vb_ + (8 + 2 * ks + 1) * 512); \
            vf[2 * ks] = (bf16x8){a0_[0], a0_[1], a0_[2], a0_[3], a1_[0], a1_[1], a1_[2], a1_[3]}; \
            vf[2 * ks + 1] = (bf16x8){b0_[0], b0_[1], b0_[2], b0_[3], b1_[0], b1_[1], b1_[2], b1_[3]}; } } while (0)
#define ATT_QK(X0, X1) do { \
        X0 = __builtin_amdgcn_mfma_f32_32x32x16_bf16(kf[0], qf[0], negm, 0, 0, 0); X1 = __builtin_amdgcn_mfma_f32_32x32x16_bf16(kf[1], qf[0], negm, 0, 0, 0); \
        _Pragma("unroll") for (int ds = 1; ds < 6; ++ds) { X0 = __builtin_amdgcn_mfma_f32_32x32x16_bf16(kf[2 * ds], qf[ds], X0, 0, 0, 0); X1 = __builtin_amdgcn_mfma_f32_32x32x16_bf16(kf[2 * ds + 1], qf[ds], X1, 0, 0, 0); } } while (0)
#define ATT_PV() do { \
        _Pragma("unroll") for (int ks = 0; ks < 4; ++ks) { const bf16x8 pf_ = __builtin_bit_cast(bf16x8, pw[ks]); \
            o0 = __builtin_amdgcn_mfma_f32_32x32x16_bf16(vf[2 * ks], pf_, o0, 0, 0, 0); o1 = __builtin_amdgcn_mfma_f32_32x32x16_bf16(vf[2 * ks + 1], pf_, o1, 0, 0, 0); } } while (0)
#define ATT_MAXPHASE(X0, X1, FIRST) do { \
        float mx_ = fmaxf(fmaxf(X0[0], X0[1]), X1[0]); float my_ = fmaxf(fmaxf(X0[2], X0[3]), X1[1]); mx_ = fmaxf(fmaxf(mx_, X1[2]), X1[3]); \
        _Pragma("unroll") for (int r = 4; r < 16; r += 4) { mx_ = fmaxf(fmaxf(mx_, X0[r]), X0[r + 1]); my_ = fmaxf(fmaxf(my_, X0[r + 2]), X0[r + 3]); mx_ = fmaxf(fmaxf(mx_, X1[r]), X1[r + 1]); my_ = fmaxf(fmaxf(my_, X1[r + 2]), X1[r + 3]); } \
        mx_ = half_max(fmaxf(mx_, my_)); \
        if ((FIRST) || __builtin_expect(__any(mx_ > (float)ATT_THR), 0)) { \
            asm volatile("; rescale (rare)" ::: "memory"); const float dl_ = (FIRST) ? mx_ : fmaxf(mx_, 0.f); mref += dl_; const float f_ = (FIRST) ? 1.f : __builtin_amdgcn_exp2f(-dl_); \
            _Pragma("unroll") for (int r = 0; r < 16; ++r) { X0[r] -= dl_; X1[r] -= dl_; o0[r] *= f_; o1[r] *= f_; negm[r] = -mref; } \
            lpart *= f_; asm volatile("" : "+v"(negm)); } } while (0)
#define ATT_EXPPHASE(X0, X1) do { float ls_ = 0.f; \
        _Pragma("unroll") for (int r = 0; r < 16; ++r) { X0[r] = __builtin_amdgcn_exp2f(X0[r]); X1[r] = __builtin_amdgcn_exp2f(X1[r]); ls_ += X0[r] + X1[r]; } \
        lpart += ls_; \
        _Pragma("unroll") for (int s = 0; s < 2; ++s) { \
            pw[s] = (u32x4){cvtpk(X0[8 * s], X0[8 * s + 1]), cvtpk(X0[8 * s + 2], X0[8 * s + 3]), cvtpk(X0[8 * s + 4], X0[8 * s + 5]), cvtpk(X0[8 * s + 6], X0[8 * s + 7])}; \
            pw[2 + s] = (u32x4){cvtpk(X1[8 * s], X1[8 * s + 1]), cvtpk(X1[8 * s + 2], X1[8 * s + 3]), cvtpk(X1[8 * s + 4], X1[8 * s + 5]), cvtpk(X1[8 * s + 6], X1[8 * s + 7])}; } } while (0)
#define ATT_ISSUE(t) do { if ((t) + 3 < NT) ATT_DMA_K((t) + 3, ((t) + 3) & 3); if ((t) + 2 < NT) ATT_DMA_V((t) + 2, ((t) + 2) & 3); } while (0)

    const bool g0 = wid < 4;
#define ATT_X(C0, C1, t) do { ATT_LOADV(((t) - 1) & 3); ATT_SB(); ATT_PV(); ATT_SB(); ATT_MAXPHASE(C0, C1, false); ATT_SB(); } while (0)
#define ATT_Y(C0, C1, N0, N1, t) do { ATT_LOADK(((t) + 1) & 3); ATT_SB(); ATT_EXPPHASE(C0, C1); ATT_SB(); ATT_QK(N0, N1); ATT_SB(); } while (0)
    ATT_DMA_K(0, 0); ATT_DMA_V(0, 0); ATT_DMA_K(1, 1);
    ATT_SYNC();
    ATT_DMA_K(2, 2); ATT_DMA_V(1, 1);
    ATT_LOADK(0); ATT_QK(sA0, sA1);
    ATT_SYNC();
    ATT_ISSUE(0);
    ATT_MAXPHASE(sA0, sA1, true);
    if (!g0) { ATT_SYNCN(1); ATT_ISSUE(1); }
    ATT_Y(sA0, sA1, sB0, sB1, 0);
    for (int t = 1; t + 2 < NT; t += 2) {
        if (g0) { ATT_SYNCN(t); ATT_ISSUE(t); }
        ATT_X(sB0, sB1, t);
        if (!g0) { ATT_SYNCN(t + 1); ATT_ISSUE(t + 1); }
        ATT_Y(sB0, sB1, sA0, sA1, t);
        if (g0) { ATT_SYNCN(t + 1); ATT_ISSUE(t + 1); }
        ATT_X(sA0, sA1, t + 1);
        if (!g0) { ATT_SYNCN(t + 2); ATT_ISSUE(t + 2); }
        ATT_Y(sA0, sA1, sB0, sB1, t + 1);
    }
    if (g0) { ATT_SYNCN(NT - 1); }
    ATT_X(sB0, sB1, NT - 1);
    ATT_EXPPHASE(sB0, sB1);
    ATT_LOADV((NT - 1) & 3); ATT_PV();
#undef ATT_X
#undef ATT_Y
    const float rl = 1.f / half_sum(lpart);
    const int b = bh >> 3, h = bh & 7;
    bf16_t* orow = MIXg + ((size_t)b * S + qb * 256 + wid * 32 + r32) * D + h * 64 + 4 * hi;
#pragma unroll
    for (int g4 = 0; g4 < 4; ++g4) {
        u32x2 w0, w1;
        w0.x = cvtpk(o0[4 * g4] * rl, o0[4 * g4 + 1] * rl); w0.y = cvtpk(o0[4 * g4 + 2] * rl, o0[4 * g4 + 3] * rl);
        w1.x = cvtpk(o1[4 * g4] * rl, o1[4 * g4 + 1] * rl); w1.y = cvtpk(o1[4 * g4 + 2] * rl, o1[4 * g4 + 3] * rl);
        *(u32x2*)(orow + 8 * g4) = w0; *(u32x2*)(orow + 32 + 8 * g4) = w1;
    }
    asm volatile("s_waitcnt lgkmcnt(0)" ::: "memory"); __builtin_amdgcn_s_barrier();
#undef ATT_DMA_K
#undef ATT_DMA_V
#undef ATT_SYNC
#undef ATT_QK
#undef ATT_PV
#undef ATT_MAXPHASE
#undef ATT_EXPPHASE
#undef ATT_SYNCN
#undef ATT_LOADK
#undef ATT_LOADV
#undef ATT_SB
#undef ATT_ISSUE
}
}


namespace ssd {
typedef short bf16x8 __attribute__((ext_vector_type(8)));
typedef short bf16x4 __attribute__((ext_vector_type(4)));
typedef float f32x16 __attribute__((ext_vector_type(16)));
constexpr int CH = 128, NCH = S / CH;
constexpr float LOG2E = 1.4426950408889634f;
__device__ __forceinline__ int crow(int r, int hi) { return (r & 3) + 8 * (r >> 2) + 4 * hi; }
__device__ __forceinline__ unsigned cvtpk(float lo, float hi) { return att::cvtpk(lo, hi); }
__device__ __forceinline__ void scan128(float a0, float a1, int lane, float& p0, float& p1, float& tot) {
    float s = a0 + a1;
#pragma unroll
    for (int o = 1; o < 64; o <<= 1) { const float t = __shfl_up(s, o); if (lane >= o) s += t; }
    tot = __shfl(s, 63); p1 = s; p0 = s - a1;
}
__device__ __forceinline__ void conv_chunk(float* smf, const bf16_t* PROJ, const float* cw, const float* cb, bf16_t* XBCC, bf16_t* XT, bf16_t* BT,
                                           const float* DTRAW, const float* dtb, float* DT, int b, int c) {
    int tid = threadIdx.x; asm volatile("" : "+v"(tid));
    const int t0 = b * S + c * CH, s0 = c * CH;
    if (tid < 2048 / 4) {
        const f32x4 raw = *(const f32x4*)(DTRAW + (size_t)t0 * 16 + tid * 4); const f32x4 bb = *(const f32x4*)(dtb + ((tid * 4) & 15)); f32x4 o;
#pragma unroll
        for (int j = 0; j < 4; ++j) { const float v = raw[j] + bb[j]; o[j] = v > 20.f ? v : log1pf(expf(v)); }
        *(f32x4*)(DT + (size_t)t0 * 16 + tid * 4) = o;
    }
    const int ch = tid & 127, lq = tid >> 7;
    for (int cbk = 0; cbk < 6; ++cbk) {
        __syncthreads();
        for (int i = tid; i < 132 * 16; i += 512) {
            const int r = i >> 4, c8 = (i & 15) * 8, ss = s0 - 2 + r;
            u32x4 v = (u32x4){0u, 0u, 0u, 0u};
            if (ss >= 0 && ss < S) v = *(const u32x4*)(PROJ + (size_t)(b * S + ss) * PROJ_N + PC_XBC + cbk * 128 + c8);
            float* d = smf + r * 128 + c8;
            d[0] = bf2f(v.x & 0xffffu); d[1] = bf2f(v.x >> 16); d[2] = bf2f(v.y & 0xffffu); d[3] = bf2f(v.y >> 16);
            d[4] = bf2f(v.z & 0xffffu); d[5] = bf2f(v.z >> 16); d[6] = bf2f(v.w & 0xffffu); d[7] = bf2f(v.w >> 16);
        }
        __syncthreads();
        const int gch = cbk * 128 + ch;
        float w[5];
#pragma unroll
        for (int k = 0; k < 5; ++k) w[k] = cw[k * XBC + gch];
        const float bias = cb[gch];
        unsigned pk[16];
        float x0 = smf[(lq * 32 + 0) * 128 + ch], x1 = smf[(lq * 32 + 1) * 128 + ch], x2 = smf[(lq * 32 + 2) * 128 + ch], x3 = smf[(lq * 32 + 3) * 128 + ch];
        float prev = 0.f;
#pragma unroll
        for (int l = 0; l < 32; ++l) {
            const float x4 = smf[(lq * 32 + l + 4) * 128 + ch];
            const float acc = bias + w[0] * x0 + w[1] * x1 + w[2] * x2 + w[3] * x3 + w[4] * x4;
            const float v = acc / (1.f + __expf(-acc));
            XBCC[(size_t)(t0 + lq * 32 + l) * XBC + gch] = (bf16_t)f2bf(v);
            if (l & 1) pk[l >> 1] = pk2(prev, v); else prev = v;
            x0 = x1; x1 = x2; x2 = x3; x3 = x4;
        }
        if (cbk < 5) {
            bf16_t* dst = cbk < 4 ? XT + ((size_t)(b * NCH + c) * 512 + gch) * CH + lq * 32 : BT + ((size_t)(b * NCH + c) * 128 + ch) * CH + lq * 32;
#pragma unroll
            for (int q = 0; q < 4; ++q) *(u32x4*)(dst + q * 8) = (u32x4){pk[4 * q], pk[4 * q + 1], pk[4 * q + 2], pk[4 * q + 3]};
        }
    }
    __syncthreads();
}
__device__ __forceinline__ void states_chunk(float* wtab_all, const bf16_t* XT, const bf16_t* BT, const float* DT, const float* alog, float* STATES, float* CDEC, int b, int c) {
    int tid = threadIdx.x; asm volatile("" : "+v"(tid));
    const int lane = tid & 63, hd = __builtin_amdgcn_readfirstlane(tid >> 6), g = hd >> 2, r32 = lane & 31, hi = lane >> 5;
    float* wtab = wtab_all + hd * 128;
    const size_t t0 = (size_t)b * S + c * CH;
    const bf16_t* xt = XT + ((size_t)(b * NCH + c) * 512 + hd * 64) * CH; const bf16_t* bt = BT + ((size_t)(b * NCH + c) * 128 + g * 64) * CH;
    for (int dir = 0; dir < 2; ++dir) {
        const float av = -expf(alog[dir * 8 + hd]);
        const float d0 = DT[(t0 + 2 * lane) * 16 + dir * 8 + hd], d1 = DT[(t0 + 2 * lane + 1) * 16 + dir * 8 + hd];
        float p0, p1, tot; scan128(d0 * av, d1 * av, lane, p0, p1, tot);
        const float w0 = dir == 0 ? __expf(tot - p0) * d0 : __expf(p0 - d0 * av) * d0;
        const float w1 = dir == 0 ? __expf(tot - p1) * d1 : __expf(p1 - d1 * av) * d1;
        wtab[2 * lane] = w0; wtab[2 * lane + 1] = w1;
        if (lane == 0) CDEC[((b * NCH + c) * 2 + dir) * 8 + hd] = __expf(tot);
        asm volatile("s_waitcnt lgkmcnt(0)" ::: "memory");
        f32x16 acc[2][2];
#pragma unroll
        for (int i = 0; i < 2; ++i)
#pragma unroll
            for (int j = 0; j < 2; ++j) acc[i][j] = (f32x16){};
#pragma unroll 2
        for (int ks = 0; ks < 8; ++ks) {
            const f32x4 wa = *(const f32x4*)(wtab + 16 * ks + 8 * hi), wb = *(const f32x4*)(wtab + 16 * ks + 8 * hi + 4);
            bf16x8 xb[2], bb[2];
#pragma unroll
            for (int pb = 0; pb < 2; ++pb) {
                const u32x4 v = *(const u32x4*)(xt + (size_t)(32 * pb + r32) * CH + 16 * ks + 8 * hi);
                u32x4 o; o.x = cvtpk(bf2f(v.x & 0xffffu) * wa.x, bf2f(v.x >> 16) * wa.y); o.y = cvtpk(bf2f(v.y & 0xffffu) * wa.z, bf2f(v.y >> 16) * wa.w);
                o.z = cvtpk(bf2f(v.z & 0xffffu) * wb.x, bf2f(v.z >> 16) * wb.y); o.w = cvtpk(bf2f(v.w & 0xffffu) * wb.z, bf2f(v.w >> 16) * wb.w);
                xb[pb] = __builtin_bit_cast(bf16x8, o);
            }
#pragma unroll
            for (int nb = 0; nb < 2; ++nb) bb[nb] = *(const bf16x8*)(bt + (size_t)(32 * nb + r32) * CH + 16 * ks + 8 * hi);
#pragma unroll
            for (int nb = 0; nb < 2; ++nb)
#pragma unroll
                for (int pb = 0; pb < 2; ++pb) acc[nb][pb] = __builtin_amdgcn_mfma_f32_32x32x16_bf16(bb[nb], xb[pb], acc[nb][pb], 0, 0, 0);
        }
        float* st = STATES + ((size_t)((b * NCH + c) * 2 + dir) * 8 + hd) * 4096;
#pragma unroll
        for (int nb = 0; nb < 2; ++nb)
#pragma unroll
            for (int pb = 0; pb < 2; ++pb)
#pragma unroll
                for (int q = 0; q < 4; ++q)
                    *(f32x4*)(st + (32 * pb + r32) * 64 + 32 * nb + 8 * q + 4 * hi) = (f32x4){acc[nb][pb][4 * q], acc[nb][pb][4 * q + 1], acc[nb][pb][4 * q + 2], acc[nb][pb][4 * q + 3]};
    }
}
__device__ __forceinline__ void finalize_chunk(float* smf, const bf16_t* XBCC, const bf16_t* XT, const bf16_t* PROJ, const float* DT, const float* alog, const float* STATES,
                                               const float* ssdd, const float* ssdnw, bf16_t* MIX, int b, int c) {
    int tid = threadIdx.x; asm volatile("" : "+v"(tid));
    const int lane = tid & 63, hd = __builtin_amdgcn_readfirstlane(tid >> 6), g = hd >> 2, r32 = lane & 31, hi = lane >> 5;
    f32x4* tab = (f32x4*)smf + hd * 128;
    float* red = smf + 8 * 128 * 4;
    const size_t t0 = (size_t)b * S + c * CH;
    {
        const float af = -expf(alog[hd]), ab = -expf(alog[8 + hd]);
        const float f0 = DT[(t0 + 2 * lane) * 16 + hd], f1 = DT[(t0 + 2 * lane + 1) * 16 + hd];
        const float b0 = DT[(t0 + 2 * lane) * 16 + 8 + hd], b1 = DT[(t0 + 2 * lane + 1) * 16 + 8 + hd];
        float pf0, pf1, tf, pb0, pb1, tb;
        scan128(f0 * af, f1 * af, lane, pf0, pf1, tf); scan128(b0 * ab, b1 * ab, lane, pb0, pb1, tb);
        tab[2 * lane] = (f32x4){pf0, f0, tb - (pb0 - b0 * ab), b0}; tab[2 * lane + 1] = (f32x4){pf1, f1, tb - (pb1 - b1 * ab), b1};
        asm volatile("s_waitcnt lgkmcnt(0)" ::: "memory");
    }
    const bf16_t* xt = XT + ((size_t)(b * NCH + c) * 512 + hd * 64) * CH;
    const float dsk = ssdd[hd];
    for (int ib = 0; ib < 4; ++ib) {
        const int i = 32 * ib + r32;
        const f32x4 ti = tab[i];
        bf16x8 cf[4];
#pragma unroll
        for (int ks = 0; ks < 4; ++ks) cf[ks] = *(const bf16x8*)(XBCC + (t0 + i) * XBC + 640 + g * 64 + 16 * ks + 8 * hi);
        f32x16 yT[2]; yT[0] = (f32x16){}; yT[1] = (f32x16){};
#pragma unroll 1
        for (int jb = 0; jb < 4; ++jb) {
            f32x16 gt = (f32x16){};
#pragma unroll
            for (int ks = 0; ks < 4; ++ks) { const bf16x8 bfr = *(const bf16x8*)(XBCC + (t0 + 32 * jb + r32) * XBC + 512 + g * 64 + 16 * ks + 8 * hi);
                gt = __builtin_amdgcn_mfma_f32_32x32x16_bf16(bfr, cf[ks], gt, 0, 0, 0); }
#pragma unroll
            for (int r = 0; r < 16; ++r) {
                const int j = 32 * jb + crow(r, hi);
                const f32x4 tj = tab[j];
                const bool lt = j < i, gtj = j > i;
                const float arg = lt ? ti.x - tj.x : (gtj ? ti.z - tj.z : 0.f);
                const float dj = lt ? tj.y : (gtj ? tj.w : ti.y + ti.w);
                gt[r] = gt[r] * __builtin_amdgcn_exp2f(arg * LOG2E) * dj;
            }
            u32x4 pw[2];
#pragma unroll
            for (int s = 0; s < 2; ++s) pw[s] = (u32x4){cvtpk(gt[8 * s], gt[8 * s + 1]), cvtpk(gt[8 * s + 2], gt[8 * s + 3]), cvtpk(gt[8 * s + 4], gt[8 * s + 5]), cvtpk(gt[8 * s + 6], gt[8 * s + 7])};
#pragma unroll
            for (int s = 0; s < 2; ++s)
#pragma unroll
                for (int pb = 0; pb < 2; ++pb) {
                    const bf16_t* xp = xt + (size_t)(32 * pb + r32) * CH + 32 * jb + 16 * s + 4 * hi;
                    const u32x2 lo = *(const u32x2*)xp, hi2 = *(const u32x2*)(xp + 8);
                    const bf16x8 xf = __builtin_bit_cast(bf16x8, (u32x4){lo.x, lo.y, hi2.x, hi2.y});
                    yT[pb] = __builtin_amdgcn_mfma_f32_32x32x16_bf16(xf, __builtin_bit_cast(bf16x8, pw[s]), yT[pb], 0, 0, 0);
                }
        }
#pragma unroll 1
        for (int dir = 0; dir < 2; ++dir) {
            const float ei = __builtin_amdgcn_exp2f((dir == 0 ? ti.x : ti.z) * LOG2E);
            const float* st = STATES + ((size_t)((b * NCH + c) * 2 + dir) * 8 + hd) * 4096;
#pragma unroll
            for (int ks = 0; ks < 4; ++ks) {
                const u32x4 cv = __builtin_bit_cast(u32x4, cf[ks]);
                u32x4 cs; cs.x = cvtpk(bf2f(cv.x & 0xffffu) * ei, bf2f(cv.x >> 16) * ei); cs.y = cvtpk(bf2f(cv.y & 0xffffu) * ei, bf2f(cv.y >> 16) * ei);
                cs.z = cvtpk(bf2f(cv.z & 0xffffu) * ei, bf2f(cv.z >> 16) * ei); cs.w = cvtpk(bf2f(cv.w & 0xffffu) * ei, bf2f(cv.w >> 16) * ei);
#pragma unroll
                for (int pb = 0; pb < 2; ++pb) {
                    const float* hp = st + (32 * pb + r32) * 64 + 16 * ks + 8 * hi;
                    const f32x4 h0 = *(const f32x4*)hp, h1 = *(const f32x4*)(hp + 4);
                    const u32x4 hw = (u32x4){cvtpk(h0.x, h0.y), cvtpk(h0.z, h0.w), cvtpk(h1.x, h1.y), cvtpk(h1.z, h1.w)};
                    yT[pb] = __builtin_amdgcn_mfma_f32_32x32x16_bf16(__builtin_bit_cast(bf16x8, hw), __builtin_bit_cast(bf16x8, cs), yT[pb], 0, 0, 0);
                }
            }
        }
        float ss = 0.f;
#pragma unroll
        for (int pb = 0; pb < 2; ++pb)
#pragma unroll
            for (int q = 0; q < 4; ++q) {
                const int p = 32 * pb + 8 * q + 4 * hi;
                const u32x2 xv = *(const u32x2*)(XBCC + (t0 + i) * XBC + hd * 64 + p);
                const u32x2 zv = *(const u32x2*)(PROJ + (t0 + i) * PROJ_N + PC_Z + hd * 64 + p);
                const float xs[4] = {bf2f(xv.x & 0xffffu), bf2f(xv.x >> 16), bf2f(xv.y & 0xffffu), bf2f(xv.y >> 16)};
                const float zs[4] = {bf2f(zv.x & 0xffffu), bf2f(zv.x >> 16), bf2f(zv.y & 0xffffu), bf2f(zv.y >> 16)};
#pragma unroll
                for (int e = 0; e < 4; ++e) { const float y = yT[pb][4 * q + e] + dsk * xs[e]; const float gv = y * (zs[e] / (1.f + __expf(-zs[e]))); yT[pb][4 * q + e] = gv; ss += gv * gv; }
            }
        ss = att::half_sum(ss);
        __syncthreads();
        if (hi == 0) red[hd * 32 + r32] = ss;
        __syncthreads();
        float tot = 0.f;
#pragma unroll
        for (int w8 = 0; w8 < 8; ++w8) tot += red[w8 * 32 + r32];
        const float rstd = 1.f / sqrtf(tot * (1.f / 512.f) + EPS);
#pragma unroll
        for (int pb = 0; pb < 2; ++pb)
#pragma unroll
            for (int q = 0; q < 4; ++q) {
                const int p = 32 * pb + 8 * q + 4 * hi;
                const f32x4 wv = *(const f32x4*)(ssdnw + hd * 64 + p);
                u32x2 o; o.x = cvtpk(yT[pb][4 * q] * rstd * wv.x, yT[pb][4 * q + 1] * rstd * wv.y); o.y = cvtpk(yT[pb][4 * q + 2] * rstd * wv.z, yT[pb][4 * q + 3] * rstd * wv.w);
                *(u32x2*)(MIX + (t0 + i) * D + 512 + hd * 64 + p) = o;
            }
    }
    __syncthreads();
}
}

struct Args { const void* in[31]; float* out; unsigned char* ws; int ph_lo, ph_hi; };
#define IN_F(i) ((const float*)a.in[i])
enum { I_X = 0, I_P, I_POS, I_ATTN_NW, I_WIN, I_QNW, I_WUQ, I_KVNW, I_WUKV, I_AONW, I_CONVW, I_CONVB, I_DTB, I_ALOG, I_SSDD, I_SSDNW, I_WO, I_FFNNW,
       I_WRG, I_BRG, I_WRE, I_BRE, I_WEG, I_WEU, I_WED, I_PLENW, I_WPG, I_BPG, I_WPP, I_PPNW, I_FNW };

template <class FA, class FB, class FE>
__device__ __forceinline__ void naive_gemm(int M, int N, int K, FA fa, FB fb, FE fe, float* sm) {
    const int tid = threadIdx.x, tx = tid & 63, ty = tid >> 6;
    float* As = sm; float* Bs = sm + 64 * 17;
    const int ntm = M / 64, ntn = (N + 63) / 64;
    for (int tile = blockIdx.x; tile < ntm * ntn; tile += gridDim.x) {
        const int tm = tile / ntn, tn = tile % ntn;
        float acc[8];
#pragma unroll
        for (int j = 0; j < 8; ++j) acc[j] = 0.f;
        for (int k0 = 0; k0 < K; k0 += 16) {
            __syncthreads();
            for (int i = tid; i < 1024; i += 512) { const int r = i >> 4, c = i & 15; As[r * 17 + c] = fa(tm * 64 + r, k0 + c); }
            for (int i = tid; i < 1024; i += 512) { const int r = i >> 6, c = i & 63; const int n = tn * 64 + c; Bs[r * 64 + c] = (n < N) ? fb(k0 + r, n) : 0.f; }
            __syncthreads();
#pragma unroll
            for (int k = 0; k < 16; ++k) { const float b = Bs[k * 64 + tx];
#pragma unroll
                for (int j = 0; j < 8; ++j) acc[j] += As[(ty * 8 + j) * 17 + k] * b; }
        }
#pragma unroll
        for (int j = 0; j < 8; ++j) { const int m = tm * 64 + ty * 8 + j, n = tn * 64 + tx; if (n < N) fe(m, n, acc[j]); }
    }
    __syncthreads();
}

__device__ __forceinline__ int proj_src_col(int j) {
    if (j < 416) return j;
    if (j < 432) return 1696 + (j - 416);
    if (j < 512) return -1;
    if (j < 1024) return 416 + (j - 512);
    return 928 + (j - 1024);
}

__device__ __forceinline__ void rms_row_to_bf16(const float* xrow, const float* w, bf16_t* orow, int lane) {
    const f32x4* xr = (const f32x4*)xrow + lane; const f32x4* wr = (const f32x4*)w + lane;
    f32x4 v[4]; float s = 0.f;
#pragma unroll
    for (int j = 0; j < 4; ++j) { v[j] = xr[64 * j]; s += (v[j].x * v[j].x + v[j].y * v[j].y) + (v[j].z * v[j].z + v[j].w * v[j].w); }
    const float rstd = 1.f / sqrtf(wave_sum(s) * (1.f / D) + EPS);
    u32x2* o8 = (u32x2*)orow + lane;
#pragma unroll
    for (int j = 0; j < 4; ++j) { const f32x4 g = wr[64 * j]; u32x2 o; o.x = pk2(v[j].x * rstd * g.x, v[j].y * rstd * g.y); o.y = pk2(v[j].z * rstd * g.z, v[j].w * rstd * g.w); o8[64 * j] = o; }
}

constexpr int LDS_BYTES = 147456;
constexpr int MISC_OFF = 131072;

__global__ void __launch_bounds__(512, 2) fwd(Args a) {
    extern __shared__ __attribute__((aligned(16))) unsigned char lds_raw[];
    float* smf = (float*)lds_raw;
    const int G = gridDim.x, NGW = G * 8, NGT = G * 512;
#define FRESH_IDS() int tid = threadIdx.x; asm volatile("" : "+v"(tid)); const int lane = tid & 63, wave = __builtin_amdgcn_readfirstlane(tid >> 6); \
    const int gw = blockIdx.x * 8 + wave, gtid = blockIdx.x * 512 + tid; (void)lane; (void)gw; (void)gtid;
    unsigned char* ws = a.ws;
    unsigned* ctl = (unsigned*)(ws + WS_CTL);
    volatile LAS unsigned* MISC = (volatile LAS unsigned*)((LAS unsigned char*)lds_raw + MISC_OFF);
    if (threadIdx.x < 32) MISC[threadIdx.x] = 0u;
    __syncthreads();
#if !MK_PER_PHASE
    XcdBarrier bar = xcd_barrier_post(ctl + CW_BAR, MISC + 8);
#define GRID_BAR() xcd_barrier(bar)
#else
#define GRID_BAR() do {} while (0)
#endif
    const int lo = a.ph_lo, hi = a.ph_hi;
#ifndef PHMASK
#define PHMASK 0xFFFF
#endif
#define IN(k) (((PHMASK >> (k)) & 1) && lo <= (k) && (k) < hi)
#ifndef REPMASK
#define REPMASK 0
#endif
#define NREP(k) (1 + ((REPMASK >> (k)) & 1))
#define SEAM(k) do { if (IN(k) && IN((k) + 1)) GRID_BAR(); } while (0)

    const float* x = IN_F(I_X);
    float* out = a.out;
    bf16_t* H = (bf16_t*)(ws + WS_H);
    bf16_t* PROJ = (bf16_t*)(ws + WS_PROJ);
    bf16_t* PLERAW = (bf16_t*)(ws + WS_PROJ);
    bf16_t* Qb = (bf16_t*)(ws + WS_Q); bf16_t* Kb = (bf16_t*)(ws + WS_K); bf16_t* Vb = (bf16_t*)(ws + WS_V);
    bf16_t* MIX = (bf16_t*)(ws + WS_MIX);
    bf16_t* XBCC = (bf16_t*)(ws + WS_XBCC);
    float* STATES = out;
    bf16_t* XT = (bf16_t*)((char*)out + 64 * MiB);
    bf16_t* BT = (bf16_t*)((char*)out + 96 * MiB);
    float* CDEC = (float*)(ws + WS_CDEC);
    float* COS = (float*)(ws + WS_COS); float* SIN = (float*)(ws + WS_SIN);
    float* DT = (float*)(ws + WS_DT); float* DTRAW = (float*)(ws + WS_DTRAW);
    float* ROUTE = (float*)(ws + WS_ROUTE);
    int* BUCKET = (int*)(ws + WS_BUCKET);
    const int* pos = (const int*)a.in[I_POS];

    bf16_t* WT_IN = (bf16_t*)(ws + WS_WEIGHTS);
    bf16_t* WT_UQ = WT_IN + (size_t)PROJ_N * D;
    bf16_t* WT_UKV = WT_UQ + 768 * 256;
    bf16_t* WT_O = WT_UKV + 1024 * 128;
    bf16_t* WT_PG = WT_O + (size_t)D * D;
    bf16_t* WT_PP = WT_PG + (size_t)D * D;
    bf16_t* WT_GU = WT_PP + (size_t)D * 256;
    bf16_t* WT_DN = WT_GU + (size_t)32 * 512 * 1024;
    bf16_t* PB = (bf16_t*)(ws + WS_PB);
    float* SSQQ = (float*)(ws + WS_SSQQ); float* SSQKV = (float*)(ws + WS_SSQKV); float* SSQPLE = (float*)(ws + WS_SSQPLE);
    LAS unsigned char* ldsb = (LAS unsigned char*)lds_raw;
    bf16_t* WRF = (bf16_t*)(ws + WS_WRF);
    float* SSQX1 = (float*)(ws + WS_SSQX1);

    if (IN(0)) {
        FRESH_IDS();
        for (int rep_ = 0; rep_ < NREP(0); ++rep_) {
        float* scr = smf + wave * 4096;
        constexpr int I_IN = 16 * 56, I_UQ = 4 * 24, I_UKV = 2 * 32, I_O = 16 * 32, I_PG = 16 * 32, I_PP = 4 * 32, I_GU = 32 * 16 * 16, I_DN = 32 * 4 * 32;
        constexpr int NITEMS = I_IN + I_UQ + I_UKV + I_O + I_PG + I_PP + I_GU + I_DN;
        const float* qnw = IN_F(I_QNW); const float* kvnw = IN_F(I_KVNW);
        const float qscale = 0.10206207261596575f * 1.4426950408889634f;
        auto one = [](int) { return 1.f; };
        auto ident = [](int n) { return n; };
        for (int it = gw; it < NITEMS; it += NGW) {
            int r = it;
            if (r < I_IN) { transpose_item(IN_F(I_WIN), IN_COLS, D, WT_IN, scr, r / 56, r % 56, lane, [](int n) { return proj_src_col(n); }, one); continue; } r -= I_IN;
            if (r < I_UQ) { transpose_item(IN_F(I_WUQ), 768, 256, WT_UQ, scr, r / 24, r % 24, lane, ident, [&](int k) { return qnw[k] * qscale; }); continue; } r -= I_UQ;
            if (r < I_UKV) { transpose_item(IN_F(I_WUKV), 1024, 128, WT_UKV, scr, r / 32, r % 32, lane, ident, [&](int k) { return kvnw[k]; }); continue; } r -= I_UKV;
            if (r < I_O) { transpose_item(IN_F(I_WO), D, D, WT_O, scr, r / 32, r % 32, lane, ident, one); continue; } r -= I_O;
            if (r < I_PG) { transpose_item(IN_F(I_WPG), D, D, WT_PG, scr, r / 32, r % 32, lane, ident, one); continue; } r -= I_PG;
            if (r < I_PP) { transpose_item(IN_F(I_WPP), D, 256, WT_PP, scr, r / 32, r % 32, lane, ident, one); continue; } r -= I_PP;
            if (r < I_GU) { const int e = r / 256, q = r % 256, kb = q / 16, nb = q % 16;
                const float* W = ((nb & 7) < 4 ? IN_F(I_WEG) : IN_F(I_WEU)) + (size_t)e * 1024 * 256;
                transpose_item(W, 256, D, WT_GU + (size_t)e * 512 * 1024, scr, kb, nb, lane, [](int n) { return (n >> 8) * 128 + (n & 127); }, one); continue; } r -= I_GU;
            { const int e = r / 128, q = r % 128; transpose_item(IN_F(I_WED) + (size_t)e * 256 * 1024, D, 256, WT_DN + (size_t)e * 1024 * 256, scr, q / 32, q % 32, lane, ident, one); }
        }
        for (int m = gw; m < T; m += NGW) rms_row_to_bf16(x + (size_t)m * D, IN_F(I_ATTN_NW), H + (size_t)m * D, lane);
        { const f32x4* pp = (const f32x4*)IN_F(I_P); u32x2* po = (u32x2*)PB;
          for (int i = gtid; i < T * 256 / 4; i += NGT) { const f32x4 v = pp[i]; u32x2 o; o.x = pk2(v.x, v.y); o.y = pk2(v.z, v.w); po[i] = o; } }
        { const float* wrg = IN_F(I_WRG); const float* wre = IN_F(I_WRE);
          for (int i = gtid; i < 32 * 3 * 64 * 8; i += NGT) { const int e = i & 7, l = (i >> 3) & 63, nb = (i >> 9) % 3, ks = i / 1536;
              const int k = 32 * ks + 8 * (l >> 4) + e, col = 16 * nb + (l & 15);
              const float w = col < 4 ? wrg[k * 4 + col] : (col < 36 ? wre[k * 32 + (col - 4)] : 0.f);
              const unsigned hi = f2bf(w); const float lo = w - bf2f(hi);
              const size_t base = ((size_t)(ks * 3 + nb) * 2) * 512 + l * 8 + e;
              WRF[base] = (bf16_t)hi; WRF[base + 512] = (bf16_t)f2bf(lo); } }
        for (int i = gtid; i < T * 16; i += NGT) {
            const int t = i >> 4, f = i & 15;
            const float inv = 1.0f / powf(10000.0f, (float)(2 * f) / 32.0f);
            const float ang = (float)pos[t] * inv;
            COS[i] = cosf(ang); SIN[i] = sinf(ang);
        }
        }
    }
    SEAM(0);
    if (IN(1)) {
        FRESH_IDS();
        for (int rep_ = 0; rep_ < NREP(1); ++rep_) {
        pg8::Gemm g{H, WT_IN, T, PROJ_N, D, D, D}; pg8::StaticOrder So; So.init(T, PROJ_N, G, (int)blockIdx.x);
        EpiInProj E{PROJ, DTRAW, SSQQ, SSQKV};
        pg8::gemm_phase(ldsb, g, So, E);
        }
    }
    SEAM(1);
    if (IN(2)) {
        FRESH_IDS();
        for (int rep_ = 0; rep_ < NREP(2); ++rep_)
        for (int u = blockIdx.x; u < NB * ssd::NCH; u += G) {
            ssd::conv_chunk(smf, PROJ, IN_F(I_CONVW), IN_F(I_CONVB), XBCC, XT, BT, DTRAW, IN_F(I_DTB), DT, u >> 5, u & 31);
            ssd::states_chunk(smf + 20480, XT, BT, DT, IN_F(I_ALOG), STATES, CDEC, u >> 5, u & 31);
            __syncthreads();
        }
        for (int i = gtid; i < T * 16; i += NGT) {
            const int t = i >> 4, f = i & 15, b = t / S, s = t % S;
            const float c = COS[i], sn = SIN[i];
            const float t1 = bf2f(PROJ[(size_t)t * PROJ_N + PC_KR + f]), t2 = bf2f(PROJ[(size_t)t * PROJ_N + PC_KR + 16 + f]);
            const bf16_t o1 = (bf16_t)f2bf(t1 * c - t2 * sn), o2 = (bf16_t)f2bf(t2 * c + t1 * sn);
            for (int h = 0; h < NH; ++h) { bf16_t* kt = Kb + ((size_t)(b * NH + h) * (S / 64) + (s >> 6)) * (12 * 512) + (s & 63) * 8 + (f & 7); kt[(8 + (f >> 3)) * 512] = o1; kt[(10 + (f >> 3)) * 512] = o2; }
        }
        __syncthreads();
        for (int rep2_ = 0; rep2_ < NREP(12); ++rep2_) {
        { pg8::Gemm g{PROJ + PC_CQ, WT_UQ, T, 768, 256, PROJ_N, 256}; pg8::StaticOrder So; So.init(T, 768, G, (int)blockIdx.x);
          EpiQUp E{Qb, SSQQ, COS, SIN}; pg8::gemm_phase(ldsb, g, So, E); }
        { pg8::Gemm g{PROJ + PC_CKV, WT_UKV, T, 1024, 128, PROJ_N, 128}; pg8::StaticOrder So; So.init(T, 1024, G, (int)blockIdx.x);
          EpiKVUp E{Kb, Vb, SSQKV}; pg8::gemm_phase(ldsb, g, So, E); }
        }
    }
    SEAM(2);
    if (IN(3)) {
        FRESH_IDS();
        for (int rep_ = 0; rep_ < NREP(13); ++rep_)
        for (int idx = gtid; idx < 128 * 1024; idx += NGT) {
            const int chain = idx >> 10, e4 = (idx & 1023) * 4, b = chain >> 4, dir = (chain >> 3) & 1, hd = chain & 7;
            f32x4 h4 = (f32x4){0.f, 0.f, 0.f, 0.f};
#pragma unroll 8
            for (int step = 0; step < ssd::NCH; ++step) {
                const int c = dir == 0 ? step : ssd::NCH - 1 - step;
                const int sidx = ((b * ssd::NCH + c) * 2 + dir) * 8 + hd;
                f32x4* ptr = (f32x4*)(STATES + (size_t)sidx * 4096 + e4);
                const f32x4 s4 = *ptr; if (rep_ == NREP(13) - 1) *ptr = h4; else *(f32x4*)((float*)H + (size_t)sidx * 4096 + e4) = h4; h4 = h4 * CDEC[sidx] + s4;
            }
        }
        __syncthreads();
        for (int rep_ = 0; rep_ < NREP(3); ++rep_) {
        {
            const int vcu = (G % 8 == 0) ? ((int)blockIdx.x % 8) * (G / 8) + (int)blockIdx.x / 8 : (int)blockIdx.x;
            for (int u = vcu; u < NB * NH * 16; u += G) att::attn_unit(ldsb, Qb, Kb, Vb, MIX, u >> 4, u & 15);
        }
        }
    }
    SEAM(3);
    if (IN(4)) {
        FRESH_IDS();
        const float* aonw = IN_F(I_AONW);
        for (int u = blockIdx.x; u < NB * ssd::NCH; u += G) {
            for (int rep_ = 0; rep_ < NREP(4); ++rep_)
                ssd::finalize_chunk(smf, XBCC, XT, PROJ, DT, IN_F(I_ALOG), STATES, IN_F(I_SSDD), IN_F(I_SSDNW), MIX, u >> 5, u & 31);
            for (int r = wave; r < ssd::CH; r += 8) {
                bf16_t* mr = MIX + ((size_t)(u >> 5) * S + (u & 31) * ssd::CH + r) * D + lane * 8;
                const u32x4 raw = *(const u32x4*)mr;
                float v[8] = {bf2f(raw.x & 0xffffu), bf2f(raw.x >> 16), bf2f(raw.y & 0xffffu), bf2f(raw.y >> 16), bf2f(raw.z & 0xffffu), bf2f(raw.z >> 16), bf2f(raw.w & 0xffffu), bf2f(raw.w >> 16)};
                float ss = 0.f;
#pragma unroll
                for (int j = 0; j < 8; ++j) ss += v[j] * v[j];
                const float rstd = 1.f / sqrtf(wave_sum(ss) * (1.f / 512.f) + EPS);
                const f32x4 w0 = *(const f32x4*)(aonw + lane * 8), w1 = *(const f32x4*)(aonw + lane * 8 + 4);
                u32x4 o; o.x = pk2(v[0] * rstd * w0.x, v[1] * rstd * w0.y); o.y = pk2(v[2] * rstd * w0.z, v[3] * rstd * w0.w);
                o.z = pk2(v[4] * rstd * w1.x, v[5] * rstd * w1.y); o.w = pk2(v[6] * rstd * w1.z, v[7] * rstd * w1.w);
                *(u32x4*)mr = o;
            }
        }
    }
    SEAM(4);
    if (IN(5)) {
        FRESH_IDS();
        for (int rep_ = 0; rep_ < NREP(5); ++rep_) {
        pg8::Gemm g{MIX, WT_O, T, D, D, D, D}; pg8::StaticOrder So; So.init(T, D, G, (int)blockIdx.x);
        EpiResid E{x, out, SSQX1}; pg8::gemm_phase(ldsb, g, So, E);
        }
    }
    SEAM(5);
    if (IN(6)) {
        FRESH_IDS();
        {
            typedef short bf16x8r __attribute__((ext_vector_type(8)));
            const float* fw = IN_F(I_FFNNW); const float* brg = IN_F(I_BRG); const float* bre = IN_F(I_BRE);
            const int r16 = lane & 15, kq = lane >> 4;
            float* lg = smf + wave * (16 * 48);
            for (int rb = gw; rb < T / 16; rb += NGW) {
                const int row = rb * 16 + r16;
                float ss = 0.f;
#pragma unroll
                for (int q = 0; q < 4; ++q) { const f32x4 sv = *(const f32x4*)(SSQX1 + row * 16 + 4 * q); ss += (sv.x + sv.y) + (sv.z + sv.w); }
                const float rstd = 1.f / sqrtf(ss * (1.f / D) + EPS);
                f32x4 acc[3]; acc[0] = (f32x4){0.f, 0.f, 0.f, 0.f}; acc[1] = acc[0]; acc[2] = acc[0];
                const float* xrow = out + (size_t)row * D + 8 * kq;
#pragma unroll 4
                for (int ks = 0; ks < 32; ++ks) {
                    const f32x4 x0 = *(const f32x4*)(xrow + 32 * ks), x1v = *(const f32x4*)(xrow + 32 * ks + 4);
                    const f32x4 g0 = *(const f32x4*)(fw + 32 * ks + 8 * kq), g1 = *(const f32x4*)(fw + 32 * ks + 8 * kq + 4);
                    const f32x4 h0 = x0 * rstd * g0, h1 = x1v * rstd * g1;
                    u32x4 hi; hi.x = att::cvtpk(h0.x, h0.y); hi.y = att::cvtpk(h0.z, h0.w); hi.z = att::cvtpk(h1.x, h1.y); hi.w = att::cvtpk(h1.z, h1.w);
                    *(u32x4*)(H + (size_t)row * D + 32 * ks + 8 * kq) = hi;
                    u32x4 lo; lo.x = att::cvtpk(h0.x - bf2f(hi.x & 0xffffu), h0.y - bf2f(hi.x >> 16)); lo.y = att::cvtpk(h0.z - bf2f(hi.y & 0xffffu), h0.w - bf2f(hi.y >> 16));
                    lo.z = att::cvtpk(h1.x - bf2f(hi.z & 0xffffu), h1.y - bf2f(hi.z >> 16)); lo.w = att::cvtpk(h1.z - bf2f(hi.w & 0xffffu), h1.w - bf2f(hi.w >> 16));
                    const bf16x8r ah = __builtin_bit_cast(bf16x8r, hi), al = __builtin_bit_cast(bf16x8r, lo);
#pragma unroll
                    for (int nb = 0; nb < 3; ++nb) {
                        const bf16_t* wf = WRF + ((size_t)(ks * 3 + nb) * 2) * 512 + lane * 8;
                        const bf16x8r bh = *(const bf16x8r*)wf, bl = *(const bf16x8r*)(wf + 512);
                        acc[nb] = __builtin_amdgcn_mfma_f32_16x16x32_bf16(ah, bh, acc[nb], 0, 0, 0);
                        acc[nb] = __builtin_amdgcn_mfma_f32_16x16x32_bf16(ah, bl, acc[nb], 0, 0, 0);
                        acc[nb] = __builtin_amdgcn_mfma_f32_16x16x32_bf16(al, bh, acc[nb], 0, 0, 0);
                    }
                }
#pragma unroll
                for (int nb = 0; nb < 3; ++nb)
#pragma unroll
                    for (int j = 0; j < 4; ++j) lg[(4 * kq + j) * 48 + 16 * nb + r16] = acc[nb][j];
                asm volatile("s_waitcnt lgkmcnt(0)" ::: "memory");
                if (lane < 16) {
                    const int m = rb * 16 + lane;
                    float lgt[36];
#pragma unroll
                    for (int q = 0; q < 9; ++q) { const f32x4 v = *(const f32x4*)(lg + lane * 48 + 4 * q); lgt[4 * q] = v.x; lgt[4 * q + 1] = v.y; lgt[4 * q + 2] = v.z; lgt[4 * q + 3] = v.w; }
                    float gl[4]; int gi = 0;
#pragma unroll
                    for (int q = 0; q < 4; ++q) gl[q] = lgt[q] + brg[q];
                    float gmax = gl[0];
#pragma unroll
                    for (int q = 1; q < 4; ++q) if (gl[q] > gmax) { gmax = gl[q]; gi = q; }
                    float gs = 0.f;
#pragma unroll
                    for (int q = 0; q < 4; ++q) gs += expf(gl[q] - gmax);
                    const float gwt = 1.f / gs;
                    float el[8];
#pragma unroll
                    for (int q = 0; q < 8; ++q) { float vv = 0.f;
#pragma unroll
                        for (int g2 = 0; g2 < 4; ++g2) vv = (g2 == gi) ? lgt[4 + g2 * 8 + q] + bre[g2 * 8 + q] : vv;
                        el[q] = vv; }
                    int i0 = 0; float v0 = el[0];
#pragma unroll
                    for (int q = 1; q < 8; ++q) if (el[q] > v0) { v0 = el[q]; i0 = q; }
                    int i1 = -1; float v1 = -3.4e38f;
#pragma unroll
                    for (int q = 0; q < 8; ++q) if (q != i0 && el[q] > v1) { v1 = el[q]; i1 = q; }
                    const float e1 = expf(v1 - v0), w0 = gwt / (1.f + e1), w1 = gwt * e1 / (1.f + e1);
                    const int ex0 = gi * 8 + i0, ex1 = gi * 8 + i1;
                    *(f32x4*)(ROUTE + m * 4) = (f32x4){__int_as_float(ex0), __int_as_float(ex1), w0, w1};
                    const unsigned p0 = atomicAdd(ctl + CW_ECNT + 64 * ex0, 1u); BUCKET[(size_t)ex0 * T + p0] = m * 2;
                    const unsigned p1 = atomicAdd(ctl + CW_ECNT + 64 * ex1, 1u); BUCKET[(size_t)ex1 * T + p1] = m * 2 + 1;
                }
                asm volatile("s_waitcnt lgkmcnt(0)" ::: "memory");
            }
        }
        __syncthreads();
        { pg8::Gemm g{PB, WT_PP, T, D, 256, 256, 256}; pg8::StaticOrder So; So.init(T, D, G, (int)blockIdx.x);
          EpiPleProj E{PLERAW, SSQPLE}; pg8::gemm_phase(ldsb, g, So, E); }
    }
    SEAM(6);
    volatile LAS unsigned* CNT_L = MISC + 64; volatile LAS unsigned* PTILE_L = MISC + 96;
    LAS unsigned* ROWTAB = (LAS unsigned*)(ldsb + MISC_OFF + 1024);
    bf16_t* HE = (bf16_t*)(ws + WS_HE); bf16_t* YPAIR = (bf16_t*)(ws + WS_Q);
    if (IN(7) || IN(8)) {
        if (threadIdx.x == 0) { unsigned acc = 0;
            for (int e2 = 0; e2 < 32; ++e2) { const unsigned c = __hip_atomic_load(ctl + CW_ECNT + 64 * e2, __ATOMIC_RELAXED, __HIP_MEMORY_SCOPE_AGENT); CNT_L[e2] = c; PTILE_L[e2] = acc; acc += (c + 255u) >> 8; }
            PTILE_L[32] = acc; }
        __syncthreads();
    }
    if (IN(7)) {
        FRESH_IDS();
        for (int rep_ = 0; rep_ < NREP(7); ++rep_) {
        GroupSched Sg{PTILE_L, 2, G, (int)blockIdx.x};
        { pg8::Unit u;
          for (int i = 0; i < 8 && Sg.next(i, u); ++i) { const int e2 = u.pn >> 1, pm_l = u.pm - (int)PTILE_L[e2];
              if (tid < 256) { const int idx = pm_l * 256 + tid; const int tok = idx < (int)CNT_L[e2] ? (BUCKET[(size_t)e2 * T + idx] >> 1) : 0; ROWTAB[i * 256 + tid] = (unsigned)tok * 2048u; } } }
        __syncthreads();
        pg8::Gemm g{H, WT_GU, T, 32 * 512, D, D, D};
        EpiMoeGU E{HE};
        pg8::gemm_phase<EpiMoeGU, GroupSched, true>(ldsb, g, Sg, E, ROWTAB);
        }
    }
    SEAM(7);
    if (IN(8)) {
        for (int rep_ = 0; rep_ < NREP(8); ++rep_) {
        GroupSched Sg{PTILE_L, 4, G, (int)blockIdx.x};
        pg8::Gemm g{HE, WT_DN, 0, 32 * 1024, 256, 256, 256};
        EpiMoeDown E{YPAIR, BUCKET, ROUTE, PTILE_L, CNT_L};
        pg8::gemm_phase(ldsb, g, Sg, E);
        }
    }
    SEAM(8);
    if (IN(9)) {
        FRESH_IDS();
        const f32x4* wr4 = (const f32x4*)IN_F(I_PLENW) + lane;
        for (int m = gw; m < T; m += NGW) {
            f32x4* xr = (f32x4*)(out + (size_t)m * D) + lane;
            const u32x2* y0 = (const u32x2*)(YPAIR + (size_t)(2 * m) * D) + lane; const u32x2* y1 = (const u32x2*)(YPAIR + (size_t)(2 * m + 1) * D) + lane;
            f32x4 v[4]; float s = 0.f;
#pragma unroll
            for (int j = 0; j < 4; ++j) { const u32x2 a0 = y0[64 * j], a1 = y1[64 * j];
                v[j] = xr[64 * j] + (f32x4){bf2f(a0.x & 0xffffu) + bf2f(a1.x & 0xffffu), bf2f(a0.x >> 16) + bf2f(a1.x >> 16), bf2f(a0.y & 0xffffu) + bf2f(a1.y & 0xffffu), bf2f(a0.y >> 16) + bf2f(a1.y >> 16)};
                xr[64 * j] = v[j]; s += (v[j].x * v[j].x + v[j].y * v[j].y) + (v[j].z * v[j].z + v[j].w * v[j].w); }
            const float rstd = 1.f / sqrtf(wave_sum(s) * (1.f / D) + EPS);
            u32x2* o8 = (u32x2*)(H + (size_t)m * D) + lane;
#pragma unroll
            for (int j = 0; j < 4; ++j) { const f32x4 g4 = wr4[64 * j]; u32x2 o; o.x = pk2(v[j].x * rstd * g4.x, v[j].y * rstd * g4.y); o.y = pk2(v[j].z * rstd * g4.z, v[j].w * rstd * g4.w); o8[64 * j] = o; }
        }
    }
    SEAM(9);
    if (IN(10)) {
        pg8::Gemm g{H, WT_PG, T, D, D, D, D}; pg8::StaticOrder So; So.init(T, D, G, (int)blockIdx.x);
        EpiPleGate E{out, PLERAW, SSQPLE, IN_F(I_BPG), IN_F(I_PPNW)}; pg8::gemm_phase(ldsb, g, So, E);
    }
    SEAM(10);
    if (IN(11)) {
        FRESH_IDS();
        const float* fnw = IN_F(I_FNW);
        for (int m = gw; m < T; m += NGW) {
            f32x4* xr = (f32x4*)(out + (size_t)m * D) + lane; const f32x4* wr = (const f32x4*)fnw + lane;
            f32x4 v[4]; float s = 0.f;
#pragma unroll
            for (int j = 0; j < 4; ++j) { v[j] = xr[64 * j]; s += (v[j].x * v[j].x + v[j].y * v[j].y) + (v[j].z * v[j].z + v[j].w * v[j].w); }
            const float rstd = 1.f / sqrtf(wave_sum(s) * (1.f / D) + EPS);
#pragma unroll
            for (int j = 0; j < 4; ++j) xr[64 * j] = v[j] * rstd * wr[64 * j];
        }
    }
#undef IN
#undef SEAM
}

extern "C" void kernel_launch(void* const* d_in, const int* in_sizes, int n_in, void* d_out, int out_size, void* d_ws, size_t ws_size, hipStream_t stream) {
    static int grid = 0;
    if (grid == 0) {
        if (n_in != 31 || out_size != T * D || ws_size < WS_END) { fprintf(stderr, "kernel_launch: unexpected shapes (n_in %d out %d ws %zu)\n", n_in, out_size, ws_size); grid = -1; return; }
        int dev = 0, cus = 0, per_cu = 0;
        if (hipGetDevice(&dev) != hipSuccess || hipDeviceGetAttribute(&cus, hipDeviceAttributeMultiprocessorCount, dev) != hipSuccess) { grid = -1; return; }
        if (hipFuncSetAttribute((const void*)fwd, hipFuncAttributeMaxDynamicSharedMemorySize, LDS_BYTES) != hipSuccess) { fprintf(stderr, "kernel_launch: hipFuncSetAttribute failed\n"); grid = -1; return; }
        if (hipOccupancyMaxActiveBlocksPerMultiprocessor(&per_cu, (const void*)fwd, 512, LDS_BYTES) != hipSuccess || per_cu < 1) { fprintf(stderr, "kernel_launch: occupancy query says %d\n", per_cu); }
        (void)hipGetLastError();
        grid = cus;
    }
    if (grid < 0) return;
    (void)hipMemsetAsync((char*)d_ws + WS_CTL, 0, CTL_ZERO_BYTES, stream);
    Args a{};
    for (int i = 0; i < 31; ++i) a.in[i] = d_in[i];
    a.out = (float*)d_out; a.ws = (unsigned char*)d_ws;
#if MK_PER_PHASE
    for (int p = 0; p < NPHASES; ++p) { a.ph_lo = p; a.ph_hi = p + 1; hipLaunchKernelGGL(fwd, dim3(grid), dim3(512), LDS_BYTES, stream, a); }
#else
    a.ph_lo = 0; a.ph_hi = NPHASES;
    hipLaunchKernelGGL(fwd, dim3(grid), dim3(512), LDS_BYTES, stream, a);
#endif
}
```

```cpp
#include <hip/hip_runtime.h>
#include <cstdio>
#include <cstdint>

#ifndef MK_PER_PHASE
#define MK_PER_PHASE 0
#endif

#define LAS __attribute__((address_space(3)))
#define GAS __attribute__((address_space(1)))
typedef unsigned short bf16_t;
typedef float f32x4 __attribute__((ext_vector_type(4)));
typedef unsigned u32x4 __attribute__((ext_vector_type(4)));
typedef unsigned u32x2 __attribute__((ext_vector_type(2)));

constexpr int NB = 8, S = 4096, T = NB * S, D = 1024;
constexpr int NH = 8, DQK = 96, DV = 64;
constexpr int PROJ_N = 1792, IN_COLS = 1712;
constexpr int PC_CQ = 0, PC_CKV = 256, PC_KR = 384, PC_DT = 416, PC_Z = 512, PC_XBC = 1024;
constexpr int XBC = 768;
constexpr float EPS = 1e-6f;
constexpr int NPHASES = 12;

constexpr size_t MiB = 1u << 20;
constexpr size_t WS_CTL = 0, CTL_ZERO_BYTES = 1 * MiB;
constexpr size_t WS_COS = 1 * MiB, WS_SIN = 3 * MiB, WS_DT = 5 * MiB, WS_ROUTE = 7 * MiB, WS_BUCKET = 8 * MiB;
constexpr size_t WS_SSQQ = 12 * MiB, WS_SSQKV = 12 * MiB + 512 * 1024, WS_DTRAW = 13 * MiB, WS_SSQPLE = 15 * MiB;
constexpr size_t WS_WR = 7 * MiB + 512 * 1024;
constexpr size_t WS_CDEC = 7 * MiB + 768 * 1024;
constexpr size_t WS_WRF = 7 * MiB + 512 * 1024;
constexpr size_t WS_SSQX1 = 17 * MiB;
constexpr size_t WS_WEIGHTS = 19 * MiB;
constexpr size_t WS_H = 80 * MiB;
constexpr size_t WS_PROJ = 144 * MiB;
constexpr size_t WS_HE = 208 * MiB;
constexpr size_t WS_Q = 256 * MiB, WS_K = 304 * MiB, WS_V = 352 * MiB;
constexpr size_t WS_MIX = 384 * MiB;
constexpr size_t WS_XBCC = 448 * MiB;
constexpr size_t WS_PB = 496 * MiB;
constexpr size_t WS_END = 512 * MiB;
constexpr int CW_BAR = 4096, CW_ECNT = 8192;

__device__ __forceinline__ unsigned f2bf(float f) { unsigned u = __builtin_bit_cast(unsigned, f); return (u + 0x7fffu + ((u >> 16) & 1u)) >> 16; }
__device__ __forceinline__ float bf2f(unsigned h) { return __builtin_bit_cast(float, h << 16); }
__device__ __forceinline__ unsigned pk2(float lo, float hi) { return f2bf(lo) | (f2bf(hi) << 16); }
__device__ __forceinline__ float wave_sum(float v) {
#pragma unroll
    for (int o = 1; o < 64; o <<= 1) v += __shfl_xor(v, o);
    return v;
}
__device__ __forceinline__ float silu_f(float v) { return v / (1.f + __expf(-v)); }

#define XB_TMO      128
#define XB_XCNT(j)  (256  + 64 * (j))
#define XB_XSUB(j)  (1280 + 64 * (j))
#define XB_XGEN(j)  (2304 + 64 * (j))
#define XB_TOP      3328
#define XB_TOPGEN   3392
#define XCD_BAR_WORDS 3456
#define XB_SPIN_CAP (1u << 22)

__device__ __forceinline__ unsigned xb_ld(unsigned* p)              { return __hip_atomic_load(p, __ATOMIC_RELAXED, __HIP_MEMORY_SCOPE_AGENT); }
__device__ __forceinline__ unsigned xb_add(unsigned* p, unsigned v) { return __hip_atomic_fetch_add(p, v, __ATOMIC_RELAXED, __HIP_MEMORY_SCOPE_AGENT); }
__device__ __forceinline__ unsigned xb_xcc_id() { return (unsigned)__builtin_amdgcn_s_getreg((3 << 11) | 20) & 0xFu; }
#define XB_SPIN(cond, bar) do { unsigned _sp = 0; while (cond) { __builtin_amdgcn_s_sleep(1); \
    if ((++_sp & 255u) == 0u) { if (xb_ld(&(bar)[XB_TMO])) break; if (_sp > XB_SPIN_CAP) { atomicAdd(&(bar)[XB_TMO], 1u); break; } } } } while (0)

struct XcdBarrier { unsigned* bar; unsigned x; volatile LAS unsigned* st; };
__device__ __forceinline__ XcdBarrier xcd_barrier_post(unsigned* bar, volatile LAS unsigned* st) {
    XcdBarrier b; b.bar = bar; b.x = xb_xcc_id(); b.st = st;
    if (threadIdx.x == 0) (void)xb_add(&bar[XB_XCNT(b.x)], 1u);
    return b;
}
__device__ __forceinline__ void xcd_barrier_complete(unsigned* bar, unsigned x, unsigned& nloc, unsigned& nx) {
    const unsigned G = gridDim.x * gridDim.y * gridDim.z;
    unsigned sum, cnt, mine, sp = 0u;
    for (;;) {
        sum = 0u; cnt = 0u; mine = 0u;
#pragma unroll
        for (unsigned j = 0; j < 16; ++j) { const unsigned c = xb_ld(&bar[XB_XCNT(j)]); sum += c; cnt += (c > 0u) ? 1u : 0u; mine = (j == x) ? c : mine; }
        if (sum == G) break;
        __builtin_amdgcn_s_sleep(1);
        if ((++sp & 255u) == 0u) { if (xb_ld(&bar[XB_TMO])) break; if (sp > XB_SPIN_CAP) { atomicAdd(&bar[XB_TMO], 1u); break; } }
    }
    nloc = mine > 0u ? mine : 1u; nx = cnt > 0u ? cnt : 1u;
}
__device__ __forceinline__ void xcd_barrier(const XcdBarrier& b) {
    asm volatile("s_waitcnt vmcnt(0)" ::: "memory");
    __syncthreads();
    if (threadIdx.x == 0) {
        unsigned* bar = b.bar;
        __builtin_amdgcn_s_waitcnt(0);
        unsigned nloc = b.st[0], nx = b.st[1];
        if (nloc == 0u) { xcd_barrier_complete(bar, b.x, nloc, nx); b.st[0] = nloc; b.st[1] = nx; }
        const unsigned old = xb_add(&bar[XB_XSUB(b.x)], 1u);
        const unsigned gen = old / nloc;
        if (old + 1u == (gen + 1u) * nloc) {
            __builtin_amdgcn_fence(__ATOMIC_RELEASE, "agent");
            asm volatile("s_waitcnt vmcnt(0)" ::: "memory");
            const unsigned og = xb_add(&bar[XB_TOP], 1u);
            const unsigned tg = og / nx;
            if (og + 1u == (tg + 1u) * nx) xb_add(&bar[XB_TOPGEN], 1u);
            else XB_SPIN(xb_ld(&bar[XB_TOPGEN]) == tg, bar);
            __builtin_amdgcn_fence(__ATOMIC_ACQUIRE, "agent");
            xb_add(&bar[XB_XGEN(b.x)], 1u);
            asm volatile("s_waitcnt vmcnt(0)" ::: "memory");
        } else {
            XB_SPIN(xb_ld(&bar[XB_XGEN(b.x)]) == gen, bar);
            __builtin_amdgcn_fence(__ATOMIC_ACQUIRE, "agent");
            asm volatile("s_waitcnt vmcnt(0)" ::: "memory");
        }
    }
    __syncthreads();
}


namespace pg8 {
typedef short bf16x8 __attribute__((ext_vector_type(8)));
constexpr int BM = 256, BK = 64, HALF = 128, HTB = HALF * BK * 2, STAGE_BYTES = 8 * HTB, NXCD = 8, WGM = 8;
__host__ __device__ __forceinline__ int lds_byte(int r, int c) { const int st = (r >> 4) * 2 + (c >> 5), rr = r & 15, cc = c & 31, ob = rr * 64 + cc * 2; return st * 1024 + (ob ^ (((ob >> 9) & 1) << 5)); }
__host__ __device__ __forceinline__ void stage_rc(int b, int& R, int& C) { const int st = b / 1024, sb = b % 1024, swz = sb ^ (((sb >> 9) & 1) << 5); R = (st >> 1) * 16 + swz / 64; C = (st & 1) * 32 + (swz % 64) / 2; }
__host__ __device__ __forceinline__ int perm32(int rho) { const int n = rho >> 4, i = rho & 15; return 8 * (i >> 2) + 4 * n + (i & 3); }
struct Unit { int pm, pn; };
struct Gemm { const bf16_t* A; const bf16_t* Bt; int M, N, K, lda, ldb; };
struct StaticOrder {
    int nM, nN, nwg, G, c;
    __host__ __device__ void init(int M, int N, int G_, int c_) { nM = M / BM; nN = N / BM; nwg = nM * nN; G = G_; c = c_; }
    __host__ __device__ bool next(int i, Unit& u) const {
        const long L = (long)i * G + c; if (L >= nwg) return false;
        int wgid = (int)L; { const int q = nwg / NXCD, r = nwg % NXCD, xcd = wgid % NXCD, off = wgid / NXCD; wgid = (xcd < r ? xcd * (q + 1) : r * (q + 1) + (xcd - r) * q) + off; }
        const int nig = WGM * nN, gid = wgid / nig, fm = gid * WGM, gsz = (nM - fm) < WGM ? (nM - fm) : WGM;
        u.pm = fm + ((wgid % nig) % gsz); u.pn = (wgid % nig) / gsz; return true;
    }
};
struct TailOrder {
    int nM, nN, nwg, G, c, first, span;
    __host__ __device__ void init(int M, int N, int G_, int c_, int first_) { nM = M / BM; nN = N / BM; nwg = nM * nN; G = G_; c = c_; first = (first_ > 0 && first_ < G_) ? first_ : 0; span = G - first; }
    __host__ __device__ bool next(int i, Unit& u) const {
        if (c < first) return false;
        const long L = (long)i * span + (c - first); if (L >= nwg) return false;
        const int wgid = (int)L;
        const int nig = WGM * nN, gid = wgid / nig, fm = gid * WGM, gsz = (nM - fm) < WGM ? (nM - fm) : WGM;
        u.pm = fm + ((wgid % nig) % gsz); u.pn = (wgid % nig) / gsz; return true;
    }
};
__device__ __forceinline__ unsigned cvt_pk_bf16(float lo, float hi) { unsigned r; asm volatile("v_cvt_pk_bf16_f32 %0, %1, %2" : "=v"(r) : "v"(lo), "v"(hi)); return r; }

template <class Epi, class Sched, bool GATHER = false>
__device__ __forceinline__ void gemm_phase(LAS unsigned char* lds, const Gemm g, const Sched& S, const Epi& E, const LAS unsigned* rowtab = nullptr) {
    int tid = threadIdx.x; asm volatile("" : "+v"(tid));
    const int wid = __builtin_amdgcn_readfirstlane(tid >> 6), lane = tid & 63, wr = wid >> 2, wc = wid & 3, fr = lane & 15, fq = lane >> 4;
    int nt = g.K / BK; asm volatile("" : "+s"(nt));
    unsigned vAc[2][2], vAn[2][2], voffB[2]; int RA[2], CA[2];
#pragma unroll
    for (int i = 0; i < 2; ++i) { int R, C; stage_rc(tid * 16 + i * 8192, R, C); const int Rb = Epi::PERM ? ((R & ~31) + perm32(R & 31)) : R; RA[i] = R; CA[i] = C;
        voffB[i] = (unsigned)(Rb * g.ldb + C) * 2u;
#pragma unroll
        for (int h = 0; h < 2; ++h) { vAc[h][i] = GATHER ? rowtab[h * HALF + R] + (unsigned)C * 2u : (unsigned)((h * HALF + R) * g.lda + C) * 2u; vAn[h][i] = vAc[h][i]; } }
    const size_t kstep = (size_t)(BK * 2);
    const size_t hstepB = (size_t)HALF * g.ldb * 2;
    const size_t tstepA = GATHER ? 0 : (size_t)BM * g.lda * 2, tstepB = 2 * hstepB;
    const unsigned ldsw = (unsigned)wid * 1024u;
    const int aoff = lds_byte(wr * 64 + fr, fq * 8), boff = lds_byte(wc * 32 + fr, fq * 8);
#define PG8_SA(b, h) (((b) * 2 + (h)) * HTB)
#define PG8_SB(b, h) ((4 + (b) * 2 + (h)) * HTB)
#define PG8_STAGE(bufoff, gbase, voff) do { _Pragma("unroll") for (int _i = 0; _i < 2; ++_i) \
        __builtin_amdgcn_global_load_lds((const unsigned*)((const char*)(gbase) + (voff)[_i]), (LAS unsigned*)(lds + (bufoff) + ldsw + _i * 8192), 16, 0, 0); } while (0)
#define PG8_LDA(dst, b, h) do { _Pragma("unroll") for (int m = 0; m < 4; ++m) _Pragma("unroll") for (int k = 0; k < 2; ++k) dst[m][k] = *(const LAS bf16x8*)(lds + PG8_SA(b, h) + aoff + m * 2048 + k * 1024); } while (0)
#define PG8_LDB(dst, b, h) do { _Pragma("unroll") for (int n = 0; n < 2; ++n) _Pragma("unroll") for (int k = 0; k < 2; ++k) dst[n][k] = *(const LAS bf16x8*)(lds + PG8_SB(b, h) + boff + n * 2048 + k * 1024); } while (0)
#define PG8_MMA(ai, bj, At, Bt) do { __builtin_amdgcn_s_setprio(1); _Pragma("unroll") for (int m = 0; m < 4; ++m) _Pragma("unroll") for (int n = 0; n < 2; ++n) _Pragma("unroll") for (int k = 0; k < 2; ++k) \
        acc[ai][bj][m][n] = __builtin_amdgcn_mfma_f32_16x16x32_bf16(Bt[n][k], At[m][k], acc[ai][bj][m][n], 0, 0, 0); __builtin_amdgcn_s_setprio(0); } while (0)
#define PG8_WAIT_V(n) asm volatile("s_waitcnt vmcnt(" #n ")" ::: "memory")
#define PG8_WAIT_L(n) asm volatile("s_waitcnt lgkmcnt(" #n ")" ::: "memory")
#define PG8_BAR __builtin_amdgcn_s_barrier()
#define PG8_SCHED __builtin_amdgcn_sched_barrier(0)
    Unit cur, nxt; int ui = 0;
    if (!S.next(0, cur)) return;
    f32x4 acc[2][2][4][2];
#pragma unroll
    for (int a = 0; a < 2; ++a)
#pragma unroll
        for (int b = 0; b < 2; ++b)
#pragma unroll
            for (int m = 0; m < 4; ++m)
#pragma unroll
                for (int n = 0; n < 2; ++n) acc[a][b][m][n] = (f32x4){0.f, 0.f, 0.f, 0.f};
    bf16x8 At[4][2], B0[2][2], B1[2][2];
    const char* cA = (const char*)g.A + (size_t)cur.pm * tstepA; const char* cB = (const char*)g.Bt + (size_t)cur.pn * tstepB;
    PG8_STAGE(PG8_SB(0, 0), cB, voffB); PG8_STAGE(PG8_SB(0, 1), cB + hstepB, voffB); PG8_STAGE(PG8_SA(0, 0), cA, vAc[0]); PG8_STAGE(PG8_SA(0, 1), cA, vAc[1]);
    if (wr == 1) PG8_BAR;
    PG8_WAIT_V(2); PG8_BAR;
    PG8_STAGE(PG8_SB(1, 0), cB + kstep, voffB); PG8_STAGE(PG8_SA(1, 0), cA + kstep, vAc[0]); PG8_STAGE(PG8_SB(1, 1), cB + hstepB + kstep, voffB);
    PG8_WAIT_V(6); PG8_BAR;
    for (;;) {
        const bool has_next = S.next(ui + 1, nxt);
        const char* nA = has_next ? (const char*)g.A + (size_t)nxt.pm * tstepA : cA; const char* nB = has_next ? (const char*)g.Bt + (size_t)nxt.pn * tstepB : cB;
        if (GATHER && has_next) {
#pragma unroll
            for (int i = 0; i < 2; ++i)
#pragma unroll
                for (int h = 0; h < 2; ++h) vAn[h][i] = rowtab[(ui + 1) * BM + h * HALF + RA[i]] + (unsigned)CA[i] * 2u;
        }
        for (int t = 0; t < nt; t += 2) {
            const bool last = (t == nt - 2);
            const char* a1 = cA + (size_t)(t + 1) * kstep;
            const char* a2 = last ? nA : cA + (size_t)(t + 2) * kstep; const char* b2 = last ? nB : cB + (size_t)(t + 2) * kstep;
            const char* a3 = a2 + kstep; const char* b3 = b2 + kstep;
            unsigned v2[2][2];
#pragma unroll
            for (int i = 0; i < 2; ++i)
#pragma unroll
                for (int h = 0; h < 2; ++h) v2[h][i] = (GATHER && last) ? vAn[h][i] : vAc[h][i];
            PG8_LDB(B0, 0, 0); PG8_LDB(B1, 0, 1); PG8_SCHED; PG8_LDA(At, 0, 0); PG8_STAGE(PG8_SA(1, 1), a1, vAc[1]);
            PG8_WAIT_V(8); PG8_WAIT_L(0); PG8_BAR; PG8_MMA(0, 0, At, B0); PG8_MMA(0, 1, At, B1); PG8_BAR; PG8_SCHED;
            PG8_LDA(At, 0, 1); PG8_STAGE(PG8_SB(0, 0), b2, voffB); PG8_STAGE(PG8_SB(0, 1), b2 + hstepB, voffB); PG8_STAGE(PG8_SA(0, 0), a2, v2[0]);
            PG8_WAIT_V(8); PG8_WAIT_L(0); PG8_BAR; PG8_MMA(1, 0, At, B0); PG8_MMA(1, 1, At, B1); PG8_BAR; PG8_SCHED;
            PG8_LDB(B0, 1, 0); PG8_LDB(B1, 1, 1); PG8_SCHED; PG8_LDA(At, 1, 0); PG8_STAGE(PG8_SA(0, 1), a2, v2[1]);
            PG8_WAIT_V(8); PG8_WAIT_L(0); PG8_BAR; PG8_MMA(0, 0, At, B0); PG8_MMA(0, 1, At, B1); PG8_BAR; PG8_SCHED;
            PG8_LDA(At, 1, 1); PG8_STAGE(PG8_SB(1, 0), b3, voffB); PG8_STAGE(PG8_SB(1, 1), b3 + hstepB, voffB); PG8_STAGE(PG8_SA(1, 0), a3, v2[0]);
            PG8_WAIT_V(8); PG8_WAIT_L(0); PG8_BAR; PG8_MMA(1, 0, At, B0); PG8_MMA(1, 1, At, B1); PG8_BAR; PG8_SCHED;
        }
        if (wr == 0) PG8_BAR;
        E(acc, cur, wr, wc, fr, fq);
        if (!has_next) break;
#pragma unroll
        for (int a = 0; a < 2; ++a)
#pragma unroll
            for (int b = 0; b < 2; ++b)
#pragma unroll
                for (int m = 0; m < 4; ++m)
#pragma unroll
                    for (int n = 0; n < 2; ++n) acc[a][b][m][n] = (f32x4){0.f, 0.f, 0.f, 0.f};
        cur = nxt; cA = nA; cB = nB; ++ui;
        if (GATHER) {
#pragma unroll
            for (int i = 0; i < 2; ++i)
#pragma unroll
                for (int h = 0; h < 2; ++h) vAc[h][i] = vAn[h][i];
        }
        if (wr == 1) PG8_BAR;
    }
    PG8_WAIT_V(0);
    PG8_BAR;
#undef PG8_SA
#undef PG8_SB
#undef PG8_STAGE
#undef PG8_LDA
#undef PG8_LDB
#undef PG8_MMA
#undef PG8_WAIT_V
#undef PG8_WAIT_L
#undef PG8_BAR
#undef PG8_SCHED
}
}

typedef f32x4 AccT[2][2][4][2];
__device__ __forceinline__ float sq4(const f32x4 v) { return (v.x * v.x + v.y * v.y) + (v.z * v.z + v.w * v.w); }
__device__ __forceinline__ u32x4 pack8(const f32x4 a, const f32x4 b) { u32x4 w; w.x = pg8::cvt_pk_bf16(a.x, a.y); w.y = pg8::cvt_pk_bf16(a.z, a.w); w.z = pg8::cvt_pk_bf16(b.x, b.y); w.w = pg8::cvt_pk_bf16(b.z, b.w); return w; }
__device__ __forceinline__ u32x2 pack4(const f32x4 a) { u32x2 w; w.x = pg8::cvt_pk_bf16(a.x, a.y); w.y = pg8::cvt_pk_bf16(a.z, a.w); return w; }

struct EpiInProj {
    static constexpr bool PERM = true;
    bf16_t* PROJ; float* DTRAW; float* SSQQ; float* SSQKV;
    __device__ __forceinline__ void operator()(const AccT& acc, const pg8::Unit& u, int wr, int wc, int fr, int fq) const {
        const int row0 = u.pm * 256 + wr * 64 + fr, col0 = u.pn * 256 + wc * 32 + 8 * fq;
#pragma unroll
        for (int ai = 0; ai < 2; ++ai)
#pragma unroll
            for (int m = 0; m < 4; ++m) {
                const int row = row0 + ai * 128 + m * 16;
                bf16_t* rowp = PROJ + (size_t)row * PROJ_N + col0;
#pragma unroll
                for (int bj = 0; bj < 2; ++bj) *(u32x4*)(rowp + bj * 128) = pack8(acc[ai][bj][m][0], acc[ai][bj][m][1]);
                if (u.pn == 0) {
                    float s = (sq4(acc[ai][0][m][0]) + sq4(acc[ai][0][m][1])) + (sq4(acc[ai][1][m][0]) + sq4(acc[ai][1][m][1]));
                    s += __shfl_xor(s, 16); s += __shfl_xor(s, 32);
                    if (fq == 0) SSQQ[row * 4 + wc] = s;
                } else if (u.pn == 1) {
                    float s = sq4(acc[ai][0][m][0]) + sq4(acc[ai][0][m][1]);
                    s += __shfl_xor(s, 16); s += __shfl_xor(s, 32);
                    if (fq == 0) SSQKV[row * 4 + wc] = s;
                    if (wc == 1 && fq < 2) { *(f32x4*)(DTRAW + row * 16 + 8 * fq) = acc[ai][1][m][0]; *(f32x4*)(DTRAW + row * 16 + 8 * fq + 4) = acc[ai][1][m][1]; }
                }
            }
    }
};
struct EpiQUp {
    static constexpr bool PERM = false;
    bf16_t* Q; const float* SSQQ; const float* COS; const float* SIN;
    __device__ __forceinline__ void operator()(const AccT& acc, const pg8::Unit& u, int wr, int wc, int fr, int fq) const {
#pragma unroll
        for (int ai = 0; ai < 2; ++ai)
#pragma unroll
            for (int m = 0; m < 4; ++m) {
                asm volatile("" ::: "memory");
                const int row = u.pm * 256 + ai * 128 + wr * 64 + m * 16 + fr, b = row / S, s = row % S;
                const f32x4 sv = *(const f32x4*)(SSQQ + row * 4);
                const float rs = 1.f / sqrtf(((sv.x + sv.y) + (sv.z + sv.w)) * (1.f / 256.f) + EPS);
                const f32x4 cs = *(const f32x4*)(COS + row * 16 + 4 * fq), sn = *(const f32x4*)(SIN + row * 16 + 4 * fq);
#pragma unroll
                for (int bj = 0; bj < 2; ++bj) {
                    const int g32 = 8 * u.pn + 4 * bj + wc, h = g32 / 3, part = g32 % 3;
                    f32x4 v0 = acc[ai][bj][m][0] * rs, v1 = acc[ai][bj][m][1] * rs;
                    if (part == 2) { const f32x4 o0 = v0 * cs - v1 * sn, o1 = v1 * cs + v0 * sn; v0 = o0; v1 = o1; }
                    bf16_t* qp = Q + ((size_t)(b * NH + h) * S + s) * DQK + part * 32 + 4 * fq;
                    *(u32x2*)qp = pack4(v0); *(u32x2*)(qp + 16) = pack4(v1);
                }
            }
    }
};
struct EpiKVUp {
    static constexpr bool PERM = true;
    bf16_t* Kb; bf16_t* Vb; const float* SSQKV;
    __device__ __forceinline__ void operator()(const AccT& acc, const pg8::Unit& u, int wr, int wc, int fr, int fq) const {
#pragma unroll
        for (int ai = 0; ai < 2; ++ai)
#pragma unroll
            for (int m = 0; m < 4; ++m) {
                asm volatile("" ::: "memory");
                const int row = u.pm * 256 + ai * 128 + wr * 64 + m * 16 + fr, b = row / S, s = row % S;
                const f32x4 sv = *(const f32x4*)(SSQKV + row * 4);
                const float rs = 1.f / sqrtf(((sv.x + sv.y) + (sv.z + sv.w)) * (1.f / 128.f) + EPS);
#pragma unroll
                for (int bj = 0; bj < 2; ++bj) {
                    const int h = 2 * u.pn + bj; const size_t tile = (size_t)(b * NH + h) * (S / 64) + (s >> 6);
                    const u32x4 w = pack8(acc[ai][bj][m][0] * rs, acc[ai][bj][m][1] * rs);
                    if (wc < 2) *(u32x4*)(Kb + (tile * 12 + 4 * wc + fq) * 512 + (s & 63) * 8) = w;
                    else *(u32x4*)(Vb + (tile * 16 + (wc - 2) * 8 + ((s & 63) >> 3)) * 256 + (s & 7) * 32 + 8 * fq) = w;
                }
            }
    }
};
struct EpiResid {
    static constexpr bool PERM = false;
    const float* base; float* out; float* SSQ;
    __device__ __forceinline__ void operator()(const AccT& acc, const pg8::Unit& u, int wr, int wc, int fr, int fq) const {
#pragma unroll
        for (int ai = 0; ai < 2; ++ai)
#pragma unroll
            for (int m = 0; m < 4; ++m) {
                const int row = u.pm * 256 + ai * 128 + wr * 64 + m * 16 + fr;
                const size_t ro = (size_t)row * D + u.pn * 256 + wc * 32 + 4 * fq;
                float s = 0.f;
#pragma unroll
                for (int bj = 0; bj < 2; ++bj)
#pragma unroll
                    for (int n = 0; n < 2; ++n) { const size_t o = ro + bj * 128 + n * 16; const f32x4 v = *(const f32x4*)(base + o) + acc[ai][bj][m][n]; *(f32x4*)(out + o) = v; s += sq4(v); }
                s += __shfl_xor(s, 16); s += __shfl_xor(s, 32);
                if (fq == 0) SSQ[row * 16 + u.pn * 4 + wc] = s;
            }
    }
};
struct EpiPleProj {
    static constexpr bool PERM = true;
    bf16_t* O; float* SSQ;
    __device__ __forceinline__ void operator()(const AccT& acc, const pg8::Unit& u, int wr, int wc, int fr, int fq) const {
#pragma unroll
        for (int ai = 0; ai < 2; ++ai)
#pragma unroll
            for (int m = 0; m < 4; ++m) {
                const int row = u.pm * 256 + ai * 128 + wr * 64 + m * 16 + fr;
                bf16_t* rowp = O + (size_t)row * D + u.pn * 256 + wc * 32 + 8 * fq;
#pragma unroll
                for (int bj = 0; bj < 2; ++bj) *(u32x4*)(rowp + bj * 128) = pack8(acc[ai][bj][m][0], acc[ai][bj][m][1]);
                float s = (sq4(acc[ai][0][m][0]) + sq4(acc[ai][0][m][1])) + (sq4(acc[ai][1][m][0]) + sq4(acc[ai][1][m][1]));
                s += __shfl_xor(s, 16); s += __shfl_xor(s, 32);
                if (fq == 0) SSQ[row * 16 + u.pn * 4 + wc] = s;
            }
    }
};
struct EpiPleGate {
    static constexpr bool PERM = true;
    bf16_t* G; const bf16_t* PR; const float* SSQ; const float* bias; const float* wpost;
    __device__ __forceinline__ void operator()(const AccT& acc, const pg8::Unit& u, int wr, int wc, int fr, int fq) const {
#pragma unroll
        for (int ai = 0; ai < 2; ++ai)
#pragma unroll
            for (int m = 0; m < 4; ++m) {
                asm volatile("" ::: "memory");
                const int row = u.pm * 256 + ai * 128 + wr * 64 + m * 16 + fr;
                float ss = 0.f;
#pragma unroll
                for (int q = 0; q < 4; ++q) { const f32x4 sv = *(const f32x4*)(SSQ + row * 16 + 4 * q); ss += (sv.x + sv.y) + (sv.z + sv.w); }
                const float rs = 1.f / sqrtf(ss * (1.f / D) + EPS);
#pragma unroll
                for (int bj = 0; bj < 2; ++bj) {
                    const int col = u.pn * 256 + bj * 128 + wc * 32 + 8 * fq;
                    const u32x4 pr = *(const u32x4*)(PR + (size_t)row * D + col);
                    const unsigned pw[4] = {pr.x, pr.y, pr.z, pr.w};
                    f32x4 o[2];
#pragma unroll
                    for (int n = 0; n < 2; ++n) {
                        const f32x4 bv = *(const f32x4*)(bias + col + 4 * n), wv = *(const f32x4*)(wpost + col + 4 * n);
                        const f32x4 av = acc[ai][bj][m][n] + bv;
                        const f32x4 pl = (f32x4){bf2f(pw[2 * n] & 0xffffu), bf2f(pw[2 * n] >> 16), bf2f(pw[2 * n + 1] & 0xffffu), bf2f(pw[2 * n + 1] >> 16)} * rs * wv;
#pragma unroll
                        for (int j = 0; j < 4; ++j) o[n][j] = pl[j] / (1.f + __expf(-av[j]));
                    }
                    *(u32x4*)(G + (size_t)row * D + col) = pack8(o[0], o[1]);
                }
            }
    }
};

struct GroupSched {
    const volatile LAS unsigned* ptile; int npn, G, c;
    __device__ __forceinline__ bool next(int i, pg8::Unit& u) const {
        const int L = i * G + c, total = (int)ptile[32] * npn; if (L >= total) return false;
        int e = 0;
        for (int q = 1; q < 32; ++q) e = (L >= (int)ptile[q] * npn) ? q : e;
        const int l = L - (int)ptile[e] * npn;
        u.pm = __builtin_amdgcn_readfirstlane((int)ptile[e] + l / npn); u.pn = __builtin_amdgcn_readfirstlane(e * npn + l % npn); return true;
    }
};
struct EpiMoeGU {
    static constexpr bool PERM = true;
    bf16_t* HE;
    __device__ __forceinline__ void operator()(const AccT& acc, const pg8::Unit& u, int wr, int wc, int fr, int fq) const {
        const int pn_l = u.pn & 1;
#pragma unroll
        for (int ai = 0; ai < 2; ++ai)
#pragma unroll
            for (int m = 0; m < 4; ++m) {
                const size_t row = (size_t)u.pm * 256 + ai * 128 + wr * 64 + m * 16 + fr;
                f32x4 h0, h1;
#pragma unroll
                for (int j = 0; j < 4; ++j) { const float g0 = acc[ai][0][m][0][j], g1 = acc[ai][0][m][1][j];
                    h0[j] = g0 / (1.f + __expf(-g0)) * acc[ai][1][m][0][j]; h1[j] = g1 / (1.f + __expf(-g1)) * acc[ai][1][m][1][j]; }
                *(u32x4*)(HE + row * 256 + pn_l * 128 + wc * 32 + 8 * fq) = pack8(h0, h1);
            }
    }
};
struct EpiMoeDown {
    static constexpr bool PERM = true;
    bf16_t* Y; const int* BUCKET; const float* ROUTE; const volatile LAS unsigned* ptile; const volatile LAS unsigned* cnt;
    __device__ __forceinline__ void operator()(const AccT& acc, const pg8::Unit& u, int wr, int wc, int fr, int fq) const {
        const int e = u.pn >> 2, pn_l = u.pn & 3, pm_l = u.pm - (int)ptile[e], n_e = (int)cnt[e];
#pragma unroll
        for (int ai = 0; ai < 2; ++ai)
#pragma unroll
            for (int m = 0; m < 4; ++m) {
                const int idx = pm_l * 256 + ai * 128 + wr * 64 + m * 16 + fr;
                if (idx < n_e) {
                    const int ent = BUCKET[(size_t)e * T + idx];
                    const float w = ROUTE[(ent >> 1) * 4 + 2 + (ent & 1)];
                    bf16_t* yp = Y + (size_t)ent * D + pn_l * 256 + wc * 32 + 8 * fq;
#pragma unroll
                    for (int bj = 0; bj < 2; ++bj) *(u32x4*)(yp + bj * 128) = pack8(acc[ai][bj][m][0] * w, acc[ai][bj][m][1] * w);
                }
            }
    }
};

template <class CM, class GN>
__device__ __forceinline__ void transpose_item(const float* W, int ldw, int K, bf16_t* WT, float* scr, int kb, int nb, int lane, CM cm, GN gain) {
    const int k0 = 64 * kb, n0 = 32 * nb;
    const int sc = cm(n0 + (lane & 31));
#pragma unroll 8
    for (int i = 0; i < 32; ++i) { const int kk = 2 * i + (lane >> 5); scr[kk * 33 + (lane & 31)] = sc >= 0 ? W[(size_t)(k0 + kk) * ldw + sc] * gain(k0 + kk) : 0.f; }
    asm volatile("s_waitcnt lgkmcnt(0)" ::: "memory");
    const int c = lane & 7;
#pragma unroll
    for (int j = 0; j < 4; ++j) { const int n = (lane >> 3) + 8 * j; const float* s = scr + (8 * c) * 33 + n;
        u32x4 o; o.x = pk2(s[0 * 33], s[1 * 33]); o.y = pk2(s[2 * 33], s[3 * 33]); o.z = pk2(s[4 * 33], s[5 * 33]); o.w = pk2(s[6 * 33], s[7 * 33]);
        *(u32x4*)(WT + (size_t)(n0 + n) * K + k0 + 8 * c) = o; }
    asm volatile("s_waitcnt lgkmcnt(0)" ::: "memory");
}


namespace att {
typedef short bf16x8 __attribute__((ext_vector_type(8)));
typedef short s16x4 __attribute__((ext_vector_type(4)));
typedef float f32x16 __attribute__((ext_vector_type(16)));
typedef short v4i16_t __attribute__((ext_vector_type(4)));
typedef float f32x2_t __attribute__((ext_vector_type(2))); typedef __bf16 bf16x2_t __attribute__((ext_vector_type(2)));
constexpr int KT = 64, NT = S / KT, KBYTES = KT * DQK * 2, VBYTES = KT * DV * 2, STAGE = KBYTES + VBYTES;
__device__ __forceinline__ unsigned cvtpk(float lo, float hi) { f32x2_t v = {lo, hi}; bf16x2_t b = __builtin_convertvector(v, bf16x2_t); return __builtin_bit_cast(unsigned, b); }
__device__ __forceinline__ s16x4 vtr(const LAS unsigned char* p) { return __builtin_bit_cast(s16x4, __builtin_amdgcn_ds_read_tr16_b64_v4i16((LAS v4i16_t*)p)); }
__device__ __forceinline__ float half_max(float m) { auto rr = __builtin_amdgcn_permlane32_swap(__float_as_uint(m), __float_as_uint(m), false, false); return fmaxf(__uint_as_float(rr[0]), __uint_as_float(rr[1])); }
__device__ __forceinline__ float half_sum(float m) { auto rr = __builtin_amdgcn_permlane32_swap(__float_as_uint(m), __float_as_uint(m), false, false); return __uint_as_float(rr[0]) + __uint_as_float(rr[1]); }

constexpr int KRING = 0, VRING = 4 * KBYTES, ATT_THR = 8;
__device__ __forceinline__ void attn_unit(LAS unsigned char* lds, const bf16_t* Qg, const bf16_t* Kg, const bf16_t* Vg, bf16_t* MIXg, int bh, int qb) {
    int tid = threadIdx.x; asm volatile("" : "+v"(tid));
    const int lane = tid & 63, wid = __builtin_amdgcn_readfirstlane(tid >> 6), r32 = lane & 31, hi = lane >> 5;
    const size_t rowbase = (size_t)bh * S;
    const bf16_t* qrow = Qg + (rowbase + qb * 256 + wid * 32 + r32) * DQK + 8 * hi;
    bf16x8 qf[6];
#pragma unroll
    for (int ds = 0; ds < 6; ++ds) qf[ds] = *(const bf16x8*)(qrow + ds * 16);
    const char* ksrc0 = (const char*)(Kg + rowbase * DQK) + wid * 1024 + lane * 16;
    const char* ksrc1 = ksrc0 + 8 * 1024;
    const char* vsrc = (const char*)(Vg + rowbase * DV) + wid * 1024 + lane * 16;
#define ATT_DMA_K(t, slot) do { \
        __builtin_amdgcn_global_load_lds((const unsigned*)(ksrc0 + (size_t)(t) * (KT * DQK * 2)), (LAS unsigned*)(lds + KRING + (slot) * KBYTES + wid * 1024), 16, 0, 0); \
        if (wid < 4) __builtin_amdgcn_global_load_lds((const unsigned*)(ksrc1 + (size_t)(t) * (KT * DQK * 2)), (LAS unsigned*)(lds + KRING + (slot) * KBYTES + (wid + 8) * 1024), 16, 0, 0); } while (0)
#define ATT_DMA_V(t, slot) __builtin_amdgcn_global_load_lds((const unsigned*)(vsrc + (size_t)(t) * (KT * DV * 2)), (LAS unsigned*)(lds + VRING + (slot) * VBYTES + wid * 1024), 16, 0, 0)
#define ATT_SYNC() do { asm volatile("s_waitcnt vmcnt(0) lgkmcnt(0)" ::: "memory"); __builtin_amdgcn_s_barrier(); __builtin_amdgcn_sched_barrier(0); } while (0)
#define ATT_SYNCN(tau) do { if ((tau) + 2 < NT) { if (g0) asm volatile("s_waitcnt vmcnt(3) lgkmcnt(0)" ::: "memory"); else asm volatile("s_waitcnt vmcnt(2) lgkmcnt(0)" ::: "memory"); } \
        else asm volatile("s_waitcnt vmcnt(0) lgkmcnt(0)" ::: "memory"); __builtin_amdgcn_s_barrier(); __builtin_amdgcn_sched_barrier(0); } while (0)
    const int koff = KRING + hi * 1024 + r32 * 16;
    const int voff = VRING + (4 * hi + ((lane & 15) >> 2)) * 64 + ((lane >> 4) & 1) * 32 + (lane & 3) * 8;
    f32x16 o0 = {}, o1 = {}, negm = {};
    float mref = 0.f, lpart = 0.f;
    f32x16 sA0, sA1, sB0, sB1;
    u32x4 pw[4];
    bf16x8 kf[12], vf[8];
#define ATT_SB() __builtin_amdgcn_sched_barrier(0)
#define ATT_LOADK(kslot) do { const LAS unsigned char* kb_ = lds + koff + (kslot) * KBYTES; \
        _Pragma("unroll") for (int ds = 0; ds < 6; ++ds) { kf[2 * ds] = *(const LAS bf16x8*)(kb_ + ds * 2048); kf[2 * ds + 1] = *(const LAS bf16x8*)(kb_ + ds * 2048 + 512); } } while (0)
#define ATT_LOADV(vslot) do { const LAS unsigned char* vb_ = lds + voff + (vslot) * VBYTES; \
        _Pragma("unroll") for (int ks = 0; ks < 4; ++ks) { \
            const s16x4 a0_ = vtr(vb_ + (2 * ks) * 512), a1_ = vtr(vb_ + (2 * ks + 1) * 512), b0_ = vtr(vb_ + (8 + 2 * ks) * 512), b1_ = vtr(vb_ + (8 + 2 * ks + 1) * 512); \
            vf[2 * ks] = (bf16x8){a0_[0], a0_[1], a0_[2], a0_[3], a1_[0], a1_[1], a1_[2], a1_[3]}; \
            vf[2 * ks + 1] = (bf16x8){b0_[0], b0_[1], b0_[2], b0_[3], b1_[0], b1_[1], b1_[2], b1_[3]}; } } while (0)
#define ATT_QK(X0, X1) do { \
        X0 = __builtin_amdgcn_mfma_f32_32x32x16_bf16(kf[0], qf[0], negm, 0, 0, 0); X1 = __builtin_amdgcn_mfma_f32_32x32x16_bf16(kf[1], qf[0], negm, 0, 0, 0); \
        _Pragma("unroll") for (int ds = 1; ds < 6; ++ds) { X0 = __builtin_amdgcn_mfma_f32_32x32x16_bf16(kf[2 * ds], qf[ds], X0, 0, 0, 0); X1 = __builtin_amdgcn_mfma_f32_32x32x16_bf16(kf[2 * ds + 1], qf[ds], X1, 0, 0, 0); } } while (0)
#define ATT_PV() do { \
        _Pragma("unroll") for (int ks = 0; ks < 4; ++ks) { const bf16x8 pf_ = __builtin_bit_cast(bf16x8, pw[ks]); \
            o0 = __builtin_amdgcn_mfma_f32_32x32x16_bf16(vf[2 * ks], pf_, o0, 0, 0, 0); o1 = __builtin_amdgcn_mfma_f32_32x32x16_bf16(vf[2 * ks + 1], pf_, o1, 0, 0, 0); } } while (0)
#define ATT_MAXPHASE(X0, X1, FIRST) do { \
        float mx_ = fmaxf(fmaxf(X0[0], X0[1]), X1[0]); float my_ = fmaxf(fmaxf(X0[2], X0[3]), X1[1]); mx_ = fmaxf(fmaxf(mx_, X1[2]), X1[3]); \
        _Pragma("unroll") for (int r = 4; r < 16; r += 4) { mx_ = fmaxf(fmaxf(mx_, X0[r]), X0[r + 1]); my_ = fmaxf(fmaxf(my_, X0[r + 2]), X0[r + 3]); mx_ = fmaxf(fmaxf(mx_, X1[r]), X1[r + 1]); my_ = fmaxf(fmaxf(my_, X1[r + 2]), X1[r + 3]); } \
        mx_ = half_max(fmaxf(mx_, my_)); \
        if ((FIRST) || __builtin_expect(__any(mx_ > (float)ATT_THR), 0)) { \
            asm volatile("; rescale (rare)" ::: "memory"); const float dl_ = (FIRST) ? mx_ : fmaxf(mx_, 0.f); mref += dl_; const float f_ = (FIRST) ? 1.f : __builtin_amdgcn_exp2f(-dl_); \
            _Pragma("unroll") for (int r = 0; r < 16; ++r) { X0[r] -= dl_; X1[r] -= dl_; o0[r] *= f_; o1[r] *= f_; negm[r] = -mref; } \
            lpart *= f_; asm volatile("" : "+v"(negm)); } } while (0)
#define ATT_EXPPHASE(X0, X1) do { float ls_ = 0.f; \
        _Pragma("unroll") for (int r = 0; r < 16; ++r) { X0[r] = __builtin_amdgcn_exp2f(X0[r]); X1[r] = __builtin_amdgcn_exp2f(X1[r]); ls_ += X0[r] + X1[r]; } \
        lpart += ls_; \
        _Pragma("unroll") for (int s = 0; s < 2; ++s) { \
            pw[s] = (u32x4){cvtpk(X0[8 * s], X0[8 * s + 1]), cvtpk(X0[8 * s + 2], X0[8 * s + 3]), cvtpk(X0[8 * s + 4], X0[8 * s + 5]), cvtpk(X0[8 * s + 6], X0[8 * s + 7])}; \
            pw[2 + s] = (u32x4){cvtpk(X1[8 * s], X1[8 * s + 1]), cvtpk(X1[8 * s + 2], X1[8 * s + 3]), cvtpk(X1[8 * s + 4], X1[8 * s + 5]), cvtpk(X1[8 * s + 6], X1[8 * s + 7])}; } } while (0)
#define ATT_ISSUE(t) do { if ((t) + 3 < NT) ATT_DMA_K((t) + 3, ((t) + 3) & 3); if ((t) + 2 < NT) ATT_DMA_V((t) + 2, ((t) + 2) & 3); } while (0)

    const bool g0 = wid < 4;
#define ATT_X(C0, C1, t) do { ATT_LOADV(((t) - 1) & 3); ATT_SB(); ATT_PV(); ATT_SB(); ATT_MAXPHASE(C0, C1, false); ATT_SB(); } while (0)
#define ATT_Y(C0, C1, N0, N1, t) do { ATT_LOADK(((t) + 1) & 3); ATT_SB(); ATT_EXPPHASE(C0, C1); ATT_SB(); ATT_QK(N0, N1); ATT_SB(); } while (0)
    ATT_DMA_K(0, 0); ATT_DMA_V(0, 0); ATT_DMA_K(1, 1);
    ATT_SYNC();
    ATT_DMA_K(2, 2); ATT_DMA_V(1, 1);
    ATT_LOADK(0); ATT_QK(sA0, sA1);
    ATT_SYNC();
    ATT_ISSUE(0);
    ATT_MAXPHASE(sA0, sA1, true);
    if (!g0) { ATT_SYNCN(1); ATT_ISSUE(1); }
    ATT_Y(sA0, sA1, sB0, sB1, 0);
    for (int t = 1; t + 2 < NT; t += 2) {
        if (g0) { ATT_SYNCN(t); ATT_ISSUE(t); }
        ATT_X(sB0, sB1, t);
        if (!g0) { ATT_SYNCN(t + 1); ATT_ISSUE(t + 1); }
        ATT_Y(sB0, sB1, sA0, sA1, t);
        if (g0) { ATT_SYNCN(t + 1); ATT_ISSUE(t + 1); }
        ATT_X(sA0, sA1, t + 1);
        if (!g0) { ATT_SYNCN(t + 2); ATT_ISSUE(t + 2); }
        ATT_Y(sA0, sA1, sB0, sB1, t + 1);
    }
    if (g0) { ATT_SYNCN(NT - 1); }
    ATT_X(sB0, sB1, NT - 1);
    ATT_EXPPHASE(sB0, sB1);
    ATT_LOADV((NT - 1) & 3); ATT_PV();
#undef ATT_X
#undef ATT_Y
    const float rl = 1.f / half_sum(lpart);
    const int b = bh >> 3, h = bh & 7;
    bf16_t* orow = MIXg + ((size_t)b * S + qb * 256 + wid * 32 + r32) * D + h * 64 + 4 * hi;
#pragma unroll
    for (int g4 = 0; g4 < 4; ++g4) {
        u32x2 w0, w1;
        w0.x = cvtpk(o0[4 * g4] * rl, o0[4 * g4 + 1] * rl); w0.y = cvtpk(o0[4 * g4 + 2] * rl, o0[4 * g4 + 3] * rl);
        w1.x = cvtpk(o1[4 * g4] * rl, o1[4 * g4 + 1] * rl); w1.y = cvtpk(o1[4 * g4 + 2] * rl, o1[4 * g4 + 3] * rl);
        *(u32x2*)(orow + 8 * g4) = w0; *(u32x2*)(orow + 32 + 8 * g4) = w1;
    }
    asm volatile("s_waitcnt lgkmcnt(0)" ::: "memory"); __builtin_amdgcn_s_barrier();
#undef ATT_DMA_K
#undef ATT_DMA_V
#undef ATT_SYNC
#undef ATT_QK
#undef ATT_PV
#undef ATT_MAXPHASE
#undef ATT_EXPPHASE
#undef ATT_SYNCN
#undef ATT_LOADK
#undef ATT_LOADV
#undef ATT_SB
#undef ATT_ISSUE
}
}


namespace ssd {
typedef short bf16x8 __attribute__((ext_vector_type(8)));
typedef short bf16x4 __attribute__((ext_vector_type(4)));
typedef float f32x16 __attribute__((ext_vector_type(16)));
constexpr int CH = 128, NCH = S / CH;
constexpr float LOG2E = 1.4426950408889634f;
__device__ __forceinline__ int crow(int r, int hi) { return (r & 3) + 8 * (r >> 2) + 4 * hi; }
__device__ __forceinline__ unsigned cvtpk(float lo, float hi) { return att::cvtpk(lo, hi); }
__device__ __forceinline__ void scan128(float a0, float a1, int lane, float& p0, float& p1, float& tot) {
    float s = a0 + a1;
#pragma unroll
    for (int o = 1; o < 64; o <<= 1) { const float t = __shfl_up(s, o); if (lane >= o) s += t; }
    tot = __shfl(s, 63); p1 = s; p0 = s - a1;
}
__device__ __forceinline__ void conv_chunk(float* smf, const bf16_t* PROJ, const float* cw, const float* cb, bf16_t* XBCC, bf16_t* XT, bf16_t* BT,
                                           const float* DTRAW, const float* dtb, float* DT, int b, int c) {
    int tid = threadIdx.x; asm volatile("" : "+v"(tid));
    const int t0 = b * S + c * CH, s0 = c * CH;
    if (tid < 2048 / 4) {
        const f32x4 raw = *(const f32x4*)(DTRAW + (size_t)t0 * 16 + tid * 4); const f32x4 bb = *(const f32x4*)(dtb + ((tid * 4) & 15)); f32x4 o;
#pragma unroll
        for (int j = 0; j < 4; ++j) { const float v = raw[j] + bb[j]; o[j] = v > 20.f ? v : log1pf(expf(v)); }
        *(f32x4*)(DT + (size_t)t0 * 16 + tid * 4) = o;
    }
    const int ch = tid & 127, lq = tid >> 7;
    for (int cbk = 0; cbk < 6; ++cbk) {
        __syncthreads();
        for (int i = tid; i < 132 * 16; i += 512) {
            const int r = i >> 4, c8 = (i & 15) * 8, ss = s0 - 2 + r;
            u32x4 v = (u32x4){0u, 0u, 0u, 0u};
            if (ss >= 0 && ss < S) v = *(const u32x4*)(PROJ + (size_t)(b * S + ss) * PROJ_N + PC_XBC + cbk * 128 + c8);
            float* d = smf + r * 128 + c8;
            d[0] = bf2f(v.x & 0xffffu); d[1] = bf2f(v.x >> 16); d[2] = bf2f(v.y & 0xffffu); d[3] = bf2f(v.y >> 16);
            d[4] = bf2f(v.z & 0xffffu); d[5] = bf2f(v.z >> 16); d[6] = bf2f(v.w & 0xffffu); d[7] = bf2f(v.w >> 16);
        }
        __syncthreads();
        const int gch = cbk * 128 + ch;
        float w[5];
#pragma unroll
        for (int k = 0; k < 5; ++k) w[k] = cw[k * XBC + gch];
        const float bias = cb[gch];
        unsigned pk[16];
        float x0 = smf[(lq * 32 + 0) * 128 + ch], x1 = smf[(lq * 32 + 1) * 128 + ch], x2 = smf[(lq * 32 + 2) * 128 + ch], x3 = smf[(lq * 32 + 3) * 128 + ch];
        float prev = 0.f;
#pragma unroll
        for (int l = 0; l < 32; ++l) {
            const float x4 = smf[(lq * 32 + l + 4) * 128 + ch];
            const float acc = bias + w[0] * x0 + w[1] * x1 + w[2] * x2 + w[3] * x3 + w[4] * x4;
            const float v = acc / (1.f + __expf(-acc));
            XBCC[(size_t)(t0 + lq * 32 + l) * XBC + gch] = (bf16_t)f2bf(v);
            if (l & 1) pk[l >> 1] = pk2(prev, v); else prev = v;
            x0 = x1; x1 = x2; x2 = x3; x3 = x4;
        }
        if (cbk < 5) {
            bf16_t* dst = cbk < 4 ? XT + ((size_t)(b * NCH + c) * 512 + gch) * CH + lq * 32 : BT + ((size_t)(b * NCH + c) * 128 + ch) * CH + lq * 32;
#pragma unroll
            for (int q = 0; q < 4; ++q) *(u32x4*)(dst + q * 8) = (u32x4){pk[4 * q], pk[4 * q + 1], pk[4 * q + 2], pk[4 * q + 3]};
        }
    }
    __syncthreads();
}
__device__ __forceinline__ void states_chunk(float* wtab_all, const bf16_t* XT, const bf16_t* BT, const float* DT, const float* alog, float* STATES, float* CDEC, int b, int c) {
    int tid = threadIdx.x; asm volatile("" : "+v"(tid));
    const int lane = tid & 63, hd = __builtin_amdgcn_readfirstlane(tid >> 6), g = hd >> 2, r32 = lane & 31, hi = lane >> 5;
    float* wtab = wtab_all + hd * 128;
    const size_t t0 = (size_t)b * S + c * CH;
    const bf16_t* xt = XT + ((size_t)(b * NCH + c) * 512 + hd * 64) * CH; const bf16_t* bt = BT + ((size_t)(b * NCH + c) * 128 + g * 64) * CH;
    for (int dir = 0; dir < 2; ++dir) {
        const float av = -expf(alog[dir * 8 + hd]);
        const float d0 = DT[(t0 + 2 * lane) * 16 + dir * 8 + hd], d1 = DT[(t0 + 2 * lane + 1) * 16 + dir * 8 + hd];
        float p0, p1, tot; scan128(d0 * av, d1 * av, lane, p0, p1, tot);
        const float w0 = dir == 0 ? __expf(tot - p0) * d0 : __expf(p0 - d0 * av) * d0;
        const float w1 = dir == 0 ? __expf(tot - p1) * d1 : __expf(p1 - d1 * av) * d1;
        wtab[2 * lane] = w0; wtab[2 * lane + 1] = w1;
        if (lane == 0) CDEC[((b * NCH + c) * 2 + dir) * 8 + hd] = __expf(tot);
        asm volatile("s_waitcnt lgkmcnt(0)" ::: "memory");
        f32x16 acc[2][2];
#pragma unroll
        for (int i = 0; i < 2; ++i)
#pragma unroll
            for (int j = 0; j < 2; ++j) acc[i][j] = (f32x16){};
#pragma unroll 2
        for (int ks = 0; ks < 8; ++ks) {
            const f32x4 wa = *(const f32x4*)(wtab + 16 * ks + 8 * hi), wb = *(const f32x4*)(wtab + 16 * ks + 8 * hi + 4);
            bf16x8 xb[2], bb[2];
#pragma unroll
            for (int pb = 0; pb < 2; ++pb) {
                const u32x4 v = *(const u32x4*)(xt + (size_t)(32 * pb + r32) * CH + 16 * ks + 8 * hi);
                u32x4 o; o.x = cvtpk(bf2f(v.x & 0xffffu) * wa.x, bf2f(v.x >> 16) * wa.y); o.y = cvtpk(bf2f(v.y & 0xffffu) * wa.z, bf2f(v.y >> 16) * wa.w);
                o.z = cvtpk(bf2f(v.z & 0xffffu) * wb.x, bf2f(v.z >> 16) * wb.y); o.w = cvtpk(bf2f(v.w & 0xffffu) * wb.z, bf2f(v.w >> 16) * wb.w);
                xb[pb] = __builtin_bit_cast(bf16x8, o);
            }
#pragma unroll
            for (int nb = 0; nb < 2; ++nb) bb[nb] = *(const bf16x8*)(bt + (size_t)(32 * nb + r32) * CH + 16 * ks + 8 * hi);
#pragma unroll
            for (int nb = 0; nb < 2; ++nb)
#pragma unroll
                for (int pb = 0; pb < 2; ++pb) acc[nb][pb] = __builtin_amdgcn_mfma_f32_32x32x16_bf16(bb[nb], xb[pb], acc[nb][pb], 0, 0, 0);
        }
        float* st = STATES + ((size_t)((b * NCH + c) * 2 + dir) * 8 + hd) * 4096;
#pragma unroll
        for (int nb = 0; nb < 2; ++nb)
#pragma unroll
            for (int pb = 0; pb < 2; ++pb)
#pragma unroll
                for (int q = 0; q < 4; ++q)
                    *(f32x4*)(st + (32 * pb + r32) * 64 + 32 * nb + 8 * q + 4 * hi) = (f32x4){acc[nb][pb][4 * q], acc[nb][pb][4 * q + 1], acc[nb][pb][4 * q + 2], acc[nb][pb][4 * q + 3]};
    }
}
__device__ __forceinline__ void finalize_chunk(float* smf, const bf16_t* XBCC, const bf16_t* XT, const bf16_t* PROJ, const float* DT, const float* alog, const bf16_t* HPB,
                                               const float* ssdd, const float* ssdnw, bf16_t* MIX, int b, int c) {
    int tid = threadIdx.x; asm volatile("" : "+v"(tid));
    const int lane = tid & 63, hd = __builtin_amdgcn_readfirstlane(tid >> 6), g = hd >> 2, r32 = lane & 31, hi = lane >> 5;
    f32x4* tab = (f32x4*)smf + hd * 128;
    float* red = smf + 8 * 128 * 4;
    const size_t t0 = (size_t)b * S + c * CH;
    {
        const float af = -expf(alog[hd]), ab = -expf(alog[8 + hd]);
        const float f0 = DT[(t0 + 2 * lane) * 16 + hd], f1 = DT[(t0 + 2 * lane + 1) * 16 + hd];
        const float b0 = DT[(t0 + 2 * lane) * 16 + 8 + hd], b1 = DT[(t0 + 2 * lane + 1) * 16 + 8 + hd];
        float pf0, pf1, tf, pb0, pb1, tb;
        scan128(f0 * af, f1 * af, lane, pf0, pf1, tf); scan128(b0 * ab, b1 * ab, lane, pb0, pb1, tb);
        tab[2 * lane] = (f32x4){pf0, f0, tb - (pb0 - b0 * ab), b0}; tab[2 * lane + 1] = (f32x4){pf1, f1, tb - (pb1 - b1 * ab), b1};
        asm volatile("s_waitcnt lgkmcnt(0)" ::: "memory");
    }
    const bf16_t* xt = XT + ((size_t)(b * NCH + c) * 512 + hd * 64) * CH + (size_t)r32 * CH + 4 * hi;
    const bf16_t* brow = XBCC + (t0 + r32) * XBC + 512 + g * 64 + 8 * hi;
    const bf16_t* hpb = HPB + ((size_t)((b * NCH + c) * 2) * 8 + hd) * 4096 + (size_t)r32 * 64 + 8 * hi;
    const float dsk = ssdd[hd];
#define FIN_LOADB(dst, jb) do { _Pragma("unroll") for (int ks = 0; ks < 4; ++ks) dst[ks] = *(const bf16x8*)(brow + (size_t)(jb) * 32 * XBC + 16 * ks); } while (0)
#define FIN_LOADX(dst, jb) do { _Pragma("unroll") for (int s = 0; s < 2; ++s) _Pragma("unroll") for (int pb = 0; pb < 2; ++pb) { \
        const bf16_t* xp_ = xt + (size_t)pb * 32 * CH + 32 * (jb) + 16 * s; const u32x2 lo_ = *(const u32x2*)xp_, hi_ = *(const u32x2*)(xp_ + 8); \
        dst[2 * s + pb] = __builtin_bit_cast(bf16x8, (u32x4){lo_.x, lo_.y, hi_.x, hi_.y}); } } while (0)
#define FIN_LOADH(dst, dir) do { _Pragma("unroll") for (int ks = 0; ks < 4; ++ks) _Pragma("unroll") for (int pb = 0; pb < 2; ++pb) \
        dst[2 * ks + pb] = *(const bf16x8*)(hpb + (size_t)(dir) * 8 * 4096 + pb * 32 * 64 + 16 * ks); } while (0)
#define FIN_TILE(jb, bfr, xf) do { \
        f32x16 gt = (f32x16){}; \
        _Pragma("unroll") for (int ks = 0; ks < 4; ++ks) gt = __builtin_amdgcn_mfma_f32_32x32x16_bf16(bfr[ks], cf[ks], gt, 0, 0, 0); \
        _Pragma("unroll") for (int r = 0; r < 16; ++r) { \
            const int j = 32 * (jb) + crow(r, hi); const f32x4 tj = tab[j]; \
            const bool lt = j < i, gtj = j > i; \
            const float arg = lt ? ti.x - tj.x : (gtj ? ti.z - tj.z : 0.f); \
            const float dj = lt ? tj.y : (gtj ? tj.w : ti.y + ti.w); \
            gt[r] = gt[r] * __builtin_amdgcn_exp2f(arg * LOG2E) * dj; } \
        u32x4 pw[2]; \
        _Pragma("unroll") for (int s = 0; s < 2; ++s) pw[s] = (u32x4){cvtpk(gt[8 * s], gt[8 * s + 1]), cvtpk(gt[8 * s + 2], gt[8 * s + 3]), cvtpk(gt[8 * s + 4], gt[8 * s + 5]), cvtpk(gt[8 * s + 6], gt[8 * s + 7])}; \
        _Pragma("unroll") for (int s = 0; s < 2; ++s) _Pragma("unroll") for (int pb = 0; pb < 2; ++pb) \
            yT[pb] = __builtin_amdgcn_mfma_f32_32x32x16_bf16(xf[2 * s + pb], __builtin_bit_cast(bf16x8, pw[s]), yT[pb], 0, 0, 0); } while (0)
#define FIN_YOFF(hp, dir) do { const float ei = __builtin_amdgcn_exp2f(((dir) == 0 ? ti.x : ti.z) * LOG2E); \
        _Pragma("unroll") for (int ks = 0; ks < 4; ++ks) { \
            const u32x4 cv = __builtin_bit_cast(u32x4, cf[ks]); u32x4 cs; \
            cs.x = cvtpk(bf2f(cv.x & 0xffffu) * ei, bf2f(cv.x >> 16) * ei); cs.y = cvtpk(bf2f(cv.y & 0xffffu) * ei, bf2f(cv.y >> 16) * ei); \
            cs.z = cvtpk(bf2f(cv.z & 0xffffu) * ei, bf2f(cv.z >> 16) * ei); cs.w = cvtpk(bf2f(cv.w & 0xffffu) * ei, bf2f(cv.w >> 16) * ei); \
            _Pragma("unroll") for (int pb = 0; pb < 2; ++pb) yT[pb] = __builtin_amdgcn_mfma_f32_32x32x16_bf16(hp[2 * ks + pb], __builtin_bit_cast(bf16x8, cs), yT[pb], 0, 0, 0); } } while (0)
    bf16x8 bA[4], bB[4], xA[4], xB[4], hA[8], hB[8];
    FIN_LOADB(bA, 0); FIN_LOADX(xA, 0);
#pragma unroll 1
    for (int ib = 0; ib < 4; ++ib) {
        asm volatile("" : "+v"(brow), "+v"(xt), "+v"(hpb));
        const int i = 32 * ib + r32;
        const f32x4 ti = tab[i];
        bf16x8 cf[4];
#pragma unroll
        for (int ks = 0; ks < 4; ++ks) cf[ks] = *(const bf16x8*)(XBCC + (t0 + i) * XBC + 640 + g * 64 + 16 * ks + 8 * hi);
        f32x16 yT[2]; yT[0] = (f32x16){}; yT[1] = (f32x16){};
        FIN_LOADB(bB, 1); FIN_LOADX(xB, 1); __builtin_amdgcn_sched_barrier(0);
        FIN_TILE(0, bA, xA);
        FIN_LOADB(bA, 2); FIN_LOADX(xA, 2); __builtin_amdgcn_sched_barrier(0);
        FIN_TILE(1, bB, xB);
        FIN_LOADB(bB, 3); FIN_LOADX(xB, 3); __builtin_amdgcn_sched_barrier(0);
        FIN_TILE(2, bA, xA);
        FIN_LOADH(hA, 0); __builtin_amdgcn_sched_barrier(0);
        FIN_TILE(3, bB, xB);
        FIN_LOADH(hB, 1); __builtin_amdgcn_sched_barrier(0);
        FIN_YOFF(hA, 0);
        u32x2 xv[8], zv[8];
#pragma unroll
        for (int q = 0; q < 8; ++q) { const int p = 32 * (q >> 2) + 8 * (q & 3) + 4 * hi;
            xv[q] = *(const u32x2*)(XBCC + (t0 + i) * XBC + hd * 64 + p); zv[q] = *(const u32x2*)(PROJ + (t0 + i) * PROJ_N + PC_Z + hd * 64 + p); }
        __builtin_amdgcn_sched_barrier(0);
        FIN_YOFF(hB, 1);
        FIN_LOADB(bA, 0); FIN_LOADX(xA, 0); __builtin_amdgcn_sched_barrier(0);
        float ss = 0.f;
#pragma unroll
        for (int q8 = 0; q8 < 8; ++q8) {
            const int pb = q8 >> 2, q = q8 & 3;
            const float xs[4] = {bf2f(xv[q8].x & 0xffffu), bf2f(xv[q8].x >> 16), bf2f(xv[q8].y & 0xffffu), bf2f(xv[q8].y >> 16)};
            const float zs[4] = {bf2f(zv[q8].x & 0xffffu), bf2f(zv[q8].x >> 16), bf2f(zv[q8].y & 0xffffu), bf2f(zv[q8].y >> 16)};
#pragma unroll
            for (int e = 0; e < 4; ++e) { const float y = yT[pb][4 * q + e] + dsk * xs[e]; const float gv = y * (zs[e] / (1.f + __expf(-zs[e]))); yT[pb][4 * q + e] = gv; ss += gv * gv; }
        }
        ss = att::half_sum(ss);
        __syncthreads();
        if (hi == 0) red[hd * 32 + r32] = ss;
        __syncthreads();
        float tot = 0.f;
#pragma unroll
        for (int w8 = 0; w8 < 8; ++w8) tot += red[w8 * 32 + r32];
        const float rstd = 1.f / sqrtf(tot * (1.f / 512.f) + EPS);
#pragma unroll
        for (int pb = 0; pb < 2; ++pb)
#pragma unroll
            for (int q = 0; q < 4; ++q) {
                const int p = 32 * pb + 8 * q + 4 * hi;
                const f32x4 wv = *(const f32x4*)(ssdnw + hd * 64 + p);
                u32x2 o; o.x = cvtpk(yT[pb][4 * q] * rstd * wv.x, yT[pb][4 * q + 1] * rstd * wv.y); o.y = cvtpk(yT[pb][4 * q + 2] * rstd * wv.z, yT[pb][4 * q + 3] * rstd * wv.w);
                *(u32x2*)(MIX + (t0 + i) * D + 512 + hd * 64 + p) = o;
            }
    }
#undef FIN_LOADB
#undef FIN_LOADX
#undef FIN_LOADH
#undef FIN_TILE
#undef FIN_YOFF
    __syncthreads();
}
}

struct Args { const void* in[31]; float* out; unsigned char* ws; int ph_lo, ph_hi; };
#define IN_F(i) ((const float*)a.in[i])
enum { I_X = 0, I_P, I_POS, I_ATTN_NW, I_WIN, I_QNW, I_WUQ, I_KVNW, I_WUKV, I_AONW, I_CONVW, I_CONVB, I_DTB, I_ALOG, I_SSDD, I_SSDNW, I_WO, I_FFNNW,
       I_WRG, I_BRG, I_WRE, I_BRE, I_WEG, I_WEU, I_WED, I_PLENW, I_WPG, I_BPG, I_WPP, I_PPNW, I_FNW };

template <class FA, class FB, class FE>
__device__ __forceinline__ void naive_gemm(int M, int N, int K, FA fa, FB fb, FE fe, float* sm) {
    const int tid = threadIdx.x, tx = tid & 63, ty = tid >> 6;
    float* As = sm; float* Bs = sm + 64 * 17;
    const int ntm = M / 64, ntn = (N + 63) / 64;
    for (int tile = blockIdx.x; tile < ntm * ntn; tile += gridDim.x) {
        const int tm = tile / ntn, tn = tile % ntn;
        float acc[8];
#pragma unroll
        for (int j = 0; j < 8; ++j) acc[j] = 0.f;
        for (int k0 = 0; k0 < K; k0 += 16) {
            __syncthreads();
            for (int i = tid; i < 1024; i += 512) { const int r = i >> 4, c = i & 15; As[r * 17 + c] = fa(tm * 64 + r, k0 + c); }
            for (int i = tid; i < 1024; i += 512) { const int r = i >> 6, c = i & 63; const int n = tn * 64 + c; Bs[r * 64 + c] = (n < N) ? fb(k0 + r, n) : 0.f; }
            __syncthreads();
#pragma unroll
            for (int k = 0; k < 16; ++k) { const float b = Bs[k * 64 + tx];
#pragma unroll
                for (int j = 0; j < 8; ++j) acc[j] += As[(ty * 8 + j) * 17 + k] * b; }
        }
#pragma unroll
        for (int j = 0; j < 8; ++j) { const int m = tm * 64 + ty * 8 + j, n = tn * 64 + tx; if (n < N) fe(m, n, acc[j]); }
    }
    __syncthreads();
}

__device__ __forceinline__ int proj_src_col(int j) {
    if (j < 416) return j;
    if (j < 432) return 1696 + (j - 416);
    if (j < 512) return -1;
    if (j < 1024) return 416 + (j - 512);
    return 928 + (j - 1024);
}

__device__ __forceinline__ void rms_row_to_bf16(const float* xrow, const float* w, bf16_t* orow, int lane) {
    const f32x4* xr = (const f32x4*)xrow + lane; const f32x4* wr = (const f32x4*)w + lane;
    f32x4 v[4]; float s = 0.f;
#pragma unroll
    for (int j = 0; j < 4; ++j) { v[j] = xr[64 * j]; s += (v[j].x * v[j].x + v[j].y * v[j].y) + (v[j].z * v[j].z + v[j].w * v[j].w); }
    const float rstd = 1.f / sqrtf(wave_sum(s) * (1.f / D) + EPS);
    u32x2* o8 = (u32x2*)orow + lane;
#pragma unroll
    for (int j = 0; j < 4; ++j) { const f32x4 g = wr[64 * j]; u32x2 o; o.x = pk2(v[j].x * rstd * g.x, v[j].y * rstd * g.y); o.y = pk2(v[j].z * rstd * g.z, v[j].w * rstd * g.w); o8[64 * j] = o; }
}

constexpr int LDS_BYTES = 147456;
constexpr int MISC_OFF = 131072;

__global__ void __launch_bounds__(512, 2) fwd(Args a) {
    extern __shared__ __attribute__((aligned(16))) unsigned char lds_raw[];
    float* smf = (float*)lds_raw;
    const int G = gridDim.x, NGW = G * 8, NGT = G * 512;
#define FRESH_IDS() int tid = threadIdx.x; asm volatile("" : "+v"(tid)); const int lane = tid & 63, wave = __builtin_amdgcn_readfirstlane(tid >> 6); \
    const int gw = blockIdx.x * 8 + wave, gtid = blockIdx.x * 512 + tid; (void)lane; (void)gw; (void)gtid;
    unsigned char* ws = a.ws;
    unsigned* ctl = (unsigned*)(ws + WS_CTL);
    volatile LAS unsigned* MISC = (volatile LAS unsigned*)((LAS unsigned char*)lds_raw + MISC_OFF);
    if (threadIdx.x < 32) MISC[threadIdx.x] = 0u;
    __syncthreads();
#if !MK_PER_PHASE
    XcdBarrier bar = xcd_barrier_post(ctl + CW_BAR, MISC + 8);
#define GRID_BAR() xcd_barrier(bar)
#else
#define GRID_BAR() do {} while (0)
#endif
    const int lo = a.ph_lo, hi = a.ph_hi;
#ifndef PHMASK
#define PHMASK 0xFFFF
#endif
#define IN(k) (((PHMASK >> (k)) & 1) && lo <= (k) && (k) < hi)
#ifndef REPMASK
#define REPMASK 0
#endif
#define NREP(k) (1 + ((REPMASK >> (k)) & 1))
#define SEAM(k) do { if (IN(k) && IN((k) + 1)) GRID_BAR(); } while (0)

    const float* x = IN_F(I_X);
    float* out = a.out;
    bf16_t* H = (bf16_t*)(ws + WS_H);
    bf16_t* PROJ = (bf16_t*)(ws + WS_PROJ);
    bf16_t* PLERAW = (bf16_t*)(ws + WS_PROJ);
    bf16_t* Qb = (bf16_t*)(ws + WS_Q); bf16_t* Kb = (bf16_t*)(ws + WS_K); bf16_t* Vb = (bf16_t*)(ws + WS_V);
    bf16_t* MIX = (bf16_t*)(ws + WS_MIX);
    bf16_t* XBCC = (bf16_t*)(ws + WS_XBCC);
    float* STATES = out;
    bf16_t* XT = (bf16_t*)((char*)out + 64 * MiB);
    bf16_t* BT = (bf16_t*)((char*)out + 96 * MiB);
    bf16_t* HPB = (bf16_t*)(ws + WS_H);
    float* CDEC = (float*)(ws + WS_CDEC);
    float* COS = (float*)(ws + WS_COS); float* SIN = (float*)(ws + WS_SIN);
    float* DT = (float*)(ws + WS_DT); float* DTRAW = (float*)(ws + WS_DTRAW);
    float* ROUTE = (float*)(ws + WS_ROUTE);
    int* BUCKET = (int*)(ws + WS_BUCKET);
    const int* pos = (const int*)a.in[I_POS];

    bf16_t* WT_IN = (bf16_t*)(ws + WS_WEIGHTS);
    bf16_t* WT_UQ = WT_IN + (size_t)PROJ_N * D;
    bf16_t* WT_UKV = WT_UQ + 768 * 256;
    bf16_t* WT_O = WT_UKV + 1024 * 128;
    bf16_t* WT_PG = WT_O + (size_t)D * D;
    bf16_t* WT_PP = WT_PG + (size_t)D * D;
    bf16_t* WT_GU = WT_PP + (size_t)D * 256;
    bf16_t* WT_DN = WT_GU + (size_t)32 * 512 * 1024;
    bf16_t* PB = (bf16_t*)(ws + WS_PB);
    float* SSQQ = (float*)(ws + WS_SSQQ); float* SSQKV = (float*)(ws + WS_SSQKV); float* SSQPLE = (float*)(ws + WS_SSQPLE);
    LAS unsigned char* ldsb = (LAS unsigned char*)lds_raw;
    bf16_t* WRF = (bf16_t*)(ws + WS_WRF);
    float* SSQX1 = (float*)(ws + WS_SSQX1);

    if (IN(0)) {
        FRESH_IDS();
        for (int rep_ = 0; rep_ < NREP(0); ++rep_) {
        float* scr = smf + wave * 4096;
        constexpr int I_IN = 16 * 56, I_UQ = 4 * 24, I_UKV = 2 * 32, I_O = 16 * 32, I_PG = 16 * 32, I_PP = 4 * 32, I_GU = 32 * 16 * 16, I_DN = 32 * 4 * 32;
        constexpr int NITEMS = I_IN + I_UQ + I_UKV + I_O + I_PG + I_PP + I_GU + I_DN;
        const float* qnw = IN_F(I_QNW); const float* kvnw = IN_F(I_KVNW);
        const float qscale = 0.10206207261596575f * 1.4426950408889634f;
        auto one = [](int) { return 1.f; };
        auto ident = [](int n) { return n; };
        for (int it = gw; it < NITEMS; it += NGW) {
            int r = it;
            if (r < I_IN) { transpose_item(IN_F(I_WIN), IN_COLS, D, WT_IN, scr, r / 56, r % 56, lane, [](int n) { return proj_src_col(n); }, one); continue; } r -= I_IN;
            if (r < I_UQ) { transpose_item(IN_F(I_WUQ), 768, 256, WT_UQ, scr, r / 24, r % 24, lane, ident, [&](int k) { return qnw[k] * qscale; }); continue; } r -= I_UQ;
            if (r < I_UKV) { transpose_item(IN_F(I_WUKV), 1024, 128, WT_UKV, scr, r / 32, r % 32, lane, ident, [&](int k) { return kvnw[k]; }); continue; } r -= I_UKV;
            if (r < I_O) { transpose_item(IN_F(I_WO), D, D, WT_O, scr, r / 32, r % 32, lane, ident, one); continue; } r -= I_O;
            if (r < I_PG) { transpose_item(IN_F(I_WPG), D, D, WT_PG, scr, r / 32, r % 32, lane, ident, one); continue; } r -= I_PG;
            if (r < I_PP) { transpose_item(IN_F(I_WPP), D, 256, WT_PP, scr, r / 32, r % 32, lane, ident, one); continue; } r -= I_PP;
            if (r < I_GU) { const int e = r / 256, q = r % 256, kb = q / 16, nb = q % 16;
                const float* W = ((nb & 7) < 4 ? IN_F(I_WEG) : IN_F(I_WEU)) + (size_t)e * 1024 * 256;
                transpose_item(W, 256, D, WT_GU + (size_t)e * 512 * 1024, scr, kb, nb, lane, [](int n) { return (n >> 8) * 128 + (n & 127); }, one); continue; } r -= I_GU;
            { const int e = r / 128, q = r % 128; transpose_item(IN_F(I_WED) + (size_t)e * 256 * 1024, D, 256, WT_DN + (size_t)e * 1024 * 256, scr, q / 32, q % 32, lane, ident, one); }
        }
        { const f32x4* wr4 = (const f32x4*)IN_F(I_ATTN_NW) + lane;
          for (int m0 = gw * 4; m0 < T; m0 += NGW * 4) {
              f32x4 v[4][4];
#pragma unroll
              for (int r = 0; r < 4; ++r)
#pragma unroll
                  for (int j = 0; j < 4; ++j) v[r][j] = ((const f32x4*)(x + (size_t)(m0 + r) * D) + lane)[64 * j];
#pragma unroll
              for (int r = 0; r < 4; ++r) {
                  float s = 0.f;
#pragma unroll
                  for (int j = 0; j < 4; ++j) s += (v[r][j].x * v[r][j].x + v[r][j].y * v[r][j].y) + (v[r][j].z * v[r][j].z + v[r][j].w * v[r][j].w);
                  const float rstd = 1.f / sqrtf(wave_sum(s) * (1.f / D) + EPS);
                  u32x2* o8 = (u32x2*)(H + (size_t)(m0 + r) * D) + lane;
#pragma unroll
                  for (int j = 0; j < 4; ++j) { const f32x4 g4 = wr4[64 * j]; u32x2 o; o.x = pk2(v[r][j].x * rstd * g4.x, v[r][j].y * rstd * g4.y); o.y = pk2(v[r][j].z * rstd * g4.z, v[r][j].w * rstd * g4.w); o8[64 * j] = o; }
              } } }
        { const f32x4* pp = (const f32x4*)IN_F(I_P); u32x2* po = (u32x2*)PB;
          for (int i = gtid; i < T * 256 / 4; i += NGT) { const f32x4 v = pp[i]; u32x2 o; o.x = pk2(v.x, v.y); o.y = pk2(v.z, v.w); po[i] = o; } }
        { const float* wrg = IN_F(I_WRG); const float* wre = IN_F(I_WRE);
          for (int i = gtid; i < 32 * 3 * 64 * 8; i += NGT) { const int e = i & 7, l = (i >> 3) & 63, nb = (i >> 9) % 3, ks = i / 1536;
              const int k = 32 * ks + 8 * (l >> 4) + e, col = 16 * nb + (l & 15);
              const float w = col < 4 ? wrg[k * 4 + col] : (col < 36 ? wre[k * 32 + (col - 4)] : 0.f);
              const unsigned hi = f2bf(w); const float lo = w - bf2f(hi);
              const size_t base = ((size_t)(ks * 3 + nb) * 2) * 512 + l * 8 + e;
              WRF[base] = (bf16_t)hi; WRF[base + 512] = (bf16_t)f2bf(lo); } }
        for (int i = gtid; i < T * 16; i += NGT) {
            const int t = i >> 4, f = i & 15;
            const float inv = 1.0f / powf(10000.0f, (float)(2 * f) / 32.0f);
            const float ang = (float)pos[t] * inv;
            COS[i] = cosf(ang); SIN[i] = sinf(ang);
        }
        }
    }
    SEAM(0);
    if (IN(1)) {
        FRESH_IDS();
        for (int rep_ = 0; rep_ < NREP(1); ++rep_) {
        pg8::Gemm g{H, WT_IN, T, PROJ_N, D, D, D}; pg8::StaticOrder So; So.init(T, PROJ_N, G, (int)blockIdx.x);
        EpiInProj E{PROJ, DTRAW, SSQQ, SSQKV};
        pg8::gemm_phase(ldsb, g, So, E);
        }
    }
    SEAM(1);
    if (IN(2)) {
        FRESH_IDS();
        for (int rep_ = 0; rep_ < NREP(2); ++rep_)
        for (int u = blockIdx.x; u < NB * ssd::NCH; u += G) {
            ssd::conv_chunk(smf, PROJ, IN_F(I_CONVW), IN_F(I_CONVB), XBCC, XT, BT, DTRAW, IN_F(I_DTB), DT, u >> 5, u & 31);
            ssd::states_chunk(smf + 20480, XT, BT, DT, IN_F(I_ALOG), STATES, CDEC, u >> 5, u & 31);
            __syncthreads();
        }
        for (int i = gtid; i < T * 16; i += NGT) {
            const int t = i >> 4, f = i & 15, b = t / S, s = t % S;
            const float c = COS[i], sn = SIN[i];
            const float t1 = bf2f(PROJ[(size_t)t * PROJ_N + PC_KR + f]), t2 = bf2f(PROJ[(size_t)t * PROJ_N + PC_KR + 16 + f]);
            const bf16_t o1 = (bf16_t)f2bf(t1 * c - t2 * sn), o2 = (bf16_t)f2bf(t2 * c + t1 * sn);
            for (int h = 0; h < NH; ++h) { bf16_t* kt = Kb + ((size_t)(b * NH + h) * (S / 64) + (s >> 6)) * (12 * 512) + (s & 63) * 8 + (f & 7); kt[(8 + (f >> 3)) * 512] = o1; kt[(10 + (f >> 3)) * 512] = o2; }
        }
        __syncthreads();
        for (int rep2_ = 0; rep2_ < NREP(12); ++rep2_) {
        { pg8::Gemm g{PROJ + PC_CQ, WT_UQ, T, 768, 256, PROJ_N, 256}; pg8::StaticOrder So; So.init(T, 768, G, (int)blockIdx.x);
          EpiQUp E{Qb, SSQQ, COS, SIN}; pg8::gemm_phase(ldsb, g, So, E); }
        { pg8::Gemm g{PROJ + PC_CKV, WT_UKV, T, 1024, 128, PROJ_N, 128}; pg8::StaticOrder So; So.init(T, 1024, G, (int)blockIdx.x);
          EpiKVUp E{Kb, Vb, SSQKV}; pg8::gemm_phase(ldsb, g, So, E); }
        }
    }
    SEAM(2);
    if (IN(3)) {
        FRESH_IDS();
        for (int rep_ = 0; rep_ < NREP(13); ++rep_)
        for (int idx = gtid; idx < 128 * 1024; idx += NGT) {
            const int chain = idx >> 10, e4 = (idx & 1023) * 4, b = chain >> 4, dir = (chain >> 3) & 1, hd = chain & 7;
            f32x4 h4 = (f32x4){0.f, 0.f, 0.f, 0.f};
#pragma unroll 8
            for (int step = 0; step < ssd::NCH; ++step) {
                const int c = dir == 0 ? step : ssd::NCH - 1 - step;
                const int sidx = ((b * ssd::NCH + c) * 2 + dir) * 8 + hd;
                const f32x4* ptr = (const f32x4*)(STATES + (size_t)sidx * 4096 + e4);
                const f32x4 s4 = *ptr; { u32x2 hb; hb.x = pk2(h4.x, h4.y); hb.y = pk2(h4.z, h4.w); *(u32x2*)(HPB + (size_t)sidx * 4096 + e4) = hb; } h4 = h4 * CDEC[sidx] + s4;
            }
        }
        __syncthreads();
        for (int rep_ = 0; rep_ < NREP(3); ++rep_) {
        {
            const int vcu = (G % 8 == 0) ? ((int)blockIdx.x % 8) * (G / 8) + (int)blockIdx.x / 8 : (int)blockIdx.x;
            for (int u = vcu; u < NB * NH * 16; u += G) att::attn_unit(ldsb, Qb, Kb, Vb, MIX, u >> 4, u & 15);
        }
        }
    }
    SEAM(3);
    if (IN(4)) {
        FRESH_IDS();
        const float* aonw = IN_F(I_AONW);
        for (int u = blockIdx.x; u < NB * ssd::NCH; u += G) {
            for (int rep_ = 0; rep_ < NREP(4); ++rep_)
                ssd::finalize_chunk(smf, XBCC, XT, PROJ, DT, IN_F(I_ALOG), HPB, IN_F(I_SSDD), IN_F(I_SSDNW), MIX, u >> 5, u & 31);
            for (int r = wave; r < ssd::CH; r += 8) {
                bf16_t* mr = MIX + ((size_t)(u >> 5) * S + (u & 31) * ssd::CH + r) * D + lane * 8;
                const u32x4 raw = *(const u32x4*)mr;
                float v[8] = {bf2f(raw.x & 0xffffu), bf2f(raw.x >> 16), bf2f(raw.y & 0xffffu), bf2f(raw.y >> 16), bf2f(raw.z & 0xffffu), bf2f(raw.z >> 16), bf2f(raw.w & 0xffffu), bf2f(raw.w >> 16)};
                float ss = 0.f;
#pragma unroll
                for (int j = 0; j < 8; ++j) ss += v[j] * v[j];
                const float rstd = 1.f / sqrtf(wave_sum(ss) * (1.f / 512.f) + EPS);
                const f32x4 w0 = *(const f32x4*)(aonw + lane * 8), w1 = *(const f32x4*)(aonw + lane * 8 + 4);
                u32x4 o; o.x = pk2(v[0] * rstd * w0.x, v[1] * rstd * w0.y); o.y = pk2(v[2] * rstd * w0.z, v[3] * rstd * w0.w);
                o.z = pk2(v[4] * rstd * w1.x, v[5] * rstd * w1.y); o.w = pk2(v[6] * rstd * w1.z, v[7] * rstd * w1.w);
                *(u32x4*)mr = o;
            }
        }
    }
    SEAM(4);
    if (IN(5)) {
        FRESH_IDS();
        for (int rep_ = 0; rep_ < NREP(5); ++rep_) {
        pg8::Gemm g{MIX, WT_O, T, D, D, D, D}; pg8::StaticOrder So; So.init(T, D, G, (int)blockIdx.x);
        EpiResid E{x, out, SSQX1}; pg8::gemm_phase(ldsb, g, So, E);
        }
    }
    SEAM(5);
    if (IN(6)) {
        FRESH_IDS();
        {
            typedef short bf16x8r __attribute__((ext_vector_type(8)));
            const float* fw = IN_F(I_FFNNW); const float* brg = IN_F(I_BRG); const float* bre = IN_F(I_BRE);
            const int r16 = lane & 15, kq = lane >> 4;
            float* lg = smf + wave * (16 * 48);
            for (int rb = gw; rb < T / 16; rb += NGW) {
                const int row = rb * 16 + r16;
                float ss = 0.f;
#pragma unroll
                for (int q = 0; q < 4; ++q) { const f32x4 sv = *(const f32x4*)(SSQX1 + row * 16 + 4 * q); ss += (sv.x + sv.y) + (sv.z + sv.w); }
                const float rstd = 1.f / sqrtf(ss * (1.f / D) + EPS);
                f32x4 acc[3]; acc[0] = (f32x4){0.f, 0.f, 0.f, 0.f}; acc[1] = acc[0]; acc[2] = acc[0];
                const float* xrow = out + (size_t)row * D + 8 * kq;
#pragma unroll 4
                for (int ks = 0; ks < 32; ++ks) {
                    const f32x4 x0 = *(const f32x4*)(xrow + 32 * ks), x1v = *(const f32x4*)(xrow + 32 * ks + 4);
                    const f32x4 g0 = *(const f32x4*)(fw + 32 * ks + 8 * kq), g1 = *(const f32x4*)(fw + 32 * ks + 8 * kq + 4);
                    const f32x4 h0 = x0 * rstd * g0, h1 = x1v * rstd * g1;
                    u32x4 hi; hi.x = att::cvtpk(h0.x, h0.y); hi.y = att::cvtpk(h0.z, h0.w); hi.z = att::cvtpk(h1.x, h1.y); hi.w = att::cvtpk(h1.z, h1.w);
                    *(u32x4*)(H + (size_t)row * D + 32 * ks + 8 * kq) = hi;
                    u32x4 lo; lo.x = att::cvtpk(h0.x - bf2f(hi.x & 0xffffu), h0.y - bf2f(hi.x >> 16)); lo.y = att::cvtpk(h0.z - bf2f(hi.y & 0xffffu), h0.w - bf2f(hi.y >> 16));
                    lo.z = att::cvtpk(h1.x - bf2f(hi.z & 0xffffu), h1.y - bf2f(hi.z >> 16)); lo.w = att::cvtpk(h1.z - bf2f(hi.w & 0xffffu), h1.w - bf2f(hi.w >> 16));
                    const bf16x8r ah = __builtin_bit_cast(bf16x8r, hi), al = __builtin_bit_cast(bf16x8r, lo);
#pragma unroll
                    for (int nb = 0; nb < 3; ++nb) {
                        const bf16_t* wf = WRF + ((size_t)(ks * 3 + nb) * 2) * 512 + lane * 8;
                        const bf16x8r bh = *(const bf16x8r*)wf, bl = *(const bf16x8r*)(wf + 512);
                        acc[nb] = __builtin_amdgcn_mfma_f32_16x16x32_bf16(ah, bh, acc[nb], 0, 0, 0);
                        acc[nb] = __builtin_amdgcn_mfma_f32_16x16x32_bf16(ah, bl, acc[nb], 0, 0, 0);
                        acc[nb] = __builtin_amdgcn_mfma_f32_16x16x32_bf16(al, bh, acc[nb], 0, 0, 0);
                    }
                }
#pragma unroll
                for (int nb = 0; nb < 3; ++nb)
#pragma unroll
                    for (int j = 0; j < 4; ++j) lg[(4 * kq + j) * 48 + 16 * nb + r16] = acc[nb][j];
                asm volatile("s_waitcnt lgkmcnt(0)" ::: "memory");
                if (lane < 16) {
                    const int m = rb * 16 + lane;
                    float lgt[36];
#pragma unroll
                    for (int q = 0; q < 9; ++q) { const f32x4 v = *(const f32x4*)(lg + lane * 48 + 4 * q); lgt[4 * q] = v.x; lgt[4 * q + 1] = v.y; lgt[4 * q + 2] = v.z; lgt[4 * q + 3] = v.w; }
                    float gl[4]; int gi = 0;
#pragma unroll
                    for (int q = 0; q < 4; ++q) gl[q] = lgt[q] + brg[q];
                    float gmax = gl[0];
#pragma unroll
                    for (int q = 1; q < 4; ++q) if (gl[q] > gmax) { gmax = gl[q]; gi = q; }
                    float gs = 0.f;
#pragma unroll
                    for (int q = 0; q < 4; ++q) gs += expf(gl[q] - gmax);
                    const float gwt = 1.f / gs;
                    float el[8];
#pragma unroll
                    for (int q = 0; q < 8; ++q) { float vv = 0.f;
#pragma unroll
                        for (int g2 = 0; g2 < 4; ++g2) vv = (g2 == gi) ? lgt[4 + g2 * 8 + q] + bre[g2 * 8 + q] : vv;
                        el[q] = vv; }
                    int i0 = 0; float v0 = el[0];
#pragma unroll
                    for (int q = 1; q < 8; ++q) if (el[q] > v0) { v0 = el[q]; i0 = q; }
                    int i1 = -1; float v1 = -3.4e38f;
#pragma unroll
                    for (int q = 0; q < 8; ++q) if (q != i0 && el[q] > v1) { v1 = el[q]; i1 = q; }
                    const float e1 = expf(v1 - v0), w0 = gwt / (1.f + e1), w1 = gwt * e1 / (1.f + e1);
                    const int ex0 = gi * 8 + i0, ex1 = gi * 8 + i1;
                    *(f32x4*)(ROUTE + m * 4) = (f32x4){__int_as_float(ex0), __int_as_float(ex1), w0, w1};
                    const unsigned p0 = atomicAdd(ctl + CW_ECNT + 64 * ex0, 1u); BUCKET[(size_t)ex0 * T + p0] = m * 2;
                    const unsigned p1 = atomicAdd(ctl + CW_ECNT + 64 * ex1, 1u); BUCKET[(size_t)ex1 * T + p1] = m * 2 + 1;
                }
                asm volatile("s_waitcnt lgkmcnt(0)" ::: "memory");
            }
        }
    }
    SEAM(6);
    volatile LAS unsigned* CNT_L = MISC + 64; volatile LAS unsigned* PTILE_L = MISC + 96;
    LAS unsigned* ROWTAB = (LAS unsigned*)(ldsb + MISC_OFF + 1024);
    bf16_t* HE = (bf16_t*)(ws + WS_HE); bf16_t* YPAIR = (bf16_t*)(ws + WS_Q);
    bf16_t* X2B = (bf16_t*)(ws + WS_MIX);
    bf16_t* GB = (bf16_t*)(ws + WS_Q);
    if (IN(7) || IN(8)) {
        if (threadIdx.x == 0) { unsigned acc = 0;
            for (int e2 = 0; e2 < 32; ++e2) { const unsigned c = __hip_atomic_load(ctl + CW_ECNT + 64 * e2, __ATOMIC_RELAXED, __HIP_MEMORY_SCOPE_AGENT); CNT_L[e2] = c; PTILE_L[e2] = acc; acc += (c + 255u) >> 8; }
            PTILE_L[32] = acc; }
        __syncthreads();
    }
    if (IN(7)) {
        FRESH_IDS();
        for (int rep_ = 0; rep_ < NREP(7); ++rep_) {
        GroupSched Sg{PTILE_L, 2, G, (int)blockIdx.x};
        { pg8::Unit u;
          for (int i = 0; i < 8 && Sg.next(i, u); ++i) { const int e2 = u.pn >> 1, pm_l = u.pm - (int)PTILE_L[e2];
              if (tid < 256) { const int idx = pm_l * 256 + tid; const int tok = idx < (int)CNT_L[e2] ? (BUCKET[(size_t)e2 * T + idx] >> 1) : 0; ROWTAB[i * 256 + tid] = (unsigned)tok * 2048u; } } }
        __syncthreads();
        pg8::Gemm g{H, WT_GU, T, 32 * 512, D, D, D};
        EpiMoeGU E{HE};
        pg8::gemm_phase<EpiMoeGU, GroupSched, true>(ldsb, g, Sg, E, ROWTAB);
        { const int total = (int)PTILE_L[32] * 2, nmax = (total + G - 1) / G, extra = total - (nmax - 1) * G;
          pg8::Gemm g2{PB, WT_PP, T, D, 256, 256, 256}; pg8::TailOrder St; St.init(T, D, G, (int)blockIdx.x, extra);
          EpiPleProj E2{PLERAW, SSQPLE}; pg8::gemm_phase(ldsb, g2, St, E2); }
        }
    }
    SEAM(7);
    if (IN(8)) {
        for (int rep_ = 0; rep_ < NREP(8); ++rep_) {
        GroupSched Sg{PTILE_L, 4, G, (int)blockIdx.x};
        pg8::Gemm g{HE, WT_DN, 0, 32 * 1024, 256, 256, 256};
        EpiMoeDown E{YPAIR, BUCKET, ROUTE, PTILE_L, CNT_L};
        pg8::gemm_phase(ldsb, g, Sg, E);
        }
    }
    SEAM(8);
    if (IN(9)) {
        FRESH_IDS();
        const f32x4* wr4 = (const f32x4*)IN_F(I_PLENW) + lane;
        for (int m0 = gw * 4; m0 < T; m0 += NGW * 4) {
            f32x4 v[4][4]; u32x2 ya[4][4], yb[4][4];
#pragma unroll
            for (int r = 0; r < 4; ++r)
#pragma unroll
                for (int j = 0; j < 4; ++j) { const size_t m = m0 + r; v[r][j] = ((const f32x4*)(out + m * D) + lane)[64 * j];
                    ya[r][j] = ((const u32x2*)(YPAIR + (2 * m) * D) + lane)[64 * j]; yb[r][j] = ((const u32x2*)(YPAIR + (2 * m + 1) * D) + lane)[64 * j]; }
#pragma unroll
            for (int r = 0; r < 4; ++r) {
                const size_t m = m0 + r; float s = 0.f;
                u32x2* x2r = (u32x2*)(X2B + m * D) + lane;
#pragma unroll
                for (int j = 0; j < 4; ++j) { const u32x2 a0 = ya[r][j], a1 = yb[r][j];
                    v[r][j] = v[r][j] + (f32x4){bf2f(a0.x & 0xffffu) + bf2f(a1.x & 0xffffu), bf2f(a0.x >> 16) + bf2f(a1.x >> 16), bf2f(a0.y & 0xffffu) + bf2f(a1.y & 0xffffu), bf2f(a0.y >> 16) + bf2f(a1.y >> 16)};
                    { u32x2 xo; xo.x = pk2(v[r][j].x, v[r][j].y); xo.y = pk2(v[r][j].z, v[r][j].w); x2r[64 * j] = xo; }
                    s += (v[r][j].x * v[r][j].x + v[r][j].y * v[r][j].y) + (v[r][j].z * v[r][j].z + v[r][j].w * v[r][j].w); }
                const float rstd = 1.f / sqrtf(wave_sum(s) * (1.f / D) + EPS);
                u32x2* o8 = (u32x2*)(H + m * D) + lane;
#pragma unroll
                for (int j = 0; j < 4; ++j) { const f32x4 g4 = wr4[64 * j]; u32x2 o; o.x = pk2(v[r][j].x * rstd * g4.x, v[r][j].y * rstd * g4.y); o.y = pk2(v[r][j].z * rstd * g4.z, v[r][j].w * rstd * g4.w); o8[64 * j] = o; }
            }
        }
    }
    SEAM(9);
    if (IN(10)) {
        pg8::Gemm g{H, WT_PG, T, D, D, D, D}; pg8::StaticOrder So; So.init(T, D, G, (int)blockIdx.x);
        EpiPleGate E{GB, PLERAW, SSQPLE, IN_F(I_BPG), IN_F(I_PPNW)}; pg8::gemm_phase(ldsb, g, So, E);
    }
    SEAM(10);
    if (IN(11)) {
        FRESH_IDS();
        const f32x4* wr4 = (const f32x4*)IN_F(I_FNW) + lane;
        for (int m0 = gw * 4; m0 < T; m0 += NGW * 4) {
            u32x2 xa[4][4], ga[4][4];
#pragma unroll
            for (int r = 0; r < 4; ++r)
#pragma unroll
                for (int j = 0; j < 4; ++j) { const size_t m = m0 + r; xa[r][j] = ((const u32x2*)(X2B + m * D) + lane)[64 * j]; ga[r][j] = ((const u32x2*)(GB + m * D) + lane)[64 * j]; }
#pragma unroll
            for (int r = 0; r < 4; ++r) {
                f32x4 v[4]; float s = 0.f;
#pragma unroll
                for (int j = 0; j < 4; ++j) { const u32x2 a0 = xa[r][j], a1 = ga[r][j];
                    v[j] = (f32x4){bf2f(a0.x & 0xffffu) + bf2f(a1.x & 0xffffu), bf2f(a0.x >> 16) + bf2f(a1.x >> 16), bf2f(a0.y & 0xffffu) + bf2f(a1.y & 0xffffu), bf2f(a0.y >> 16) + bf2f(a1.y >> 16)};
                    s += (v[j].x * v[j].x + v[j].y * v[j].y) + (v[j].z * v[j].z + v[j].w * v[j].w); }
                const float rstd = 1.f / sqrtf(wave_sum(s) * (1.f / D) + EPS);
                f32x4* xr = (f32x4*)(out + (size_t)(m0 + r) * D) + lane;
#pragma unroll
                for (int j = 0; j < 4; ++j) xr[64 * j] = v[j] * rstd * wr4[64 * j];
            }
        }
    }
#undef IN
#undef SEAM
}

extern "C" void kernel_launch(void* const* d_in, const int* in_sizes, int n_in, void* d_out, int out_size, void* d_ws, size_t ws_size, hipStream_t stream) {
    static int grid = 0;
    if (grid == 0) {
        if (n_in != 31 || out_size != T * D || ws_size < WS_END) { fprintf(stderr, "kernel_launch: unexpected shapes (n_in %d out %d ws %zu)\n", n_in, out_size, ws_size); grid = -1; return; }
        int dev = 0, cus = 0, per_cu = 0;
        if (hipGetDevice(&dev) != hipSuccess || hipDeviceGetAttribute(&cus, hipDeviceAttributeMultiprocessorCount, dev) != hipSuccess) { grid = -1; return; }
        if (hipFuncSetAttribute((const void*)fwd, hipFuncAttributeMaxDynamicSharedMemorySize, LDS_BYTES) != hipSuccess) { fprintf(stderr, "kernel_launch: hipFuncSetAttribute failed\n"); grid = -1; return; }
        if (hipOccupancyMaxActiveBlocksPerMultiprocessor(&per_cu, (const void*)fwd, 512, LDS_BYTES) != hipSuccess || per_cu < 1) { fprintf(stderr, "kernel_launch: occupancy query says %d\n", per_cu); }
        (void)hipGetLastError();
        grid = cus;
    }
    if (grid < 0) return;
    (void)hipMemsetAsync((char*)d_ws + WS_CTL, 0, CTL_ZERO_BYTES, stream);
    Args a{};
    for (int i = 0; i < 31; ++i) a.in[i] = d_in[i];
    a.out = (float*)d_out; a.ws = (unsigned char*)d_ws;
#if MK_PER_PHASE
    for (int p = 0; p < NPHASES; ++p) { a.ph_lo = p; a.ph_hi = p + 1; hipLaunchKernelGGL(fwd, dim3(grid), dim3(512), LDS_BYTES, stream, a); }
#else
    a.ph_lo = 0; a.ph_hi = NPHASES;
    hipLaunchKernelGGL(fwd, dim3(grid), dim3(512), LDS_BYTES, stream, a);
#endif
}
```

```cpp
#include <hip/hip_runtime.h>
#include <cstdio>
#include <cstdint>

#ifndef MK_PER_PHASE
#define MK_PER_PHASE 0
#endif

#define LAS __attribute__((address_space(3)))
#define GAS __attribute__((address_space(1)))
typedef unsigned short bf16_t;
typedef float f32x4 __attribute__((ext_vector_type(4)));
typedef unsigned u32x4 __attribute__((ext_vector_type(4)));
typedef unsigned u32x2 __attribute__((ext_vector_type(2)));

constexpr int NB = 8, S = 4096, T = NB * S, D = 1024;
constexpr int NH = 8, DQK = 96, DV = 64;
constexpr int PROJ_N = 1792, IN_COLS = 1712;
constexpr int PC_CQ = 0, PC_CKV = 256, PC_KR = 384, PC_DT = 416, PC_Z = 512, PC_XBC = 1024;
constexpr int XBC = 768;
constexpr float EPS = 1e-6f;
constexpr int NPHASES = 12;

constexpr size_t MiB = 1u << 20;
constexpr size_t WS_CTL = 0, CTL_ZERO_BYTES = 1 * MiB;
constexpr size_t WS_COS = 1 * MiB, WS_SIN = 3 * MiB, WS_DT = 5 * MiB, WS_ROUTE = 7 * MiB, WS_BUCKET = 8 * MiB;
constexpr size_t WS_SSQQ = 12 * MiB, WS_SSQKV = 12 * MiB + 512 * 1024, WS_DTRAW = 13 * MiB, WS_SSQPLE = 15 * MiB;
constexpr size_t WS_WR = 7 * MiB + 512 * 1024;
constexpr size_t WS_CDEC = 7 * MiB + 768 * 1024;
constexpr size_t WS_WRF = 7 * MiB + 512 * 1024;
constexpr size_t WS_SSQX1 = 17 * MiB;
constexpr size_t WS_WEIGHTS = 19 * MiB;
constexpr size_t WS_H = 80 * MiB;
constexpr size_t WS_PROJ = 144 * MiB;
constexpr size_t WS_HE = 208 * MiB;
constexpr size_t WS_Q = 256 * MiB, WS_K = 304 * MiB, WS_V = 352 * MiB;
constexpr size_t WS_MIX = 384 * MiB;
constexpr size_t WS_XBCC = 448 * MiB;
constexpr size_t WS_PB = 496 * MiB;
constexpr size_t WS_END = 512 * MiB;
constexpr int CW_BAR = 4096, CW_ECNT = 8192;

__device__ __forceinline__ unsigned f2bf(float f) { unsigned u = __builtin_bit_cast(unsigned, f); return (u + 0x7fffu + ((u >> 16) & 1u)) >> 16; }
__device__ __forceinline__ float bf2f(unsigned h) { return __builtin_bit_cast(float, h << 16); }
__device__ __forceinline__ unsigned pk2(float lo, float hi) { return f2bf(lo) | (f2bf(hi) << 16); }
__device__ __forceinline__ float wave_sum(float v) {
#pragma unroll
    for (int o = 1; o < 64; o <<= 1) v += __shfl_xor(v, o);
    return v;
}
__device__ __forceinline__ float silu_f(float v) { return v / (1.f + __expf(-v)); }

#define XB_TMO      128
#define XB_XCNT(j)  (256  + 64 * (j))
#define XB_XSUB(j)  (1280 + 64 * (j))
#define XB_XGEN(j)  (2304 + 64 * (j))
#define XB_TOP      3328
#define XB_TOPGEN   3392
#define XCD_BAR_WORDS 3456
#define XB_SPIN_CAP (1u << 22)

__device__ __forceinline__ unsigned xb_ld(unsigned* p)              { return __hip_atomic_load(p, __ATOMIC_RELAXED, __HIP_MEMORY_SCOPE_AGENT); }
__device__ __forceinline__ unsigned xb_add(unsigned* p, unsigned v) { return __hip_atomic_fetch_add(p, v, __ATOMIC_RELAXED, __HIP_MEMORY_SCOPE_AGENT); }
__device__ __forceinline__ unsigned xb_xcc_id() { return (unsigned)__builtin_amdgcn_s_getreg((3 << 11) | 20) & 0xFu; }
#define XB_SPIN(cond, bar) do { unsigned _sp = 0; while (cond) { __builtin_amdgcn_s_sleep(1); \
    if ((++_sp & 255u) == 0u) { if (xb_ld(&(bar)[XB_TMO])) break; if (_sp > XB_SPIN_CAP) { atomicAdd(&(bar)[XB_TMO], 1u); break; } } } } while (0)

struct XcdBarrier { unsigned* bar; unsigned x; volatile LAS unsigned* st; };
__device__ __forceinline__ XcdBarrier xcd_barrier_post(unsigned* bar, volatile LAS unsigned* st) {
    XcdBarrier b; b.bar = bar; b.x = xb_xcc_id(); b.st = st;
    if (threadIdx.x == 0) (void)xb_add(&bar[XB_XCNT(b.x)], 1u);
    return b;
}
__device__ __forceinline__ void xcd_barrier_complete(unsigned* bar, unsigned x, unsigned& nloc, unsigned& nx) {
    const unsigned G = gridDim.x * gridDim.y * gridDim.z;
    unsigned sum, cnt, mine, sp = 0u;
    for (;;) {
        sum = 0u; cnt = 0u; mine = 0u;
#pragma unroll
        for (unsigned j = 0; j < 16; ++j) { const unsigned c = xb_ld(&bar[XB_XCNT(j)]); sum += c; cnt += (c > 0u) ? 1u : 0u; mine = (j == x) ? c : mine; }
        if (sum == G) break;
        __builtin_amdgcn_s_sleep(1);
        if ((++sp & 255u) == 0u) { if (xb_ld(&bar[XB_TMO])) break; if (sp > XB_SPIN_CAP) { atomicAdd(&bar[XB_TMO], 1u); break; } }
    }
    nloc = mine > 0u ? mine : 1u; nx = cnt > 0u ? cnt : 1u;
}
__device__ __forceinline__ void xcd_barrier(const XcdBarrier& b) {
    asm volatile("s_waitcnt vmcnt(0)" ::: "memory");
    __syncthreads();
    if (threadIdx.x == 0) {
        unsigned* bar = b.bar;
        __builtin_amdgcn_s_waitcnt(0);
        unsigned nloc = b.st[0], nx = b.st[1];
        if (nloc == 0u) { xcd_barrier_complete(bar, b.x, nloc, nx); b.st[0] = nloc; b.st[1] = nx; }
        const unsigned old = xb_add(&bar[XB_XSUB(b.x)], 1u);
        const unsigned gen = old / nloc;
        if (old + 1u == (gen + 1u) * nloc) {
            __builtin_amdgcn_fence(__ATOMIC_RELEASE, "agent");
            asm volatile("s_waitcnt vmcnt(0)" ::: "memory");
            const unsigned og = xb_add(&bar[XB_TOP], 1u);
            const unsigned tg = og / nx;
            if (og + 1u == (tg + 1u) * nx) xb_add(&bar[XB_TOPGEN], 1u);
            else XB_SPIN(xb_ld(&bar[XB_TOPGEN]) == tg, bar);
            __builtin_amdgcn_fence(__ATOMIC_ACQUIRE, "agent");
            xb_add(&bar[XB_XGEN(b.x)], 1u);
            asm volatile("s_waitcnt vmcnt(0)" ::: "memory");
        } else {
            XB_SPIN(xb_ld(&bar[XB_XGEN(b.x)]) == gen, bar);
            __builtin_amdgcn_fence(__ATOMIC_ACQUIRE, "agent");
            asm volatile("s_waitcnt vmcnt(0)" ::: "memory");
        }
    }
    __syncthreads();
}


namespace pg8 {
typedef short bf16x8 __attribute__((ext_vector_type(8)));
constexpr int BM = 256, BK = 64, HALF = 128, HTB = HALF * BK * 2, STAGE_BYTES = 8 * HTB, NXCD = 8, WGM = 8;
__host__ __device__ __forceinline__ int lds_byte(int r, int c) { const int st = (r >> 4) * 2 + (c >> 5), rr = r & 15, cc = c & 31, ob = rr * 64 + cc * 2; return st * 1024 + (ob ^ (((ob >> 9) & 1) << 5)); }
__host__ __device__ __forceinline__ void stage_rc(int b, int& R, int& C) { const int st = b / 1024, sb = b % 1024, swz = sb ^ (((sb >> 9) & 1) << 5); R = (st >> 1) * 16 + swz / 64; C = (st & 1) * 32 + (swz % 64) / 2; }
__host__ __device__ __forceinline__ int perm32(int rho) { const int n = rho >> 4, i = rho & 15; return 8 * (i >> 2) + 4 * n + (i & 3); }
struct Unit { int pm, pn; };
struct Gemm { const bf16_t* A; const bf16_t* Bt; int M, N, K, lda, ldb; };
struct StaticOrder {
    int nM, nN, nwg, G, c;
    __host__ __device__ void init(int M, int N, int G_, int c_) { nM = M / BM; nN = N / BM; nwg = nM * nN; G = G_; c = c_; }
    __host__ __device__ bool next(int i, Unit& u) const {
        const long L = (long)i * G + c; if (L >= nwg) return false;
        int wgid = (int)L; { const int q = nwg / NXCD, r = nwg % NXCD, xcd = wgid % NXCD, off = wgid / NXCD; wgid = (xcd < r ? xcd * (q + 1) : r * (q + 1) + (xcd - r) * q) + off; }
        const int nig = WGM * nN, gid = wgid / nig, fm = gid * WGM, gsz = (nM - fm) < WGM ? (nM - fm) : WGM;
        u.pm = fm + ((wgid % nig) % gsz); u.pn = (wgid % nig) / gsz; return true;
    }
};
struct TailOrder {
    int nM, nN, nwg, G, c, first, span;
    __host__ __device__ void init(int M, int N, int G_, int c_, int first_) { nM = M / BM; nN = N / BM; nwg = nM * nN; G = G_; c = c_; first = (first_ > 0 && first_ < G_) ? first_ : 0; span = G - first; }
    __host__ __device__ bool next(int i, Unit& u) const {
        if (c < first) return false;
        const long L = (long)i * span + (c - first); if (L >= nwg) return false;
        const int wgid = (int)L;
        const int nig = WGM * nN, gid = wgid / nig, fm = gid * WGM, gsz = (nM - fm) < WGM ? (nM - fm) : WGM;
        u.pm = fm + ((wgid % nig) % gsz); u.pn = (wgid % nig) / gsz; return true;
    }
};
__device__ __forceinline__ unsigned cvt_pk_bf16(float lo, float hi) { unsigned r; asm volatile("v_cvt_pk_bf16_f32 %0, %1, %2" : "=v"(r) : "v"(lo), "v"(hi)); return r; }

template <class Epi, class Sched, bool GATHER = false>
__device__ __forceinline__ void gemm_phase(LAS unsigned char* lds, const Gemm g, const Sched& S, const Epi& E, const LAS unsigned* rowtab = nullptr) {
    int tid = threadIdx.x; asm volatile("" : "+v"(tid));
    const int wid = __builtin_amdgcn_readfirstlane(tid >> 6), lane = tid & 63, wr = wid >> 2, wc = wid & 3, fr = lane & 15, fq = lane >> 4;
    int nt = g.K / BK; asm volatile("" : "+s"(nt));
    unsigned vAc[2][2], vAn[2][2], voffB[2]; int RA[2], CA[2];
#pragma unroll
    for (int i = 0; i < 2; ++i) { int R, C; stage_rc(tid * 16 + i * 8192, R, C); const int Rb = Epi::PERM ? ((R & ~31) + perm32(R & 31)) : R; RA[i] = R; CA[i] = C;
        voffB[i] = (unsigned)(Rb * g.ldb + C) * 2u;
#pragma unroll
        for (int h = 0; h < 2; ++h) { vAc[h][i] = GATHER ? rowtab[h * HALF + R] + (unsigned)C * 2u : (unsigned)((h * HALF + R) * g.lda + C) * 2u; vAn[h][i] = vAc[h][i]; } }
    const size_t kstep = (size_t)(BK * 2);
    const size_t hstepB = (size_t)HALF * g.ldb * 2;
    const size_t tstepA = GATHER ? 0 : (size_t)BM * g.lda * 2, tstepB = 2 * hstepB;
    const unsigned ldsw = (unsigned)wid * 1024u;
    const int aoff = lds_byte(wr * 64 + fr, fq * 8), boff = lds_byte(wc * 32 + fr, fq * 8);
#define PG8_SA(b, h) (((b) * 2 + (h)) * HTB)
#define PG8_SB(b, h) ((4 + (b) * 2 + (h)) * HTB)
#define PG8_STAGE(bufoff, gbase, voff) do { _Pragma("unroll") for (int _i = 0; _i < 2; ++_i) \
        __builtin_amdgcn_global_load_lds((const unsigned*)((const char*)(gbase) + (voff)[_i]), (LAS unsigned*)(lds + (bufoff) + ldsw + _i * 8192), 16, 0, 0); } while (0)
#define PG8_LDA(dst, b, h) do { _Pragma("unroll") for (int m = 0; m < 4; ++m) _Pragma("unroll") for (int k = 0; k < 2; ++k) dst[m][k] = *(const LAS bf16x8*)(lds + PG8_SA(b, h) + aoff + m * 2048 + k * 1024); } while (0)
#define PG8_LDB(dst, b, h) do { _Pragma("unroll") for (int n = 0; n < 2; ++n) _Pragma("unroll") for (int k = 0; k < 2; ++k) dst[n][k] = *(const LAS bf16x8*)(lds + PG8_SB(b, h) + boff + n * 2048 + k * 1024); } while (0)
#define PG8_MMA(ai, bj, At, Bt) do { __builtin_amdgcn_s_setprio(1); _Pragma("unroll") for (int m = 0; m < 4; ++m) _Pragma("unroll") for (int n = 0; n < 2; ++n) _Pragma("unroll") for (int k = 0; k < 2; ++k) \
        acc[ai][bj][m][n] = __builtin_amdgcn_mfma_f32_16x16x32_bf16(Bt[n][k], At[m][k], acc[ai][bj][m][n], 0, 0, 0); __builtin_amdgcn_s_setprio(0); } while (0)
#define PG8_WAIT_V(n) asm volatile("s_waitcnt vmcnt(" #n ")" ::: "memory")
#define PG8_WAIT_L(n) asm volatile("s_waitcnt lgkmcnt(" #n ")" ::: "memory")
#define PG8_BAR __builtin_amdgcn_s_barrier()
#define PG8_SCHED __builtin_amdgcn_sched_barrier(0)
    Unit cur, nxt; int ui = 0;
    if (!S.next(0, cur)) return;
    f32x4 acc[2][2][4][2];
#pragma unroll
    for (int a = 0; a < 2; ++a)
#pragma unroll
        for (int b = 0; b < 2; ++b)
#pragma unroll
            for (int m = 0; m < 4; ++m)
#pragma unroll
                for (int n = 0; n < 2; ++n) acc[a][b][m][n] = (f32x4){0.f, 0.f, 0.f, 0.f};
    bf16x8 At[4][2], B0[2][2], B1[2][2];
    const char* cA = (const char*)g.A + (size_t)cur.pm * tstepA; const char* cB = (const char*)g.Bt + (size_t)cur.pn * tstepB;
    PG8_STAGE(PG8_SB(0, 0), cB, voffB); PG8_STAGE(PG8_SB(0, 1), cB + hstepB, voffB); PG8_STAGE(PG8_SA(0, 0), cA, vAc[0]); PG8_STAGE(PG8_SA(0, 1), cA, vAc[1]);
    if (wr == 1) PG8_BAR;
    PG8_WAIT_V(2); PG8_BAR;
    PG8_STAGE(PG8_SB(1, 0), cB + kstep, voffB); PG8_STAGE(PG8_SA(1, 0), cA + kstep, vAc[0]); PG8_STAGE(PG8_SB(1, 1), cB + hstepB + kstep, voffB);
    PG8_WAIT_V(6); PG8_BAR;
    for (;;) {
        const bool has_next = S.next(ui + 1, nxt);
        const char* nA = has_next ? (const char*)g.A + (size_t)nxt.pm * tstepA : cA; const char* nB = has_next ? (const char*)g.Bt + (size_t)nxt.pn * tstepB : cB;
        if (GATHER && has_next) {
#pragma unroll
            for (int i = 0; i < 2; ++i)
#pragma unroll
                for (int h = 0; h < 2; ++h) vAn[h][i] = rowtab[(ui + 1) * BM + h * HALF + RA[i]] + (unsigned)CA[i] * 2u;
        }
        for (int t = 0; t < nt; t += 2) {
            const bool last = (t == nt - 2);
            const char* a1 = cA + (size_t)(t + 1) * kstep;
            const char* a2 = last ? nA : cA + (size_t)(t + 2) * kstep; const char* b2 = last ? nB : cB + (size_t)(t + 2) * kstep;
            const char* a3 = a2 + kstep; const char* b3 = b2 + kstep;
            unsigned v2[2][2];
#pragma unroll
            for (int i = 0; i < 2; ++i)
#pragma unroll
                for (int h = 0; h < 2; ++h) v2[h][i] = (GATHER && last) ? vAn[h][i] : vAc[h][i];
            PG8_LDB(B0, 0, 0); PG8_LDB(B1, 0, 1); PG8_SCHED; PG8_LDA(At, 0, 0); PG8_STAGE(PG8_SA(1, 1), a1, vAc[1]);
            PG8_WAIT_V(8); PG8_WAIT_L(0); PG8_BAR; PG8_MMA(0, 0, At, B0); PG8_MMA(0, 1, At, B1); PG8_BAR; PG8_SCHED;
            PG8_LDA(At, 0, 1); PG8_STAGE(PG8_SB(0, 0), b2, voffB); PG8_STAGE(PG8_SB(0, 1), b2 + hstepB, voffB); PG8_STAGE(PG8_SA(0, 0), a2, v2[0]);
            PG8_WAIT_V(8); PG8_WAIT_L(0); PG8_BAR; PG8_MMA(1, 0, At, B0); PG8_MMA(1, 1, At, B1); PG8_BAR; PG8_SCHED;
            PG8_LDB(B0, 1, 0); PG8_LDB(B1, 1, 1); PG8_SCHED; PG8_LDA(At, 1, 0); PG8_STAGE(PG8_SA(0, 1), a2, v2[1]);
            PG8_WAIT_V(8); PG8_WAIT_L(0); PG8_BAR; PG8_MMA(0, 0, At, B0); PG8_MMA(0, 1, At, B1); PG8_BAR; PG8_SCHED;
            PG8_LDA(At, 1, 1); PG8_STAGE(PG8_SB(1, 0), b3, voffB); PG8_STAGE(PG8_SB(1, 1), b3 + hstepB, voffB); PG8_STAGE(PG8_SA(1, 0), a3, v2[0]);
            PG8_WAIT_V(8); PG8_WAIT_L(0); PG8_BAR; PG8_MMA(1, 0, At, B0); PG8_MMA(1, 1, At, B1); PG8_BAR; PG8_SCHED;
        }
        if (wr == 0) PG8_BAR;
        E(acc, cur, wr, wc, fr, fq);
        if (!has_next) break;
#pragma unroll
        for (int a = 0; a < 2; ++a)
#pragma unroll
            for (int b = 0; b < 2; ++b)
#pragma unroll
                for (int m = 0; m < 4; ++m)
#pragma unroll
                    for (int n = 0; n < 2; ++n) acc[a][b][m][n] = (f32x4){0.f, 0.f, 0.f, 0.f};
        cur = nxt; cA = nA; cB = nB; ++ui;
        if (GATHER) {
#pragma unroll
            for (int i = 0; i < 2; ++i)
#pragma unroll
                for (int h = 0; h < 2; ++h) vAc[h][i] = vAn[h][i];
        }
        if (wr == 1) PG8_BAR;
    }
    PG8_WAIT_V(0);
    PG8_BAR;
#undef PG8_SA
#undef PG8_SB
#undef PG8_STAGE
#undef PG8_LDA
#undef PG8_LDB
#undef PG8_MMA
#undef PG8_WAIT_V
#undef PG8_WAIT_L
#undef PG8_BAR
#undef PG8_SCHED
}
}

typedef f32x4 AccT[2][2][4][2];
__device__ __forceinline__ float sq4(const f32x4 v) { return (v.x * v.x + v.y * v.y) + (v.z * v.z + v.w * v.w); }
__device__ __forceinline__ u32x4 pack8(const f32x4 a, const f32x4 b) { u32x4 w; w.x = pg8::cvt_pk_bf16(a.x, a.y); w.y = pg8::cvt_pk_bf16(a.z, a.w); w.z = pg8::cvt_pk_bf16(b.x, b.y); w.w = pg8::cvt_pk_bf16(b.z, b.w); return w; }
__device__ __forceinline__ u32x2 pack4(const f32x4 a) { u32x2 w; w.x = pg8::cvt_pk_bf16(a.x, a.y); w.y = pg8::cvt_pk_bf16(a.z, a.w); return w; }

struct EpiInProj {
    static constexpr bool PERM = true;
    bf16_t* PROJ; float* DTRAW; float* SSQQ; float* SSQKV;
    __device__ __forceinline__ void operator()(const AccT& acc, const pg8::Unit& u, int wr, int wc, int fr, int fq) const {
        const int row0 = u.pm * 256 + wr * 64 + fr, col0 = u.pn * 256 + wc * 32 + 8 * fq;
#pragma unroll
        for (int ai = 0; ai < 2; ++ai)
#pragma unroll
            for (int m = 0; m < 4; ++m) {
                const int row = row0 + ai * 128 + m * 16;
                bf16_t* rowp = PROJ + (size_t)row * PROJ_N + col0;
#pragma unroll
                for (int bj = 0; bj < 2; ++bj) *(u32x4*)(rowp + bj * 128) = pack8(acc[ai][bj][m][0], acc[ai][bj][m][1]);
                if (u.pn == 0) {
                    float s = (sq4(acc[ai][0][m][0]) + sq4(acc[ai][0][m][1])) + (sq4(acc[ai][1][m][0]) + sq4(acc[ai][1][m][1]));
                    s += __shfl_xor(s, 16); s += __shfl_xor(s, 32);
                    if (fq == 0) SSQQ[row * 4 + wc] = s;
                } else if (u.pn == 1) {
                    float s = sq4(acc[ai][0][m][0]) + sq4(acc[ai][0][m][1]);
                    s += __shfl_xor(s, 16); s += __shfl_xor(s, 32);
                    if (fq == 0) SSQKV[row * 4 + wc] = s;
                    if (wc == 1 && fq < 2) { *(f32x4*)(DTRAW + row * 16 + 8 * fq) = acc[ai][1][m][0]; *(f32x4*)(DTRAW + row * 16 + 8 * fq + 4) = acc[ai][1][m][1]; }
                }
            }
    }
};
struct EpiQUp {
    static constexpr bool PERM = false;
    bf16_t* Q; const float* SSQQ; const float* COS; const float* SIN;
    __device__ __forceinline__ void operator()(const AccT& acc, const pg8::Unit& u, int wr, int wc, int fr, int fq) const {
#pragma unroll
        for (int ai = 0; ai < 2; ++ai)
#pragma unroll
            for (int m = 0; m < 4; ++m) {
                asm volatile("" ::: "memory");
                const int row = u.pm * 256 + ai * 128 + wr * 64 + m * 16 + fr, b = row / S, s = row % S;
                const f32x4 sv = *(const f32x4*)(SSQQ + row * 4);
                const float rs = 1.f / sqrtf(((sv.x + sv.y) + (sv.z + sv.w)) * (1.f / 256.f) + EPS);
                const f32x4 cs = *(const f32x4*)(COS + row * 16 + 4 * fq), sn = *(const f32x4*)(SIN + row * 16 + 4 * fq);
#pragma unroll
                for (int bj = 0; bj < 2; ++bj) {
                    const int g32 = 8 * u.pn + 4 * bj + wc, h = g32 / 3, part = g32 % 3;
                    f32x4 v0 = acc[ai][bj][m][0] * rs, v1 = acc[ai][bj][m][1] * rs;
                    if (part == 2) { const f32x4 o0 = v0 * cs - v1 * sn, o1 = v1 * cs + v0 * sn; v0 = o0; v1 = o1; }
                    bf16_t* qp = Q + ((size_t)(b * NH + h) * S + s) * DQK + part * 32 + 4 * fq;
                    *(u32x2*)qp = pack4(v0); *(u32x2*)(qp + 16) = pack4(v1);
                }
            }
    }
};
struct EpiKVUp {
    static constexpr bool PERM = true;
    bf16_t* Kb; bf16_t* Vb; const float* SSQKV;
    __device__ __forceinline__ void operator()(const AccT& acc, const pg8::Unit& u, int wr, int wc, int fr, int fq) const {
#pragma unroll
        for (int ai = 0; ai < 2; ++ai)
#pragma unroll
            for (int m = 0; m < 4; ++m) {
                asm volatile("" ::: "memory");
                const int row = u.pm * 256 + ai * 128 + wr * 64 + m * 16 + fr, b = row / S, s = row % S;
                const f32x4 sv = *(const f32x4*)(SSQKV + row * 4);
                const float rs = 1.f / sqrtf(((sv.x + sv.y) + (sv.z + sv.w)) * (1.f / 128.f) + EPS);
#pragma unroll
                for (int bj = 0; bj < 2; ++bj) {
                    const int h = 2 * u.pn + bj; const size_t tile = (size_t)(b * NH + h) * (S / 64) + (s >> 6);
                    const u32x4 w = pack8(acc[ai][bj][m][0] * rs, acc[ai][bj][m][1] * rs);
                    if (wc < 2) *(u32x4*)(Kb + (tile * 12 + 4 * wc + fq) * 512 + (s & 63) * 8) = w;
                    else *(u32x4*)(Vb + (tile * 16 + (wc - 2) * 8 + ((s & 63) >> 3)) * 256 + (s & 7) * 32 + 8 * fq) = w;
                }
            }
    }
};
struct EpiResid {
    static constexpr bool PERM = false;
    const float* base; float* out; float* SSQ;
    __device__ __forceinline__ void operator()(const AccT& acc, const pg8::Unit& u, int wr, int wc, int fr, int fq) const {
#pragma unroll
        for (int ai = 0; ai < 2; ++ai)
#pragma unroll
            for (int m = 0; m < 4; ++m) {
                const int row = u.pm * 256 + ai * 128 + wr * 64 + m * 16 + fr;
                const size_t ro = (size_t)row * D + u.pn * 256 + wc * 32 + 4 * fq;
                float s = 0.f;
#pragma unroll
                for (int bj = 0; bj < 2; ++bj)
#pragma unroll
                    for (int n = 0; n < 2; ++n) { const size_t o = ro + bj * 128 + n * 16; const f32x4 v = *(const f32x4*)(base + o) + acc[ai][bj][m][n]; *(f32x4*)(out + o) = v; s += sq4(v); }
                s += __shfl_xor(s, 16); s += __shfl_xor(s, 32);
                if (fq == 0) SSQ[row * 16 + u.pn * 4 + wc] = s;
            }
    }
};
struct EpiPleProj {
    static constexpr bool PERM = true;
    bf16_t* O; float* SSQ;
    __device__ __forceinline__ void operator()(const AccT& acc, const pg8::Unit& u, int wr, int wc, int fr, int fq) const {
#pragma unroll
        for (int ai = 0; ai < 2; ++ai)
#pragma unroll
            for (int m = 0; m < 4; ++m) {
                const int row = u.pm * 256 + ai * 128 + wr * 64 + m * 16 + fr;
                bf16_t* rowp = O + (size_t)row * D + u.pn * 256 + wc * 32 + 8 * fq;
#pragma unroll
                for (int bj = 0; bj < 2; ++bj) *(u32x4*)(rowp + bj * 128) = pack8(acc[ai][bj][m][0], acc[ai][bj][m][1]);
                float s = (sq4(acc[ai][0][m][0]) + sq4(acc[ai][0][m][1])) + (sq4(acc[ai][1][m][0]) + sq4(acc[ai][1][m][1]));
                s += __shfl_xor(s, 16); s += __shfl_xor(s, 32);
                if (fq == 0) SSQ[row * 16 + u.pn * 4 + wc] = s;
            }
    }
};
struct EpiPleGate {
    static constexpr bool PERM = true;
    bf16_t* G; const bf16_t* PR; const float* SSQ; const float* bias; const float* wpost;
    __device__ __forceinline__ void operator()(const AccT& acc, const pg8::Unit& u, int wr, int wc, int fr, int fq) const {
#pragma unroll
        for (int ai = 0; ai < 2; ++ai)
#pragma unroll
            for (int m = 0; m < 4; ++m) {
                asm volatile("" ::: "memory");
                const int row = u.pm * 256 + ai * 128 + wr * 64 + m * 16 + fr;
                float ss = 0.f;
#pragma unroll
                for (int q = 0; q < 4; ++q) { const f32x4 sv = *(const f32x4*)(SSQ + row * 16 + 4 * q); ss += (sv.x + sv.y) + (sv.z + sv.w); }
                const float rs = 1.f / sqrtf(ss * (1.f / D) + EPS);
#pragma unroll
                for (int bj = 0; bj < 2; ++bj) {
                    const int col = u.pn * 256 + bj * 128 + wc * 32 + 8 * fq;
                    const u32x4 pr = *(const u32x4*)(PR + (size_t)row * D + col);
                    const unsigned pw[4] = {pr.x, pr.y, pr.z, pr.w};
                    f32x4 o[2];
#pragma unroll
                    for (int n = 0; n < 2; ++n) {
                        const f32x4 bv = *(const f32x4*)(bias + col + 4 * n), wv = *(const f32x4*)(wpost + col + 4 * n);
                        const f32x4 av = acc[ai][bj][m][n] + bv;
                        const f32x4 pl = (f32x4){bf2f(pw[2 * n] & 0xffffu), bf2f(pw[2 * n] >> 16), bf2f(pw[2 * n + 1] & 0xffffu), bf2f(pw[2 * n + 1] >> 16)} * rs * wv;
#pragma unroll
                        for (int j = 0; j < 4; ++j) o[n][j] = pl[j] / (1.f + __expf(-av[j]));
                    }
                    *(u32x4*)(G + (size_t)row * D + col) = pack8(o[0], o[1]);
                }
            }
    }
};

struct GroupSched {
    const volatile LAS unsigned* ptile; int npn, G, c;
    __device__ __forceinline__ bool next(int i, pg8::Unit& u) const {
        const int L = i * G + c, total = (int)ptile[32] * npn; if (L >= total) return false;
        int e = 0;
        for (int q = 1; q < 32; ++q) e = (L >= (int)ptile[q] * npn) ? q : e;
        const int l = L - (int)ptile[e] * npn;
        u.pm = __builtin_amdgcn_readfirstlane((int)ptile[e] + l / npn); u.pn = __builtin_amdgcn_readfirstlane(e * npn + l % npn); return true;
    }
};
struct EpiMoeGU {
    static constexpr bool PERM = true;
    bf16_t* HE;
    __device__ __forceinline__ void operator()(const AccT& acc, const pg8::Unit& u, int wr, int wc, int fr, int fq) const {
        const int pn_l = u.pn & 1;
#pragma unroll
        for (int ai = 0; ai < 2; ++ai)
#pragma unroll
            for (int m = 0; m < 4; ++m) {
                const size_t row = (size_t)u.pm * 256 + ai * 128 + wr * 64 + m * 16 + fr;
                f32x4 h0, h1;
#pragma unroll
                for (int j = 0; j < 4; ++j) { const float g0 = acc[ai][0][m][0][j], g1 = acc[ai][0][m][1][j];
                    h0[j] = g0 / (1.f + __expf(-g0)) * acc[ai][1][m][0][j]; h1[j] = g1 / (1.f + __expf(-g1)) * acc[ai][1][m][1][j]; }
                *(u32x4*)(HE + row * 256 + pn_l * 128 + wc * 32 + 8 * fq) = pack8(h0, h1);
            }
    }
};
struct EpiMoeDown {
    static constexpr bool PERM = true;
    bf16_t* Y; const int* BUCKET; const float* ROUTE; const volatile LAS unsigned* ptile; const volatile LAS unsigned* cnt;
    __device__ __forceinline__ void operator()(const AccT& acc, const pg8::Unit& u, int wr, int wc, int fr, int fq) const {
        const int e = u.pn >> 2, pn_l = u.pn & 3, pm_l = u.pm - (int)ptile[e], n_e = (int)cnt[e];
#pragma unroll
        for (int ai = 0; ai < 2; ++ai)
#pragma unroll
            for (int m = 0; m < 4; ++m) {
                const int idx = pm_l * 256 + ai * 128 + wr * 64 + m * 16 + fr;
                if (idx < n_e) {
                    const int ent = BUCKET[(size_t)e * T + idx];
                    const float w = ROUTE[(ent >> 1) * 4 + 2 + (ent & 1)];
                    bf16_t* yp = Y + (size_t)ent * D + pn_l * 256 + wc * 32 + 8 * fq;
#pragma unroll
                    for (int bj = 0; bj < 2; ++bj) *(u32x4*)(yp + bj * 128) = pack8(acc[ai][bj][m][0] * w, acc[ai][bj][m][1] * w);
                }
            }
    }
};

template <class CM, class GN>
__device__ __forceinline__ void transpose_item(const float* W, int ldw, int K, bf16_t* WT, float* scr, int kb, int nb, int lane, CM cm, GN gain) {
    const int k0 = 64 * kb, n0 = 32 * nb;
    const int sc = cm(n0 + (lane & 31));
    float tv[32];
#pragma unroll
    for (int i = 0; i < 32; ++i) { const int kk = 2 * i + (lane >> 5); tv[i] = sc >= 0 ? W[(size_t)(k0 + kk) * ldw + sc] : 0.f; }
#pragma unroll
    for (int i = 0; i < 32; ++i) { const int kk = 2 * i + (lane >> 5); scr[kk * 33 + (lane & 31)] = tv[i] * gain(k0 + kk); }
    asm volatile("s_waitcnt lgkmcnt(0)" ::: "memory");
    const int c = lane & 7;
#pragma unroll
    for (int j = 0; j < 4; ++j) { const int n = (lane >> 3) + 8 * j; const float* s = scr + (8 * c) * 33 + n;
        u32x4 o; o.x = pk2(s[0 * 33], s[1 * 33]); o.y = pk2(s[2 * 33], s[3 * 33]); o.z = pk2(s[4 * 33], s[5 * 33]); o.w = pk2(s[6 * 33], s[7 * 33]);
        *(u32x4*)(WT + (size_t)(n0 + n) * K + k0 + 8 * c) = o; }
    asm volatile("s_waitcnt lgkmcnt(0)" ::: "memory");
}


namespace att {
typedef short bf16x8 __attribute__((ext_vector_type(8)));
typedef short s16x4 __attribute__((ext_vector_type(4)));
typedef float f32x16 __attribute__((ext_vector_type(16)));
typedef short v4i16_t __attribute__((ext_vector_type(4)));
typedef float f32x2_t __attribute__((ext_vector_type(2))); typedef __bf16 bf16x2_t __attribute__((ext_vector_type(2)));
constexpr int KT = 64, NT = S / KT, KBYTES = KT * DQK * 2, VBYTES = KT * DV * 2, STAGE = KBYTES + VBYTES;
__device__ __forceinline__ unsigned cvtpk(float lo, float hi) { f32x2_t v = {lo, hi}; bf16x2_t b = __builtin_convertvector(v, bf16x2_t); return __builtin_bit_cast(unsigned, b); }
__device__ __forceinline__ s16x4 vtr(const LAS unsigned char* p) { return __builtin_bit_cast(s16x4, __builtin_amdgcn_ds_read_tr16_b64_v4i16((LAS v4i16_t*)p)); }
__device__ __forceinline__ float half_max(float m) { auto rr = __builtin_amdgcn_permlane32_swap(__float_as_uint(m), __float_as_uint(m), false, false); return fmaxf(__uint_as_float(rr[0]), __uint_as_float(rr[1])); }
__device__ __forceinline__ float half_sum(float m) { auto rr = __builtin_amdgcn_permlane32_swap(__float_as_uint(m), __float_as_uint(m), false, false); return __uint_as_float(rr[0]) + __uint_as_float(rr[1]); }

constexpr int KRING = 0, VRING = 4 * KBYTES, ATT_THR = 8;
__device__ __forceinline__ void attn_unit(LAS unsigned char* lds, const bf16_t* Qg, const bf16_t* Kg, const bf16_t* Vg, bf16_t* MIXg, int bh, int qb) {
    int tid = threadIdx.x; asm volatile("" : "+v"(tid));
    const int lane = tid & 63, wid = __builtin_amdgcn_readfirstlane(tid >> 6), r32 = lane & 31, hi = lane >> 5;
    const size_t rowbase = (size_t)bh * S;
    const bf16_t* qrow = Qg + (rowbase + qb * 256 + wid * 32 + r32) * DQK + 8 * hi;
    bf16x8 qf[6];
#pragma unroll
    for (int ds = 0; ds < 6; ++ds) qf[ds] = *(const bf16x8*)(qrow + ds * 16);
    const char* ksrc0 = (const char*)(Kg + rowbase * DQK) + wid * 1024 + lane * 16;
    const char* ksrc1 = ksrc0 + 8 * 1024;
    const char* vsrc = (const char*)(Vg + rowbase * DV) + wid * 1024 + lane * 16;
#define ATT_DMA_K(t, slot) do { \
        __builtin_amdgcn_global_load_lds((const unsigned*)(ksrc0 + (size_t)(t) * (KT * DQK * 2)), (LAS unsigned*)(lds + KRING + (slot) * KBYTES + wid * 1024), 16, 0, 0); \
        if (wid < 4) __builtin_amdgcn_global_load_lds((const unsigned*)(ksrc1 + (size_t)(t) * (KT * DQK * 2)), (LAS unsigned*)(lds + KRING + (slot) * KBYTES + (wid + 8) * 1024), 16, 0, 0); } while (0)
#define ATT_DMA_V(t, slot) __builtin_amdgcn_global_load_lds((const unsigned*)(vsrc + (size_t)(t) * (KT * DV * 2)), (LAS unsigned*)(lds + VRING + (slot) * VBYTES + wid * 1024), 16, 0, 0)
#define ATT_SYNC() do { asm volatile("s_waitcnt vmcnt(0) lgkmcnt(0)" ::: "memory"); __builtin_amdgcn_s_barrier(); __builtin_amdgcn_sched_barrier(0); } while (0)
#define ATT_SYNCN(tau) do { if ((tau) + 2 < NT) { if (g0) asm volatile("s_waitcnt vmcnt(3) lgkmcnt(0)" ::: "memory"); else asm volatile("s_waitcnt vmcnt(2) lgkmcnt(0)" ::: "memory"); } \
        else asm volatile("s_waitcnt vmcnt(0) lgkmcnt(0)" ::: "memory"); __builtin_amdgcn_s_barrier(); __builtin_amdgcn_sched_barrier(0); } while (0)
    const int koff = KRING + hi * 1024 + r32 * 16;
    const int voff = VRING + (4 * hi + ((lane & 15) >> 2)) * 64 + ((lane >> 4) & 1) * 32 + (lane & 3) * 8;
    f32x16 o0 = {}, o1 = {}, negm = {};
    float mref = 0.f, lpart = 0.f;
    f32x16 sA0, sA1, sB0, sB1;
    u32x4 pw[4];
    bf16x8 kf[12], vf[8];
#define ATT_SB() __builtin_amdgcn_sched_barrier(0)
#define ATT_LOADK(kslot) do { const LAS unsigned char* kb_ = lds + koff + (kslot) * KBYTES; \
        _Pragma("unroll") for (int ds = 0; ds < 6; ++ds) { kf[2 * ds] = *(const LAS bf16x8*)(kb_ + ds * 2048); kf[2 * ds + 1] = *(const LAS bf16x8*)(kb_ + ds * 2048 + 512); } } while (0)
#define ATT_LOADV(vslot) do { const LAS unsigned char* vb_ = lds + voff + (vslot) * VBYTES; \
        _Pragma("unroll") for (int ks = 0; ks < 4; ++ks) { \
            const s16x4 a0_ = vtr(vb_ + (2 * ks) * 512), a1_ = vtr(vb_ + (2 * ks + 1) * 512), b0_ = vtr(vb_ + (8 + 2 * ks) * 512), b1_ = vtr(vb_ + (8 + 2 * ks + 1) * 512); \
            vf[2 * ks] = (bf16x8){a0_[0], a0_[1], a0_[2], a0_[3], a1_[0], a1_[1], a1_[2], a1_[3]}; \
            vf[2 * ks + 1] = (bf16x8){b0_[0], b0_[1], b0_[2], b0_[3], b1_[0], b1_[1], b1_[2], b1_[3]}; } } while (0)
#define ATT_QK(X0, X1) do { \
        X0 = __builtin_amdgcn_mfma_f32_32x32x16_bf16(kf[0], qf[0], negm, 0, 0, 0); X1 = __builtin_amdgcn_mfma_f32_32x32x16_bf16(kf[1], qf[0], negm, 0, 0, 0); \
        _Pragma("unroll") for (int ds = 1; ds < 6; ++ds) { X0 = __builtin_amdgcn_mfma_f32_32x32x16_bf16(kf[2 * ds], qf[ds], X0, 0, 0, 0); X1 = __builtin_amdgcn_mfma_f32_32x32x16_bf16(kf[2 * ds + 1], qf[ds], X1, 0, 0, 0); } } while (0)
#define ATT_PV() do { \
        _Pragma("unroll") for (int ks = 0; ks < 4; ++ks) { const bf16x8 pf_ = __builtin_bit_cast(bf16x8, pw[ks]); \
            o0 = __builtin_amdgcn_mfma_f32_32x32x16_bf16(vf[2 * ks], pf_, o0, 0, 0, 0); o1 = __builtin_amdgcn_mfma_f32_32x32x16_bf16(vf[2 * ks + 1], pf_, o1, 0, 0, 0); } } while (0)
#define ATT_MAXPHASE(X0, X1, FIRST) do { \
        float mx_ = fmaxf(fmaxf(X0[0], X0[1]), X1[0]); float my_ = fmaxf(fmaxf(X0[2], X0[3]), X1[1]); mx_ = fmaxf(fmaxf(mx_, X1[2]), X1[3]); \
        _Pragma("unroll") for (int r = 4; r < 16; r += 4) { mx_ = fmaxf(fmaxf(mx_, X0[r]), X0[r + 1]); my_ = fmaxf(fmaxf(my_, X0[r + 2]), X0[r + 3]); mx_ = fmaxf(fmaxf(mx_, X1[r]), X1[r + 1]); my_ = fmaxf(fmaxf(my_, X1[r + 2]), X1[r + 3]); } \
        mx_ = half_max(fmaxf(mx_, my_)); \
        if ((FIRST) || __builtin_expect(__any(mx_ > (float)ATT_THR), 0)) { \
            asm volatile("; rescale (rare)" ::: "memory"); const float dl_ = (FIRST) ? mx_ : fmaxf(mx_, 0.f); mref += dl_; const float f_ = (FIRST) ? 1.f : __builtin_amdgcn_exp2f(-dl_); \
            _Pragma("unroll") for (int r = 0; r < 16; ++r) { X0[r] -= dl_; X1[r] -= dl_; o0[r] *= f_; o1[r] *= f_; negm[r] = -mref; } \
            lpart *= f_; asm volatile("" : "+v"(negm)); } } while (0)
#define ATT_EXPPHASE(X0, X1) do { float ls_ = 0.f; \
        _Pragma("unroll") for (int r = 0; r < 16; ++r) { X0[r] = __builtin_amdgcn_exp2f(X0[r]); X1[r] = __builtin_amdgcn_exp2f(X1[r]); ls_ += X0[r] + X1[r]; } \
        lpart += ls_; \
        _Pragma("unroll") for (int s = 0; s < 2; ++s) { \
            pw[s] = (u32x4){cvtpk(X0[8 * s], X0[8 * s + 1]), cvtpk(X0[8 * s + 2], X0[8 * s + 3]), cvtpk(X0[8 * s + 4], X0[8 * s + 5]), cvtpk(X0[8 * s + 6], X0[8 * s + 7])}; \
            pw[2 + s] = (u32x4){cvtpk(X1[8 * s], X1[8 * s + 1]), cvtpk(X1[8 * s + 2], X1[8 * s + 3]), cvtpk(X1[8 * s + 4], X1[8 * s + 5]), cvtpk(X1[8 * s + 6], X1[8 * s + 7])}; } } while (0)
#define ATT_ISSUE(t) do { if ((t) + 3 < NT) ATT_DMA_K((t) + 3, ((t) + 3) & 3); if ((t) + 2 < NT) ATT_DMA_V((t) + 2, ((t) + 2) & 3); } while (0)

    const bool g0 = wid < 4;
#define ATT_X(C0, C1, t) do { ATT_LOADV(((t) - 1) & 3); ATT_SB(); ATT_PV(); ATT_SB(); ATT_MAXPHASE(C0, C1, false); ATT_SB(); } while (0)
#define ATT_Y(C0, C1, N0, N1, t) do { ATT_LOADK(((t) + 1) & 3); ATT_SB(); ATT_EXPPHASE(C0, C1); ATT_SB(); ATT_QK(N0, N1); ATT_SB(); } while (0)
    ATT_DMA_K(0, 0); ATT_DMA_V(0, 0); ATT_DMA_K(1, 1);
    ATT_SYNC();
    ATT_DMA_K(2, 2); ATT_DMA_V(1, 1);
    ATT_LOADK(0); ATT_QK(sA0, sA1);
    ATT_SYNC();
    ATT_ISSUE(0);
    ATT_MAXPHASE(sA0, sA1, true);
    if (!g0) { ATT_SYNCN(1); ATT_ISSUE(1); }
    ATT_Y(sA0, sA1, sB0, sB1, 0);
    for (int t = 1; t + 2 < NT; t += 2) {
        if (g0) { ATT_SYNCN(t); ATT_ISSUE(t); }
        ATT_X(sB0, sB1, t);
        if (!g0) { ATT_SYNCN(t + 1); ATT_ISSUE(t + 1); }
        ATT_Y(sB0, sB1, sA0, sA1, t);
        if (g0) { ATT_SYNCN(t + 1); ATT_ISSUE(t + 1); }
        ATT_X(sA0, sA1, t + 1);
        if (!g0) { ATT_SYNCN(t + 2); ATT_ISSUE(t + 2); }
        ATT_Y(sA0, sA1, sB0, sB1, t + 1);
    }
    if (g0) { ATT_SYNCN(NT - 1); }
    ATT_X(sB0, sB1, NT - 1);
    ATT_EXPPHASE(sB0, sB1);
    ATT_LOADV((NT - 1) & 3); ATT_PV();
#undef ATT_X
#undef ATT_Y
    const float rl = 1.f / half_sum(lpart);
    const int b = bh >> 3, h = bh & 7;
    bf16_t* orow = MIXg + ((size_t)b * S + qb * 256 + wid * 32 + r32) * D + h * 64 + 4 * hi;
#pragma unroll
    for (int g4 = 0; g4 < 4; ++g4) {
        u32x2 w0, w1;
        w0.x = cvtpk(o0[4 * g4] * rl, o0[4 * g4 + 1] * rl); w0.y = cvtpk(o0[4 * g4 + 2] * rl, o0[4 * g4 + 3] * rl);
        w1.x = cvtpk(o1[4 * g4] * rl, o1[4 * g4 + 1] * rl); w1.y = cvtpk(o1[4 * g4 + 2] * rl, o1[4 * g4 + 3] * rl);
        *(u32x2*)(orow + 8 * g4) = w0; *(u32x2*)(orow + 32 + 8 * g4) = w1;
    }
    asm volatile("s_waitcnt lgkmcnt(0)" ::: "memory"); __builtin_amdgcn_s_barrier();
#undef ATT_DMA_K
#undef ATT_DMA_V
#undef ATT_SYNC
#undef ATT_QK
#undef ATT_PV
#undef ATT_MAXPHASE
#undef ATT_EXPPHASE
#undef ATT_SYNCN
#undef ATT_LOADK
#undef ATT_LOADV
#undef ATT_SB
#undef ATT_ISSUE
}
}


namespace ssd {
typedef short bf16x8 __attribute__((ext_vector_type(8)));
typedef short bf16x4 __attribute__((ext_vector_type(4)));
typedef float f32x16 __attribute__((ext_vector_type(16)));
constexpr int CH = 128, NCH = S / CH;
constexpr float LOG2E = 1.4426950408889634f;
__device__ __forceinline__ int crow(int r, int hi) { return (r & 3) + 8 * (r >> 2) + 4 * hi; }
__device__ __forceinline__ unsigned cvtpk(float lo, float hi) { return att::cvtpk(lo, hi); }
__device__ __forceinline__ void scan128(float a0, float a1, int lane, float& p0, float& p1, float& tot) {
    float s = a0 + a1;
#pragma unroll
    for (int o = 1; o < 64; o <<= 1) { const float t = __shfl_up(s, o); if (lane >= o) s += t; }
    tot = __shfl(s, 63); p1 = s; p0 = s - a1;
}
__device__ __forceinline__ void conv_chunk(float* smf, const bf16_t* PROJ, const float* cw, const float* cb, bf16_t* XBCC, bf16_t* XT, bf16_t* BT,
                                           const float* DTRAW, const float* dtb, float* DT, int b, int c) {
    int tid = threadIdx.x; asm volatile("" : "+v"(tid));
    const int t0 = b * S + c * CH, s0 = c * CH;
    if (tid < 2048 / 4) {
        const f32x4 raw = *(const f32x4*)(DTRAW + (size_t)t0 * 16 + tid * 4); const f32x4 bb = *(const f32x4*)(dtb + ((tid * 4) & 15)); f32x4 o;
#pragma unroll
        for (int j = 0; j < 4; ++j) { const float v = raw[j] + bb[j]; o[j] = v > 20.f ? v : log1pf(expf(v)); }
        *(f32x4*)(DT + (size_t)t0 * 16 + tid * 4) = o;
    }
    const int ch = tid & 127, lq = tid >> 7;
    for (int cbk = 0; cbk < 6; ++cbk) {
        __syncthreads();
        {
            u32x4 v[5];
#pragma unroll
            for (int q = 0; q < 5; ++q) { const int i = tid + q * 512, r = i >> 4, c8 = (i & 15) * 8, ss = s0 - 2 + r;
                v[q] = (u32x4){0u, 0u, 0u, 0u};
                if (i < 132 * 16 && ss >= 0 && ss < S) v[q] = *(const u32x4*)(PROJ + (size_t)(b * S + ss) * PROJ_N + PC_XBC + cbk * 128 + c8); }
#pragma unroll
            for (int q = 0; q < 5; ++q) { const int i = tid + q * 512, r = i >> 4, c8 = (i & 15) * 8;
                if (i < 132 * 16) { float* d = smf + r * 128 + c8;
                    d[0] = bf2f(v[q].x & 0xffffu); d[1] = bf2f(v[q].x >> 16); d[2] = bf2f(v[q].y & 0xffffu); d[3] = bf2f(v[q].y >> 16);
                    d[4] = bf2f(v[q].z & 0xffffu); d[5] = bf2f(v[q].z >> 16); d[6] = bf2f(v[q].w & 0xffffu); d[7] = bf2f(v[q].w >> 16); } }
        }
        __syncthreads();
        const int gch = cbk * 128 + ch;
        float w[5];
#pragma unroll
        for (int k = 0; k < 5; ++k) w[k] = cw[k * XBC + gch];
        const float bias = cb[gch];
        unsigned pk[16];
        float x0 = smf[(lq * 32 + 0) * 128 + ch], x1 = smf[(lq * 32 + 1) * 128 + ch], x2 = smf[(lq * 32 + 2) * 128 + ch], x3 = smf[(lq * 32 + 3) * 128 + ch];
        float prev = 0.f;
#pragma unroll
        for (int l = 0; l < 32; ++l) {
            const float x4 = smf[(lq * 32 + l + 4) * 128 + ch];
            const float acc = bias + w[0] * x0 + w[1] * x1 + w[2] * x2 + w[3] * x3 + w[4] * x4;
            const float v = acc / (1.f + __expf(-acc));
            XBCC[(size_t)(t0 + lq * 32 + l) * XBC + gch] = (bf16_t)f2bf(v);
            if (l & 1) pk[l >> 1] = pk2(prev, v); else prev = v;
            x0 = x1; x1 = x2; x2 = x3; x3 = x4;
        }
        if (cbk < 5) {
            bf16_t* dst = cbk < 4 ? XT + ((size_t)(b * NCH + c) * 512 + gch) * CH + lq * 32 : BT + ((size_t)(b * NCH + c) * 128 + ch) * CH + lq * 32;
#pragma unroll
            for (int q = 0; q < 4; ++q) *(u32x4*)(dst + q * 8) = (u32x4){pk[4 * q], pk[4 * q + 1], pk[4 * q + 2], pk[4 * q + 3]};
        }
    }
    __syncthreads();
}
__device__ __forceinline__ void states_chunk(float* wtab_all, const bf16_t* XT, const bf16_t* BT, const float* DT, const float* alog, float* STATES, float* CDEC, int b, int c) {
    int tid = threadIdx.x; asm volatile("" : "+v"(tid));
    const int lane = tid & 63, hd = __builtin_amdgcn_readfirstlane(tid >> 6), g = hd >> 2, r32 = lane & 31, hi = lane >> 5;
    float* wtab = wtab_all + hd * 128;
    const size_t t0 = (size_t)b * S + c * CH;
    const bf16_t* xt = XT + ((size_t)(b * NCH + c) * 512 + hd * 64) * CH; const bf16_t* bt = BT + ((size_t)(b * NCH + c) * 128 + g * 64) * CH;
    for (int dir = 0; dir < 2; ++dir) {
        const float av = -expf(alog[dir * 8 + hd]);
        const float d0 = DT[(t0 + 2 * lane) * 16 + dir * 8 + hd], d1 = DT[(t0 + 2 * lane + 1) * 16 + dir * 8 + hd];
        float p0, p1, tot; scan128(d0 * av, d1 * av, lane, p0, p1, tot);
        const float w0 = dir == 0 ? __expf(tot - p0) * d0 : __expf(p0 - d0 * av) * d0;
        const float w1 = dir == 0 ? __expf(tot - p1) * d1 : __expf(p1 - d1 * av) * d1;
        wtab[2 * lane] = w0; wtab[2 * lane + 1] = w1;
        if (lane == 0) CDEC[((b * NCH + c) * 2 + dir) * 8 + hd] = __expf(tot);
        asm volatile("s_waitcnt lgkmcnt(0)" ::: "memory");
        f32x16 acc[2][2];
#pragma unroll
        for (int i = 0; i < 2; ++i)
#pragma unroll
            for (int j = 0; j < 2; ++j) acc[i][j] = (f32x16){};
#pragma unroll 4
        for (int ks = 0; ks < 8; ++ks) {
            const f32x4 wa = *(const f32x4*)(wtab + 16 * ks + 8 * hi), wb = *(const f32x4*)(wtab + 16 * ks + 8 * hi + 4);
            bf16x8 xb[2], bb[2];
#pragma unroll
            for (int pb = 0; pb < 2; ++pb) {
                const u32x4 v = *(const u32x4*)(xt + (size_t)(32 * pb + r32) * CH + 16 * ks + 8 * hi);
                u32x4 o; o.x = cvtpk(bf2f(v.x & 0xffffu) * wa.x, bf2f(v.x >> 16) * wa.y); o.y = cvtpk(bf2f(v.y & 0xffffu) * wa.z, bf2f(v.y >> 16) * wa.w);
                o.z = cvtpk(bf2f(v.z & 0xffffu) * wb.x, bf2f(v.z >> 16) * wb.y); o.w = cvtpk(bf2f(v.w & 0xffffu) * wb.z, bf2f(v.w >> 16) * wb.w);
                xb[pb] = __builtin_bit_cast(bf16x8, o);
            }
#pragma unroll
            for (int nb = 0; nb < 2; ++nb) bb[nb] = *(const bf16x8*)(bt + (size_t)(32 * nb + r32) * CH + 16 * ks + 8 * hi);
#pragma unroll
            for (int nb = 0; nb < 2; ++nb)
#pragma unroll
                for (int pb = 0; pb < 2; ++pb) acc[nb][pb] = __builtin_amdgcn_mfma_f32_32x32x16_bf16(bb[nb], xb[pb], acc[nb][pb], 0, 0, 0);
        }
        float* st = STATES + ((size_t)((b * NCH + c) * 2 + dir) * 8 + hd) * 4096;
#pragma unroll
        for (int nb = 0; nb < 2; ++nb)
#pragma unroll
            for (int pb = 0; pb < 2; ++pb)
#pragma unroll
                for (int q = 0; q < 4; ++q)
                    *(f32x4*)(st + (32 * pb + r32) * 64 + 32 * nb + 8 * q + 4 * hi) = (f32x4){acc[nb][pb][4 * q], acc[nb][pb][4 * q + 1], acc[nb][pb][4 * q + 2], acc[nb][pb][4 * q + 3]};
    }
}
__device__ __forceinline__ void finalize_chunk(float* smf, const bf16_t* XBCC, const bf16_t* XT, const bf16_t* PROJ, const float* DT, const float* alog, const bf16_t* HPB,
                                               const float* ssdd, const float* ssdnw, bf16_t* MIX, int b, int c) {
    int tid = threadIdx.x; asm volatile("" : "+v"(tid));
    const int lane = tid & 63, hd = __builtin_amdgcn_readfirstlane(tid >> 6), g = hd >> 2, r32 = lane & 31, hi = lane >> 5;
    f32x4* tab = (f32x4*)smf + hd * 128;
    float* red = smf + 8 * 128 * 4;
    const size_t t0 = (size_t)b * S + c * CH;
    {
        const float af = -expf(alog[hd]), ab = -expf(alog[8 + hd]);
        const float f0 = DT[(t0 + 2 * lane) * 16 + hd], f1 = DT[(t0 + 2 * lane + 1) * 16 + hd];
        const float b0 = DT[(t0 + 2 * lane) * 16 + 8 + hd], b1 = DT[(t0 + 2 * lane + 1) * 16 + 8 + hd];
        float pf0, pf1, tf, pb0, pb1, tb;
        scan128(f0 * af, f1 * af, lane, pf0, pf1, tf); scan128(b0 * ab, b1 * ab, lane, pb0, pb1, tb);
        tab[2 * lane] = (f32x4){pf0, f0, tb - (pb0 - b0 * ab), b0}; tab[2 * lane + 1] = (f32x4){pf1, f1, tb - (pb1 - b1 * ab), b1};
        asm volatile("s_waitcnt lgkmcnt(0)" ::: "memory");
    }
    const bf16_t* xt = XT + ((size_t)(b * NCH + c) * 512 + hd * 64) * CH + (size_t)r32 * CH + 4 * hi;
    const bf16_t* brow = XBCC + (t0 + r32) * XBC + 512 + g * 64 + 8 * hi;
    const bf16_t* hpb = HPB + ((size_t)((b * NCH + c) * 2) * 8 + hd) * 4096 + (size_t)r32 * 64 + 8 * hi;
    const float dsk = ssdd[hd];
#define FIN_LOADB(dst, jb) do { _Pragma("unroll") for (int ks = 0; ks < 4; ++ks) dst[ks] = *(const bf16x8*)(brow + (size_t)(jb) * 32 * XBC + 16 * ks); } while (0)
#define FIN_LOADX(dst, jb) do { _Pragma("unroll") for (int s = 0; s < 2; ++s) _Pragma("unroll") for (int pb = 0; pb < 2; ++pb) { \
        const bf16_t* xp_ = xt + (size_t)pb * 32 * CH + 32 * (jb) + 16 * s; const u32x2 lo_ = *(const u32x2*)xp_, hi_ = *(const u32x2*)(xp_ + 8); \
        dst[2 * s + pb] = __builtin_bit_cast(bf16x8, (u32x4){lo_.x, lo_.y, hi_.x, hi_.y}); } } while (0)
#define FIN_LOADH(dst, dir) do { _Pragma("unroll") for (int ks = 0; ks < 4; ++ks) _Pragma("unroll") for (int pb = 0; pb < 2; ++pb) \
        dst[2 * ks + pb] = *(const bf16x8*)(hpb + (size_t)(dir) * 8 * 4096 + pb * 32 * 64 + 16 * ks); } while (0)
#define FIN_TILE(jb, bfr, xf) do { \
        f32x16 gt = (f32x16){}; \
        _Pragma("unroll") for (int ks = 0; ks < 4; ++ks) gt = __builtin_amdgcn_mfma_f32_32x32x16_bf16(bfr[ks], cf[ks], gt, 0, 0, 0); \
        _Pragma("unroll") for (int r = 0; r < 16; ++r) { \
            const int j = 32 * (jb) + crow(r, hi); const f32x4 tj = tab[j]; \
            const bool lt = j < i, gtj = j > i; \
            const float arg = lt ? ti.x - tj.x : (gtj ? ti.z - tj.z : 0.f); \
            const float dj = lt ? tj.y : (gtj ? tj.w : ti.y + ti.w); \
            gt[r] = gt[r] * __builtin_amdgcn_exp2f(arg * LOG2E) * dj; } \
        u32x4 pw[2]; \
        _Pragma("unroll") for (int s = 0; s < 2; ++s) pw[s] = (u32x4){cvtpk(gt[8 * s], gt[8 * s + 1]), cvtpk(gt[8 * s + 2], gt[8 * s + 3]), cvtpk(gt[8 * s + 4], gt[8 * s + 5]), cvtpk(gt[8 * s + 6], gt[8 * s + 7])}; \
        _Pragma("unroll") for (int s = 0; s < 2; ++s) _Pragma("unroll") for (int pb = 0; pb < 2; ++pb) \
            yT[pb] = __builtin_amdgcn_mfma_f32_32x32x16_bf16(xf[2 * s + pb], __builtin_bit_cast(bf16x8, pw[s]), yT[pb], 0, 0, 0); } while (0)
#define FIN_YOFF(hp, dir) do { const float ei = __builtin_amdgcn_exp2f(((dir) == 0 ? ti.x : ti.z) * LOG2E); \
        _Pragma("unroll") for (int ks = 0; ks < 4; ++ks) { \
            const u32x4 cv = __builtin_bit_cast(u32x4, cf[ks]); u32x4 cs; \
            cs.x = cvtpk(bf2f(cv.x & 0xffffu) * ei, bf2f(cv.x >> 16) * ei); cs.y = cvtpk(bf2f(cv.y & 0xffffu) * ei, bf2f(cv.y >> 16) * ei); \
            cs.z = cvtpk(bf2f(cv.z & 0xffffu) * ei, bf2f(cv.z >> 16) * ei); cs.w = cvtpk(bf2f(cv.w & 0xffffu) * ei, bf2f(cv.w >> 16) * ei); \
            _Pragma("unroll") for (int pb = 0; pb < 2; ++pb) yT[pb] = __builtin_amdgcn_mfma_f32_32x32x16_bf16(hp[2 * ks + pb], __builtin_bit_cast(bf16x8, cs), yT[pb], 0, 0, 0); } } while (0)
    bf16x8 bA[4], bB[4], xA[4], xB[4], hA[8], hB[8];
    FIN_LOADB(bA, 0); FIN_LOADX(xA, 0);
#pragma unroll 1
    for (int ib = 0; ib < 4; ++ib) {
        asm volatile("" : "+v"(brow), "+v"(xt), "+v"(hpb));
        const int i = 32 * ib + r32;
        const f32x4 ti = tab[i];
        bf16x8 cf[4];
#pragma unroll
        for (int ks = 0; ks < 4; ++ks) cf[ks] = *(const bf16x8*)(XBCC + (t0 + i) * XBC + 640 + g * 64 + 16 * ks + 8 * hi);
        f32x16 yT[2]; yT[0] = (f32x16){}; yT[1] = (f32x16){};
        FIN_LOADB(bB, 1); FIN_LOADX(xB, 1); __builtin_amdgcn_sched_barrier(0);
        FIN_TILE(0, bA, xA);
        FIN_LOADB(bA, 2); FIN_LOADX(xA, 2); __builtin_amdgcn_sched_barrier(0);
        FIN_TILE(1, bB, xB);
        FIN_LOADB(bB, 3); FIN_LOADX(xB, 3); __builtin_amdgcn_sched_barrier(0);
        FIN_TILE(2, bA, xA);
        FIN_LOADH(hA, 0); __builtin_amdgcn_sched_barrier(0);
        FIN_TILE(3, bB, xB);
        FIN_LOADH(hB, 1); __builtin_amdgcn_sched_barrier(0);
        FIN_YOFF(hA, 0);
        u32x2 xv[8], zv[8];
#pragma unroll
        for (int q = 0; q < 8; ++q) { const int p = 32 * (q >> 2) + 8 * (q & 3) + 4 * hi;
            xv[q] = *(const u32x2*)(XBCC + (t0 + i) * XBC + hd * 64 + p); zv[q] = *(const u32x2*)(PROJ + (t0 + i) * PROJ_N + PC_Z + hd * 64 + p); }
        __builtin_amdgcn_sched_barrier(0);
        FIN_YOFF(hB, 1);
        FIN_LOADB(bA, 0); FIN_LOADX(xA, 0); __builtin_amdgcn_sched_barrier(0);
        float ss = 0.f;
#pragma unroll
        for (int q8 = 0; q8 < 8; ++q8) {
            const int pb = q8 >> 2, q = q8 & 3;
            const float xs[4] = {bf2f(xv[q8].x & 0xffffu), bf2f(xv[q8].x >> 16), bf2f(xv[q8].y & 0xffffu), bf2f(xv[q8].y >> 16)};
            const float zs[4] = {bf2f(zv[q8].x & 0xffffu), bf2f(zv[q8].x >> 16), bf2f(zv[q8].y & 0xffffu), bf2f(zv[q8].y >> 16)};
#pragma unroll
            for (int e = 0; e < 4; ++e) { const float y = yT[pb][4 * q + e] + dsk * xs[e]; const float gv = y * (zs[e] / (1.f + __expf(-zs[e]))); yT[pb][4 * q + e] = gv; ss += gv * gv; }
        }
        ss = att::half_sum(ss);
        __syncthreads();
        if (hi == 0) red[hd * 32 + r32] = ss;
        __syncthreads();
        float tot = 0.f;
#pragma unroll
        for (int w8 = 0; w8 < 8; ++w8) tot += red[w8 * 32 + r32];
        const float rstd = 1.f / sqrtf(tot * (1.f / 512.f) + EPS);
#pragma unroll
        for (int pb = 0; pb < 2; ++pb)
#pragma unroll
            for (int q = 0; q < 4; ++q) {
                const int p = 32 * pb + 8 * q + 4 * hi;
                const f32x4 wv = *(const f32x4*)(ssdnw + hd * 64 + p);
                u32x2 o; o.x = cvtpk(yT[pb][4 * q] * rstd * wv.x, yT[pb][4 * q + 1] * rstd * wv.y); o.y = cvtpk(yT[pb][4 * q + 2] * rstd * wv.z, yT[pb][4 * q + 3] * rstd * wv.w);
                *(u32x2*)(MIX + (t0 + i) * D + 512 + hd * 64 + p) = o;
            }
    }
#undef FIN_LOADB
#undef FIN_LOADX
#undef FIN_LOADH
#undef FIN_TILE
#undef FIN_YOFF
    __syncthreads();
}
}

struct Args { const void* in[31]; float* out; unsigned char* ws; int ph_lo, ph_hi; };
#define IN_F(i) ((const float*)a.in[i])
enum { I_X = 0, I_P, I_POS, I_ATTN_NW, I_WIN, I_QNW, I_WUQ, I_KVNW, I_WUKV, I_AONW, I_CONVW, I_CONVB, I_DTB, I_ALOG, I_SSDD, I_SSDNW, I_WO, I_FFNNW,
       I_WRG, I_BRG, I_WRE, I_BRE, I_WEG, I_WEU, I_WED, I_PLENW, I_WPG, I_BPG, I_WPP, I_PPNW, I_FNW };

template <class FA, class FB, class FE>
__device__ __forceinline__ void naive_gemm(int M, int N, int K, FA fa, FB fb, FE fe, float* sm) {
    const int tid = threadIdx.x, tx = tid & 63, ty = tid >> 6;
    float* As = sm; float* Bs = sm + 64 * 17;
    const int ntm = M / 64, ntn = (N + 63) / 64;
    for (int tile = blockIdx.x; tile < ntm * ntn; tile += gridDim.x) {
        const int tm = tile / ntn, tn = tile % ntn;
        float acc[8];
#pragma unroll
        for (int j = 0; j < 8; ++j) acc[j] = 0.f;
        for (int k0 = 0; k0 < K; k0 += 16) {
            __syncthreads();
            for (int i = tid; i < 1024; i += 512) { const int r = i >> 4, c = i & 15; As[r * 17 + c] = fa(tm * 64 + r, k0 + c); }
            for (int i = tid; i < 1024; i += 512) { const int r = i >> 6, c = i & 63; const int n = tn * 64 + c; Bs[r * 64 + c] = (n < N) ? fb(k0 + r, n) : 0.f; }
            __syncthreads();
#pragma unroll
            for (int k = 0; k < 16; ++k) { const float b = Bs[k * 64 + tx];
#pragma unroll
                for (int j = 0; j < 8; ++j) acc[j] += As[(ty * 8 + j) * 17 + k] * b; }
        }
#pragma unroll
        for (int j = 0; j < 8; ++j) { const int m = tm * 64 + ty * 8 + j, n = tn * 64 + tx; if (n < N) fe(m, n, acc[j]); }
    }
    __syncthreads();
}

__device__ __forceinline__ int proj_src_col(int j) {
    if (j < 416) return j;
    if (j < 432) return 1696 + (j - 416);
    if (j < 512) return -1;
    if (j < 1024) return 416 + (j - 512);
    return 928 + (j - 1024);
}

__device__ __forceinline__ void rms_row_to_bf16(const float* xrow, const float* w, bf16_t* orow, int lane) {
    const f32x4* xr = (const f32x4*)xrow + lane; const f32x4* wr = (const f32x4*)w + lane;
    f32x4 v[4]; float s = 0.f;
#pragma unroll
    for (int j = 0; j < 4; ++j) { v[j] = xr[64 * j]; s += (v[j].x * v[j].x + v[j].y * v[j].y) + (v[j].z * v[j].z + v[j].w * v[j].w); }
    const float rstd = 1.f / sqrtf(wave_sum(s) * (1.f / D) + EPS);
    u32x2* o8 = (u32x2*)orow + lane;
#pragma unroll
    for (int j = 0; j < 4; ++j) { const f32x4 g = wr[64 * j]; u32x2 o; o.x = pk2(v[j].x * rstd * g.x, v[j].y * rstd * g.y); o.y = pk2(v[j].z * rstd * g.z, v[j].w * rstd * g.w); o8[64 * j] = o; }
}

constexpr int LDS_BYTES = 147456;
constexpr int MISC_OFF = 131072;

__global__ void __launch_bounds__(512, 2) fwd(Args a) {
    extern __shared__ __attribute__((aligned(16))) unsigned char lds_raw[];
    float* smf = (float*)lds_raw;
    const int G = gridDim.x, NGW = G * 8, NGT = G * 512;
#define FRESH_IDS() int tid = threadIdx.x; asm volatile("" : "+v"(tid)); const int lane = tid & 63, wave = __builtin_amdgcn_readfirstlane(tid >> 6); \
    const int gw = blockIdx.x * 8 + wave, gtid = blockIdx.x * 512 + tid; (void)lane; (void)gw; (void)gtid;
    unsigned char* ws = a.ws;
    unsigned* ctl = (unsigned*)(ws + WS_CTL);
    volatile LAS unsigned* MISC = (volatile LAS unsigned*)((LAS unsigned char*)lds_raw + MISC_OFF);
    if (threadIdx.x < 32) MISC[threadIdx.x] = 0u;
    __syncthreads();
#if !MK_PER_PHASE
    XcdBarrier bar = xcd_barrier_post(ctl + CW_BAR, MISC + 8);
#define GRID_BAR() xcd_barrier(bar)
#else
#define GRID_BAR() do {} while (0)
#endif
    const int lo = a.ph_lo, hi = a.ph_hi;
#ifndef PHMASK
#define PHMASK 0xFFFF
#endif
#define IN(k) (((PHMASK >> (k)) & 1) && lo <= (k) && (k) < hi)
#ifndef REPMASK
#define REPMASK 0
#endif
#define NREP(k) (1 + ((REPMASK >> (k)) & 1))
#define SEAM(k) do { if (IN(k) && IN((k) + 1)) GRID_BAR(); } while (0)

    const float* x = IN_F(I_X);
    float* out = a.out;
    bf16_t* H = (bf16_t*)(ws + WS_H);
    bf16_t* PROJ = (bf16_t*)(ws + WS_PROJ);
    bf16_t* PLERAW = (bf16_t*)(ws + WS_PROJ);
    bf16_t* Qb = (bf16_t*)(ws + WS_Q); bf16_t* Kb = (bf16_t*)(ws + WS_K); bf16_t* Vb = (bf16_t*)(ws + WS_V);
    bf16_t* MIX = (bf16_t*)(ws + WS_MIX);
    bf16_t* XBCC = (bf16_t*)(ws + WS_XBCC);
    float* STATES = out;
    bf16_t* XT = (bf16_t*)((char*)out + 64 * MiB);
    bf16_t* BT = (bf16_t*)((char*)out + 96 * MiB);
    bf16_t* HPB = (bf16_t*)(ws + WS_H);
    float* CDEC = (float*)(ws + WS_CDEC);
    float* COS = (float*)(ws + WS_COS); float* SIN = (float*)(ws + WS_SIN);
    float* DT = (float*)(ws + WS_DT); float* DTRAW = (float*)(ws + WS_DTRAW);
    float* ROUTE = (float*)(ws + WS_ROUTE);
    int* BUCKET = (int*)(ws + WS_BUCKET);
    const int* pos = (const int*)a.in[I_POS];

    bf16_t* WT_IN = (bf16_t*)(ws + WS_WEIGHTS);
    bf16_t* WT_UQ = WT_IN + (size_t)PROJ_N * D;
    bf16_t* WT_UKV = WT_UQ + 768 * 256;
    bf16_t* WT_O = WT_UKV + 1024 * 128;
    bf16_t* WT_PG = WT_O + (size_t)D * D;
    bf16_t* WT_PP = WT_PG + (size_t)D * D;
    bf16_t* WT_GU = WT_PP + (size_t)D * 256;
    bf16_t* WT_DN = WT_GU + (size_t)32 * 512 * 1024;
    bf16_t* PB = (bf16_t*)(ws + WS_PB);
    float* SSQQ = (float*)(ws + WS_SSQQ); float* SSQKV = (float*)(ws + WS_SSQKV); float* SSQPLE = (float*)(ws + WS_SSQPLE);
    LAS unsigned char* ldsb = (LAS unsigned char*)lds_raw;
    bf16_t* WRF = (bf16_t*)(ws + WS_WRF);
    float* SSQX1 = (float*)(ws + WS_SSQX1);

    if (IN(0)) {
        FRESH_IDS();
        for (int rep_ = 0; rep_ < NREP(0); ++rep_) {
        float* scr = smf + wave * 4096;
        constexpr int I_IN = 16 * 56, I_UQ = 4 * 24, I_UKV = 2 * 32, I_O = 16 * 32, I_PG = 16 * 32, I_PP = 4 * 32, I_GU = 32 * 16 * 16, I_DN = 32 * 4 * 32;
        constexpr int NITEMS = I_IN + I_UQ + I_UKV + I_O + I_PG + I_PP + I_GU + I_DN;
        const float* qnw = IN_F(I_QNW); const float* kvnw = IN_F(I_KVNW);
        const float qscale = 0.10206207261596575f * 1.4426950408889634f;
        auto one = [](int) { return 1.f; };
        auto ident = [](int n) { return n; };
        for (int it = gw; it < NITEMS; it += NGW) {
            int r = it;
            if (r < I_IN) { transpose_item(IN_F(I_WIN), IN_COLS, D, WT_IN, scr, r / 56, r % 56, lane, [](int n) { return proj_src_col(n); }, one); continue; } r -= I_IN;
            if (r < I_UQ) { transpose_item(IN_F(I_WUQ), 768, 256, WT_UQ, scr, r / 24, r % 24, lane, ident, [&](int k) { return qnw[k] * qscale; }); continue; } r -= I_UQ;
            if (r < I_UKV) { transpose_item(IN_F(I_WUKV), 1024, 128, WT_UKV, scr, r / 32, r % 32, lane, ident, [&](int k) { return kvnw[k]; }); continue; } r -= I_UKV;
            if (r < I_O) { transpose_item(IN_F(I_WO), D, D, WT_O, scr, r / 32, r % 32, lane, ident, one); continue; } r -= I_O;
            if (r < I_PG) { transpose_item(IN_F(I_WPG), D, D, WT_PG, scr, r / 32, r % 32, lane, ident, one); continue; } r -= I_PG;
            if (r < I_PP) { transpose_item(IN_F(I_WPP), D, 256, WT_PP, scr, r / 32, r % 32, lane, ident, one); continue; } r -= I_PP;
            if (r < I_GU) { const int e = r / 256, q = r % 256, kb = q / 16, nb = q % 16;
                const float* W = ((nb & 7) < 4 ? IN_F(I_WEG) : IN_F(I_WEU)) + (size_t)e * 1024 * 256;
                transpose_item(W, 256, D, WT_GU + (size_t)e * 512 * 1024, scr, kb, nb, lane, [](int n) { return (n >> 8) * 128 + (n & 127); }, one); continue; } r -= I_GU;
            { const int e = r / 128, q = r % 128; transpose_item(IN_F(I_WED) + (size_t)e * 256 * 1024, D, 256, WT_DN + (size_t)e * 1024 * 256, scr, q / 32, q % 32, lane, ident, one); }
        }
        { const f32x4* wr4 = (const f32x4*)IN_F(I_ATTN_NW) + lane;
          for (int m0 = gw * 4; m0 < T; m0 += NGW * 4) {
              f32x4 v[4][4];
#pragma unroll
              for (int r = 0; r < 4; ++r)
#pragma unroll
                  for (int j = 0; j < 4; ++j) v[r][j] = ((const f32x4*)(x + (size_t)(m0 + r) * D) + lane)[64 * j];
#pragma unroll
              for (int r = 0; r < 4; ++r) {
                  float s = 0.f;
#pragma unroll
                  for (int j = 0; j < 4; ++j) s += (v[r][j].x * v[r][j].x + v[r][j].y * v[r][j].y) + (v[r][j].z * v[r][j].z + v[r][j].w * v[r][j].w);
                  const float rstd = 1.f / sqrtf(wave_sum(s) * (1.f / D) + EPS);
                  u32x2* o8 = (u32x2*)(H + (size_t)(m0 + r) * D) + lane;
#pragma unroll
                  for (int j = 0; j < 4; ++j) { const f32x4 g4 = wr4[64 * j]; u32x2 o; o.x = pk2(v[r][j].x * rstd * g4.x, v[r][j].y * rstd * g4.y); o.y = pk2(v[r][j].z * rstd * g4.z, v[r][j].w * rstd * g4.w); o8[64 * j] = o; }
              } } }
        { const f32x4* pp = (const f32x4*)IN_F(I_P); u32x2* po = (u32x2*)PB;
          for (int i0 = gtid; i0 < T * 256 / 4; i0 += NGT * 8) { f32x4 v[8];
#pragma unroll
              for (int q = 0; q < 8; ++q) v[q] = pp[i0 + q * NGT];
#pragma unroll
              for (int q = 0; q < 8; ++q) { u32x2 o; o.x = pk2(v[q].x, v[q].y); o.y = pk2(v[q].z, v[q].w); po[i0 + q * NGT] = o; } } }
        { const float* wrg = IN_F(I_WRG); const float* wre = IN_F(I_WRE);
          for (int i = gtid; i < 32 * 3 * 64 * 8; i += NGT) { const int e = i & 7, l = (i >> 3) & 63, nb = (i >> 9) % 3, ks = i / 1536;
              const int k = 32 * ks + 8 * (l >> 4) + e, col = 16 * nb + (l & 15);
              const float w = col < 4 ? wrg[k * 4 + col] : (col < 36 ? wre[k * 32 + (col - 4)] : 0.f);
              const unsigned hi = f2bf(w); const float lo = w - bf2f(hi);
              const size_t base = ((size_t)(ks * 3 + nb) * 2) * 512 + l * 8 + e;
              WRF[base] = (bf16_t)hi; WRF[base + 512] = (bf16_t)f2bf(lo); } }
        for (int i = gtid; i < T * 16; i += NGT) {
            const int t = i >> 4, f = i & 15;
            const float inv = 1.0f / powf(10000.0f, (float)(2 * f) / 32.0f);
            const float ang = (float)pos[t] * inv;
            COS[i] = cosf(ang); SIN[i] = sinf(ang);
        }
        }
    }
    SEAM(0);
    if (IN(1)) {
        FRESH_IDS();
        for (int rep_ = 0; rep_ < NREP(1); ++rep_) {
        pg8::Gemm g{H, WT_IN, T, PROJ_N, D, D, D}; pg8::StaticOrder So; So.init(T, PROJ_N, G, (int)blockIdx.x);
        EpiInProj E{PROJ, DTRAW, SSQQ, SSQKV};
        pg8::gemm_phase(ldsb, g, So, E);
        }
    }
    SEAM(1);
    if (IN(2)) {
        FRESH_IDS();
        for (int rep_ = 0; rep_ < NREP(2); ++rep_)
        for (int u = blockIdx.x; u < NB * ssd::NCH; u += G) {
            ssd::conv_chunk(smf, PROJ, IN_F(I_CONVW), IN_F(I_CONVB), XBCC, XT, BT, DTRAW, IN_F(I_DTB), DT, u >> 5, u & 31);
            ssd::states_chunk(smf + 20480, XT, BT, DT, IN_F(I_ALOG), STATES, CDEC, u >> 5, u & 31);
            __syncthreads();
        }
        for (int i = gtid; i < T * 16; i += NGT) {
            const int t = i >> 4, f = i & 15, b = t / S, s = t % S;
            const float c = COS[i], sn = SIN[i];
            const float t1 = bf2f(PROJ[(size_t)t * PROJ_N + PC_KR + f]), t2 = bf2f(PROJ[(size_t)t * PROJ_N + PC_KR + 16 + f]);
            const bf16_t o1 = (bf16_t)f2bf(t1 * c - t2 * sn), o2 = (bf16_t)f2bf(t2 * c + t1 * sn);
            for (int h = 0; h < NH; ++h) { bf16_t* kt = Kb + ((size_t)(b * NH + h) * (S / 64) + (s >> 6)) * (12 * 512) + (s & 63) * 8 + (f & 7); kt[(8 + (f >> 3)) * 512] = o1; kt[(10 + (f >> 3)) * 512] = o2; }
        }
        __syncthreads();
        for (int rep2_ = 0; rep2_ < NREP(12); ++rep2_) {
        { pg8::Gemm g{PROJ + PC_CQ, WT_UQ, T, 768, 256, PROJ_N, 256}; pg8::StaticOrder So; So.init(T, 768, G, (int)blockIdx.x);
          EpiQUp E{Qb, SSQQ, COS, SIN}; pg8::gemm_phase(ldsb, g, So, E); }
        { pg8::Gemm g{PROJ + PC_CKV, WT_UKV, T, 1024, 128, PROJ_N, 128}; pg8::StaticOrder So; So.init(T, 1024, G, (int)blockIdx.x);
          EpiKVUp E{Kb, Vb, SSQKV}; pg8::gemm_phase(ldsb, g, So, E); }
        }
    }
    SEAM(2);
    if (IN(3)) {
        FRESH_IDS();
        for (int rep_ = 0; rep_ < NREP(13); ++rep_)
        for (int idx = gtid; idx < 128 * 1024; idx += NGT) {
            const int chain = idx >> 10, e4 = (idx & 1023) * 4, b = chain >> 4, dir = (chain >> 3) & 1, hd = chain & 7;
            f32x4 h4 = (f32x4){0.f, 0.f, 0.f, 0.f};
#pragma unroll 8
            for (int step = 0; step < ssd::NCH; ++step) {
                const int c = dir == 0 ? step : ssd::NCH - 1 - step;
                const int sidx = ((b * ssd::NCH + c) * 2 + dir) * 8 + hd;
                const f32x4* ptr = (const f32x4*)(STATES + (size_t)sidx * 4096 + e4);
                const f32x4 s4 = *ptr; { u32x2 hb; hb.x = pk2(h4.x, h4.y); hb.y = pk2(h4.z, h4.w); *(u32x2*)(HPB + (size_t)sidx * 4096 + e4) = hb; } h4 = h4 * CDEC[sidx] + s4;
            }
        }
        __syncthreads();
        for (int rep_ = 0; rep_ < NREP(3); ++rep_) {
        {
            const int vcu = (G % 8 == 0) ? ((int)blockIdx.x % 8) * (G / 8) + (int)blockIdx.x / 8 : (int)blockIdx.x;
            for (int u = vcu; u < NB * NH * 16; u += G) att::attn_unit(ldsb, Qb, Kb, Vb, MIX, u >> 4, u & 15);
        }
        }
    }
    SEAM(3);
    if (IN(4)) {
        FRESH_IDS();
        const float* aonw = IN_F(I_AONW);
        for (int u = blockIdx.x; u < NB * ssd::NCH; u += G) {
            for (int rep_ = 0; rep_ < NREP(4); ++rep_)
                ssd::finalize_chunk(smf, XBCC, XT, PROJ, DT, IN_F(I_ALOG), HPB, IN_F(I_SSDD), IN_F(I_SSDNW), MIX, u >> 5, u & 31);
            for (int r0 = wave * 4; r0 < ssd::CH; r0 += 32) {
                u32x4 raw[4];
#pragma unroll
                for (int q = 0; q < 4; ++q) raw[q] = *(const u32x4*)(MIX + ((size_t)(u >> 5) * S + (u & 31) * ssd::CH + r0 + q) * D + lane * 8);
                const f32x4 w0 = *(const f32x4*)(aonw + lane * 8), w1 = *(const f32x4*)(aonw + lane * 8 + 4);
#pragma unroll
                for (int q = 0; q < 4; ++q) {
                    float v[8] = {bf2f(raw[q].x & 0xffffu), bf2f(raw[q].x >> 16), bf2f(raw[q].y & 0xffffu), bf2f(raw[q].y >> 16), bf2f(raw[q].z & 0xffffu), bf2f(raw[q].z >> 16), bf2f(raw[q].w & 0xffffu), bf2f(raw[q].w >> 16)};
                    float ss = 0.f;
#pragma unroll
                    for (int j = 0; j < 8; ++j) ss += v[j] * v[j];
                    const float rstd = 1.f / sqrtf(wave_sum(ss) * (1.f / 512.f) + EPS);
                    u32x4 o; o.x = pk2(v[0] * rstd * w0.x, v[1] * rstd * w0.y); o.y = pk2(v[2] * rstd * w0.z, v[3] * rstd * w0.w);
                    o.z = pk2(v[4] * rstd * w1.x, v[5] * rstd * w1.y); o.w = pk2(v[6] * rstd * w1.z, v[7] * rstd * w1.w);
                    *(u32x4*)(MIX + ((size_t)(u >> 5) * S + (u & 31) * ssd::CH + r0 + q) * D + lane * 8) = o;
                }
            }
        }
    }
    SEAM(4);
    if (IN(5)) {
        FRESH_IDS();
        for (int rep_ = 0; rep_ < NREP(5); ++rep_) {
        pg8::Gemm g{MIX, WT_O, T, D, D, D, D}; pg8::StaticOrder So; So.init(T, D, G, (int)blockIdx.x);
        EpiResid E{x, out, SSQX1}; pg8::gemm_phase(ldsb, g, So, E);
        }
    }
    SEAM(5);
    if (IN(6)) {
        FRESH_IDS();
        {
            typedef short bf16x8r __attribute__((ext_vector_type(8)));
            const float* fw = IN_F(I_FFNNW); const float* brg = IN_F(I_BRG); const float* bre = IN_F(I_BRE);
            const int r16 = lane & 15, kq = lane >> 4;
            float* lg = smf + wave * (16 * 48);
            for (int rb = gw; rb < T / 16; rb += NGW) {
                const int row = rb * 16 + r16;
                float ss = 0.f;
#pragma unroll
                for (int q = 0; q < 4; ++q) { const f32x4 sv = *(const f32x4*)(SSQX1 + row * 16 + 4 * q); ss += (sv.x + sv.y) + (sv.z + sv.w); }
                const float rstd = 1.f / sqrtf(ss * (1.f / D) + EPS);
                f32x4 acc[3]; acc[0] = (f32x4){0.f, 0.f, 0.f, 0.f}; acc[1] = acc[0]; acc[2] = acc[0];
                const float* xrow = out + (size_t)row * D + 8 * kq;
#pragma unroll 4
                for (int ks = 0; ks < 32; ++ks) {
                    const f32x4 x0 = *(const f32x4*)(xrow + 32 * ks), x1v = *(const f32x4*)(xrow + 32 * ks + 4);
                    const f32x4 g0 = *(const f32x4*)(fw + 32 * ks + 8 * kq), g1 = *(const f32x4*)(fw + 32 * ks + 8 * kq + 4);
                    const f32x4 h0 = x0 * rstd * g0, h1 = x1v * rstd * g1;
                    u32x4 hi; hi.x = att::cvtpk(h0.x, h0.y); hi.y = att::cvtpk(h0.z, h0.w); hi.z = att::cvtpk(h1.x, h1.y); hi.w = att::cvtpk(h1.z, h1.w);
                    *(u32x4*)(H + (size_t)row * D + 32 * ks + 8 * kq) = hi;
                    u32x4 lo; lo.x = att::cvtpk(h0.x - bf2f(hi.x & 0xffffu), h0.y - bf2f(hi.x >> 16)); lo.y = att::cvtpk(h0.z - bf2f(hi.y & 0xffffu), h0.w - bf2f(hi.y >> 16));
                    lo.z = att::cvtpk(h1.x - bf2f(hi.z & 0xffffu), h1.y - bf2f(hi.z >> 16)); lo.w = att::cvtpk(h1.z - bf2f(hi.w & 0xffffu), h1.w - bf2f(hi.w >> 16));
                    const bf16x8r ah = __builtin_bit_cast(bf16x8r, hi), al = __builtin_bit_cast(bf16x8r, lo);
#pragma unroll
                    for (int nb = 0; nb < 3; ++nb) {
                        const bf16_t* wf = WRF + ((size_t)(ks * 3 + nb) * 2) * 512 + lane * 8;
                        const bf16x8r bh = *(const bf16x8r*)wf, bl = *(const bf16x8r*)(wf + 512);
                        acc[nb] = __builtin_amdgcn_mfma_f32_16x16x32_bf16(ah, bh, acc[nb], 0, 0, 0);
                        acc[nb] = __builtin_amdgcn_mfma_f32_16x16x32_bf16(ah, bl, acc[nb], 0, 0, 0);
                        acc[nb] = __builtin_amdgcn_mfma_f32_16x16x32_bf16(al, bh, acc[nb], 0, 0, 0);
                    }
                }
#pragma unroll
                for (int nb = 0; nb < 3; ++nb)
#pragma unroll
                    for (int j = 0; j < 4; ++j) lg[(4 * kq + j) * 48 + 16 * nb + r16] = acc[nb][j];
                asm volatile("s_waitcnt lgkmcnt(0)" ::: "memory");
                if (lane < 16) {
                    const int m = rb * 16 + lane;
                    float lgt[36];
#pragma unroll
                    for (int q = 0; q < 9; ++q) { const f32x4 v = *(const f32x4*)(lg + lane * 48 + 4 * q); lgt[4 * q] = v.x; lgt[4 * q + 1] = v.y; lgt[4 * q + 2] = v.z; lgt[4 * q + 3] = v.w; }
                    float gl[4]; int gi = 0;
#pragma unroll
                    for (int q = 0; q < 4; ++q) gl[q] = lgt[q] + brg[q];
                    float gmax = gl[0];
#pragma unroll
                    for (int q = 1; q < 4; ++q) if (gl[q] > gmax) { gmax = gl[q]; gi = q; }
                    float gs = 0.f;
#pragma unroll
                    for (int q = 0; q < 4; ++q) gs += expf(gl[q] - gmax);
                    const float gwt = 1.f / gs;
                    float el[8];
#pragma unroll
                    for (int q = 0; q < 8; ++q) { float vv = 0.f;
#pragma unroll
                        for (int g2 = 0; g2 < 4; ++g2) vv = (g2 == gi) ? lgt[4 + g2 * 8 + q] + bre[g2 * 8 + q] : vv;
                        el[q] = vv; }
                    int i0 = 0; float v0 = el[0];
#pragma unroll
                    for (int q = 1; q < 8; ++q) if (el[q] > v0) { v0 = el[q]; i0 = q; }
                    int i1 = -1; float v1 = -3.4e38f;
#pragma unroll
                    for (int q = 0; q < 8; ++q) if (q != i0 && el[q] > v1) { v1 = el[q]; i1 = q; }
                    const float e1 = expf(v1 - v0), w0 = gwt / (1.f + e1), w1 = gwt * e1 / (1.f + e1);
                    const int ex0 = gi * 8 + i0, ex1 = gi * 8 + i1;
                    *(f32x4*)(ROUTE + m * 4) = (f32x4){__int_as_float(ex0), __int_as_float(ex1), w0, w1};
                    const unsigned p0 = atomicAdd(ctl + CW_ECNT + 64 * ex0, 1u); BUCKET[(size_t)ex0 * T + p0] = m * 2;
                    const unsigned p1 = atomicAdd(ctl + CW_ECNT + 64 * ex1, 1u); BUCKET[(size_t)ex1 * T + p1] = m * 2 + 1;
                }
                asm volatile("s_waitcnt lgkmcnt(0)" ::: "memory");
            }
        }
    }
    SEAM(6);
    volatile LAS unsigned* CNT_L = MISC + 64; volatile LAS unsigned* PTILE_L = MISC + 96;
    LAS unsigned* ROWTAB = (LAS unsigned*)(ldsb + MISC_OFF + 1024);
    bf16_t* HE = (bf16_t*)(ws + WS_HE); bf16_t* YPAIR = (bf16_t*)(ws + WS_Q);
    bf16_t* X2B = (bf16_t*)(ws + WS_MIX);
    bf16_t* GB = (bf16_t*)(ws + WS_Q);
    if (IN(7) || IN(8)) {
        if (threadIdx.x == 0) { unsigned acc = 0;
            for (int e2 = 0; e2 < 32; ++e2) { const unsigned c = __hip_atomic_load(ctl + CW_ECNT + 64 * e2, __ATOMIC_RELAXED, __HIP_MEMORY_SCOPE_AGENT); CNT_L[e2] = c; PTILE_L[e2] = acc; acc += (c + 255u) >> 8; }
            PTILE_L[32] = acc; }
        __syncthreads();
    }
    if (IN(7)) {
        FRESH_IDS();
        for (int rep_ = 0; rep_ < NREP(7); ++rep_) {
        GroupSched Sg{PTILE_L, 2, G, (int)blockIdx.x};
        { pg8::Unit u;
          for (int i = 0; i < 8 && Sg.next(i, u); ++i) { const int e2 = u.pn >> 1, pm_l = u.pm - (int)PTILE_L[e2];
              if (tid < 256) { const int idx = pm_l * 256 + tid; const int tok = idx < (int)CNT_L[e2] ? (BUCKET[(size_t)e2 * T + idx] >> 1) : 0; ROWTAB[i * 256 + tid] = (unsigned)tok * 2048u; } } }
        __syncthreads();
        pg8::Gemm g{H, WT_GU, T, 32 * 512, D, D, D};
        EpiMoeGU E{HE};
        pg8::gemm_phase<EpiMoeGU, GroupSched, true>(ldsb, g, Sg, E, ROWTAB);
        { const int total = (int)PTILE_L[32] * 2, nmax = (total + G - 1) / G, extra = total - (nmax - 1) * G;
          pg8::Gemm g2{PB, WT_PP, T, D, 256, 256, 256}; pg8::TailOrder St; St.init(T, D, G, (int)blockIdx.x, extra);
          EpiPleProj E2{PLERAW, SSQPLE}; pg8::gemm_phase(ldsb, g2, St, E2); }
        }
    }
    SEAM(7);
    if (IN(8)) {
        for (int rep_ = 0; rep_ < NREP(8); ++rep_) {
        GroupSched Sg{PTILE_L, 4, G, (int)blockIdx.x};
        pg8::Gemm g{HE, WT_DN, 0, 32 * 1024, 256, 256, 256};
        EpiMoeDown E{YPAIR, BUCKET, ROUTE, PTILE_L, CNT_L};
        pg8::gemm_phase(ldsb, g, Sg, E);
        }
    }
    SEAM(8);
    if (IN(9)) {
        FRESH_IDS();
        const f32x4* wr4 = (const f32x4*)IN_F(I_PLENW) + lane;
        for (int m0 = gw * 4; m0 < T; m0 += NGW * 4) {
            f32x4 v[4][4]; u32x2 ya[4][4], yb[4][4];
#pragma unroll
            for (int r = 0; r < 4; ++r)
#pragma unroll
                for (int j = 0; j < 4; ++j) { const size_t m = m0 + r; v[r][j] = ((const f32x4*)(out + m * D) + lane)[64 * j];
                    ya[r][j] = ((const u32x2*)(YPAIR + (2 * m) * D) + lane)[64 * j]; yb[r][j] = ((const u32x2*)(YPAIR + (2 * m + 1) * D) + lane)[64 * j]; }
#pragma unroll
            for (int r = 0; r < 4; ++r) {
                const size_t m = m0 + r; float s = 0.f;
                u32x2* x2r = (u32x2*)(X2B + m * D) + lane;
#pragma unroll
                for (int j = 0; j < 4; ++j) { const u32x2 a0 = ya[r][j], a1 = yb[r][j];
                    v[r][j] = v[r][j] + (f32x4){bf2f(a0.x & 0xffffu) + bf2f(a1.x & 0xffffu), bf2f(a0.x >> 16) + bf2f(a1.x >> 16), bf2f(a0.y & 0xffffu) + bf2f(a1.y & 0xffffu), bf2f(a0.y >> 16) + bf2f(a1.y >> 16)};
                    { u32x2 xo; xo.x = pk2(v[r][j].x, v[r][j].y); xo.y = pk2(v[r][j].z, v[r][j].w); x2r[64 * j] = xo; }
                    s += (v[r][j].x * v[r][j].x + v[r][j].y * v[r][j].y) + (v[r][j].z * v[r][j].z + v[r][j].w * v[r][j].w); }
                const float rstd = 1.f / sqrtf(wave_sum(s) * (1.f / D) + EPS);
                u32x2* o8 = (u32x2*)(H + m * D) + lane;
#pragma unroll
                for (int j = 0; j < 4; ++j) { const f32x4 g4 = wr4[64 * j]; u32x2 o; o.x = pk2(v[r][j].x * rstd * g4.x, v[r][j].y * rstd * g4.y); o.y = pk2(v[r][j].z * rstd * g4.z, v[r][j].w * rstd * g4.w); o8[64 * j] = o; }
            }
        }
    }
    SEAM(9);
    if (IN(10)) {
        pg8::Gemm g{H, WT_PG, T, D, D, D, D}; pg8::StaticOrder So; So.init(T, D, G, (int)blockIdx.x);
        EpiPleGate E{GB, PLERAW, SSQPLE, IN_F(I_BPG), IN_F(I_PPNW)}; pg8::gemm_phase(ldsb, g, So, E);
    }
    SEAM(10);
    if (IN(11)) {
        FRESH_IDS();
        const f32x4* wr4 = (const f32x4*)IN_F(I_FNW) + lane;
        for (int m0 = gw * 4; m0 < T; m0 += NGW * 4) {
            u32x2 xa[4][4], ga[4][4];
#pragma unroll
            for (int r = 0; r < 4; ++r)
#pragma unroll
                for (int j = 0; j < 4; ++j) { const size_t m = m0 + r; xa[r][j] = ((const u32x2*)(X2B + m * D) + lane)[64 * j]; ga[r][j] = ((const u32x2*)(GB + m * D) + lane)[64 * j]; }
#pragma unroll
            for (int r = 0; r < 4; ++r) {
                f32x4 v[4]; float s = 0.f;
#pragma unroll
                for (int j = 0; j < 4; ++j) { const u32x2 a0 = xa[r][j], a1 = ga[r][j];
                    v[j] = (f32x4){bf2f(a0.x & 0xffffu) + bf2f(a1.x & 0xffffu), bf2f(a0.x >> 16) + bf2f(a1.x >> 16), bf2f(a0.y & 0xffffu) + bf2f(a1.y & 0xffffu), bf2f(a0.y >> 16) + bf2f(a1.y >> 16)};
                    s += (v[j].x * v[j].x + v[j].y * v[j].y) + (v[j].z * v[j].z + v[j].w * v[j].w); }
                const float rstd = 1.f / sqrtf(wave_sum(s) * (1.f / D) + EPS);
                f32x4* xr = (f32x4*)(out + (size_t)(m0 + r) * D) + lane;
#pragma unroll
                for (int j = 0; j < 4; ++j) xr[64 * j] = v[j] * rstd * wr4[64 * j];
            }
        }
    }
#undef IN
#undef SEAM
}

extern "C" void kernel_launch(void* const* d_in, const int* in_sizes, int n_in, void* d_out, int out_size, void* d_ws, size_t ws_size, hipStream_t stream) {
    static int grid = 0;
    if (grid == 0) {
        if (n_in != 31 || out_size != T * D || ws_size < WS_END) { fprintf(stderr, "kernel_launch: unexpected shapes (n_in %d out %d ws %zu)\n", n_in, out_size, ws_size); grid = -1; return; }
        int dev = 0, cus = 0, per_cu = 0;
        if (hipGetDevice(&dev) != hipSuccess || hipDeviceGetAttribute(&cus, hipDeviceAttributeMultiprocessorCount, dev) != hipSuccess) { grid = -1; return; }
        if (hipFuncSetAttribute((const void*)fwd, hipFuncAttributeMaxDynamicSharedMemorySize, LDS_BYTES) != hipSuccess) { fprintf(stderr, "kernel_launch: hipFuncSetAttribute failed\n"); grid = -1; return; }
        if (hipOccupancyMaxActiveBlocksPerMultiprocessor(&per_cu, (const void*)fwd, 512, LDS_BYTES) != hipSuccess || per_cu < 1) { fprintf(stderr, "kernel_launch: occupancy query says %d\n", per_cu); }
        (void)hipGetLastError();
        grid = cus;
    }
    if (grid < 0) return;
    (void)hipMemsetAsync((char*)d_ws + WS_CTL, 0, CTL_ZERO_BYTES, stream);
    Args a{};
    for (int i = 0; i < 31; ++i) a.in[i] = d_in[i];
    a.out = (float*)d_out; a.ws = (unsigned char*)d_ws;
#if MK_PER_PHASE
    for (int p = 0; p < NPHASES; ++p) { a.ph_lo = p; a.ph_hi = p + 1; hipLaunchKernelGGL(fwd, dim3(grid), dim3(512), LDS_BYTES, stream, a); }
#else
    a.ph_lo = 0; a.ph_hi = NPHASES;
    hipLaunchKernelGGL(fwd, dim3(grid), dim3(512), LDS_BYTES, stream, a);
#endif
}
```

```cpp
#include <hip/hip_runtime.h>
#include <cstdio>
#include <cstdint>

#ifndef MK_PER_PHASE
#define MK_PER_PHASE 0
#endif

#define LAS __attribute__((address_space(3)))
#define GAS __attribute__((address_space(1)))
typedef unsigned short bf16_t;
typedef float f32x4 __attribute__((ext_vector_type(4)));
typedef unsigned u32x4 __attribute__((ext_vector_type(4)));
typedef unsigned u32x2 __attribute__((ext_vector_type(2)));

constexpr int NB = 8, S = 4096, T = NB * S, D = 1024;
constexpr int NH = 8, DQK = 96, DV = 64;
constexpr int PROJ_N = 1792, IN_COLS = 1712;
constexpr int PC_CQ = 0, PC_CKV = 256, PC_KR = 384, PC_DT = 416, PC_Z = 512, PC_XBC = 1024;
constexpr int XBC = 768;
constexpr float EPS = 1e-6f;
constexpr int NPHASES = 12;

constexpr size_t MiB = 1u << 20;
constexpr size_t WS_CTL = 0, CTL_ZERO_BYTES = 1 * MiB;
constexpr size_t WS_COS = 1 * MiB, WS_SIN = 3 * MiB, WS_DT = 5 * MiB, WS_ROUTE = 7 * MiB, WS_BUCKET = 8 * MiB;
constexpr size_t WS_SSQQ = 12 * MiB, WS_SSQKV = 12 * MiB + 512 * 1024, WS_DTRAW = 13 * MiB, WS_SSQPLE = 15 * MiB;
constexpr size_t WS_WR = 7 * MiB + 512 * 1024;
constexpr size_t WS_CDEC = 7 * MiB + 768 * 1024;
constexpr size_t WS_WRF = 7 * MiB + 512 * 1024;
constexpr size_t WS_SSQX1 = 17 * MiB;
constexpr size_t WS_WEIGHTS = 19 * MiB;
constexpr size_t WS_H = 80 * MiB;
constexpr size_t WS_PROJ = 144 * MiB;
constexpr size_t WS_HE = 208 * MiB;
constexpr size_t WS_Q = 256 * MiB, WS_K = 304 * MiB, WS_V = 352 * MiB;
constexpr size_t WS_MIX = 384 * MiB;
constexpr size_t WS_XBCC = 448 * MiB;
constexpr size_t WS_PB = 496 * MiB;
constexpr size_t WS_END = 512 * MiB;
constexpr int CW_BAR = 4096, CW_ECNT = 8192;

__device__ __forceinline__ unsigned f2bf(float f) { unsigned u = __builtin_bit_cast(unsigned, f); return (u + 0x7fffu + ((u >> 16) & 1u)) >> 16; }
__device__ __forceinline__ float bf2f(unsigned h) { return __builtin_bit_cast(float, h << 16); }
__device__ __forceinline__ unsigned pk2(float lo, float hi) { return f2bf(lo) | (f2bf(hi) << 16); }
__device__ __forceinline__ float wave_sum(float v) {
#pragma unroll
    for (int o = 1; o < 64; o <<= 1) v += __shfl_xor(v, o);
    return v;
}
__device__ __forceinline__ float silu_f(float v) { return v / (1.f + __expf(-v)); }

#define XB_TMO      128
#define XB_XCNT(j)  (256  + 64 * (j))
#define XB_XSUB(j)  (1280 + 64 * (j))
#define XB_XGEN(j)  (2304 + 64 * (j))
#define XB_TOP      3328
#define XB_TOPGEN   3392
#define XCD_BAR_WORDS 3456
#define XB_SPIN_CAP (1u << 22)

__device__ __forceinline__ unsigned xb_ld(unsigned* p)              { return __hip_atomic_load(p, __ATOMIC_RELAXED, __HIP_MEMORY_SCOPE_AGENT); }
__device__ __forceinline__ unsigned xb_add(unsigned* p, unsigned v) { return __hip_atomic_fetch_add(p, v, __ATOMIC_RELAXED, __HIP_MEMORY_SCOPE_AGENT); }
__device__ __forceinline__ unsigned xb_xcc_id() { return (unsigned)__builtin_amdgcn_s_getreg((3 << 11) | 20) & 0xFu; }
#define XB_SPIN(cond, bar) do { unsigned _sp = 0; while (cond) { __builtin_amdgcn_s_sleep(1); \
    if ((++_sp & 255u) == 0u) { if (xb_ld(&(bar)[XB_TMO])) break; if (_sp > XB_SPIN_CAP) { atomicAdd(&(bar)[XB_TMO], 1u); break; } } } } while (0)

struct XcdBarrier { unsigned* bar; unsigned x; volatile LAS unsigned* st; };
__device__ __forceinline__ XcdBarrier xcd_barrier_post(unsigned* bar, volatile LAS unsigned* st) {
    XcdBarrier b; b.bar = bar; b.x = xb_xcc_id(); b.st = st;
    if (threadIdx.x == 0) (void)xb_add(&bar[XB_XCNT(b.x)], 1u);
    return b;
}
__device__ __forceinline__ void xcd_barrier_complete(unsigned* bar, unsigned x, unsigned& nloc, unsigned& nx) {
    const unsigned G = gridDim.x * gridDim.y * gridDim.z;
    unsigned sum, cnt, mine, sp = 0u;
    for (;;) {
        sum = 0u; cnt = 0u; mine = 0u;
#pragma unroll
        for (unsigned j = 0; j < 16; ++j) { const unsigned c = xb_ld(&bar[XB_XCNT(j)]); sum += c; cnt += (c > 0u) ? 1u : 0u; mine = (j == x) ? c : mine; }
        if (sum == G) break;
        __builtin_amdgcn_s_sleep(1);
        if ((++sp & 255u) == 0u) { if (xb_ld(&bar[XB_TMO])) break; if (sp > XB_SPIN_CAP) { atomicAdd(&bar[XB_TMO], 1u); break; } }
    }
    nloc = mine > 0u ? mine : 1u; nx = cnt > 0u ? cnt : 1u;
}
__device__ __forceinline__ void xcd_barrier(const XcdBarrier& b) {
    asm volatile("s_waitcnt vmcnt(0)" ::: "memory");
    __syncthreads();
    if (threadIdx.x == 0) {
        unsigned* bar = b.bar;
        __builtin_amdgcn_s_waitcnt(0);
        unsigned nloc = b.st[0], nx = b.st[1];
        if (nloc == 0u) { xcd_barrier_complete(bar, b.x, nloc, nx); b.st[0] = nloc; b.st[1] = nx; }
        const unsigned old = xb_add(&bar[XB_XSUB(b.x)], 1u);
        const unsigned gen = old / nloc;
        if (old + 1u == (gen + 1u) * nloc) {
            __builtin_amdgcn_fence(__ATOMIC_RELEASE, "agent");
            asm volatile("s_waitcnt vmcnt(0)" ::: "memory");
            const unsigned og = xb_add(&bar[XB_TOP], 1u);
            const unsigned tg = og / nx;
            if (og + 1u == (tg + 1u) * nx) xb_add(&bar[XB_TOPGEN], 1u);
            else XB_SPIN(xb_ld(&bar[XB_TOPGEN]) == tg, bar);
            __builtin_amdgcn_fence(__ATOMIC_ACQUIRE, "agent");
            xb_add(&bar[XB_XGEN(b.x)], 1u);
            asm volatile("s_waitcnt vmcnt(0)" ::: "memory");
        } else {
            XB_SPIN(xb_ld(&bar[XB_XGEN(b.x)]) == gen, bar);
            __builtin_amdgcn_fence(__ATOMIC_ACQUIRE, "agent");
            asm volatile("s_waitcnt vmcnt(0)" ::: "memory");
        }
    }
    __syncthreads();
}


namespace pg8 {
typedef short bf16x8 __attribute__((ext_vector_type(8)));
constexpr int BM = 256, BK = 64, HALF = 128, HTB = HALF * BK * 2, STAGE_BYTES = 8 * HTB, NXCD = 8, WGM = 8;
__host__ __device__ __forceinline__ int lds_byte(int r, int c) { const int st = (r >> 4) * 2 + (c >> 5), rr = r & 15, cc = c & 31, ob = rr * 64 + cc * 2; return st * 1024 + (ob ^ (((ob >> 9) & 1) << 5)); }
__host__ __device__ __forceinline__ void stage_rc(int b, int& R, int& C) { const int st = b / 1024, sb = b % 1024, swz = sb ^ (((sb >> 9) & 1) << 5); R = (st >> 1) * 16 + swz / 64; C = (st & 1) * 32 + (swz % 64) / 2; }
__host__ __device__ __forceinline__ int perm32(int rho) { const int n = rho >> 4, i = rho & 15; return 8 * (i >> 2) + 4 * n + (i & 3); }
struct Unit { int pm, pn; };
struct Gemm { const bf16_t* A; const bf16_t* Bt; int M, N, K, lda, ldb; };
struct StaticOrder {
    int nM, nN, nwg, G, c;
    __host__ __device__ void init(int M, int N, int G_, int c_) { nM = M / BM; nN = N / BM; nwg = nM * nN; G = G_; c = c_; }
    __host__ __device__ bool next(int i, Unit& u) const {
        const long L = (long)i * G + c; if (L >= nwg) return false;
        int wgid = (int)L; { const int q = nwg / NXCD, r = nwg % NXCD, xcd = wgid % NXCD, off = wgid / NXCD; wgid = (xcd < r ? xcd * (q + 1) : r * (q + 1) + (xcd - r) * q) + off; }
        const int nig = WGM * nN, gid = wgid / nig, fm = gid * WGM, gsz = (nM - fm) < WGM ? (nM - fm) : WGM;
        u.pm = fm + ((wgid % nig) % gsz); u.pn = (wgid % nig) / gsz; return true;
    }
};
struct TailOrder {
    int nM, nN, nwg, G, c, first, span;
    __host__ __device__ void init(int M, int N, int G_, int c_, int first_) { nM = M / BM; nN = N / BM; nwg = nM * nN; G = G_; c = c_; first = (first_ > 0 && first_ < G_) ? first_ : 0; span = G - first; }
    __host__ __device__ bool next(int i, Unit& u) const {
        if (c < first) return false;
        const long L = (long)i * span + (c - first); if (L >= nwg) return false;
        const int wgid = (int)L;
        const int nig = WGM * nN, gid = wgid / nig, fm = gid * WGM, gsz = (nM - fm) < WGM ? (nM - fm) : WGM;
        u.pm = fm + ((wgid % nig) % gsz); u.pn = (wgid % nig) / gsz; return true;
    }
};
__device__ __forceinline__ unsigned cvt_pk_bf16(float lo, float hi) { unsigned r; asm volatile("v_cvt_pk_bf16_f32 %0, %1, %2" : "=v"(r) : "v"(lo), "v"(hi)); return r; }

template <class Epi, class Sched, bool GATHER = false>
__device__ __forceinline__ void gemm_phase(LAS unsigned char* lds, const Gemm g, const Sched& S, const Epi& E, const LAS unsigned* rowtab = nullptr) {
    int tid = threadIdx.x; asm volatile("" : "+v"(tid));
    const int wid = __builtin_amdgcn_readfirstlane(tid >> 6), lane = tid & 63, wr = wid >> 2, wc = wid & 3, fr = lane & 15, fq = lane >> 4;
    int nt = g.K / BK; asm volatile("" : "+s"(nt));
    unsigned vAc[2][2], vAn[2][2], voffB[2]; int RA[2], CA[2];
#pragma unroll
    for (int i = 0; i < 2; ++i) { int R, C; stage_rc(tid * 16 + i * 8192, R, C); const int Rb = Epi::PERM ? ((R & ~31) + perm32(R & 31)) : R; RA[i] = R; CA[i] = C;
        voffB[i] = (unsigned)(Rb * g.ldb + C) * 2u;
#pragma unroll
        for (int h = 0; h < 2; ++h) { vAc[h][i] = GATHER ? rowtab[h * HALF + R] + (unsigned)C * 2u : (unsigned)((h * HALF + R) * g.lda + C) * 2u; vAn[h][i] = vAc[h][i]; } }
    const size_t kstep = (size_t)(BK * 2);
    const size_t hstepB = (size_t)HALF * g.ldb * 2;
    const size_t tstepA = GATHER ? 0 : (size_t)BM * g.lda * 2, tstepB = 2 * hstepB;
    const unsigned ldsw = (unsigned)wid * 1024u;
    const int aoff = lds_byte(wr * 64 + fr, fq * 8), boff = lds_byte(wc * 32 + fr, fq * 8);
#define PG8_SA(b, h) (((b) * 2 + (h)) * HTB)
#define PG8_SB(b, h) ((4 + (b) * 2 + (h)) * HTB)
#define PG8_STAGE(bufoff, gbase, voff) do { _Pragma("unroll") for (int _i = 0; _i < 2; ++_i) \
        __builtin_amdgcn_global_load_lds((const unsigned*)((const char*)(gbase) + (voff)[_i]), (LAS unsigned*)(lds + (bufoff) + ldsw + _i * 8192), 16, 0, 0); } while (0)
#define PG8_LDA(dst, b, h) do { _Pragma("unroll") for (int m = 0; m < 4; ++m) _Pragma("unroll") for (int k = 0; k < 2; ++k) dst[m][k] = *(const LAS bf16x8*)(lds + PG8_SA(b, h) + aoff + m * 2048 + k * 1024); } while (0)
#define PG8_LDB(dst, b, h) do { _Pragma("unroll") for (int n = 0; n < 2; ++n) _Pragma("unroll") for (int k = 0; k < 2; ++k) dst[n][k] = *(const LAS bf16x8*)(lds + PG8_SB(b, h) + boff + n * 2048 + k * 1024); } while (0)
#define PG8_MMA(ai, bj, At, Bt) do { __builtin_amdgcn_s_setprio(1); _Pragma("unroll") for (int m = 0; m < 4; ++m) _Pragma("unroll") for (int n = 0; n < 2; ++n) _Pragma("unroll") for (int k = 0; k < 2; ++k) \
        acc[ai][bj][m][n] = __builtin_amdgcn_mfma_f32_16x16x32_bf16(Bt[n][k], At[m][k], acc[ai][bj][m][n], 0, 0, 0); __builtin_amdgcn_s_setprio(0); } while (0)
#define PG8_WAIT_V(n) asm volatile("s_waitcnt vmcnt(" #n ")" ::: "memory")
#define PG8_WAIT_L(n) asm volatile("s_waitcnt lgkmcnt(" #n ")" ::: "memory")
#define PG8_BAR __builtin_amdgcn_s_barrier()
#define PG8_SCHED __builtin_amdgcn_sched_barrier(0)
    Unit cur, nxt; int ui = 0;
    if (!S.next(0, cur)) return;
    f32x4 acc[2][2][4][2];
#pragma unroll
    for (int a = 0; a < 2; ++a)
#pragma unroll
        for (int b = 0; b < 2; ++b)
#pragma unroll
            for (int m = 0; m < 4; ++m)
#pragma unroll
                for (int n = 0; n < 2; ++n) acc[a][b][m][n] = (f32x4){0.f, 0.f, 0.f, 0.f};
    bf16x8 At[4][2], B0[2][2], B1[2][2];
    const char* cA = (const char*)g.A + (size_t)cur.pm * tstepA; const char* cB = (const char*)g.Bt + (size_t)cur.pn * tstepB;
    PG8_STAGE(PG8_SB(0, 0), cB, voffB); PG8_STAGE(PG8_SB(0, 1), cB + hstepB, voffB); PG8_STAGE(PG8_SA(0, 0), cA, vAc[0]); PG8_STAGE(PG8_SA(0, 1), cA, vAc[1]);
    if (wr == 1) PG8_BAR;
    PG8_WAIT_V(2); PG8_BAR;
    PG8_STAGE(PG8_SB(1, 0), cB + kstep, voffB); PG8_STAGE(PG8_SA(1, 0), cA + kstep, vAc[0]); PG8_STAGE(PG8_SB(1, 1), cB + hstepB + kstep, voffB);
    PG8_WAIT_V(6); PG8_BAR;
    for (;;) {
        const bool has_next = S.next(ui + 1, nxt);
        const char* nA = has_next ? (const char*)g.A + (size_t)nxt.pm * tstepA : cA; const char* nB = has_next ? (const char*)g.Bt + (size_t)nxt.pn * tstepB : cB;
        if (GATHER && has_next) {
#pragma unroll
            for (int i = 0; i < 2; ++i)
#pragma unroll
                for (int h = 0; h < 2; ++h) vAn[h][i] = rowtab[(ui + 1) * BM + h * HALF + RA[i]] + (unsigned)CA[i] * 2u;
        }
        for (int t = 0; t < nt; t += 2) {
            const bool last = (t == nt - 2);
            const char* a1 = cA + (size_t)(t + 1) * kstep;
            const char* a2 = last ? nA : cA + (size_t)(t + 2) * kstep; const char* b2 = last ? nB : cB + (size_t)(t + 2) * kstep;
            const char* a3 = a2 + kstep; const char* b3 = b2 + kstep;
            unsigned v2[2][2];
#pragma unroll
            for (int i = 0; i < 2; ++i)
#pragma unroll
                for (int h = 0; h < 2; ++h) v2[h][i] = (GATHER && last) ? vAn[h][i] : vAc[h][i];
            PG8_LDB(B0, 0, 0); PG8_LDB(B1, 0, 1); PG8_SCHED; PG8_LDA(At, 0, 0); PG8_STAGE(PG8_SA(1, 1), a1, vAc[1]);
            PG8_WAIT_V(8); PG8_WAIT_L(0); PG8_BAR; PG8_MMA(0, 0, At, B0); PG8_MMA(0, 1, At, B1); PG8_BAR; PG8_SCHED;
            PG8_LDA(At, 0, 1); PG8_STAGE(PG8_SB(0, 0), b2, voffB); PG8_STAGE(PG8_SB(0, 1), b2 + hstepB, voffB); PG8_STAGE(PG8_SA(0, 0), a2, v2[0]);
            PG8_WAIT_V(8); PG8_WAIT_L(0); PG8_BAR; PG8_MMA(1, 0, At, B0); PG8_MMA(1, 1, At, B1); PG8_BAR; PG8_SCHED;
            PG8_LDB(B0, 1, 0); PG8_LDB(B1, 1, 1); PG8_SCHED; PG8_LDA(At, 1, 0); PG8_STAGE(PG8_SA(0, 1), a2, v2[1]);
            PG8_WAIT_V(8); PG8_WAIT_L(0); PG8_BAR; PG8_MMA(0, 0, At, B0); PG8_MMA(0, 1, At, B1); PG8_BAR; PG8_SCHED;
            PG8_LDA(At, 1, 1); PG8_STAGE(PG8_SB(1, 0), b3, voffB); PG8_STAGE(PG8_SB(1, 1), b3 + hstepB, voffB); PG8_STAGE(PG8_SA(1, 0), a3, v2[0]);
            PG8_WAIT_V(8); PG8_WAIT_L(0); PG8_BAR; PG8_MMA(1, 0, At, B0); PG8_MMA(1, 1, At, B1); PG8_BAR; PG8_SCHED;
        }
        if (wr == 0) PG8_BAR;
        E(acc, cur, wr, wc, fr, fq);
        if (!has_next) break;
#pragma unroll
        for (int a = 0; a < 2; ++a)
#pragma unroll
            for (int b = 0; b < 2; ++b)
#pragma unroll
                for (int m = 0; m < 4; ++m)
#pragma unroll
                    for (int n = 0; n < 2; ++n) acc[a][b][m][n] = (f32x4){0.f, 0.f, 0.f, 0.f};
        cur = nxt; cA = nA; cB = nB; ++ui;
        if (GATHER) {
#pragma unroll
            for (int i = 0; i < 2; ++i)
#pragma unroll
                for (int h = 0; h < 2; ++h) vAc[h][i] = vAn[h][i];
        }
        if (wr == 1) PG8_BAR;
    }
    PG8_WAIT_V(0);
    PG8_BAR;
#undef PG8_SA
#undef PG8_SB
#undef PG8_STAGE
#undef PG8_LDA
#undef PG8_LDB
#undef PG8_MMA
#undef PG8_WAIT_V
#undef PG8_WAIT_L
#undef PG8_BAR
#undef PG8_SCHED
}
}

typedef f32x4 AccT[2][2][4][2];
__device__ __forceinline__ float sq4(const f32x4 v) { return (v.x * v.x + v.y * v.y) + (v.z * v.z + v.w * v.w); }
__device__ __forceinline__ u32x4 pack8(const f32x4 a, const f32x4 b) { u32x4 w; w.x = pg8::cvt_pk_bf16(a.x, a.y); w.y = pg8::cvt_pk_bf16(a.z, a.w); w.z = pg8::cvt_pk_bf16(b.x, b.y); w.w = pg8::cvt_pk_bf16(b.z, b.w); return w; }
__device__ __forceinline__ u32x2 pack4(const f32x4 a) { u32x2 w; w.x = pg8::cvt_pk_bf16(a.x, a.y); w.y = pg8::cvt_pk_bf16(a.z, a.w); return w; }

struct EpiInProj {
    static constexpr bool PERM = true;
    bf16_t* PROJ; float* DTRAW; float* SSQQ; float* SSQKV;
    __device__ __forceinline__ void operator()(const AccT& acc, const pg8::Unit& u, int wr, int wc, int fr, int fq) const {
        const int row0 = u.pm * 256 + wr * 64 + fr, col0 = u.pn * 256 + wc * 32 + 8 * fq;
#pragma unroll
        for (int ai = 0; ai < 2; ++ai)
#pragma unroll
            for (int m = 0; m < 4; ++m) {
                const int row = row0 + ai * 128 + m * 16;
                bf16_t* rowp = PROJ + (size_t)row * PROJ_N + col0;
#pragma unroll
                for (int bj = 0; bj < 2; ++bj) *(u32x4*)(rowp + bj * 128) = pack8(acc[ai][bj][m][0], acc[ai][bj][m][1]);
                if (u.pn == 0) {
                    float s = (sq4(acc[ai][0][m][0]) + sq4(acc[ai][0][m][1])) + (sq4(acc[ai][1][m][0]) + sq4(acc[ai][1][m][1]));
                    s += __shfl_xor(s, 16); s += __shfl_xor(s, 32);
                    if (fq == 0) SSQQ[row * 4 + wc] = s;
                } else if (u.pn == 1) {
                    float s = sq4(acc[ai][0][m][0]) + sq4(acc[ai][0][m][1]);
                    s += __shfl_xor(s, 16); s += __shfl_xor(s, 32);
                    if (fq == 0) SSQKV[row * 4 + wc] = s;
                    if (wc == 1 && fq < 2) { *(f32x4*)(DTRAW + row * 16 + 8 * fq) = acc[ai][1][m][0]; *(f32x4*)(DTRAW + row * 16 + 8 * fq + 4) = acc[ai][1][m][1]; }
                }
            }
    }
};
struct EpiQUp {
    static constexpr bool PERM = false;
    bf16_t* Q; const float* SSQQ; const float* COS; const float* SIN;
    __device__ __forceinline__ void operator()(const AccT& acc, const pg8::Unit& u, int wr, int wc, int fr, int fq) const {
#pragma unroll
        for (int ai = 0; ai < 2; ++ai)
#pragma unroll
            for (int m = 0; m < 4; ++m) {
                asm volatile("" ::: "memory");
                const int row = u.pm * 256 + ai * 128 + wr * 64 + m * 16 + fr, b = row / S, s = row % S;
                const f32x4 sv = *(const f32x4*)(SSQQ + row * 4);
                const float rs = 1.f / sqrtf(((sv.x + sv.y) + (sv.z + sv.w)) * (1.f / 256.f) + EPS);
                const f32x4 cs = *(const f32x4*)(COS + row * 16 + 4 * fq), sn = *(const f32x4*)(SIN + row * 16 + 4 * fq);
#pragma unroll
                for (int bj = 0; bj < 2; ++bj) {
                    const int g32 = 8 * u.pn + 4 * bj + wc, h = g32 / 3, part = g32 % 3;
                    f32x4 v0 = acc[ai][bj][m][0] * rs, v1 = acc[ai][bj][m][1] * rs;
                    if (part == 2) { const f32x4 o0 = v0 * cs - v1 * sn, o1 = v1 * cs + v0 * sn; v0 = o0; v1 = o1; }
                    bf16_t* qp = Q + ((size_t)(b * NH + h) * S + s) * DQK + part * 32 + 4 * fq;
                    *(u32x2*)qp = pack4(v0); *(u32x2*)(qp + 16) = pack4(v1);
                }
            }
    }
};
struct EpiKVUp {
    static constexpr bool PERM = true;
    bf16_t* Kb; bf16_t* Vb; const float* SSQKV;
    __device__ __forceinline__ void operator()(const AccT& acc, const pg8::Unit& u, int wr, int wc, int fr, int fq) const {
#pragma unroll
        for (int ai = 0; ai < 2; ++ai)
#pragma unroll
            for (int m = 0; m < 4; ++m) {
                asm volatile("" ::: "memory");
                const int row = u.pm * 256 + ai * 128 + wr * 64 + m * 16 + fr, b = row / S, s = row % S;
                const f32x4 sv = *(const f32x4*)(SSQKV + row * 4);
                const float rs = 1.f / sqrtf(((sv.x + sv.y) + (sv.z + sv.w)) * (1.f / 128.f) + EPS);
#pragma unroll
                for (int bj = 0; bj < 2; ++bj) {
                    const int h = 2 * u.pn + bj; const size_t tile = (size_t)(b * NH + h) * (S / 64) + (s >> 6);
                    const u32x4 w = pack8(acc[ai][bj][m][0] * rs, acc[ai][bj][m][1] * rs);
                    if (wc < 2) *(u32x4*)(Kb + (tile * 12 + 4 * wc + fq) * 512 + (s & 63) * 8) = w;
                    else *(u32x4*)(Vb + (tile * 16 + (wc - 2) * 8 + ((s & 63) >> 3)) * 256 + (s & 7) * 32 + 8 * fq) = w;
                }
            }
    }
};
struct EpiResid {
    static constexpr bool PERM = true;
    const float* base; bf16_t* X1; float* SSQ;
    __device__ __forceinline__ void operator()(const AccT& acc, const pg8::Unit& u, int wr, int wc, int fr, int fq) const {
#pragma unroll
        for (int ai = 0; ai < 2; ++ai)
#pragma unroll
            for (int m = 0; m < 4; ++m) {
                asm volatile("" ::: "memory");
                const int row = u.pm * 256 + ai * 128 + wr * 64 + m * 16 + fr;
                const size_t ro = (size_t)row * D + u.pn * 256 + wc * 32 + 8 * fq;
                float s = 0.f;
#pragma unroll
                for (int bj = 0; bj < 2; ++bj) { const size_t o = ro + bj * 128;
                    const f32x4 v0 = *(const f32x4*)(base + o) + acc[ai][bj][m][0], v1 = *(const f32x4*)(base + o + 4) + acc[ai][bj][m][1];
                    *(u32x4*)(X1 + o) = pack8(v0, v1); s += sq4(v0) + sq4(v1); }
                s += __shfl_xor(s, 16); s += __shfl_xor(s, 32);
                if (fq == 0) SSQ[row * 16 + u.pn * 4 + wc] = s;
            }
    }
};
struct EpiPleProj {
    static constexpr bool PERM = true;
    bf16_t* O; float* SSQ;
    __device__ __forceinline__ void operator()(const AccT& acc, const pg8::Unit& u, int wr, int wc, int fr, int fq) const {
#pragma unroll
        for (int ai = 0; ai < 2; ++ai)
#pragma unroll
            for (int m = 0; m < 4; ++m) {
                const int row = u.pm * 256 + ai * 128 + wr * 64 + m * 16 + fr;
                bf16_t* rowp = O + (size_t)row * D + u.pn * 256 + wc * 32 + 8 * fq;
#pragma unroll
                for (int bj = 0; bj < 2; ++bj) *(u32x4*)(rowp + bj * 128) = pack8(acc[ai][bj][m][0], acc[ai][bj][m][1]);
                float s = (sq4(acc[ai][0][m][0]) + sq4(acc[ai][0][m][1])) + (sq4(acc[ai][1][m][0]) + sq4(acc[ai][1][m][1]));
                s += __shfl_xor(s, 16); s += __shfl_xor(s, 32);
                if (fq == 0) SSQ[row * 16 + u.pn * 4 + wc] = s;
            }
    }
};
struct EpiPleGate {
    static constexpr bool PERM = true;
    bf16_t* G; const bf16_t* PR; const float* SSQ; const float* bias; const float* wpost;
    __device__ __forceinline__ void operator()(const AccT& acc, const pg8::Unit& u, int wr, int wc, int fr, int fq) const {
#pragma unroll
        for (int ai = 0; ai < 2; ++ai)
#pragma unroll
            for (int m = 0; m < 4; ++m) {
                asm volatile("" ::: "memory");
                const int row = u.pm * 256 + ai * 128 + wr * 64 + m * 16 + fr;
                float ss = 0.f;
#pragma unroll
                for (int q = 0; q < 4; ++q) { const f32x4 sv = *(const f32x4*)(SSQ + row * 16 + 4 * q); ss += (sv.x + sv.y) + (sv.z + sv.w); }
                const float rs = 1.f / sqrtf(ss * (1.f / D) + EPS);
#pragma unroll
                for (int bj = 0; bj < 2; ++bj) {
                    const int col = u.pn * 256 + bj * 128 + wc * 32 + 8 * fq;
                    const u32x4 pr = *(const u32x4*)(PR + (size_t)row * D + col);
                    const unsigned pw[4] = {pr.x, pr.y, pr.z, pr.w};
                    f32x4 o[2];
#pragma unroll
                    for (int n = 0; n < 2; ++n) {
                        const f32x4 bv = *(const f32x4*)(bias + col + 4 * n), wv = *(const f32x4*)(wpost + col + 4 * n);
                        const f32x4 av = acc[ai][bj][m][n] + bv;
                        const f32x4 pl = (f32x4){bf2f(pw[2 * n] & 0xffffu), bf2f(pw[2 * n] >> 16), bf2f(pw[2 * n + 1] & 0xffffu), bf2f(pw[2 * n + 1] >> 16)} * rs * wv;
#pragma unroll
                        for (int j = 0; j < 4; ++j) o[n][j] = pl[j] / (1.f + __expf(-av[j]));
                    }
                    *(u32x4*)(G + (size_t)row * D + col) = pack8(o[0], o[1]);
                }
            }
    }
};

struct GroupSched {
    const volatile LAS unsigned* ptile; int npn, G, c;
    __device__ __forceinline__ bool next(int i, pg8::Unit& u) const {
        const int L = i * G + c, total = (int)ptile[32] * npn; if (L >= total) return false;
        int e = 0;
        for (int q = 1; q < 32; ++q) e = (L >= (int)ptile[q] * npn) ? q : e;
        const int l = L - (int)ptile[e] * npn;
        u.pm = __builtin_amdgcn_readfirstlane((int)ptile[e] + l / npn); u.pn = __builtin_amdgcn_readfirstlane(e * npn + l % npn); return true;
    }
};
struct EpiMoeGU {
    static constexpr bool PERM = true;
    bf16_t* HE;
    __device__ __forceinline__ void operator()(const AccT& acc, const pg8::Unit& u, int wr, int wc, int fr, int fq) const {
        const int pn_l = u.pn & 1;
#pragma unroll
        for (int ai = 0; ai < 2; ++ai)
#pragma unroll
            for (int m = 0; m < 4; ++m) {
                const size_t row = (size_t)u.pm * 256 + ai * 128 + wr * 64 + m * 16 + fr;
                f32x4 h0, h1;
#pragma unroll
                for (int j = 0; j < 4; ++j) { const float g0 = acc[ai][0][m][0][j], g1 = acc[ai][0][m][1][j];
                    h0[j] = g0 / (1.f + __expf(-g0)) * acc[ai][1][m][0][j]; h1[j] = g1 / (1.f + __expf(-g1)) * acc[ai][1][m][1][j]; }
                *(u32x4*)(HE + row * 256 + pn_l * 128 + wc * 32 + 8 * fq) = pack8(h0, h1);
            }
    }
};
struct EpiMoeDown {
    static constexpr bool PERM = true;
    bf16_t* Y; const int* BUCKET; const float* ROUTE; const volatile LAS unsigned* ptile; const volatile LAS unsigned* cnt;
    __device__ __forceinline__ void operator()(const AccT& acc, const pg8::Unit& u, int wr, int wc, int fr, int fq) const {
        const int e = u.pn >> 2, pn_l = u.pn & 3, pm_l = u.pm - (int)ptile[e], n_e = (int)cnt[e];
#pragma unroll
        for (int ai = 0; ai < 2; ++ai)
#pragma unroll
            for (int m = 0; m < 4; ++m) {
                const int idx = pm_l * 256 + ai * 128 + wr * 64 + m * 16 + fr;
                if (idx < n_e) {
                    const int ent = BUCKET[(size_t)e * T + idx];
                    const float w = ROUTE[(ent >> 1) * 4 + 2 + (ent & 1)];
                    bf16_t* yp = Y + (size_t)ent * D + pn_l * 256 + wc * 32 + 8 * fq;
#pragma unroll
                    for (int bj = 0; bj < 2; ++bj) *(u32x4*)(yp + bj * 128) = pack8(acc[ai][bj][m][0] * w, acc[ai][bj][m][1] * w);
                }
            }
    }
};

template <class CM, class GN>
__device__ __forceinline__ void transpose_item(const float* W, int ldw, int K, bf16_t* WT, float* scr, int kb, int nb, int lane, CM cm, GN gain) {
    const int k0 = 64 * kb, n0 = 32 * nb;
    const int sc = cm(n0 + (lane & 31));
    float tv[32];
#pragma unroll
    for (int i = 0; i < 32; ++i) { const int kk = 2 * i + (lane >> 5); tv[i] = sc >= 0 ? W[(size_t)(k0 + kk) * ldw + sc] : 0.f; }
#pragma unroll
    for (int i = 0; i < 32; ++i) { const int kk = 2 * i + (lane >> 5); scr[kk * 33 + (lane & 31)] = tv[i] * gain(k0 + kk); }
    asm volatile("s_waitcnt lgkmcnt(0)" ::: "memory");
    const int c = lane & 7;
#pragma unroll
    for (int j = 0; j < 4; ++j) { const int n = (lane >> 3) + 8 * j; const float* s = scr + (8 * c) * 33 + n;
        u32x4 o; o.x = pk2(s[0 * 33], s[1 * 33]); o.y = pk2(s[2 * 33], s[3 * 33]); o.z = pk2(s[4 * 33], s[5 * 33]); o.w = pk2(s[6 * 33], s[7 * 33]);
        *(u32x4*)(WT + (size_t)(n0 + n) * K + k0 + 8 * c) = o; }
    asm volatile("s_waitcnt lgkmcnt(0)" ::: "memory");
}


namespace att {
typedef short bf16x8 __attribute__((ext_vector_type(8)));
typedef short s16x4 __attribute__((ext_vector_type(4)));
typedef float f32x16 __attribute__((ext_vector_type(16)));
typedef short v4i16_t __attribute__((ext_vector_type(4)));
typedef float f32x2_t __attribute__((ext_vector_type(2))); typedef __bf16 bf16x2_t __attribute__((ext_vector_type(2)));
constexpr int KT = 64, NT = S / KT, KBYTES = KT * DQK * 2, VBYTES = KT * DV * 2, STAGE = KBYTES + VBYTES;
__device__ __forceinline__ unsigned cvtpk(float lo, float hi) { f32x2_t v = {lo, hi}; bf16x2_t b = __builtin_convertvector(v, bf16x2_t); return __builtin_bit_cast(unsigned, b); }
__device__ __forceinline__ s16x4 vtr(const LAS unsigned char* p) { return __builtin_bit_cast(s16x4, __builtin_amdgcn_ds_read_tr16_b64_v4i16((LAS v4i16_t*)p)); }
__device__ __forceinline__ float half_max(float m) { auto rr = __builtin_amdgcn_permlane32_swap(__float_as_uint(m), __float_as_uint(m), false, false); return fmaxf(__uint_as_float(rr[0]), __uint_as_float(rr[1])); }
__device__ __forceinline__ float half_sum(float m) { auto rr = __builtin_amdgcn_permlane32_swap(__float_as_uint(m), __float_as_uint(m), false, false); return __uint_as_float(rr[0]) + __uint_as_float(rr[1]); }

constexpr int KRING = 0, VRING = 4 * KBYTES, ATT_THR = 8;
__device__ __forceinline__ void attn_unit(LAS unsigned char* lds, const bf16_t* Qg, const bf16_t* Kg, const bf16_t* Vg, bf16_t* MIXg, int bh, int qb) {
    int tid = threadIdx.x; asm volatile("" : "+v"(tid));
    const int lane = tid & 63, wid = __builtin_amdgcn_readfirstlane(tid >> 6), r32 = lane & 31, hi = lane >> 5;
    const size_t rowbase = (size_t)bh * S;
    const bf16_t* qrow = Qg + (rowbase + qb * 256 + wid * 32 + r32) * DQK + 8 * hi;
    bf16x8 qf[6];
#pragma unroll
    for (int ds = 0; ds < 6; ++ds) qf[ds] = *(const bf16x8*)(qrow + ds * 16);
    const char* ksrc0 = (const char*)(Kg + rowbase * DQK) + wid * 1024 + lane * 16;
    const char* ksrc1 = ksrc0 + 8 * 1024;
    const char* vsrc = (const char*)(Vg + rowbase * DV) + wid * 1024 + lane * 16;
#define ATT_DMA_K(t, slot) do { \
        __builtin_amdgcn_global_load_lds((const unsigned*)(ksrc0 + (size_t)(t) * (KT * DQK * 2)), (LAS unsigned*)(lds + KRING + (slot) * KBYTES + wid * 1024), 16, 0, 0); \
        if (wid < 4) __builtin_amdgcn_global_load_lds((const unsigned*)(ksrc1 + (size_t)(t) * (KT * DQK * 2)), (LAS unsigned*)(lds + KRING + (slot) * KBYTES + (wid + 8) * 1024), 16, 0, 0); } while (0)
#define ATT_DMA_V(t, slot) __builtin_amdgcn_global_load_lds((const unsigned*)(vsrc + (size_t)(t) * (KT * DV * 2)), (LAS unsigned*)(lds + VRING + (slot) * VBYTES + wid * 1024), 16, 0, 0)
#define ATT_SYNC() do { asm volatile("s_waitcnt vmcnt(0) lgkmcnt(0)" ::: "memory"); __builtin_amdgcn_s_barrier(); __builtin_amdgcn_sched_barrier(0); } while (0)
#define ATT_SYNCN(tau) do { if ((tau) + 2 < NT) { if (g0) asm volatile("s_waitcnt vmcnt(3) lgkmcnt(0)" ::: "memory"); else asm volatile("s_waitcnt vmcnt(2) lgkmcnt(0)" ::: "memory"); } \
        else asm volatile("s_waitcnt vmcnt(0) lgkmcnt(0)" ::: "memory"); __builtin_amdgcn_s_barrier(); __builtin_amdgcn_sched_barrier(0); } while (0)
    const int koff = KRING + hi * 1024 + r32 * 16;
    const int voff = VRING + (4 * hi + ((lane & 15) >> 2)) * 64 + ((lane >> 4) & 1) * 32 + (lane & 3) * 8;
    f32x16 o0 = {}, o1 = {}, negm = {};
    float mref = 0.f, lpart = 0.f;
    f32x16 sA0, sA1, sB0, sB1;
    u32x4 pw[4];
    bf16x8 kf[12], vf[8];
#define ATT_SB() __builtin_amdgcn_sched_barrier(0)
#define ATT_LOADK(kslot) do { const LAS unsigned char* kb_ = lds + koff + (kslot) * KBYTES; \
        _Pragma("unroll") for (int ds = 0; ds < 6; ++ds) { kf[2 * ds] = *(const LAS bf16x8*)(kb_ + ds * 2048); kf[2 * ds + 1] = *(const LAS bf16x8*)(kb_ + ds * 2048 + 512); } } while (0)
#define ATT_LOADV(vslot) do { const LAS unsigned char* vb_ = lds + voff + (vslot) * VBYTES; \
        _Pragma("unroll") for (int ks = 0; ks < 4; ++ks) { \
            const s16x4 a0_ = vtr(vb_ + (2 * ks) * 512), a1_ = vtr(vb_ + (2 * ks + 1) * 512), b0_ = vtr(vb_ + (8 + 2 * ks) * 512), b1_ = vtr(vb_ + (8 + 2 * ks + 1) * 512); \
            vf[2 * ks] = (bf16x8){a0_[0], a0_[1], a0_[2], a0_[3], a1_[0], a1_[1], a1_[2], a1_[3]}; \
            vf[2 * ks + 1] = (bf16x8){b0_[0], b0_[1], b0_[2], b0_[3], b1_[0], b1_[1], b1_[2], b1_[3]}; } } while (0)
#define ATT_QK(X0, X1) do { \
        X0 = __builtin_amdgcn_mfma_f32_32x32x16_bf16(kf[0], qf[0], negm, 0, 0, 0); X1 = __builtin_amdgcn_mfma_f32_32x32x16_bf16(kf[1], qf[0], negm, 0, 0, 0); \
        _Pragma("unroll") for (int ds = 1; ds < 6; ++ds) { X0 = __builtin_amdgcn_mfma_f32_32x32x16_bf16(kf[2 * ds], qf[ds], X0, 0, 0, 0); X1 = __builtin_amdgcn_mfma_f32_32x32x16_bf16(kf[2 * ds + 1], qf[ds], X1, 0, 0, 0); } } while (0)
#define ATT_PV() do { \
        _Pragma("unroll") for (int ks = 0; ks < 4; ++ks) { const bf16x8 pf_ = __builtin_bit_cast(bf16x8, pw[ks]); \
            o0 = __builtin_amdgcn_mfma_f32_32x32x16_bf16(vf[2 * ks], pf_, o0, 0, 0, 0); o1 = __builtin_amdgcn_mfma_f32_32x32x16_bf16(vf[2 * ks + 1], pf_, o1, 0, 0, 0); } } while (0)
#define ATT_MAXPHASE(X0, X1, FIRST) do { \
        float mx_ = fmaxf(fmaxf(X0[0], X0[1]), X1[0]); float my_ = fmaxf(fmaxf(X0[2], X0[3]), X1[1]); mx_ = fmaxf(fmaxf(mx_, X1[2]), X1[3]); \
        _Pragma("unroll") for (int r = 4; r < 16; r += 4) { mx_ = fmaxf(fmaxf(mx_, X0[r]), X0[r + 1]); my_ = fmaxf(fmaxf(my_, X0[r + 2]), X0[r + 3]); mx_ = fmaxf(fmaxf(mx_, X1[r]), X1[r + 1]); my_ = fmaxf(fmaxf(my_, X1[r + 2]), X1[r + 3]); } \
        mx_ = half_max(fmaxf(mx_, my_)); \
        if ((FIRST) || __builtin_expect(__any(mx_ > (float)ATT_THR), 0)) { \
            asm volatile("; rescale (rare)" ::: "memory"); const float dl_ = (FIRST) ? mx_ : fmaxf(mx_, 0.f); mref += dl_; const float f_ = (FIRST) ? 1.f : __builtin_amdgcn_exp2f(-dl_); \
            _Pragma("unroll") for (int r = 0; r < 16; ++r) { X0[r] -= dl_; X1[r] -= dl_; o0[r] *= f_; o1[r] *= f_; negm[r] = -mref; } \
            lpart *= f_; asm volatile("" : "+v"(negm)); } } while (0)
#define ATT_EXPPHASE(X0, X1) do { float ls_ = 0.f; \
        _Pragma("unroll") for (int r = 0; r < 16; ++r) { X0[r] = __builtin_amdgcn_exp2f(X0[r]); X1[r] = __builtin_amdgcn_exp2f(X1[r]); ls_ += X0[r] + X1[r]; } \
        lpart += ls_; \
        _Pragma("unroll") for (int s = 0; s < 2; ++s) { \
            pw[s] = (u32x4){cvtpk(X0[8 * s], X0[8 * s + 1]), cvtpk(X0[8 * s + 2], X0[8 * s + 3]), cvtpk(X0[8 * s + 4], X0[8 * s + 5]), cvtpk(X0[8 * s + 6], X0[8 * s + 7])}; \
            pw[2 + s] = (u32x4){cvtpk(X1[8 * s], X1[8 * s + 1]), cvtpk(X1[8 * s + 2], X1[8 * s + 3]), cvtpk(X1[8 * s + 4], X1[8 * s + 5]), cvtpk(X1[8 * s + 6], X1[8 * s + 7])}; } } while (0)
#define ATT_ISSUE(t) do { if ((t) + 3 < NT) ATT_DMA_K((t) + 3, ((t) + 3) & 3); if ((t) + 2 < NT) ATT_DMA_V((t) + 2, ((t) + 2) & 3); } while (0)

    const bool g0 = wid < 4;
#define ATT_X(C0, C1, t) do { ATT_LOADV(((t) - 1) & 3); ATT_SB(); ATT_PV(); ATT_SB(); ATT_MAXPHASE(C0, C1, false); ATT_SB(); } while (0)
#define ATT_Y(C0, C1, N0, N1, t) do { ATT_LOADK(((t) + 1) & 3); ATT_SB(); ATT_EXPPHASE(C0, C1); ATT_SB(); ATT_QK(N0, N1); ATT_SB(); } while (0)
    ATT_DMA_K(0, 0); ATT_DMA_V(0, 0); ATT_DMA_K(1, 1);
    ATT_SYNC();
    ATT_DMA_K(2, 2); ATT_DMA_V(1, 1);
    ATT_LOADK(0); ATT_QK(sA0, sA1);
    ATT_SYNC();
    ATT_ISSUE(0);
    ATT_MAXPHASE(sA0, sA1, true);
    if (!g0) { ATT_SYNCN(1); ATT_ISSUE(1); }
    ATT_Y(sA0, sA1, sB0, sB1, 0);
    for (int t = 1; t + 2 < NT; t += 2) {
        if (g0) { ATT_SYNCN(t); ATT_ISSUE(t); }
        ATT_X(sB0, sB1, t);
        if (!g0) { ATT_SYNCN(t + 1); ATT_ISSUE(t + 1); }
        ATT_Y(sB0, sB1, sA0, sA1, t);
        if (g0) { ATT_SYNCN(t + 1); ATT_ISSUE(t + 1); }
        ATT_X(sA0, sA1, t + 1);
        if (!g0) { ATT_SYNCN(t + 2); ATT_ISSUE(t + 2); }
        ATT_Y(sA0, sA1, sB0, sB1, t + 1);
    }
    if (g0) { ATT_SYNCN(NT - 1); }
    ATT_X(sB0, sB1, NT - 1);
    ATT_EXPPHASE(sB0, sB1);
    ATT_LOADV((NT - 1) & 3); ATT_PV();
#undef ATT_X
#undef ATT_Y
    const float rl = 1.f / half_sum(lpart);
    const int b = bh >> 3, h = bh & 7;
    bf16_t* orow = MIXg + ((size_t)b * S + qb * 256 + wid * 32 + r32) * D + h * 64 + 4 * hi;
#pragma unroll
    for (int g4 = 0; g4 < 4; ++g4) {
        u32x2 w0, w1;
        w0.x = cvtpk(o0[4 * g4] * rl, o0[4 * g4 + 1] * rl); w0.y = cvtpk(o0[4 * g4 + 2] * rl, o0[4 * g4 + 3] * rl);
        w1.x = cvtpk(o1[4 * g4] * rl, o1[4 * g4 + 1] * rl); w1.y = cvtpk(o1[4 * g4 + 2] * rl, o1[4 * g4 + 3] * rl);
        *(u32x2*)(orow + 8 * g4) = w0; *(u32x2*)(orow + 32 + 8 * g4) = w1;
    }
    asm volatile("s_waitcnt lgkmcnt(0)" ::: "memory"); __builtin_amdgcn_s_barrier();
#undef ATT_DMA_K
#undef ATT_DMA_V
#undef ATT_SYNC
#undef ATT_QK
#undef ATT_PV
#undef ATT_MAXPHASE
#undef ATT_EXPPHASE
#undef ATT_SYNCN
#undef ATT_LOADK
#undef ATT_LOADV
#undef ATT_SB
#undef ATT_ISSUE
}
}


namespace ssd {
typedef short bf16x8 __attribute__((ext_vector_type(8)));
typedef short bf16x4 __attribute__((ext_vector_type(4)));
typedef float f32x16 __attribute__((ext_vector_type(16)));
constexpr int CH = 128, NCH = S / CH;
constexpr float LOG2E = 1.4426950408889634f;
__device__ __forceinline__ int crow(int r, int hi) { return (r & 3) + 8 * (r >> 2) + 4 * hi; }
__device__ __forceinline__ unsigned cvtpk(float lo, float hi) { return att::cvtpk(lo, hi); }
__device__ __forceinline__ void scan128(float a0, float a1, int lane, float& p0, float& p1, float& tot) {
    float s = a0 + a1;
#pragma unroll
    for (int o = 1; o < 64; o <<= 1) { const float t = __shfl_up(s, o); if (lane >= o) s += t; }
    tot = __shfl(s, 63); p1 = s; p0 = s - a1;
}
__device__ __forceinline__ void conv_chunk(float* smf, const bf16_t* PROJ, const float* cw, const float* cb, bf16_t* XBCC, bf16_t* XT, bf16_t* BT,
                                           const float* DTRAW, const float* dtb, float* DT, int b, int c) {
    int tid = threadIdx.x; asm volatile("" : "+v"(tid));
    const int t0 = b * S + c * CH, s0 = c * CH;
    if (tid < 2048 / 4) {
        const f32x4 raw = *(const f32x4*)(DTRAW + (size_t)t0 * 16 + tid * 4); const f32x4 bb = *(const f32x4*)(dtb + ((tid * 4) & 15)); f32x4 o;
#pragma unroll
        for (int j = 0; j < 4; ++j) { const float v = raw[j] + bb[j]; o[j] = v > 20.f ? v : log1pf(expf(v)); }
        *(f32x4*)(DT + (size_t)t0 * 16 + tid * 4) = o;
    }
    const int ch = tid & 127, lq = tid >> 7;
    for (int cbk = 0; cbk < 6; ++cbk) {
        __syncthreads();
        {
            u32x4 v[5];
#pragma unroll
            for (int q = 0; q < 5; ++q) { const int i = tid + q * 512, r = i >> 4, c8 = (i & 15) * 8, ss = s0 - 2 + r;
                v[q] = (u32x4){0u, 0u, 0u, 0u};
                if (i < 132 * 16 && ss >= 0 && ss < S) v[q] = *(const u32x4*)(PROJ + (size_t)(b * S + ss) * PROJ_N + PC_XBC + cbk * 128 + c8); }
#pragma unroll
            for (int q = 0; q < 5; ++q) { const int i = tid + q * 512, r = i >> 4, c8 = (i & 15) * 8;
                if (i < 132 * 16) { float* d = smf + r * 128 + c8;
                    d[0] = bf2f(v[q].x & 0xffffu); d[1] = bf2f(v[q].x >> 16); d[2] = bf2f(v[q].y & 0xffffu); d[3] = bf2f(v[q].y >> 16);
                    d[4] = bf2f(v[q].z & 0xffffu); d[5] = bf2f(v[q].z >> 16); d[6] = bf2f(v[q].w & 0xffffu); d[7] = bf2f(v[q].w >> 16); } }
        }
        __syncthreads();
        const int gch = cbk * 128 + ch;
        float w[5];
#pragma unroll
        for (int k = 0; k < 5; ++k) w[k] = cw[k * XBC + gch];
        const float bias = cb[gch];
        unsigned pk[16];
        float x0 = smf[(lq * 32 + 0) * 128 + ch], x1 = smf[(lq * 32 + 1) * 128 + ch], x2 = smf[(lq * 32 + 2) * 128 + ch], x3 = smf[(lq * 32 + 3) * 128 + ch];
        float prev = 0.f;
#pragma unroll
        for (int l = 0; l < 32; ++l) {
            const float x4 = smf[(lq * 32 + l + 4) * 128 + ch];
            const float acc = bias + w[0] * x0 + w[1] * x1 + w[2] * x2 + w[3] * x3 + w[4] * x4;
            const float v = acc / (1.f + __expf(-acc));
            XBCC[(size_t)(t0 + lq * 32 + l) * XBC + gch] = (bf16_t)f2bf(v);
            if (l & 1) pk[l >> 1] = pk2(prev, v); else prev = v;
            x0 = x1; x1 = x2; x2 = x3; x3 = x4;
        }
        if (cbk < 5) {
            bf16_t* dst = cbk < 4 ? XT + ((size_t)(b * NCH + c) * 512 + gch) * CH + lq * 32 : BT + ((size_t)(b * NCH + c) * 128 + ch) * CH + lq * 32;
#pragma unroll
            for (int q = 0; q < 4; ++q) *(u32x4*)(dst + q * 8) = (u32x4){pk[4 * q], pk[4 * q + 1], pk[4 * q + 2], pk[4 * q + 3]};
        }
    }
    __syncthreads();
}
__device__ __forceinline__ void states_chunk(float* wtab_all, const bf16_t* XT, const bf16_t* BT, const float* DT, const float* alog, float* STATES, float* CDEC, int b, int c) {
    int tid = threadIdx.x; asm volatile("" : "+v"(tid));
    const int lane = tid & 63, hd = __builtin_amdgcn_readfirstlane(tid >> 6), g = hd >> 2, r32 = lane & 31, hi = lane >> 5;
    float* wtab = wtab_all + hd * 128;
    const size_t t0 = (size_t)b * S + c * CH;
    const bf16_t* xt = XT + ((size_t)(b * NCH + c) * 512 + hd * 64) * CH; const bf16_t* bt = BT + ((size_t)(b * NCH + c) * 128 + g * 64) * CH;
    for (int dir = 0; dir < 2; ++dir) {
        const float av = -expf(alog[dir * 8 + hd]);
        const float d0 = DT[(t0 + 2 * lane) * 16 + dir * 8 + hd], d1 = DT[(t0 + 2 * lane + 1) * 16 + dir * 8 + hd];
        float p0, p1, tot; scan128(d0 * av, d1 * av, lane, p0, p1, tot);
        const float w0 = dir == 0 ? __expf(tot - p0) * d0 : __expf(p0 - d0 * av) * d0;
        const float w1 = dir == 0 ? __expf(tot - p1) * d1 : __expf(p1 - d1 * av) * d1;
        wtab[2 * lane] = w0; wtab[2 * lane + 1] = w1;
        if (lane == 0) CDEC[((b * NCH + c) * 2 + dir) * 8 + hd] = __expf(tot);
        asm volatile("s_waitcnt lgkmcnt(0)" ::: "memory");
        f32x16 acc[2][2];
#pragma unroll
        for (int i = 0; i < 2; ++i)
#pragma unroll
            for (int j = 0; j < 2; ++j) acc[i][j] = (f32x16){};
#pragma unroll 4
        for (int ks = 0; ks < 8; ++ks) {
            const f32x4 wa = *(const f32x4*)(wtab + 16 * ks + 8 * hi), wb = *(const f32x4*)(wtab + 16 * ks + 8 * hi + 4);
            bf16x8 xb[2], bb[2];
#pragma unroll
            for (int pb = 0; pb < 2; ++pb) {
                const u32x4 v = *(const u32x4*)(xt + (size_t)(32 * pb + r32) * CH + 16 * ks + 8 * hi);
                u32x4 o; o.x = cvtpk(bf2f(v.x & 0xffffu) * wa.x, bf2f(v.x >> 16) * wa.y); o.y = cvtpk(bf2f(v.y & 0xffffu) * wa.z, bf2f(v.y >> 16) * wa.w);
                o.z = cvtpk(bf2f(v.z & 0xffffu) * wb.x, bf2f(v.z >> 16) * wb.y); o.w = cvtpk(bf2f(v.w & 0xffffu) * wb.z, bf2f(v.w >> 16) * wb.w);
                xb[pb] = __builtin_bit_cast(bf16x8, o);
            }
#pragma unroll
            for (int nb = 0; nb < 2; ++nb) bb[nb] = *(const bf16x8*)(bt + (size_t)(32 * nb + r32) * CH + 16 * ks + 8 * hi);
#pragma unroll
            for (int nb = 0; nb < 2; ++nb)
#pragma unroll
                for (int pb = 0; pb < 2; ++pb) acc[nb][pb] = __builtin_amdgcn_mfma_f32_32x32x16_bf16(bb[nb], xb[pb], acc[nb][pb], 0, 0, 0);
        }
        float* st = STATES + ((size_t)((b * NCH + c) * 2 + dir) * 8 + hd) * 4096;
#pragma unroll
        for (int nb = 0; nb < 2; ++nb)
#pragma unroll
            for (int pb = 0; pb < 2; ++pb)
#pragma unroll
                for (int q = 0; q < 4; ++q)
                    *(f32x4*)(st + (32 * pb + r32) * 64 + 32 * nb + 8 * q + 4 * hi) = (f32x4){acc[nb][pb][4 * q], acc[nb][pb][4 * q + 1], acc[nb][pb][4 * q + 2], acc[nb][pb][4 * q + 3]};
    }
}
__device__ __forceinline__ void finalize_chunk(float* smf, const bf16_t* XBCC, const bf16_t* XT, const bf16_t* PROJ, const float* DT, const float* alog, const bf16_t* HPB,
                                               const float* ssdd, const float* ssdnw, bf16_t* MIX, int b, int c) {
    int tid = threadIdx.x; asm volatile("" : "+v"(tid));
    const int lane = tid & 63, hd = __builtin_amdgcn_readfirstlane(tid >> 6), g = hd >> 2, r32 = lane & 31, hi = lane >> 5;
    f32x4* tab = (f32x4*)smf + hd * 128;
    float* red = smf + 8 * 128 * 4;
    const size_t t0 = (size_t)b * S + c * CH;
    {
        const float af = -expf(alog[hd]), ab = -expf(alog[8 + hd]);
        const float f0 = DT[(t0 + 2 * lane) * 16 + hd], f1 = DT[(t0 + 2 * lane + 1) * 16 + hd];
        const float b0 = DT[(t0 + 2 * lane) * 16 + 8 + hd], b1 = DT[(t0 + 2 * lane + 1) * 16 + 8 + hd];
        float pf0, pf1, tf, pb0, pb1, tb;
        scan128(f0 * af, f1 * af, lane, pf0, pf1, tf); scan128(b0 * ab, b1 * ab, lane, pb0, pb1, tb);
        tab[2 * lane] = (f32x4){pf0, f0, tb - (pb0 - b0 * ab), b0}; tab[2 * lane + 1] = (f32x4){pf1, f1, tb - (pb1 - b1 * ab), b1};
        asm volatile("s_waitcnt lgkmcnt(0)" ::: "memory");
    }
    const bf16_t* xt = XT + ((size_t)(b * NCH + c) * 512 + hd * 64) * CH + (size_t)r32 * CH + 4 * hi;
    const bf16_t* brow = XBCC + (t0 + r32) * XBC + 512 + g * 64 + 8 * hi;
    const bf16_t* hpb = HPB + ((size_t)((b * NCH + c) * 2) * 8 + hd) * 4096 + (size_t)r32 * 64 + 8 * hi;
    const float dsk = ssdd[hd];
#define FIN_LOADB(dst, jb) do { _Pragma("unroll") for (int ks = 0; ks < 4; ++ks) dst[ks] = *(const bf16x8*)(brow + (size_t)(jb) * 32 * XBC + 16 * ks); } while (0)
#define FIN_LOADX(dst, jb) do { _Pragma("unroll") for (int s = 0; s < 2; ++s) _Pragma("unroll") for (int pb = 0; pb < 2; ++pb) { \
        const bf16_t* xp_ = xt + (size_t)pb * 32 * CH + 32 * (jb) + 16 * s; const u32x2 lo_ = *(const u32x2*)xp_, hi_ = *(const u32x2*)(xp_ + 8); \
        dst[2 * s + pb] = __builtin_bit_cast(bf16x8, (u32x4){lo_.x, lo_.y, hi_.x, hi_.y}); } } while (0)
#define FIN_LOADH(dst, dir) do { _Pragma("unroll") for (int ks = 0; ks < 4; ++ks) _Pragma("unroll") for (int pb = 0; pb < 2; ++pb) \
        dst[2 * ks + pb] = *(const bf16x8*)(hpb + (size_t)(dir) * 8 * 4096 + pb * 32 * 64 + 16 * ks); } while (0)
#define FIN_TILE(jb, bfr, xf) do { \
        f32x16 gt = (f32x16){}; \
        _Pragma("unroll") for (int ks = 0; ks < 4; ++ks) gt = __builtin_amdgcn_mfma_f32_32x32x16_bf16(bfr[ks], cf[ks], gt, 0, 0, 0); \
        _Pragma("unroll") for (int r = 0; r < 16; ++r) { \
            const int j = 32 * (jb) + crow(r, hi); const f32x4 tj = tab[j]; \
            const bool lt = j < i, gtj = j > i; \
            const float arg = lt ? ti.x - tj.x : (gtj ? ti.z - tj.z : 0.f); \
            const float dj = lt ? tj.y : (gtj ? tj.w : ti.y + ti.w); \
            gt[r] = gt[r] * __builtin_amdgcn_exp2f(arg * LOG2E) * dj; } \
        u32x4 pw[2]; \
        _Pragma("unroll") for (int s = 0; s < 2; ++s) pw[s] = (u32x4){cvtpk(gt[8 * s], gt[8 * s + 1]), cvtpk(gt[8 * s + 2], gt[8 * s + 3]), cvtpk(gt[8 * s + 4], gt[8 * s + 5]), cvtpk(gt[8 * s + 6], gt[8 * s + 7])}; \
        _Pragma("unroll") for (int s = 0; s < 2; ++s) _Pragma("unroll") for (int pb = 0; pb < 2; ++pb) \
            yT[pb] = __builtin_amdgcn_mfma_f32_32x32x16_bf16(xf[2 * s + pb], __builtin_bit_cast(bf16x8, pw[s]), yT[pb], 0, 0, 0); } while (0)
#define FIN_YOFF(hp, dir) do { const float ei = __builtin_amdgcn_exp2f(((dir) == 0 ? ti.x : ti.z) * LOG2E); \
        _Pragma("unroll") for (int ks = 0; ks < 4; ++ks) { \
            const u32x4 cv = __builtin_bit_cast(u32x4, cf[ks]); u32x4 cs; \
            cs.x = cvtpk(bf2f(cv.x & 0xffffu) * ei, bf2f(cv.x >> 16) * ei); cs.y = cvtpk(bf2f(cv.y & 0xffffu) * ei, bf2f(cv.y >> 16) * ei); \
            cs.z = cvtpk(bf2f(cv.z & 0xffffu) * ei, bf2f(cv.z >> 16) * ei); cs.w = cvtpk(bf2f(cv.w & 0xffffu) * ei, bf2f(cv.w >> 16) * ei); \
            _Pragma("unroll") for (int pb = 0; pb < 2; ++pb) yT[pb] = __builtin_amdgcn_mfma_f32_32x32x16_bf16(hp[2 * ks + pb], __builtin_bit_cast(bf16x8, cs), yT[pb], 0, 0, 0); } } while (0)
    bf16x8 bA[4], bB[4], xA[4], xB[4], hA[8], hB[8];
    FIN_LOADB(bA, 0); FIN_LOADX(xA, 0);
#pragma unroll 1
    for (int ib = 0; ib < 4; ++ib) {
        asm volatile("" : "+v"(brow), "+v"(xt), "+v"(hpb));
        const int i = 32 * ib + r32;
        const f32x4 ti = tab[i];
        bf16x8 cf[4];
#pragma unroll
        for (int ks = 0; ks < 4; ++ks) cf[ks] = *(const bf16x8*)(XBCC + (t0 + i) * XBC + 640 + g * 64 + 16 * ks + 8 * hi);
        f32x16 yT[2]; yT[0] = (f32x16){}; yT[1] = (f32x16){};
        FIN_LOADB(bB, 1); FIN_LOADX(xB, 1); __builtin_amdgcn_sched_barrier(0);
        FIN_TILE(0, bA, xA);
        FIN_LOADB(bA, 2); FIN_LOADX(xA, 2); __builtin_amdgcn_sched_barrier(0);
        FIN_TILE(1, bB, xB);
        FIN_LOADB(bB, 3); FIN_LOADX(xB, 3); __builtin_amdgcn_sched_barrier(0);
        FIN_TILE(2, bA, xA);
        FIN_LOADH(hA, 0); __builtin_amdgcn_sched_barrier(0);
        FIN_TILE(3, bB, xB);
        FIN_LOADH(hB, 1); __builtin_amdgcn_sched_barrier(0);
        FIN_YOFF(hA, 0);
        u32x2 xv[8], zv[8];
#pragma unroll
        for (int q = 0; q < 8; ++q) { const int p = 32 * (q >> 2) + 8 * (q & 3) + 4 * hi;
            xv[q] = *(const u32x2*)(XBCC + (t0 + i) * XBC + hd * 64 + p); zv[q] = *(const u32x2*)(PROJ + (t0 + i) * PROJ_N + PC_Z + hd * 64 + p); }
        __builtin_amdgcn_sched_barrier(0);
        FIN_YOFF(hB, 1);
        FIN_LOADB(bA, 0); FIN_LOADX(xA, 0); __builtin_amdgcn_sched_barrier(0);
        float ss = 0.f;
#pragma unroll
        for (int q8 = 0; q8 < 8; ++q8) {
            const int pb = q8 >> 2, q = q8 & 3;
            const float xs[4] = {bf2f(xv[q8].x & 0xffffu), bf2f(xv[q8].x >> 16), bf2f(xv[q8].y & 0xffffu), bf2f(xv[q8].y >> 16)};
            const float zs[4] = {bf2f(zv[q8].x & 0xffffu), bf2f(zv[q8].x >> 16), bf2f(zv[q8].y & 0xffffu), bf2f(zv[q8].y >> 16)};
#pragma unroll
            for (int e = 0; e < 4; ++e) { const float y = yT[pb][4 * q + e] + dsk * xs[e]; const float gv = y * (zs[e] / (1.f + __expf(-zs[e]))); yT[pb][4 * q + e] = gv; ss += gv * gv; }
        }
        ss = att::half_sum(ss);
        __syncthreads();
        if (hi == 0) red[hd * 32 + r32] = ss;
        __syncthreads();
        float tot = 0.f;
#pragma unroll
        for (int w8 = 0; w8 < 8; ++w8) tot += red[w8 * 32 + r32];
        const float rstd = 1.f / sqrtf(tot * (1.f / 512.f) + EPS);
#pragma unroll
        for (int pb = 0; pb < 2; ++pb)
#pragma unroll
            for (int q = 0; q < 4; ++q) {
                const int p = 32 * pb + 8 * q + 4 * hi;
                const f32x4 wv = *(const f32x4*)(ssdnw + hd * 64 + p);
                u32x2 o; o.x = cvtpk(yT[pb][4 * q] * rstd * wv.x, yT[pb][4 * q + 1] * rstd * wv.y); o.y = cvtpk(yT[pb][4 * q + 2] * rstd * wv.z, yT[pb][4 * q + 3] * rstd * wv.w);
                *(u32x2*)(MIX + (t0 + i) * D + 512 + hd * 64 + p) = o;
            }
    }
#undef FIN_LOADB
#undef FIN_LOADX
#undef FIN_LOADH
#undef FIN_TILE
#undef FIN_YOFF
    __syncthreads();
}
}

struct Args { const void* in[31]; float* out; unsigned char* ws; int ph_lo, ph_hi; };
#define IN_F(i) ((const float*)a.in[i])
enum { I_X = 0, I_P, I_POS, I_ATTN_NW, I_WIN, I_QNW, I_WUQ, I_KVNW, I_WUKV, I_AONW, I_CONVW, I_CONVB, I_DTB, I_ALOG, I_SSDD, I_SSDNW, I_WO, I_FFNNW,
       I_WRG, I_BRG, I_WRE, I_BRE, I_WEG, I_WEU, I_WED, I_PLENW, I_WPG, I_BPG, I_WPP, I_PPNW, I_FNW };

template <class FA, class FB, class FE>
__device__ __forceinline__ void naive_gemm(int M, int N, int K, FA fa, FB fb, FE fe, float* sm) {
    const int tid = threadIdx.x, tx = tid & 63, ty = tid >> 6;
    float* As = sm; float* Bs = sm + 64 * 17;
    const int ntm = M / 64, ntn = (N + 63) / 64;
    for (int tile = blockIdx.x; tile < ntm * ntn; tile += gridDim.x) {
        const int tm = tile / ntn, tn = tile % ntn;
        float acc[8];
#pragma unroll
        for (int j = 0; j < 8; ++j) acc[j] = 0.f;
        for (int k0 = 0; k0 < K; k0 += 16) {
            __syncthreads();
            for (int i = tid; i < 1024; i += 512) { const int r = i >> 4, c = i & 15; As[r * 17 + c] = fa(tm * 64 + r, k0 + c); }
            for (int i = tid; i < 1024; i += 512) { const int r = i >> 6, c = i & 63; const int n = tn * 64 + c; Bs[r * 64 + c] = (n < N) ? fb(k0 + r, n) : 0.f; }
            __syncthreads();
#pragma unroll
            for (int k = 0; k < 16; ++k) { const float b = Bs[k * 64 + tx];
#pragma unroll
                for (int j = 0; j < 8; ++j) acc[j] += As[(ty * 8 + j) * 17 + k] * b; }
        }
#pragma unroll
        for (int j = 0; j < 8; ++j) { const int m = tm * 64 + ty * 8 + j, n = tn * 64 + tx; if (n < N) fe(m, n, acc[j]); }
    }
    __syncthreads();
}

__device__ __forceinline__ int proj_src_col(int j) {
    if (j < 416) return j;
    if (j < 432) return 1696 + (j - 416);
    if (j < 512) return -1;
    if (j < 1024) return 416 + (j - 512);
    return 928 + (j - 1024);
}

__device__ __forceinline__ void rms_row_to_bf16(const float* xrow, const float* w, bf16_t* orow, int lane) {
    const f32x4* xr = (const f32x4*)xrow + lane; const f32x4* wr = (const f32x4*)w + lane;
    f32x4 v[4]; float s = 0.f;
#pragma unroll
    for (int j = 0; j < 4; ++j) { v[j] = xr[64 * j]; s += (v[j].x * v[j].x + v[j].y * v[j].y) + (v[j].z * v[j].z + v[j].w * v[j].w); }
    const float rstd = 1.f / sqrtf(wave_sum(s) * (1.f / D) + EPS);
    u32x2* o8 = (u32x2*)orow + lane;
#pragma unroll
    for (int j = 0; j < 4; ++j) { const f32x4 g = wr[64 * j]; u32x2 o; o.x = pk2(v[j].x * rstd * g.x, v[j].y * rstd * g.y); o.y = pk2(v[j].z * rstd * g.z, v[j].w * rstd * g.w); o8[64 * j] = o; }
}

constexpr int LDS_BYTES = 147456;
constexpr int MISC_OFF = 131072;

__global__ void __launch_bounds__(512, 2) fwd(Args a) {
    extern __shared__ __attribute__((aligned(16))) unsigned char lds_raw[];
    float* smf = (float*)lds_raw;
    const int G = gridDim.x, NGW = G * 8, NGT = G * 512;
#define FRESH_IDS() int tid = threadIdx.x; asm volatile("" : "+v"(tid)); const int lane = tid & 63, wave = __builtin_amdgcn_readfirstlane(tid >> 6); \
    const int gw = blockIdx.x * 8 + wave, gtid = blockIdx.x * 512 + tid; (void)lane; (void)gw; (void)gtid;
    unsigned char* ws = a.ws;
    unsigned* ctl = (unsigned*)(ws + WS_CTL);
    volatile LAS unsigned* MISC = (volatile LAS unsigned*)((LAS unsigned char*)lds_raw + MISC_OFF);
    if (threadIdx.x < 32) MISC[threadIdx.x] = 0u;
    __syncthreads();
#if !MK_PER_PHASE
    XcdBarrier bar = xcd_barrier_post(ctl + CW_BAR, MISC + 8);
#define GRID_BAR() xcd_barrier(bar)
#else
#define GRID_BAR() do {} while (0)
#endif
    const int lo = a.ph_lo, hi = a.ph_hi;
#ifndef PHMASK
#define PHMASK 0xFFFF
#endif
#define IN(k) (((PHMASK >> (k)) & 1) && lo <= (k) && (k) < hi)
#ifndef REPMASK
#define REPMASK 0
#endif
#define NREP(k) (1 + ((REPMASK >> (k)) & 1))
#define SEAM(k) do { if (IN(k) && IN((k) + 1)) GRID_BAR(); } while (0)

    const float* x = IN_F(I_X);
    float* out = a.out;
    bf16_t* H = (bf16_t*)(ws + WS_H);
    bf16_t* PROJ = (bf16_t*)(ws + WS_PROJ);
    bf16_t* PLERAW = (bf16_t*)(ws + WS_PROJ);
    bf16_t* Qb = (bf16_t*)(ws + WS_Q); bf16_t* Kb = (bf16_t*)(ws + WS_K); bf16_t* Vb = (bf16_t*)(ws + WS_V);
    bf16_t* MIX = (bf16_t*)(ws + WS_MIX);
    bf16_t* XBCC = (bf16_t*)(ws + WS_XBCC);
    float* STATES = out;
    bf16_t* XT = (bf16_t*)((char*)out + 64 * MiB);
    bf16_t* BT = (bf16_t*)((char*)out + 96 * MiB);
    bf16_t* HPB = (bf16_t*)(ws + WS_H);
    bf16_t* X1B = (bf16_t*)out;
    float* CDEC = (float*)(ws + WS_CDEC);
    float* COS = (float*)(ws + WS_COS); float* SIN = (float*)(ws + WS_SIN);
    float* DT = (float*)(ws + WS_DT); float* DTRAW = (float*)(ws + WS_DTRAW);
    float* ROUTE = (float*)(ws + WS_ROUTE);
    int* BUCKET = (int*)(ws + WS_BUCKET);
    const int* pos = (const int*)a.in[I_POS];

    bf16_t* WT_IN = (bf16_t*)(ws + WS_WEIGHTS);
    bf16_t* WT_UQ = WT_IN + (size_t)PROJ_N * D;
    bf16_t* WT_UKV = WT_UQ + 768 * 256;
    bf16_t* WT_O = WT_UKV + 1024 * 128;
    bf16_t* WT_PG = WT_O + (size_t)D * D;
    bf16_t* WT_PP = WT_PG + (size_t)D * D;
    bf16_t* WT_GU = WT_PP + (size_t)D * 256;
    bf16_t* WT_DN = WT_GU + (size_t)32 * 512 * 1024;
    bf16_t* PB = (bf16_t*)(ws + WS_PB);
    float* SSQQ = (float*)(ws + WS_SSQQ); float* SSQKV = (float*)(ws + WS_SSQKV); float* SSQPLE = (float*)(ws + WS_SSQPLE);
    LAS unsigned char* ldsb = (LAS unsigned char*)lds_raw;
    bf16_t* WRF = (bf16_t*)(ws + WS_WRF);
    float* SSQX1 = (float*)(ws + WS_SSQX1);

    if (IN(0)) {
        FRESH_IDS();
        for (int rep_ = 0; rep_ < NREP(0); ++rep_) {
        float* scr = smf + wave * 4096;
        constexpr int I_IN = 16 * 56, I_UQ = 4 * 24, I_UKV = 2 * 32, I_O = 16 * 32, I_PG = 16 * 32, I_PP = 4 * 32, I_GU = 32 * 16 * 16, I_DN = 32 * 4 * 32;
        constexpr int NITEMS = I_IN + I_UQ + I_UKV + I_O + I_PG + I_PP + I_GU + I_DN;
        const float* qnw = IN_F(I_QNW); const float* kvnw = IN_F(I_KVNW);
        const float qscale = 0.10206207261596575f * 1.4426950408889634f;
        auto one = [](int) { return 1.f; };
        auto ident = [](int n) { return n; };
        for (int it = gw; it < NITEMS; it += NGW) {
            int r = it;
            if (r < I_IN) { transpose_item(IN_F(I_WIN), IN_COLS, D, WT_IN, scr, r / 56, r % 56, lane, [](int n) { return proj_src_col(n); }, one); continue; } r -= I_IN;
            if (r < I_UQ) { transpose_item(IN_F(I_WUQ), 768, 256, WT_UQ, scr, r / 24, r % 24, lane, ident, [&](int k) { return qnw[k] * qscale; }); continue; } r -= I_UQ;
            if (r < I_UKV) { transpose_item(IN_F(I_WUKV), 1024, 128, WT_UKV, scr, r / 32, r % 32, lane, ident, [&](int k) { return kvnw[k]; }); continue; } r -= I_UKV;
            if (r < I_O) { transpose_item(IN_F(I_WO), D, D, WT_O, scr, r / 32, r % 32, lane, ident, one); continue; } r -= I_O;
            if (r < I_PG) { transpose_item(IN_F(I_WPG), D, D, WT_PG, scr, r / 32, r % 32, lane, ident, one); continue; } r -= I_PG;
            if (r < I_PP) { transpose_item(IN_F(I_WPP), D, 256, WT_PP, scr, r / 32, r % 32, lane, ident, one); continue; } r -= I_PP;
            if (r < I_GU) { const int e = r / 256, q = r % 256, kb = q / 16, nb = q % 16;
                const float* W = ((nb & 7) < 4 ? IN_F(I_WEG) : IN_F(I_WEU)) + (size_t)e * 1024 * 256;
                transpose_item(W, 256, D, WT_GU + (size_t)e * 512 * 1024, scr, kb, nb, lane, [](int n) { return (n >> 8) * 128 + (n & 127); }, one); continue; } r -= I_GU;
            { const int e = r / 128, q = r % 128; transpose_item(IN_F(I_WED) + (size_t)e * 256 * 1024, D, 256, WT_DN + (size_t)e * 1024 * 256, scr, q / 32, q % 32, lane, ident, one); }
        }
        { const f32x4* wr4 = (const f32x4*)IN_F(I_ATTN_NW) + lane;
          for (int m0 = gw * 4; m0 < T; m0 += NGW * 4) {
              f32x4 v[4][4];
#pragma unroll
              for (int r = 0; r < 4; ++r)
#pragma unroll
                  for (int j = 0; j < 4; ++j) v[r][j] = ((const f32x4*)(x + (size_t)(m0 + r) * D) + lane)[64 * j];
#pragma unroll
              for (int r = 0; r < 4; ++r) {
                  float s = 0.f;
#pragma unroll
                  for (int j = 0; j < 4; ++j) s += (v[r][j].x * v[r][j].x + v[r][j].y * v[r][j].y) + (v[r][j].z * v[r][j].z + v[r][j].w * v[r][j].w);
                  const float rstd = 1.f / sqrtf(wave_sum(s) * (1.f / D) + EPS);
                  u32x2* o8 = (u32x2*)(H + (size_t)(m0 + r) * D) + lane;
#pragma unroll
                  for (int j = 0; j < 4; ++j) { const f32x4 g4 = wr4[64 * j]; u32x2 o; o.x = pk2(v[r][j].x * rstd * g4.x, v[r][j].y * rstd * g4.y); o.y = pk2(v[r][j].z * rstd * g4.z, v[r][j].w * rstd * g4.w); o8[64 * j] = o; }
              } } }
        { const f32x4* pp = (const f32x4*)IN_F(I_P); u32x2* po = (u32x2*)PB;
          for (int i0 = gtid; i0 < T * 256 / 4; i0 += NGT * 8) { f32x4 v[8];
#pragma unroll
              for (int q = 0; q < 8; ++q) v[q] = pp[i0 + q * NGT];
#pragma unroll
              for (int q = 0; q < 8; ++q) { u32x2 o; o.x = pk2(v[q].x, v[q].y); o.y = pk2(v[q].z, v[q].w); po[i0 + q * NGT] = o; } } }
        { const float* wrg = IN_F(I_WRG); const float* wre = IN_F(I_WRE);
          for (int i = gtid; i < 32 * 3 * 64 * 8; i += NGT) { const int e = i & 7, l = (i >> 3) & 63, nb = (i >> 9) % 3, ks = i / 1536;
              const int k = 32 * ks + 8 * (l >> 4) + e, col = 16 * nb + (l & 15);
              const float w = col < 4 ? wrg[k * 4 + col] : (col < 36 ? wre[k * 32 + (col - 4)] : 0.f);
              const unsigned hi = f2bf(w); const float lo = w - bf2f(hi);
              const size_t base = ((size_t)(ks * 3 + nb) * 2) * 512 + l * 8 + e;
              WRF[base] = (bf16_t)hi; WRF[base + 512] = (bf16_t)f2bf(lo); } }
        for (int i = gtid; i < T * 16; i += NGT) {
            const int t = i >> 4, f = i & 15;
            const float inv = 1.0f / powf(10000.0f, (float)(2 * f) / 32.0f);
            const float ang = (float)pos[t] * inv;
            COS[i] = cosf(ang); SIN[i] = sinf(ang);
        }
        }
    }
    SEAM(0);
    if (IN(1)) {
        FRESH_IDS();
        for (int rep_ = 0; rep_ < NREP(1); ++rep_) {
        pg8::Gemm g{H, WT_IN, T, PROJ_N, D, D, D}; pg8::StaticOrder So; So.init(T, PROJ_N, G, (int)blockIdx.x);
        EpiInProj E{PROJ, DTRAW, SSQQ, SSQKV};
        pg8::gemm_phase(ldsb, g, So, E);
        }
    }
    SEAM(1);
    if (IN(2)) {
        FRESH_IDS();
        for (int rep_ = 0; rep_ < NREP(2); ++rep_)
        for (int u = blockIdx.x; u < NB * ssd::NCH; u += G) {
            ssd::conv_chunk(smf, PROJ, IN_F(I_CONVW), IN_F(I_CONVB), XBCC, XT, BT, DTRAW, IN_F(I_DTB), DT, u >> 5, u & 31);
            ssd::states_chunk(smf + 20480, XT, BT, DT, IN_F(I_ALOG), STATES, CDEC, u >> 5, u & 31);
            __syncthreads();
        }
        for (int i = gtid; i < T * 16; i += NGT) {
            const int t = i >> 4, f = i & 15, b = t / S, s = t % S;
            const float c = COS[i], sn = SIN[i];
            const float t1 = bf2f(PROJ[(size_t)t * PROJ_N + PC_KR + f]), t2 = bf2f(PROJ[(size_t)t * PROJ_N + PC_KR + 16 + f]);
            const bf16_t o1 = (bf16_t)f2bf(t1 * c - t2 * sn), o2 = (bf16_t)f2bf(t2 * c + t1 * sn);
            for (int h = 0; h < NH; ++h) { bf16_t* kt = Kb + ((size_t)(b * NH + h) * (S / 64) + (s >> 6)) * (12 * 512) + (s & 63) * 8 + (f & 7); kt[(8 + (f >> 3)) * 512] = o1; kt[(10 + (f >> 3)) * 512] = o2; }
        }
        __syncthreads();
        for (int rep2_ = 0; rep2_ < NREP(12); ++rep2_) {
        { pg8::Gemm g{PROJ + PC_CQ, WT_UQ, T, 768, 256, PROJ_N, 256}; pg8::StaticOrder So; So.init(T, 768, G, (int)blockIdx.x);
          EpiQUp E{Qb, SSQQ, COS, SIN}; pg8::gemm_phase(ldsb, g, So, E); }
        { pg8::Gemm g{PROJ + PC_CKV, WT_UKV, T, 1024, 128, PROJ_N, 128}; pg8::StaticOrder So; So.init(T, 1024, G, (int)blockIdx.x);
          EpiKVUp E{Kb, Vb, SSQKV}; pg8::gemm_phase(ldsb, g, So, E); }
        }
    }
    SEAM(2);
    if (IN(3)) {
        FRESH_IDS();
        for (int rep_ = 0; rep_ < NREP(13); ++rep_)
        for (int idx = gtid; idx < 128 * 1024; idx += NGT) {
            const int chain = idx >> 10, e4 = (idx & 1023) * 4, b = chain >> 4, dir = (chain >> 3) & 1, hd = chain & 7;
            f32x4 h4 = (f32x4){0.f, 0.f, 0.f, 0.f};
#pragma unroll 8
            for (int step = 0; step < ssd::NCH; ++step) {
                const int c = dir == 0 ? step : ssd::NCH - 1 - step;
                const int sidx = ((b * ssd::NCH + c) * 2 + dir) * 8 + hd;
                const f32x4* ptr = (const f32x4*)(STATES + (size_t)sidx * 4096 + e4);
                const f32x4 s4 = *ptr; { u32x2 hb; hb.x = pk2(h4.x, h4.y); hb.y = pk2(h4.z, h4.w); *(u32x2*)(HPB + (size_t)sidx * 4096 + e4) = hb; } h4 = h4 * CDEC[sidx] + s4;
            }
        }
        __syncthreads();
        for (int rep_ = 0; rep_ < NREP(3); ++rep_) {
        {
            const int vcu = (G % 8 == 0) ? ((int)blockIdx.x % 8) * (G / 8) + (int)blockIdx.x / 8 : (int)blockIdx.x;
            for (int u = vcu; u < NB * NH * 16; u += G) att::attn_unit(ldsb, Qb, Kb, Vb, MIX, u >> 4, u & 15);
        }
        }
    }
    SEAM(3);
    if (IN(4)) {
        FRESH_IDS();
        const float* aonw = IN_F(I_AONW);
        for (int u = blockIdx.x; u < NB * ssd::NCH; u += G) {
            for (int rep_ = 0; rep_ < NREP(4); ++rep_)
                ssd::finalize_chunk(smf, XBCC, XT, PROJ, DT, IN_F(I_ALOG), HPB, IN_F(I_SSDD), IN_F(I_SSDNW), MIX, u >> 5, u & 31);
            for (int r0 = wave * 4; r0 < ssd::CH; r0 += 32) {
                u32x4 raw[4];
#pragma unroll
                for (int q = 0; q < 4; ++q) raw[q] = *(const u32x4*)(MIX + ((size_t)(u >> 5) * S + (u & 31) * ssd::CH + r0 + q) * D + lane * 8);
                const f32x4 w0 = *(const f32x4*)(aonw + lane * 8), w1 = *(const f32x4*)(aonw + lane * 8 + 4);
#pragma unroll
                for (int q = 0; q < 4; ++q) {
                    float v[8] = {bf2f(raw[q].x & 0xffffu), bf2f(raw[q].x >> 16), bf2f(raw[q].y & 0xffffu), bf2f(raw[q].y >> 16), bf2f(raw[q].z & 0xffffu), bf2f(raw[q].z >> 16), bf2f(raw[q].w & 0xffffu), bf2f(raw[q].w >> 16)};
                    float ss = 0.f;
#pragma unroll
                    for (int j = 0; j < 8; ++j) ss += v[j] * v[j];
                    const float rstd = 1.f / sqrtf(wave_sum(ss) * (1.f / 512.f) + EPS);
                    u32x4 o; o.x = pk2(v[0] * rstd * w0.x, v[1] * rstd * w0.y); o.y = pk2(v[2] * rstd * w0.z, v[3] * rstd * w0.w);
                    o.z = pk2(v[4] * rstd * w1.x, v[5] * rstd * w1.y); o.w = pk2(v[6] * rstd * w1.z, v[7] * rstd * w1.w);
                    *(u32x4*)(MIX + ((size_t)(u >> 5) * S + (u & 31) * ssd::CH + r0 + q) * D + lane * 8) = o;
                }
            }
        }
    }
    SEAM(4);
    if (IN(5)) {
        FRESH_IDS();
        for (int rep_ = 0; rep_ < NREP(5); ++rep_) {
        pg8::Gemm g{MIX, WT_O, T, D, D, D, D}; pg8::StaticOrder So; So.init(T, D, G, (int)blockIdx.x);
        EpiResid E{x, X1B, SSQX1}; pg8::gemm_phase(ldsb, g, So, E);
        }
    }
    SEAM(5);
    if (IN(6)) {
        FRESH_IDS();
        {
            typedef short bf16x8r __attribute__((ext_vector_type(8)));
            const float* fw = IN_F(I_FFNNW); const float* brg = IN_F(I_BRG); const float* bre = IN_F(I_BRE);
            const int r16 = lane & 15, kq = lane >> 4;
            float* lg = smf + wave * (16 * 48);
            for (int rb = gw; rb < T / 16; rb += NGW) {
                const int row = rb * 16 + r16;
                float ss = 0.f;
#pragma unroll
                for (int q = 0; q < 4; ++q) { const f32x4 sv = *(const f32x4*)(SSQX1 + row * 16 + 4 * q); ss += (sv.x + sv.y) + (sv.z + sv.w); }
                const float rstd = 1.f / sqrtf(ss * (1.f / D) + EPS);
                f32x4 acc[3]; acc[0] = (f32x4){0.f, 0.f, 0.f, 0.f}; acc[1] = acc[0]; acc[2] = acc[0];
                const bf16_t* xrow = X1B + (size_t)row * D + 8 * kq;
#pragma unroll 8
                for (int ks = 0; ks < 32; ++ks) {
                    const u32x4 xb = *(const u32x4*)(xrow + 32 * ks);
                    const f32x4 x0 = (f32x4){bf2f(xb.x & 0xffffu), bf2f(xb.x >> 16), bf2f(xb.y & 0xffffu), bf2f(xb.y >> 16)}, x1v = (f32x4){bf2f(xb.z & 0xffffu), bf2f(xb.z >> 16), bf2f(xb.w & 0xffffu), bf2f(xb.w >> 16)};
                    const f32x4 g0 = *(const f32x4*)(fw + 32 * ks + 8 * kq), g1 = *(const f32x4*)(fw + 32 * ks + 8 * kq + 4);
                    const f32x4 h0 = x0 * rstd * g0, h1 = x1v * rstd * g1;
                    u32x4 hi; hi.x = att::cvtpk(h0.x, h0.y); hi.y = att::cvtpk(h0.z, h0.w); hi.z = att::cvtpk(h1.x, h1.y); hi.w = att::cvtpk(h1.z, h1.w);
                    *(u32x4*)(H + (size_t)row * D + 32 * ks + 8 * kq) = hi;
                    u32x4 lo; lo.x = att::cvtpk(h0.x - bf2f(hi.x & 0xffffu), h0.y - bf2f(hi.x >> 16)); lo.y = att::cvtpk(h0.z - bf2f(hi.y & 0xffffu), h0.w - bf2f(hi.y >> 16));
                    lo.z = att::cvtpk(h1.x - bf2f(hi.z & 0xffffu), h1.y - bf2f(hi.z >> 16)); lo.w = att::cvtpk(h1.z - bf2f(hi.w & 0xffffu), h1.w - bf2f(hi.w >> 16));
                    const bf16x8r ah = __builtin_bit_cast(bf16x8r, hi), al = __builtin_bit_cast(bf16x8r, lo);
#pragma unroll
                    for (int nb = 0; nb < 3; ++nb) {
                        const bf16_t* wf = WRF + ((size_t)(ks * 3 + nb) * 2) * 512 + lane * 8;
                        const bf16x8r bh = *(const bf16x8r*)wf, bl = *(const bf16x8r*)(wf + 512);
                        acc[nb] = __builtin_amdgcn_mfma_f32_16x16x32_bf16(ah, bh, acc[nb], 0, 0, 0);
                        acc[nb] = __builtin_amdgcn_mfma_f32_16x16x32_bf16(ah, bl, acc[nb], 0, 0, 0);
                        acc[nb] = __builtin_amdgcn_mfma_f32_16x16x32_bf16(al, bh, acc[nb], 0, 0, 0);
                    }
                }
#pragma unroll
                for (int nb = 0; nb < 3; ++nb)
#pragma unroll
                    for (int j = 0; j < 4; ++j) lg[(4 * kq + j) * 48 + 16 * nb + r16] = acc[nb][j];
                asm volatile("s_waitcnt lgkmcnt(0)" ::: "memory");
                if (lane < 16) {
                    const int m = rb * 16 + lane;
                    float lgt[36];
#pragma unroll
                    for (int q = 0; q < 9; ++q) { const f32x4 v = *(const f32x4*)(lg + lane * 48 + 4 * q); lgt[4 * q] = v.x; lgt[4 * q + 1] = v.y; lgt[4 * q + 2] = v.z; lgt[4 * q + 3] = v.w; }
                    float gl[4]; int gi = 0;
#pragma unroll
                    for (int q = 0; q < 4; ++q) gl[q] = lgt[q] + brg[q];
                    float gmax = gl[0];
#pragma unroll
                    for (int q = 1; q < 4; ++q) if (gl[q] > gmax) { gmax = gl[q]; gi = q; }
                    float gs = 0.f;
#pragma unroll
                    for (int q = 0; q < 4; ++q) gs += expf(gl[q] - gmax);
                    const float gwt = 1.f / gs;
                    float el[8];
#pragma unroll
                    for (int q = 0; q < 8; ++q) { float vv = 0.f;
#pragma unroll
                        for (int g2 = 0; g2 < 4; ++g2) vv = (g2 == gi) ? lgt[4 + g2 * 8 + q] + bre[g2 * 8 + q] : vv;
                        el[q] = vv; }
                    int i0 = 0; float v0 = el[0];
#pragma unroll
                    for (int q = 1; q < 8; ++q) if (el[q] > v0) { v0 = el[q]; i0 = q; }
                    int i1 = -1; float v1 = -3.4e38f;
#pragma unroll
                    for (int q = 0; q < 8; ++q) if (q != i0 && el[q] > v1) { v1 = el[q]; i1 = q; }
                    const float e1 = expf(v1 - v0), w0 = gwt / (1.f + e1), w1 = gwt * e1 / (1.f + e1);
                    const int ex0 = gi * 8 + i0, ex1 = gi * 8 + i1;
                    *(f32x4*)(ROUTE + m * 4) = (f32x4){__int_as_float(ex0), __int_as_float(ex1), w0, w1};
                    const unsigned p0 = atomicAdd(ctl + CW_ECNT + 64 * ex0, 1u); BUCKET[(size_t)ex0 * T + p0] = m * 2;
                    const unsigned p1 = atomicAdd(ctl + CW_ECNT + 64 * ex1, 1u); BUCKET[(size_t)ex1 * T + p1] = m * 2 + 1;
                }
                asm volatile("s_waitcnt lgkmcnt(0)" ::: "memory");
            }
        }
    }
    SEAM(6);
    volatile LAS unsigned* CNT_L = MISC + 64; volatile LAS unsigned* PTILE_L = MISC + 96;
    LAS unsigned* ROWTAB = (LAS unsigned*)(ldsb + MISC_OFF + 1024);
    bf16_t* HE = (bf16_t*)(ws + WS_HE); bf16_t* YPAIR = (bf16_t*)(ws + WS_Q);
    bf16_t* X2B = (bf16_t*)(ws + WS_MIX);
    bf16_t* GB = (bf16_t*)(ws + WS_Q);
    if (IN(7) || IN(8)) {
        if (threadIdx.x == 0) { unsigned acc = 0;
            for (int e2 = 0; e2 < 32; ++e2) { const unsigned c = __hip_atomic_load(ctl + CW_ECNT + 64 * e2, __ATOMIC_RELAXED, __HIP_MEMORY_SCOPE_AGENT); CNT_L[e2] = c; PTILE_L[e2] = acc; acc += (c + 255u) >> 8; }
            PTILE_L[32] = acc; }
        __syncthreads();
    }
    if (IN(7)) {
        FRESH_IDS();
        for (int rep_ = 0; rep_ < NREP(7); ++rep_) {
        GroupSched Sg{PTILE_L, 2, G, (int)blockIdx.x};
        { pg8::Unit u;
          for (int i = 0; i < 8 && Sg.next(i, u); ++i) { const int e2 = u.pn >> 1, pm_l = u.pm - (int)PTILE_L[e2];
              if (tid < 256) { const int idx = pm_l * 256 + tid; const int tok = idx < (int)CNT_L[e2] ? (BUCKET[(size_t)e2 * T + idx] >> 1) : 0; ROWTAB[i * 256 + tid] = (unsigned)tok * 2048u; } } }
        __syncthreads();
        pg8::Gemm g{H, WT_GU, T, 32 * 512, D, D, D};
        EpiMoeGU E{HE};
        pg8::gemm_phase<EpiMoeGU, GroupSched, true>(ldsb, g, Sg, E, ROWTAB);
        { const int total = (int)PTILE_L[32] * 2, nmax = (total + G - 1) / G, extra = total - (nmax - 1) * G;
          pg8::Gemm g2{PB, WT_PP, T, D, 256, 256, 256}; pg8::TailOrder St; St.init(T, D, G, (int)blockIdx.x, extra);
          EpiPleProj E2{PLERAW, SSQPLE}; pg8::gemm_phase(ldsb, g2, St, E2); }
        }
    }
    SEAM(7);
    if (IN(8)) {
        for (int rep_ = 0; rep_ < NREP(8); ++rep_) {
        GroupSched Sg{PTILE_L, 4, G, (int)blockIdx.x};
        pg8::Gemm g{HE, WT_DN, 0, 32 * 1024, 256, 256, 256};
        EpiMoeDown E{YPAIR, BUCKET, ROUTE, PTILE_L, CNT_L};
        pg8::gemm_phase(ldsb, g, Sg, E);
        }
    }
    SEAM(8);
    if (IN(9)) {
        FRESH_IDS();
        const f32x4* wr4 = (const f32x4*)IN_F(I_PLENW) + lane;
        for (int m0 = gw * 4; m0 < T; m0 += NGW * 4) {
            f32x4 v[4][4]; u32x2 ya[4][4], yb[4][4];
#pragma unroll
            for (int r = 0; r < 4; ++r)
#pragma unroll
                for (int j = 0; j < 4; ++j) { const size_t m = m0 + r; { const u32x2 xb = ((const u32x2*)(X1B + m * D) + lane)[64 * j]; v[r][j] = (f32x4){bf2f(xb.x & 0xffffu), bf2f(xb.x >> 16), bf2f(xb.y & 0xffffu), bf2f(xb.y >> 16)}; }
                    ya[r][j] = ((const u32x2*)(YPAIR + (2 * m) * D) + lane)[64 * j]; yb[r][j] = ((const u32x2*)(YPAIR + (2 * m + 1) * D) + lane)[64 * j]; }
#pragma unroll
            for (int r = 0; r < 4; ++r) {
                const size_t m = m0 + r; float s = 0.f;
                u32x2* x2r = (u32x2*)(X2B + m * D) + lane;
#pragma unroll
                for (int j = 0; j < 4; ++j) { const u32x2 a0 = ya[r][j], a1 = yb[r][j];
                    v[r][j] = v[r][j] + (f32x4){bf2f(a0.x & 0xffffu) + bf2f(a1.x & 0xffffu), bf2f(a0.x >> 16) + bf2f(a1.x >> 16), bf2f(a0.y & 0xffffu) + bf2f(a1.y & 0xffffu), bf2f(a0.y >> 16) + bf2f(a1.y >> 16)};
                    { u32x2 xo; xo.x = pk2(v[r][j].x, v[r][j].y); xo.y = pk2(v[r][j].z, v[r][j].w); x2r[64 * j] = xo; }
                    s += (v[r][j].x * v[r][j].x + v[r][j].y * v[r][j].y) + (v[r][j].z * v[r][j].z + v[r][j].w * v[r][j].w); }
                const float rstd = 1.f / sqrtf(wave_sum(s) * (1.f / D) + EPS);
                u32x2* o8 = (u32x2*)(H + m * D) + lane;
#pragma unroll
                for (int j = 0; j < 4; ++j) { const f32x4 g4 = wr4[64 * j]; u32x2 o; o.x = pk2(v[r][j].x * rstd * g4.x, v[r][j].y * rstd * g4.y); o.y = pk2(v[r][j].z * rstd * g4.z, v[r][j].w * rstd * g4.w); o8[64 * j] = o; }
            }
        }
    }
    SEAM(9);
    if (IN(10)) {
        pg8::Gemm g{H, WT_PG, T, D, D, D, D}; pg8::StaticOrder So; So.init(T, D, G, (int)blockIdx.x);
        EpiPleGate E{GB, PLERAW, SSQPLE, IN_F(I_BPG), IN_F(I_PPNW)}; pg8::gemm_phase(ldsb, g, So, E);
    }
    SEAM(10);
    if (IN(11)) {
        FRESH_IDS();
        const f32x4* wr4 = (const f32x4*)IN_F(I_FNW) + lane;
        for (int m0 = gw * 4; m0 < T; m0 += NGW * 4) {
            u32x2 xa[4][4], ga[4][4];
#pragma unroll
            for (int r = 0; r < 4; ++r)
#pragma unroll
                for (int j = 0; j < 4; ++j) { const size_t m = m0 + r; xa[r][j] = ((const u32x2*)(X2B + m * D) + lane)[64 * j]; ga[r][j] = ((const u32x2*)(GB + m * D) + lane)[64 * j]; }
#pragma unroll
            for (int r = 0; r < 4; ++r) {
                f32x4 v[4]; float s = 0.f;
#pragma unroll
                for (int j = 0; j < 4; ++j) { const u32x2 a0 = xa[r][j], a1 = ga[r][j];
                    v[j] = (f32x4){bf2f(a0.x & 0xffffu) + bf2f(a1.x & 0xffffu), bf2f(a0.x >> 16) + bf2f(a1.x >> 16), bf2f(a0.y & 0xffffu) + bf2f(a1.y & 0xffffu), bf2f(a0.y >> 16) + bf2f(a1.y >> 16)};
                    s += (v[j].x * v[j].x + v[j].y * v[j].y) + (v[j].z * v[j].z + v[j].w * v[j].w); }
                const float rstd = 1.f / sqrtf(wave_sum(s) * (1.f / D) + EPS);
                f32x4* xr = (f32x4*)(out + (size_t)(m0 + r) * D) + lane;
#pragma unroll
                for (int j = 0; j < 4; ++j) xr[64 * j] = v[j] * rstd * wr4[64 * j];
            }
        }
    }
#undef IN
#undef SEAM
}

extern "C" void kernel_launch(void* const* d_in, const int* in_sizes, int n_in, void* d_out, int out_size, void* d_ws, size_t ws_size, hipStream_t stream) {
    static int grid = 0;
    if (grid == 0) {
        if (n_in != 31 || out_size != T * D || ws_size < WS_END) { fprintf(stderr, "kernel_launch: unexpected shapes (n_in %d out %d ws %zu)\n", n_in, out_size, ws_size); grid = -1; return; }
        int dev = 0, cus = 0, per_cu = 0;
        if (hipGetDevice(&dev) != hipSuccess || hipDeviceGetAttribute(&cus, hipDeviceAttributeMultiprocessorCount, dev) != hipSuccess) { grid = -1; return; }
        if (hipFuncSetAttribute((const void*)fwd, hipFuncAttributeMaxDynamicSharedMemorySize, LDS_BYTES) != hipSuccess) { fprintf(stderr, "kernel_launch: hipFuncSetAttribute failed\n"); grid = -1; return; }
        if (hipOccupancyMaxActiveBlocksPerMultiprocessor(&per_cu, (const void*)fwd, 512, LDS_BYTES) != hipSuccess || per_cu < 1) { fprintf(stderr, "kernel_launch: occupancy query says %d\n", per_cu); }
        (void)hipGetLastError();
        grid = cus;
    }
    if (grid < 0) return;
    (void)hipMemsetAsync((char*)d_ws + WS_CTL, 0, CTL_ZERO_BYTES, stream);
    Args a{};
    for (int i = 0; i < 31; ++i) a.in[i] = d_in[i];
    a.out = (float*)d_out; a.ws = (unsigned char*)d_ws;
#if MK_PER_PHASE
    for (int p = 0; p < NPHASES; ++p) { a.ph_lo = p; a.ph_hi = p + 1; hipLaunchKernelGGL(fwd, dim3(grid), dim3(512), LDS_BYTES, stream, a); }
#else
    a.ph_lo = 0; a.ph_hi = NPHASES;
    hipLaunchKernelGGL(fwd, dim3(grid), dim3(512), LDS_BYTES, stream, a);
#endif
}
```

```cpp
#include <hip/hip_runtime.h>
#include <cstdio>
#include <cstdint>

#ifndef MK_PER_PHASE
#define MK_PER_PHASE 0
#endif

#define LAS __attribute__((address_space(3)))
#define GAS __attribute__((address_space(1)))
typedef unsigned short bf16_t;
typedef float f32x4 __attribute__((ext_vector_type(4)));
typedef unsigned u32x4 __attribute__((ext_vector_type(4)));
typedef unsigned u32x2 __attribute__((ext_vector_type(2)));

constexpr int NB = 8, S = 4096, T = NB * S, D = 1024;
constexpr int NH = 8, DQK = 96, DV = 64;
constexpr int PROJ_N = 1792, IN_COLS = 1712;
constexpr int PC_CQ = 0, PC_CKV = 256, PC_KR = 384, PC_DT = 416, PC_Z = 512, PC_XBC = 1024;
constexpr int XBC = 768;
constexpr float EPS = 1e-6f;
constexpr int NPHASES = 12;

constexpr size_t MiB = 1u << 20;
constexpr size_t WS_CTL = 0, CTL_ZERO_BYTES = 1 * MiB;
constexpr size_t WS_COS = 1 * MiB, WS_SIN = 3 * MiB, WS_DT = 5 * MiB, WS_ROUTE = 7 * MiB, WS_BUCKET = 8 * MiB;
constexpr size_t WS_SSQQ = 12 * MiB, WS_SSQKV = 12 * MiB + 512 * 1024, WS_DTRAW = 13 * MiB, WS_SSQPLE = 15 * MiB;
constexpr size_t WS_WR = 7 * MiB + 512 * 1024;
constexpr size_t WS_CDEC = 7 * MiB + 768 * 1024;
constexpr size_t WS_RSTDP = 7 * MiB + 832 * 1024;
constexpr size_t WS_WRF = 7 * MiB + 512 * 1024;
constexpr size_t WS_SSQX1 = 17 * MiB;
constexpr size_t WS_WEIGHTS = 19 * MiB;
constexpr size_t WS_H = 80 * MiB;
constexpr size_t WS_PROJ = 144 * MiB;
constexpr size_t WS_HE = 208 * MiB;
constexpr size_t WS_Q = 256 * MiB, WS_K = 304 * MiB, WS_V = 352 * MiB;
constexpr size_t WS_MIX = 384 * MiB;
constexpr size_t WS_XBCC = 448 * MiB;
constexpr size_t WS_PB = 496 * MiB;
constexpr size_t WS_END = 512 * MiB;
constexpr int CW_BAR = 4096, CW_ECNT = 8192;

__device__ __forceinline__ unsigned f2bf(float f) { unsigned u = __builtin_bit_cast(unsigned, f); return (u + 0x7fffu + ((u >> 16) & 1u)) >> 16; }
__device__ __forceinline__ float bf2f(unsigned h) { return __builtin_bit_cast(float, h << 16); }
__device__ __forceinline__ unsigned pk2(float lo, float hi) { return f2bf(lo) | (f2bf(hi) << 16); }
__device__ __forceinline__ float wave_sum(float v) {
#pragma unroll
    for (int o = 1; o < 64; o <<= 1) v += __shfl_xor(v, o);
    return v;
}
__device__ __forceinline__ float silu_f(float v) { return v / (1.f + __expf(-v)); }

#define XB_TMO      128
#define XB_XCNT(j)  (256  + 64 * (j))
#define XB_XSUB(j)  (1280 + 64 * (j))
#define XB_XGEN(j)  (2304 + 64 * (j))
#define XB_TOP      3328
#define XB_TOPGEN   3392
#define XCD_BAR_WORDS 3456
#define XB_SPIN_CAP (1u << 22)

__device__ __forceinline__ unsigned xb_ld(unsigned* p)              { return __hip_atomic_load(p, __ATOMIC_RELAXED, __HIP_MEMORY_SCOPE_AGENT); }
__device__ __forceinline__ unsigned xb_add(unsigned* p, unsigned v) { return __hip_atomic_fetch_add(p, v, __ATOMIC_RELAXED, __HIP_MEMORY_SCOPE_AGENT); }
__device__ __forceinline__ unsigned xb_xcc_id() { return (unsigned)__builtin_amdgcn_s_getreg((3 << 11) | 20) & 0xFu; }
#define XB_SPIN(cond, bar) do { unsigned _sp = 0; while (cond) { __builtin_amdgcn_s_sleep(1); \
    if ((++_sp & 255u) == 0u) { if (xb_ld(&(bar)[XB_TMO])) break; if (_sp > XB_SPIN_CAP) { atomicAdd(&(bar)[XB_TMO], 1u); break; } } } } while (0)

struct XcdBarrier { unsigned* bar; unsigned x; volatile LAS unsigned* st; };
__device__ __forceinline__ XcdBarrier xcd_barrier_post(unsigned* bar, volatile LAS unsigned* st) {
    XcdBarrier b; b.bar = bar; b.x = xb_xcc_id(); b.st = st;
    if (threadIdx.x == 0) (void)xb_add(&bar[XB_XCNT(b.x)], 1u);
    return b;
}
__device__ __forceinline__ void xcd_barrier_complete(unsigned* bar, unsigned x, unsigned& nloc, unsigned& nx) {
    const unsigned G = gridDim.x * gridDim.y * gridDim.z;
    unsigned sum, cnt, mine, sp = 0u;
    for (;;) {
        sum = 0u; cnt = 0u; mine = 0u;
#pragma unroll
        for (unsigned j = 0; j < 16; ++j) { const unsigned c = xb_ld(&bar[XB_XCNT(j)]); sum += c; cnt += (c > 0u) ? 1u : 0u; mine = (j == x) ? c : mine; }
        if (sum == G) break;
        __builtin_amdgcn_s_sleep(1);
        if ((++sp & 255u) == 0u) { if (xb_ld(&bar[XB_TMO])) break; if (sp > XB_SPIN_CAP) { atomicAdd(&bar[XB_TMO], 1u); break; } }
    }
    nloc = mine > 0u ? mine : 1u; nx = cnt > 0u ? cnt : 1u;
}
__device__ __forceinline__ void xcd_barrier(const XcdBarrier& b) {
    asm volatile("s_waitcnt vmcnt(0)" ::: "memory");
    __syncthreads();
    if (threadIdx.x == 0) {
        unsigned* bar = b.bar;
        __builtin_amdgcn_s_waitcnt(0);
        unsigned nloc = b.st[0], nx = b.st[1];
        if (nloc == 0u) { xcd_barrier_complete(bar, b.x, nloc, nx); b.st[0] = nloc; b.st[1] = nx; }
        const unsigned old = xb_add(&bar[XB_XSUB(b.x)], 1u);
        const unsigned gen = old / nloc;
        if (old + 1u == (gen + 1u) * nloc) {
            __builtin_amdgcn_fence(__ATOMIC_RELEASE, "agent");
            asm volatile("s_waitcnt vmcnt(0)" ::: "memory");
            const unsigned og = xb_add(&bar[XB_TOP], 1u);
            const unsigned tg = og / nx;
            if (og + 1u == (tg + 1u) * nx) xb_add(&bar[XB_TOPGEN], 1u);
            else XB_SPIN(xb_ld(&bar[XB_TOPGEN]) == tg, bar);
            __builtin_amdgcn_fence(__ATOMIC_ACQUIRE, "agent");
            xb_add(&bar[XB_XGEN(b.x)], 1u);
            asm volatile("s_waitcnt vmcnt(0)" ::: "memory");
        } else {
            XB_SPIN(xb_ld(&bar[XB_XGEN(b.x)]) == gen, bar);
            __builtin_amdgcn_fence(__ATOMIC_ACQUIRE, "agent");
            asm volatile("s_waitcnt vmcnt(0)" ::: "memory");
        }
    }
    __syncthreads();
}


namespace pg8 {
typedef short bf16x8 __attribute__((ext_vector_type(8)));
constexpr int BM = 256, BK = 64, HALF = 128, HTB = HALF * BK * 2, STAGE_BYTES = 8 * HTB, NXCD = 8, WGM = 8;
__host__ __device__ __forceinline__ int lds_byte(int r, int c) { const int st = (r >> 4) * 2 + (c >> 5), rr = r & 15, cc = c & 31, ob = rr * 64 + cc * 2; return st * 1024 + (ob ^ (((ob >> 9) & 1) << 5)); }
__host__ __device__ __forceinline__ void stage_rc(int b, int& R, int& C) { const int st = b / 1024, sb = b % 1024, swz = sb ^ (((sb >> 9) & 1) << 5); R = (st >> 1) * 16 + swz / 64; C = (st & 1) * 32 + (swz % 64) / 2; }
__host__ __device__ __forceinline__ int perm32(int rho) { const int n = rho >> 4, i = rho & 15; return 8 * (i >> 2) + 4 * n + (i & 3); }
struct Unit { int pm, pn; };
struct Gemm { const bf16_t* A; const bf16_t* Bt; int M, N, K, lda, ldb; };
struct StaticOrder {
    int nM, nN, nwg, G, c;
    __host__ __device__ void init(int M, int N, int G_, int c_) { nM = M / BM; nN = N / BM; nwg = nM * nN; G = G_; c = c_; }
    __host__ __device__ bool next(int i, Unit& u) const {
        const long L = (long)i * G + c; if (L >= nwg) return false;
        int wgid = (int)L; { const int q = nwg / NXCD, r = nwg % NXCD, xcd = wgid % NXCD, off = wgid / NXCD; wgid = (xcd < r ? xcd * (q + 1) : r * (q + 1) + (xcd - r) * q) + off; }
        const int nig = WGM * nN, gid = wgid / nig, fm = gid * WGM, gsz = (nM - fm) < WGM ? (nM - fm) : WGM;
        u.pm = fm + ((wgid % nig) % gsz); u.pn = (wgid % nig) / gsz; return true;
    }
};
struct TailOrder {
    int nM, nN, nwg, G, c, first, span;
    __host__ __device__ void init(int M, int N, int G_, int c_, int first_) { nM = M / BM; nN = N / BM; nwg = nM * nN; G = G_; c = c_; first = (first_ > 0 && first_ < G_) ? first_ : 0; span = G - first; }
    __host__ __device__ bool next(int i, Unit& u) const {
        if (c < first) return false;
        const long L = (long)i * span + (c - first); if (L >= nwg) return false;
        const int wgid = (int)L;
        const int nig = WGM * nN, gid = wgid / nig, fm = gid * WGM, gsz = (nM - fm) < WGM ? (nM - fm) : WGM;
        u.pm = fm + ((wgid % nig) % gsz); u.pn = (wgid % nig) / gsz; return true;
    }
};
__device__ __forceinline__ unsigned cvt_pk_bf16(float lo, float hi) { unsigned r; asm volatile("v_cvt_pk_bf16_f32 %0, %1, %2" : "=v"(r) : "v"(lo), "v"(hi)); return r; }

template <class Epi, class Sched, bool GATHER = false>
__device__ __forceinline__ void gemm_phase(LAS unsigned char* lds, const Gemm g, const Sched& S, const Epi& E, const LAS unsigned* rowtab = nullptr) {
    int tid = threadIdx.x; asm volatile("" : "+v"(tid));
    const int wid = __builtin_amdgcn_readfirstlane(tid >> 6), lane = tid & 63, wr = wid >> 2, wc = wid & 3, fr = lane & 15, fq = lane >> 4;
    int nt = g.K / BK; asm volatile("" : "+s"(nt));
    unsigned vAc[2][2], vAn[2][2], voffB[2]; int RA[2], CA[2];
#pragma unroll
    for (int i = 0; i < 2; ++i) { int R, C; stage_rc(tid * 16 + i * 8192, R, C); const int Rb = Epi::PERM ? ((R & ~31) + perm32(R & 31)) : R; RA[i] = R; CA[i] = C;
        voffB[i] = (unsigned)(Rb * g.ldb + C) * 2u;
#pragma unroll
        for (int h = 0; h < 2; ++h) { vAc[h][i] = GATHER ? rowtab[h * HALF + R] + (unsigned)C * 2u : (unsigned)((h * HALF + R) * g.lda + C) * 2u; vAn[h][i] = vAc[h][i]; } }
    const size_t kstep = (size_t)(BK * 2);
    const size_t hstepB = (size_t)HALF * g.ldb * 2;
    const size_t tstepA = GATHER ? 0 : (size_t)BM * g.lda * 2, tstepB = 2 * hstepB;
    const unsigned ldsw = (unsigned)wid * 1024u;
    const int aoff = lds_byte(wr * 64 + fr, fq * 8), boff = lds_byte(wc * 32 + fr, fq * 8);
#define PG8_SA(b, h) (((b) * 2 + (h)) * HTB)
#define PG8_SB(b, h) ((4 + (b) * 2 + (h)) * HTB)
#define PG8_STAGE(bufoff, gbase, voff) do { _Pragma("unroll") for (int _i = 0; _i < 2; ++_i) \
        __builtin_amdgcn_global_load_lds((const unsigned*)((const char*)(gbase) + (voff)[_i]), (LAS unsigned*)(lds + (bufoff) + ldsw + _i * 8192), 16, 0, 0); } while (0)
#define PG8_LDA(dst, b, h) do { _Pragma("unroll") for (int m = 0; m < 4; ++m) _Pragma("unroll") for (int k = 0; k < 2; ++k) dst[m][k] = *(const LAS bf16x8*)(lds + PG8_SA(b, h) + aoff + m * 2048 + k * 1024); } while (0)
#define PG8_LDB(dst, b, h) do { _Pragma("unroll") for (int n = 0; n < 2; ++n) _Pragma("unroll") for (int k = 0; k < 2; ++k) dst[n][k] = *(const LAS bf16x8*)(lds + PG8_SB(b, h) + boff + n * 2048 + k * 1024); } while (0)
#define PG8_MMA(ai, bj, At, Bt) do { __builtin_amdgcn_s_setprio(1); _Pragma("unroll") for (int m = 0; m < 4; ++m) _Pragma("unroll") for (int n = 0; n < 2; ++n) _Pragma("unroll") for (int k = 0; k < 2; ++k) \
        acc[ai][bj][m][n] = __builtin_amdgcn_mfma_f32_16x16x32_bf16(Bt[n][k], At[m][k], acc[ai][bj][m][n], 0, 0, 0); __builtin_amdgcn_s_setprio(0); } while (0)
#define PG8_WAIT_V(n) asm volatile("s_waitcnt vmcnt(" #n ")" ::: "memory")
#define PG8_WAIT_L(n) asm volatile("s_waitcnt lgkmcnt(" #n ")" ::: "memory")
#define PG8_BAR __builtin_amdgcn_s_barrier()
#define PG8_SCHED __builtin_amdgcn_sched_barrier(0)
    Unit cur, nxt; int ui = 0;
    if (!S.next(0, cur)) return;
    f32x4 acc[2][2][4][2];
#pragma unroll
    for (int a = 0; a < 2; ++a)
#pragma unroll
        for (int b = 0; b < 2; ++b)
#pragma unroll
            for (int m = 0; m < 4; ++m)
#pragma unroll
                for (int n = 0; n < 2; ++n) acc[a][b][m][n] = (f32x4){0.f, 0.f, 0.f, 0.f};
    bf16x8 At[4][2], B0[2][2], B1[2][2];
    const char* cA = (const char*)g.A + (size_t)cur.pm * tstepA; const char* cB = (const char*)g.Bt + (size_t)cur.pn * tstepB;
    PG8_STAGE(PG8_SB(0, 0), cB, voffB); PG8_STAGE(PG8_SB(0, 1), cB + hstepB, voffB); PG8_STAGE(PG8_SA(0, 0), cA, vAc[0]); PG8_STAGE(PG8_SA(0, 1), cA, vAc[1]);
    if (wr == 1) PG8_BAR;
    PG8_WAIT_V(2); PG8_BAR;
    PG8_STAGE(PG8_SB(1, 0), cB + kstep, voffB); PG8_STAGE(PG8_SA(1, 0), cA + kstep, vAc[0]); PG8_STAGE(PG8_SB(1, 1), cB + hstepB + kstep, voffB);
    PG8_WAIT_V(6); PG8_BAR;
    for (;;) {
        const bool has_next = S.next(ui + 1, nxt);
        const char* nA = has_next ? (const char*)g.A + (size_t)nxt.pm * tstepA : cA; const char* nB = has_next ? (const char*)g.Bt + (size_t)nxt.pn * tstepB : cB;
        if (GATHER && has_next) {
#pragma unroll
            for (int i = 0; i < 2; ++i)
#pragma unroll
                for (int h = 0; h < 2; ++h) vAn[h][i] = rowtab[(ui + 1) * BM + h * HALF + RA[i]] + (unsigned)CA[i] * 2u;
        }
        for (int t = 0; t < nt; t += 2) {
            const bool last = (t == nt - 2);
            const char* a1 = cA + (size_t)(t + 1) * kstep;
            const char* a2 = last ? nA : cA + (size_t)(t + 2) * kstep; const char* b2 = last ? nB : cB + (size_t)(t + 2) * kstep;
            const char* a3 = a2 + kstep; const char* b3 = b2 + kstep;
            unsigned v2[2][2];
#pragma unroll
            for (int i = 0; i < 2; ++i)
#pragma unroll
                for (int h = 0; h < 2; ++h) v2[h][i] = (GATHER && last) ? vAn[h][i] : vAc[h][i];
            PG8_LDB(B0, 0, 0); PG8_LDB(B1, 0, 1); PG8_SCHED; PG8_LDA(At, 0, 0); PG8_STAGE(PG8_SA(1, 1), a1, vAc[1]);
            PG8_WAIT_V(8); PG8_WAIT_L(0); PG8_BAR; PG8_MMA(0, 0, At, B0); PG8_MMA(0, 1, At, B1); PG8_BAR; PG8_SCHED;
            PG8_LDA(At, 0, 1); PG8_STAGE(PG8_SB(0, 0), b2, voffB); PG8_STAGE(PG8_SB(0, 1), b2 + hstepB, voffB); PG8_STAGE(PG8_SA(0, 0), a2, v2[0]);
            PG8_WAIT_V(8); PG8_WAIT_L(0); PG8_BAR; PG8_MMA(1, 0, At, B0); PG8_MMA(1, 1, At, B1); PG8_BAR; PG8_SCHED;
            PG8_LDB(B0, 1, 0); PG8_LDB(B1, 1, 1); PG8_SCHED; PG8_LDA(At, 1, 0); PG8_STAGE(PG8_SA(0, 1), a2, v2[1]);
            PG8_WAIT_V(8); PG8_WAIT_L(0); PG8_BAR; PG8_MMA(0, 0, At, B0); PG8_MMA(0, 1, At, B1); PG8_BAR; PG8_SCHED;
            PG8_LDA(At, 1, 1); PG8_STAGE(PG8_SB(1, 0), b3, voffB); PG8_STAGE(PG8_SB(1, 1), b3 + hstepB, voffB); PG8_STAGE(PG8_SA(1, 0), a3, v2[0]);
            PG8_WAIT_V(8); PG8_WAIT_L(0); PG8_BAR; PG8_MMA(1, 0, At, B0); PG8_MMA(1, 1, At, B1); PG8_BAR; PG8_SCHED;
        }
        if (wr == 0) PG8_BAR;
        E(acc, cur, wr, wc, fr, fq);
        if (!has_next) break;
#pragma unroll
        for (int a = 0; a < 2; ++a)
#pragma unroll
            for (int b = 0; b < 2; ++b)
#pragma unroll
                for (int m = 0; m < 4; ++m)
#pragma unroll
                    for (int n = 0; n < 2; ++n) acc[a][b][m][n] = (f32x4){0.f, 0.f, 0.f, 0.f};
        cur = nxt; cA = nA; cB = nB; ++ui;
        if (GATHER) {
#pragma unroll
            for (int i = 0; i < 2; ++i)
#pragma unroll
                for (int h = 0; h < 2; ++h) vAc[h][i] = vAn[h][i];
        }
        if (wr == 1) PG8_BAR;
    }
    PG8_WAIT_V(0);
    PG8_BAR;
#undef PG8_SA
#undef PG8_SB
#undef PG8_STAGE
#undef PG8_LDA
#undef PG8_LDB
#undef PG8_MMA
#undef PG8_WAIT_V
#undef PG8_WAIT_L
#undef PG8_BAR
#undef PG8_SCHED
}
}

typedef f32x4 AccT[2][2][4][2];
__device__ __forceinline__ float sq4(const f32x4 v) { return (v.x * v.x + v.y * v.y) + (v.z * v.z + v.w * v.w); }
__device__ __forceinline__ u32x4 pack8(const f32x4 a, const f32x4 b) { u32x4 w; w.x = pg8::cvt_pk_bf16(a.x, a.y); w.y = pg8::cvt_pk_bf16(a.z, a.w); w.z = pg8::cvt_pk_bf16(b.x, b.y); w.w = pg8::cvt_pk_bf16(b.z, b.w); return w; }
__device__ __forceinline__ u32x2 pack4(const f32x4 a) { u32x2 w; w.x = pg8::cvt_pk_bf16(a.x, a.y); w.y = pg8::cvt_pk_bf16(a.z, a.w); return w; }

struct EpiInProj {
    static constexpr bool PERM = true;
    bf16_t* PROJ; float* DTRAW; float* SSQQ; float* SSQKV;
    __device__ __forceinline__ void operator()(const AccT& acc, const pg8::Unit& u, int wr, int wc, int fr, int fq) const {
        const int row0 = u.pm * 256 + wr * 64 + fr, col0 = u.pn * 256 + wc * 32 + 8 * fq;
#pragma unroll
        for (int ai = 0; ai < 2; ++ai)
#pragma unroll
            for (int m = 0; m < 4; ++m) {
                const int row = row0 + ai * 128 + m * 16;
                bf16_t* rowp = PROJ + (size_t)row * PROJ_N + col0;
#pragma unroll
                for (int bj = 0; bj < 2; ++bj) *(u32x4*)(rowp + bj * 128) = pack8(acc[ai][bj][m][0], acc[ai][bj][m][1]);
                if (u.pn == 0) {
                    float s = (sq4(acc[ai][0][m][0]) + sq4(acc[ai][0][m][1])) + (sq4(acc[ai][1][m][0]) + sq4(acc[ai][1][m][1]));
                    s += __shfl_xor(s, 16); s += __shfl_xor(s, 32);
                    if (fq == 0) SSQQ[row * 4 + wc] = s;
                } else if (u.pn == 1) {
                    float s = sq4(acc[ai][0][m][0]) + sq4(acc[ai][0][m][1]);
                    s += __shfl_xor(s, 16); s += __shfl_xor(s, 32);
                    if (fq == 0) SSQKV[row * 4 + wc] = s;
                    if (wc == 1 && fq < 2) { *(f32x4*)(DTRAW + row * 16 + 8 * fq) = acc[ai][1][m][0]; *(f32x4*)(DTRAW + row * 16 + 8 * fq + 4) = acc[ai][1][m][1]; }
                }
            }
    }
};
struct EpiQUp {
    static constexpr bool PERM = false;
    bf16_t* Q; const float* SSQQ; const float* COS; const float* SIN;
    __device__ __forceinline__ void operator()(const AccT& acc, const pg8::Unit& u, int wr, int wc, int fr, int fq) const {
#pragma unroll
        for (int ai = 0; ai < 2; ++ai) {
            asm volatile("" ::: "memory");
            f32x4 sv[4], cs[4], sn[4];
#pragma unroll
            for (int m = 0; m < 4; ++m) { const int row = u.pm * 256 + ai * 128 + wr * 64 + m * 16 + fr;
                sv[m] = *(const f32x4*)(SSQQ + row * 4); cs[m] = *(const f32x4*)(COS + row * 16 + 4 * fq); sn[m] = *(const f32x4*)(SIN + row * 16 + 4 * fq); }
#pragma unroll
            for (int m = 0; m < 4; ++m) {
                const int row = u.pm * 256 + ai * 128 + wr * 64 + m * 16 + fr, b = row / S, s = row % S;
                const float rs = 1.f / sqrtf(((sv[m].x + sv[m].y) + (sv[m].z + sv[m].w)) * (1.f / 256.f) + EPS);
#pragma unroll
                for (int bj = 0; bj < 2; ++bj) {
                    const int g32 = 8 * u.pn + 4 * bj + wc, h = g32 / 3, part = g32 % 3;
                    f32x4 v0 = acc[ai][bj][m][0] * rs, v1 = acc[ai][bj][m][1] * rs;
                    if (part == 2) { const f32x4 o0 = v0 * cs[m] - v1 * sn[m], o1 = v1 * cs[m] + v0 * sn[m]; v0 = o0; v1 = o1; }
                    bf16_t* qp = Q + ((size_t)(b * NH + h) * S + s) * DQK + part * 32 + 4 * fq;
                    *(u32x2*)qp = pack4(v0); *(u32x2*)(qp + 16) = pack4(v1);
                }
            }
        }
    }
};
struct EpiKVUp {
    static constexpr bool PERM = true;
    bf16_t* Kb; bf16_t* Vb; const float* SSQKV;
    __device__ __forceinline__ void operator()(const AccT& acc, const pg8::Unit& u, int wr, int wc, int fr, int fq) const {
        f32x4 svv[2][4];
#pragma unroll
        for (int ai = 0; ai < 2; ++ai)
#pragma unroll
            for (int m = 0; m < 4; ++m) svv[ai][m] = *(const f32x4*)(SSQKV + (u.pm * 256 + ai * 128 + wr * 64 + m * 16 + fr) * 4);
#pragma unroll
        for (int ai = 0; ai < 2; ++ai)
#pragma unroll
            for (int m = 0; m < 4; ++m) {
                const int row = u.pm * 256 + ai * 128 + wr * 64 + m * 16 + fr, b = row / S, s = row % S;
                const f32x4 sv = svv[ai][m];
                const float rs = 1.f / sqrtf(((sv.x + sv.y) + (sv.z + sv.w)) * (1.f / 128.f) + EPS);
#pragma unroll
                for (int bj = 0; bj < 2; ++bj) {
                    const int h = 2 * u.pn + bj; const size_t tile = (size_t)(b * NH + h) * (S / 64) + (s >> 6);
                    const u32x4 w = pack8(acc[ai][bj][m][0] * rs, acc[ai][bj][m][1] * rs);
                    if (wc < 2) *(u32x4*)(Kb + (tile * 12 + 4 * wc + fq) * 512 + (s & 63) * 8) = w;
                    else *(u32x4*)(Vb + (tile * 16 + (wc - 2) * 8 + ((s & 63) >> 3)) * 256 + (s & 7) * 32 + 8 * fq) = w;
                }
            }
    }
};
struct EpiResid {
    static constexpr bool PERM = true;
    const float* base; bf16_t* X1; float* SSQ;
    __device__ __forceinline__ void operator()(const AccT& acc, const pg8::Unit& u, int wr, int wc, int fr, int fq) const {
#pragma unroll
        for (int ai = 0; ai < 2; ++ai) {
            asm volatile("" ::: "memory");
            f32x4 xv[4][2][2];
#pragma unroll
            for (int m = 0; m < 4; ++m)
#pragma unroll
                for (int bj = 0; bj < 2; ++bj) { const size_t o = (size_t)(u.pm * 256 + ai * 128 + wr * 64 + m * 16 + fr) * D + u.pn * 256 + wc * 32 + 8 * fq + bj * 128;
                    xv[m][bj][0] = *(const f32x4*)(base + o); xv[m][bj][1] = *(const f32x4*)(base + o + 4); }
#pragma unroll
            for (int m = 0; m < 4; ++m) {
                const int row = u.pm * 256 + ai * 128 + wr * 64 + m * 16 + fr;
                const size_t ro = (size_t)row * D + u.pn * 256 + wc * 32 + 8 * fq;
                float s = 0.f;
#pragma unroll
                for (int bj = 0; bj < 2; ++bj) { const f32x4 v0 = xv[m][bj][0] + acc[ai][bj][m][0], v1 = xv[m][bj][1] + acc[ai][bj][m][1];
                    *(u32x4*)(X1 + ro + bj * 128) = pack8(v0, v1); s += sq4(v0) + sq4(v1); }
                s += __shfl_xor(s, 16); s += __shfl_xor(s, 32);
                if (fq == 0) SSQ[row * 16 + u.pn * 4 + wc] = s;
            }
        }
    }
};
struct EpiPleProj {
    static constexpr bool PERM = true;
    bf16_t* O; float* SSQ;
    __device__ __forceinline__ void operator()(const AccT& acc, const pg8::Unit& u, int wr, int wc, int fr, int fq) const {
#pragma unroll
        for (int ai = 0; ai < 2; ++ai)
#pragma unroll
            for (int m = 0; m < 4; ++m) {
                const int row = u.pm * 256 + ai * 128 + wr * 64 + m * 16 + fr;
                bf16_t* rowp = O + (size_t)row * D + u.pn * 256 + wc * 32 + 8 * fq;
#pragma unroll
                for (int bj = 0; bj < 2; ++bj) *(u32x4*)(rowp + bj * 128) = pack8(acc[ai][bj][m][0], acc[ai][bj][m][1]);
                float s = (sq4(acc[ai][0][m][0]) + sq4(acc[ai][0][m][1])) + (sq4(acc[ai][1][m][0]) + sq4(acc[ai][1][m][1]));
                s += __shfl_xor(s, 16); s += __shfl_xor(s, 32);
                if (fq == 0) SSQ[row * 16 + u.pn * 4 + wc] = s;
            }
    }
};
struct EpiPleGate {
    static constexpr bool PERM = true;
    bf16_t* G; const bf16_t* PR; const float* RSTDP; const float* bias; const float* wpost;
    __device__ __forceinline__ void operator()(const AccT& acc, const pg8::Unit& u, int wr, int wc, int fr, int fq) const {
        f32x4 bv[2][2], wv[2][2];
#pragma unroll
        for (int bj = 0; bj < 2; ++bj)
#pragma unroll
            for (int n = 0; n < 2; ++n) { const int col = u.pn * 256 + bj * 128 + wc * 32 + 8 * fq + 4 * n; bv[bj][n] = *(const f32x4*)(bias + col); wv[bj][n] = *(const f32x4*)(wpost + col); }
#pragma unroll
        for (int ai = 0; ai < 2; ++ai) {
            asm volatile("" ::: "memory");
            u32x4 pr[4][2]; float rsv[4];
#pragma unroll
            for (int m = 0; m < 4; ++m) { const int row = u.pm * 256 + ai * 128 + wr * 64 + m * 16 + fr; rsv[m] = RSTDP[row];
#pragma unroll
                for (int bj = 0; bj < 2; ++bj) pr[m][bj] = *(const u32x4*)(PR + (size_t)row * D + u.pn * 256 + bj * 128 + wc * 32 + 8 * fq); }
#pragma unroll
            for (int m = 0; m < 4; ++m) {
                const int row = u.pm * 256 + ai * 128 + wr * 64 + m * 16 + fr;
                const float rs = rsv[m];
#pragma unroll
                for (int bj = 0; bj < 2; ++bj) {
                    const unsigned pw[4] = {pr[m][bj].x, pr[m][bj].y, pr[m][bj].z, pr[m][bj].w};
                    f32x4 o[2];
#pragma unroll
                    for (int n = 0; n < 2; ++n) {
                        const f32x4 av = acc[ai][bj][m][n] + bv[bj][n];
                        const f32x4 pl = (f32x4){bf2f(pw[2 * n] & 0xffffu), bf2f(pw[2 * n] >> 16), bf2f(pw[2 * n + 1] & 0xffffu), bf2f(pw[2 * n + 1] >> 16)} * rs * wv[bj][n];
#pragma unroll
                        for (int j = 0; j < 4; ++j) o[n][j] = pl[j] / (1.f + __expf(-av[j]));
                    }
                    *(u32x4*)(G + (size_t)row * D + u.pn * 256 + bj * 128 + wc * 32 + 8 * fq) = pack8(o[0], o[1]);
                }
            }
        }
    }
};

struct GroupSched {
    const volatile LAS unsigned* ptile; int npn, G, c;
    __device__ __forceinline__ bool next(int i, pg8::Unit& u) const {
        const int L = i * G + c, total = (int)ptile[32] * npn; if (L >= total) return false;
        int e = 0;
        for (int q = 1; q < 32; ++q) e = (L >= (int)ptile[q] * npn) ? q : e;
        const int l = L - (int)ptile[e] * npn;
        u.pm = __builtin_amdgcn_readfirstlane((int)ptile[e] + l / npn); u.pn = __builtin_amdgcn_readfirstlane(e * npn + l % npn); return true;
    }
};
struct EpiMoeGU {
    static constexpr bool PERM = true;
    bf16_t* HE;
    __device__ __forceinline__ void operator()(const AccT& acc, const pg8::Unit& u, int wr, int wc, int fr, int fq) const {
        const int pn_l = u.pn & 1;
#pragma unroll
        for (int ai = 0; ai < 2; ++ai)
#pragma unroll
            for (int m = 0; m < 4; ++m) {
                const size_t row = (size_t)u.pm * 256 + ai * 128 + wr * 64 + m * 16 + fr;
                f32x4 h0, h1;
#pragma unroll
                for (int j = 0; j < 4; ++j) { const float g0 = acc[ai][0][m][0][j], g1 = acc[ai][0][m][1][j];
                    h0[j] = g0 / (1.f + __expf(-g0)) * acc[ai][1][m][0][j]; h1[j] = g1 / (1.f + __expf(-g1)) * acc[ai][1][m][1][j]; }
                *(u32x4*)(HE + row * 256 + pn_l * 128 + wc * 32 + 8 * fq) = pack8(h0, h1);
            }
    }
};
struct EpiMoeDown {
    static constexpr bool PERM = true;
    bf16_t* Y; const int* BUCKET; const float* ROUTE; const volatile LAS unsigned* ptile; const volatile LAS unsigned* cnt;
    __device__ __forceinline__ void operator()(const AccT& acc, const pg8::Unit& u, int wr, int wc, int fr, int fq) const {
        const int e = u.pn >> 2, pn_l = u.pn & 3, pm_l = u.pm - (int)ptile[e], n_e = (int)cnt[e];
        int entv[2][4]; float wvv[2][4];
#pragma unroll
        for (int ai = 0; ai < 2; ++ai)
#pragma unroll
            for (int m = 0; m < 4; ++m) { const int idx = pm_l * 256 + ai * 128 + wr * 64 + m * 16 + fr; entv[ai][m] = idx < n_e ? BUCKET[(size_t)e * T + idx] : 0; }
#pragma unroll
        for (int ai = 0; ai < 2; ++ai)
#pragma unroll
            for (int m = 0; m < 4; ++m) wvv[ai][m] = ROUTE[(entv[ai][m] >> 1) * 4 + 2 + (entv[ai][m] & 1)];
#pragma unroll
        for (int ai = 0; ai < 2; ++ai)
#pragma unroll
            for (int m = 0; m < 4; ++m) {
                const int idx = pm_l * 256 + ai * 128 + wr * 64 + m * 16 + fr;
                if (idx < n_e) {
                    const int ent = entv[ai][m];
                    const float w = wvv[ai][m];
                    bf16_t* yp = Y + (size_t)ent * D + pn_l * 256 + wc * 32 + 8 * fq;
#pragma unroll
                    for (int bj = 0; bj < 2; ++bj) *(u32x4*)(yp + bj * 128) = pack8(acc[ai][bj][m][0] * w, acc[ai][bj][m][1] * w);
                }
            }
    }
};

template <class CM, class GN>
__device__ __forceinline__ void transpose_item(const float* W, int ldw, int K, bf16_t* WT, float* scr, int kb, int nb, int lane, CM cm, GN gain) {
    const int k0 = 64 * kb, n0 = 32 * nb;
    const int sc = cm(n0 + (lane & 31));
    float tv[32];
#pragma unroll
    for (int i = 0; i < 32; ++i) { const int kk = 2 * i + (lane >> 5); tv[i] = sc >= 0 ? W[(size_t)(k0 + kk) * ldw + sc] : 0.f; }
#pragma unroll
    for (int i = 0; i < 32; ++i) { const int kk = 2 * i + (lane >> 5); scr[kk * 33 + (lane & 31)] = tv[i] * gain(k0 + kk); }
    asm volatile("s_waitcnt lgkmcnt(0)" ::: "memory");
    const int c = lane & 7;
#pragma unroll
    for (int j = 0; j < 4; ++j) { const int n = (lane >> 3) + 8 * j; const float* s = scr + (8 * c) * 33 + n;
        u32x4 o; o.x = pk2(s[0 * 33], s[1 * 33]); o.y = pk2(s[2 * 33], s[3 * 33]); o.z = pk2(s[4 * 33], s[5 * 33]); o.w = pk2(s[6 * 33], s[7 * 33]);
        *(u32x4*)(WT + (size_t)(n0 + n) * K + k0 + 8 * c) = o; }
    asm volatile("s_waitcnt lgkmcnt(0)" ::: "memory");
}


namespace att {
typedef short bf16x8 __attribute__((ext_vector_type(8)));
typedef short s16x4 __attribute__((ext_vector_type(4)));
typedef float f32x16 __attribute__((ext_vector_type(16)));
typedef short v4i16_t __attribute__((ext_vector_type(4)));
typedef float f32x2_t __attribute__((ext_vector_type(2))); typedef __bf16 bf16x2_t __attribute__((ext_vector_type(2)));
constexpr int KT = 64, NT = S / KT, KBYTES = KT * DQK * 2, VBYTES = KT * DV * 2, STAGE = KBYTES + VBYTES;
__device__ __forceinline__ unsigned cvtpk(float lo, float hi) { f32x2_t v = {lo, hi}; bf16x2_t b = __builtin_convertvector(v, bf16x2_t); return __builtin_bit_cast(unsigned, b); }
__device__ __forceinline__ s16x4 vtr(const LAS unsigned char* p) { return __builtin_bit_cast(s16x4, __builtin_amdgcn_ds_read_tr16_b64_v4i16((LAS v4i16_t*)p)); }
__device__ __forceinline__ float half_max(float m) { auto rr = __builtin_amdgcn_permlane32_swap(__float_as_uint(m), __float_as_uint(m), false, false); return fmaxf(__uint_as_float(rr[0]), __uint_as_float(rr[1])); }
__device__ __forceinline__ float half_sum(float m) { auto rr = __builtin_amdgcn_permlane32_swap(__float_as_uint(m), __float_as_uint(m), false, false); return __uint_as_float(rr[0]) + __uint_as_float(rr[1]); }

constexpr int KRING = 0, VRING = 4 * KBYTES, ATT_THR = 8;
__device__ __forceinline__ void attn_unit(LAS unsigned char* lds, const bf16_t* Qg, const bf16_t* Kg, const bf16_t* Vg, bf16_t* MIXg, int bh, int qb) {
    int tid = threadIdx.x; asm volatile("" : "+v"(tid));
    const int lane = tid & 63, wid = __builtin_amdgcn_readfirstlane(tid >> 6), r32 = lane & 31, hi = lane >> 5;
    const size_t rowbase = (size_t)bh * S;
    const bf16_t* qrow = Qg + (rowbase + qb * 256 + wid * 32 + r32) * DQK + 8 * hi;
    bf16x8 qf[6];
#pragma unroll
    for (int ds = 0; ds < 6; ++ds) qf[ds] = *(const bf16x8*)(qrow + ds * 16);
    const char* ksrc0 = (const char*)(Kg + rowbase * DQK) + wid * 1024 + lane * 16;
    const char* ksrc1 = ksrc0 + 8 * 1024;
    const char* vsrc = (const char*)(Vg + rowbase * DV) + wid * 1024 + lane * 16;
#define ATT_DMA_K(t, slot) do { \
        __builtin_amdgcn_global_load_lds((const unsigned*)(ksrc0 + (size_t)(t) * (KT * DQK * 2)), (LAS unsigned*)(lds + KRING + (slot) * KBYTES + wid * 1024), 16, 0, 0); \
        if (wid < 4) __builtin_amdgcn_global_load_lds((const unsigned*)(ksrc1 + (size_t)(t) * (KT * DQK * 2)), (LAS unsigned*)(lds + KRING + (slot) * KBYTES + (wid + 8) * 1024), 16, 0, 0); } while (0)
#define ATT_DMA_V(t, slot) __builtin_amdgcn_global_load_lds((const unsigned*)(vsrc + (size_t)(t) * (KT * DV * 2)), (LAS unsigned*)(lds + VRING + (slot) * VBYTES + wid * 1024), 16, 0, 0)
#define ATT_SYNC() do { asm volatile("s_waitcnt vmcnt(0) lgkmcnt(0)" ::: "memory"); __builtin_amdgcn_s_barrier(); __builtin_amdgcn_sched_barrier(0); } while (0)
#define ATT_SYNCN(tau) do { if ((tau) + 2 < NT) { if (g0) asm volatile("s_waitcnt vmcnt(3) lgkmcnt(0)" ::: "memory"); else asm volatile("s_waitcnt vmcnt(2) lgkmcnt(0)" ::: "memory"); } \
        else asm volatile("s_waitcnt vmcnt(0) lgkmcnt(0)" ::: "memory"); __builtin_amdgcn_s_barrier(); __builtin_amdgcn_sched_barrier(0); } while (0)
    const int koff = KRING + hi * 1024 + r32 * 16;
    const int voff = VRING + (4 * hi + ((lane & 15) >> 2)) * 64 + ((lane >> 4) & 1) * 32 + (lane & 3) * 8;
    f32x16 o0 = {}, o1 = {}, negm = {};
    float mref = 0.f, lpart = 0.f;
    f32x16 sA0, sA1, sB0, sB1;
    u32x4 pw[4];
    bf16x8 kf[12], vf[8];
#define ATT_SB() __builtin_amdgcn_sched_barrier(0)
#define ATT_LOADK(kslot) do { const LAS unsigned char* kb_ = lds + koff + (kslot) * KBYTES; \
        _Pragma("unroll") for (int ds = 0; ds < 6; ++ds) { kf[2 * ds] = *(const LAS bf16x8*)(kb_ + ds * 2048); kf[2 * ds + 1] = *(const LAS bf16x8*)(kb_ + ds * 2048 + 512); } } while (0)
#define ATT_LOADV(vslot) do { const LAS unsigned char* vb_ = lds + voff + (vslot) * VBYTES; \
        _Pragma("unroll") for (int ks = 0; ks < 4; ++ks) { \
            const s16x4 a0_ = vtr(vb_ + (2 * ks) * 512), a1_ = vtr(vb_ + (2 * ks + 1) * 512), b0_ = vtr(vb_ + (8 + 2 * ks) * 512), b1_ = vtr(vb_ + (8 + 2 * ks + 1) * 512); \
            vf[2 * ks] = (bf16x8){a0_[0], a0_[1], a0_[2], a0_[3], a1_[0], a1_[1], a1_[2], a1_[3]}; \
            vf[2 * ks + 1] = (bf16x8){b0_[0], b0_[1], b0_[2], b0_[3], b1_[0], b1_[1], b1_[2], b1_[3]}; } } while (0)
#define ATT_QK(X0, X1) do { \
        X0 = __builtin_amdgcn_mfma_f32_32x32x16_bf16(kf[0], qf[0], negm, 0, 0, 0); X1 = __builtin_amdgcn_mfma_f32_32x32x16_bf16(kf[1], qf[0], negm, 0, 0, 0); \
        _Pragma("unroll") for (int ds = 1; ds < 6; ++ds) { X0 = __builtin_amdgcn_mfma_f32_32x32x16_bf16(kf[2 * ds], qf[ds], X0, 0, 0, 0); X1 = __builtin_amdgcn_mfma_f32_32x32x16_bf16(kf[2 * ds + 1], qf[ds], X1, 0, 0, 0); } } while (0)
#define ATT_PV() do { \
        _Pragma("unroll") for (int ks = 0; ks < 4; ++ks) { const bf16x8 pf_ = __builtin_bit_cast(bf16x8, pw[ks]); \
            o0 = __builtin_amdgcn_mfma_f32_32x32x16_bf16(vf[2 * ks], pf_, o0, 0, 0, 0); o1 = __builtin_amdgcn_mfma_f32_32x32x16_bf16(vf[2 * ks + 1], pf_, o1, 0, 0, 0); } } while (0)
#define ATT_MAXPHASE(X0, X1, FIRST) do { \
        float mx_ = fmaxf(fmaxf(X0[0], X0[1]), X1[0]); float my_ = fmaxf(fmaxf(X0[2], X0[3]), X1[1]); mx_ = fmaxf(fmaxf(mx_, X1[2]), X1[3]); \
        _Pragma("unroll") for (int r = 4; r < 16; r += 4) { mx_ = fmaxf(fmaxf(mx_, X0[r]), X0[r + 1]); my_ = fmaxf(fmaxf(my_, X0[r + 2]), X0[r + 3]); mx_ = fmaxf(fmaxf(mx_, X1[r]), X1[r + 1]); my_ = fmaxf(fmaxf(my_, X1[r + 2]), X1[r + 3]); } \
        mx_ = half_max(fmaxf(mx_, my_)); \
        if ((FIRST) || __builtin_expect(__any(mx_ > (float)ATT_THR), 0)) { \
            asm volatile("; rescale (rare)" ::: "memory"); const float dl_ = (FIRST) ? mx_ : fmaxf(mx_, 0.f); mref += dl_; const float f_ = (FIRST) ? 1.f : __builtin_amdgcn_exp2f(-dl_); \
            _Pragma("unroll") for (int r = 0; r < 16; ++r) { X0[r] -= dl_; X1[r] -= dl_; o0[r] *= f_; o1[r] *= f_; negm[r] = -mref; } \
            lpart *= f_; asm volatile("" : "+v"(negm)); } } while (0)
#define ATT_EXPPHASE(X0, X1) do { float ls_ = 0.f; \
        _Pragma("unroll") for (int r = 0; r < 16; ++r) { X0[r] = __builtin_amdgcn_exp2f(X0[r]); X1[r] = __builtin_amdgcn_exp2f(X1[r]); ls_ += X0[r] + X1[r]; } \
        lpart += ls_; \
        _Pragma("unroll") for (int s = 0; s < 2; ++s) { \
            pw[s] = (u32x4){cvtpk(X0[8 * s], X0[8 * s + 1]), cvtpk(X0[8 * s + 2], X0[8 * s + 3]), cvtpk(X0[8 * s + 4], X0[8 * s + 5]), cvtpk(X0[8 * s + 6], X0[8 * s + 7])}; \
            pw[2 + s] = (u32x4){cvtpk(X1[8 * s], X1[8 * s + 1]), cvtpk(X1[8 * s + 2], X1[8 * s + 3]), cvtpk(X1[8 * s + 4], X1[8 * s + 5]), cvtpk(X1[8 * s + 6], X1[8 * s + 7])}; } } while (0)
#define ATT_ISSUE(t) do { if ((t) + 3 < NT) ATT_DMA_K((t) + 3, ((t) + 3) & 3); if ((t) + 2 < NT) ATT_DMA_V((t) + 2, ((t) + 2) & 3); } while (0)

    const bool g0 = wid < 4;
#define ATT_X(C0, C1, t) do { ATT_LOADV(((t) - 1) & 3); ATT_SB(); ATT_PV(); ATT_SB(); ATT_MAXPHASE(C0, C1, false); ATT_SB(); } while (0)
#define ATT_Y(C0, C1, N0, N1, t) do { ATT_LOADK(((t) + 1) & 3); ATT_SB(); ATT_EXPPHASE(C0, C1); ATT_SB(); ATT_QK(N0, N1); ATT_SB(); } while (0)
    ATT_DMA_K(0, 0); ATT_DMA_V(0, 0); ATT_DMA_K(1, 1);
    ATT_SYNC();
    ATT_DMA_K(2, 2); ATT_DMA_V(1, 1);
    ATT_LOADK(0); ATT_QK(sA0, sA1);
    ATT_SYNC();
    ATT_ISSUE(0);
    ATT_MAXPHASE(sA0, sA1, true);
    if (!g0) { ATT_SYNCN(1); ATT_ISSUE(1); }
    ATT_Y(sA0, sA1, sB0, sB1, 0);
    for (int t = 1; t + 2 < NT; t += 2) {
        if (g0) { ATT_SYNCN(t); ATT_ISSUE(t); }
        ATT_X(sB0, sB1, t);
        if (!g0) { ATT_SYNCN(t + 1); ATT_ISSUE(t + 1); }
        ATT_Y(sB0, sB1, sA0, sA1, t);
        if (g0) { ATT_SYNCN(t + 1); ATT_ISSUE(t + 1); }
        ATT_X(sA0, sA1, t + 1);
        if (!g0) { ATT_SYNCN(t + 2); ATT_ISSUE(t + 2); }
        ATT_Y(sA0, sA1, sB0, sB1, t + 1);
    }
    if (g0) { ATT_SYNCN(NT - 1); }
    ATT_X(sB0, sB1, NT - 1);
    ATT_EXPPHASE(sB0, sB1);
    ATT_LOADV((NT - 1) & 3); ATT_PV();
#undef ATT_X
#undef ATT_Y
    const float rl = 1.f / half_sum(lpart);
    const int b = bh >> 3, h = bh & 7;
    bf16_t* orow = MIXg + ((size_t)b * S + qb * 256 + wid * 32 + r32) * D + h * 64 + 4 * hi;
#pragma unroll
    for (int g4 = 0; g4 < 4; ++g4) {
        u32x2 w0, w1;
        w0.x = cvtpk(o0[4 * g4] * rl, o0[4 * g4 + 1] * rl); w0.y = cvtpk(o0[4 * g4 + 2] * rl, o0[4 * g4 + 3] * rl);
        w1.x = cvtpk(o1[4 * g4] * rl, o1[4 * g4 + 1] * rl); w1.y = cvtpk(o1[4 * g4 + 2] * rl, o1[4 * g4 + 3] * rl);
        *(u32x2*)(orow + 8 * g4) = w0; *(u32x2*)(orow + 32 + 8 * g4) = w1;
    }
    asm volatile("s_waitcnt lgkmcnt(0)" ::: "memory"); __builtin_amdgcn_s_barrier();
#undef ATT_DMA_K
#undef ATT_DMA_V
#undef ATT_SYNC
#undef ATT_QK
#undef ATT_PV
#undef ATT_MAXPHASE
#undef ATT_EXPPHASE
#undef ATT_SYNCN
#undef ATT_LOADK
#undef ATT_LOADV
#undef ATT_SB
#undef ATT_ISSUE
}
}


namespace ssd {
typedef short bf16x8 __attribute__((ext_vector_type(8)));
typedef short bf16x4 __attribute__((ext_vector_type(4)));
typedef float f32x16 __attribute__((ext_vector_type(16)));
constexpr int CH = 128, NCH = S / CH;
constexpr float LOG2E = 1.4426950408889634f;
__device__ __forceinline__ int crow(int r, int hi) { return (r & 3) + 8 * (r >> 2) + 4 * hi; }
__device__ __forceinline__ unsigned cvtpk(float lo, float hi) { return att::cvtpk(lo, hi); }
__device__ __forceinline__ void scan128(float a0, float a1, int lane, float& p0, float& p1, float& tot) {
    float s = a0 + a1;
#pragma unroll
    for (int o = 1; o < 64; o <<= 1) { const float t = __shfl_up(s, o); if (lane >= o) s += t; }
    tot = __shfl(s, 63); p1 = s; p0 = s - a1;
}
__device__ __forceinline__ void conv_chunk(float* smf, const bf16_t* PROJ, const float* cw, const float* cb, bf16_t* XBCC, bf16_t* XT, bf16_t* BT,
                                           const float* DTRAW, const float* dtb, float* DT, int b, int c) {
    int tid = threadIdx.x; asm volatile("" : "+v"(tid));
    const int t0 = b * S + c * CH, s0 = c * CH;
    if (tid < 2048 / 4) {
        const f32x4 raw = *(const f32x4*)(DTRAW + (size_t)t0 * 16 + tid * 4); const f32x4 bb = *(const f32x4*)(dtb + ((tid * 4) & 15)); f32x4 o;
#pragma unroll
        for (int j = 0; j < 4; ++j) { const float v = raw[j] + bb[j]; o[j] = v > 20.f ? v : log1pf(expf(v)); }
        *(f32x4*)(DT + (size_t)t0 * 16 + tid * 4) = o;
    }
    const int ch = tid & 127, lq = tid >> 7;
    for (int cbk = 0; cbk < 6; ++cbk) {
        __syncthreads();
        {
            u32x4 v[5];
#pragma unroll
            for (int q = 0; q < 5; ++q) { const int i = tid + q * 512, r = i >> 4, c8 = (i & 15) * 8, ss = s0 - 2 + r;
                v[q] = (u32x4){0u, 0u, 0u, 0u};
                if (i < 132 * 16 && ss >= 0 && ss < S) v[q] = *(const u32x4*)(PROJ + (size_t)(b * S + ss) * PROJ_N + PC_XBC + cbk * 128 + c8); }
#pragma unroll
            for (int q = 0; q < 5; ++q) { const int i = tid + q * 512, r = i >> 4, c8 = (i & 15) * 8;
                if (i < 132 * 16) { float* d = smf + r * 128 + c8;
                    d[0] = bf2f(v[q].x & 0xffffu); d[1] = bf2f(v[q].x >> 16); d[2] = bf2f(v[q].y & 0xffffu); d[3] = bf2f(v[q].y >> 16);
                    d[4] = bf2f(v[q].z & 0xffffu); d[5] = bf2f(v[q].z >> 16); d[6] = bf2f(v[q].w & 0xffffu); d[7] = bf2f(v[q].w >> 16); } }
        }
        __syncthreads();
        const int gch = cbk * 128 + ch;
        float w[5];
#pragma unroll
        for (int k = 0; k < 5; ++k) w[k] = cw[k * XBC + gch];
        const float bias = cb[gch];
        unsigned pk[16];
        float x0 = smf[(lq * 32 + 0) * 128 + ch], x1 = smf[(lq * 32 + 1) * 128 + ch], x2 = smf[(lq * 32 + 2) * 128 + ch], x3 = smf[(lq * 32 + 3) * 128 + ch];
        float prev = 0.f;
#pragma unroll
        for (int l = 0; l < 32; ++l) {
            const float x4 = smf[(lq * 32 + l + 4) * 128 + ch];
            const float acc = bias + w[0] * x0 + w[1] * x1 + w[2] * x2 + w[3] * x3 + w[4] * x4;
            const float v = acc / (1.f + __expf(-acc));
            XBCC[(size_t)(t0 + lq * 32 + l) * XBC + gch] = (bf16_t)f2bf(v);
            if (l & 1) pk[l >> 1] = pk2(prev, v); else prev = v;
            x0 = x1; x1 = x2; x2 = x3; x3 = x4;
        }
        if (cbk < 5) {
            bf16_t* dst = cbk < 4 ? XT + ((size_t)(b * NCH + c) * 512 + gch) * CH + lq * 32 : BT + ((size_t)(b * NCH + c) * 128 + ch) * CH + lq * 32;
#pragma unroll
            for (int q = 0; q < 4; ++q) *(u32x4*)(dst + q * 8) = (u32x4){pk[4 * q], pk[4 * q + 1], pk[4 * q + 2], pk[4 * q + 3]};
        }
    }
    __syncthreads();
}
__device__ __forceinline__ void states_chunk(float* wtab_all, const bf16_t* XT, const bf16_t* BT, const float* DT, const float* alog, float* STATES, float* CDEC, int b, int c) {
    int tid = threadIdx.x; asm volatile("" : "+v"(tid));
    const int lane = tid & 63, hd = __builtin_amdgcn_readfirstlane(tid >> 6), g = hd >> 2, r32 = lane & 31, hi = lane >> 5;
    float* wtab = wtab_all + hd * 128;
    const size_t t0 = (size_t)b * S + c * CH;
    const bf16_t* xt = XT + ((size_t)(b * NCH + c) * 512 + hd * 64) * CH; const bf16_t* bt = BT + ((size_t)(b * NCH + c) * 128 + g * 64) * CH;
    for (int dir = 0; dir < 2; ++dir) {
        const float av = -expf(alog[dir * 8 + hd]);
        const float d0 = DT[(t0 + 2 * lane) * 16 + dir * 8 + hd], d1 = DT[(t0 + 2 * lane + 1) * 16 + dir * 8 + hd];
        float p0, p1, tot; scan128(d0 * av, d1 * av, lane, p0, p1, tot);
        const float w0 = dir == 0 ? __expf(tot - p0) * d0 : __expf(p0 - d0 * av) * d0;
        const float w1 = dir == 0 ? __expf(tot - p1) * d1 : __expf(p1 - d1 * av) * d1;
        wtab[2 * lane] = w0; wtab[2 * lane + 1] = w1;
        if (lane == 0) CDEC[((b * NCH + c) * 2 + dir) * 8 + hd] = __expf(tot);
        asm volatile("s_waitcnt lgkmcnt(0)" ::: "memory");
        f32x16 acc[2][2];
#pragma unroll
        for (int i = 0; i < 2; ++i)
#pragma unroll
            for (int j = 0; j < 2; ++j) acc[i][j] = (f32x16){};
#pragma unroll 4
        for (int ks = 0; ks < 8; ++ks) {
            const f32x4 wa = *(const f32x4*)(wtab + 16 * ks + 8 * hi), wb = *(const f32x4*)(wtab + 16 * ks + 8 * hi + 4);
            bf16x8 xb[2], bb[2];
#pragma unroll
            for (int pb = 0; pb < 2; ++pb) {
                const u32x4 v = *(const u32x4*)(xt + (size_t)(32 * pb + r32) * CH + 16 * ks + 8 * hi);
                u32x4 o; o.x = cvtpk(bf2f(v.x & 0xffffu) * wa.x, bf2f(v.x >> 16) * wa.y); o.y = cvtpk(bf2f(v.y & 0xffffu) * wa.z, bf2f(v.y >> 16) * wa.w);
                o.z = cvtpk(bf2f(v.z & 0xffffu) * wb.x, bf2f(v.z >> 16) * wb.y); o.w = cvtpk(bf2f(v.w & 0xffffu) * wb.z, bf2f(v.w >> 16) * wb.w);
                xb[pb] = __builtin_bit_cast(bf16x8, o);
            }
#pragma unroll
            for (int nb = 0; nb < 2; ++nb) bb[nb] = *(const bf16x8*)(bt + (size_t)(32 * nb + r32) * CH + 16 * ks + 8 * hi);
#pragma unroll
            for (int nb = 0; nb < 2; ++nb)
#pragma unroll
                for (int pb = 0; pb < 2; ++pb) acc[nb][pb] = __builtin_amdgcn_mfma_f32_32x32x16_bf16(bb[nb], xb[pb], acc[nb][pb], 0, 0, 0);
        }
        float* st = STATES + ((size_t)((b * NCH + c) * 2 + dir) * 8 + hd) * 4096;
#pragma unroll
        for (int nb = 0; nb < 2; ++nb)
#pragma unroll
            for (int pb = 0; pb < 2; ++pb)
#pragma unroll
                for (int q = 0; q < 4; ++q)
                    *(f32x4*)(st + (32 * pb + r32) * 64 + 32 * nb + 8 * q + 4 * hi) = (f32x4){acc[nb][pb][4 * q], acc[nb][pb][4 * q + 1], acc[nb][pb][4 * q + 2], acc[nb][pb][4 * q + 3]};
    }
}
__device__ __forceinline__ void finalize_chunk(float* smf, const bf16_t* XBCC, const bf16_t* XT, const bf16_t* PROJ, const float* DT, const float* alog, const bf16_t* HPB,
                                               const float* ssdd, const float* ssdnw, bf16_t* MIX, int b, int c) {
    int tid = threadIdx.x; asm volatile("" : "+v"(tid));
    const int lane = tid & 63, hd = __builtin_amdgcn_readfirstlane(tid >> 6), g = hd >> 2, r32 = lane & 31, hi = lane >> 5;
    f32x4* tab = (f32x4*)smf + hd * 128;
    float* red = smf + 8 * 128 * 4;
    const size_t t0 = (size_t)b * S + c * CH;
    {
        const float af = -expf(alog[hd]), ab = -expf(alog[8 + hd]);
        const float f0 = DT[(t0 + 2 * lane) * 16 + hd], f1 = DT[(t0 + 2 * lane + 1) * 16 + hd];
        const float b0 = DT[(t0 + 2 * lane) * 16 + 8 + hd], b1 = DT[(t0 + 2 * lane + 1) * 16 + 8 + hd];
        float pf0, pf1, tf, pb0, pb1, tb;
        scan128(f0 * af, f1 * af, lane, pf0, pf1, tf); scan128(b0 * ab, b1 * ab, lane, pb0, pb1, tb);
        tab[2 * lane] = (f32x4){pf0, f0, tb - (pb0 - b0 * ab), b0}; tab[2 * lane + 1] = (f32x4){pf1, f1, tb - (pb1 - b1 * ab), b1};
        asm volatile("s_waitcnt lgkmcnt(0)" ::: "memory");
    }
    const bf16_t* xt = XT + ((size_t)(b * NCH + c) * 512 + hd * 64) * CH + (size_t)r32 * CH + 4 * hi;
    const bf16_t* brow = XBCC + (t0 + r32) * XBC + 512 + g * 64 + 8 * hi;
    const bf16_t* hpb = HPB + ((size_t)((b * NCH + c) * 2) * 8 + hd) * 4096 + (size_t)r32 * 64 + 8 * hi;
    const float dsk = ssdd[hd];
#define FIN_LOADB(dst, jb) do { _Pragma("unroll") for (int ks = 0; ks < 4; ++ks) dst[ks] = *(const bf16x8*)(brow + (size_t)(jb) * 32 * XBC + 16 * ks); } while (0)
#define FIN_LOADX(dst, jb) do { _Pragma("unroll") for (int s = 0; s < 2; ++s) _Pragma("unroll") for (int pb = 0; pb < 2; ++pb) { \
        const bf16_t* xp_ = xt + (size_t)pb * 32 * CH + 32 * (jb) + 16 * s; const u32x2 lo_ = *(const u32x2*)xp_, hi_ = *(const u32x2*)(xp_ + 8); \
        dst[2 * s + pb] = __builtin_bit_cast(bf16x8, (u32x4){lo_.x, lo_.y, hi_.x, hi_.y}); } } while (0)
#define FIN_LOADH(dst, dir) do { _Pragma("unroll") for (int ks = 0; ks < 4; ++ks) _Pragma("unroll") for (int pb = 0; pb < 2; ++pb) \
        dst[2 * ks + pb] = *(const bf16x8*)(hpb + (size_t)(dir) * 8 * 4096 + pb * 32 * 64 + 16 * ks); } while (0)
#define FIN_TILE(jb, bfr, xf) do { \
        f32x16 gt = (f32x16){}; \
        _Pragma("unroll") for (int ks = 0; ks < 4; ++ks) gt = __builtin_amdgcn_mfma_f32_32x32x16_bf16(bfr[ks], cf[ks], gt, 0, 0, 0); \
        _Pragma("unroll") for (int r = 0; r < 16; ++r) { \
            const int j = 32 * (jb) + crow(r, hi); const f32x4 tj = tab[j]; \
            const bool lt = j < i, gtj = j > i; \
            const float arg = lt ? ti.x - tj.x : (gtj ? ti.z - tj.z : 0.f); \
            const float dj = lt ? tj.y : (gtj ? tj.w : ti.y + ti.w); \
            gt[r] = gt[r] * __builtin_amdgcn_exp2f(arg * LOG2E) * dj; } \
        u32x4 pw[2]; \
        _Pragma("unroll") for (int s = 0; s < 2; ++s) pw[s] = (u32x4){cvtpk(gt[8 * s], gt[8 * s + 1]), cvtpk(gt[8 * s + 2], gt[8 * s + 3]), cvtpk(gt[8 * s + 4], gt[8 * s + 5]), cvtpk(gt[8 * s + 6], gt[8 * s + 7])}; \
        _Pragma("unroll") for (int s = 0; s < 2; ++s) _Pragma("unroll") for (int pb = 0; pb < 2; ++pb) \
            yT[pb] = __builtin_amdgcn_mfma_f32_32x32x16_bf16(xf[2 * s + pb], __builtin_bit_cast(bf16x8, pw[s]), yT[pb], 0, 0, 0); } while (0)
#define FIN_YOFF(hp, dir) do { const float ei = __builtin_amdgcn_exp2f(((dir) == 0 ? ti.x : ti.z) * LOG2E); \
        _Pragma("unroll") for (int ks = 0; ks < 4; ++ks) { \
            const u32x4 cv = __builtin_bit_cast(u32x4, cf[ks]); u32x4 cs; \
            cs.x = cvtpk(bf2f(cv.x & 0xffffu) * ei, bf2f(cv.x >> 16) * ei); cs.y = cvtpk(bf2f(cv.y & 0xffffu) * ei, bf2f(cv.y >> 16) * ei); \
            cs.z = cvtpk(bf2f(cv.z & 0xffffu) * ei, bf2f(cv.z >> 16) * ei); cs.w = cvtpk(bf2f(cv.w & 0xffffu) * ei, bf2f(cv.w >> 16) * ei); \
            _Pragma("unroll") for (int pb = 0; pb < 2; ++pb) yT[pb] = __builtin_amdgcn_mfma_f32_32x32x16_bf16(hp[2 * ks + pb], __builtin_bit_cast(bf16x8, cs), yT[pb], 0, 0, 0); } } while (0)
    bf16x8 bA[4], bB[4], xA[4], xB[4], hA[8], hB[8];
    FIN_LOADB(bA, 0); FIN_LOADX(xA, 0);
#pragma unroll 1
    for (int ib = 0; ib < 4; ++ib) {
        asm volatile("" : "+v"(brow), "+v"(xt), "+v"(hpb));
        const int i = 32 * ib + r32;
        const f32x4 ti = tab[i];
        bf16x8 cf[4];
#pragma unroll
        for (int ks = 0; ks < 4; ++ks) cf[ks] = *(const bf16x8*)(XBCC + (t0 + i) * XBC + 640 + g * 64 + 16 * ks + 8 * hi);
        f32x16 yT[2]; yT[0] = (f32x16){}; yT[1] = (f32x16){};
        FIN_LOADB(bB, 1); FIN_LOADX(xB, 1); __builtin_amdgcn_sched_barrier(0);
        FIN_TILE(0, bA, xA);
        FIN_LOADB(bA, 2); FIN_LOADX(xA, 2); __builtin_amdgcn_sched_barrier(0);
        FIN_TILE(1, bB, xB);
        FIN_LOADB(bB, 3); FIN_LOADX(xB, 3); __builtin_amdgcn_sched_barrier(0);
        FIN_TILE(2, bA, xA);
        FIN_LOADH(hA, 0); __builtin_amdgcn_sched_barrier(0);
        FIN_TILE(3, bB, xB);
        FIN_LOADH(hB, 1); __builtin_amdgcn_sched_barrier(0);
        FIN_YOFF(hA, 0);
        u32x2 xv[8], zv[8];
#pragma unroll
        for (int q = 0; q < 8; ++q) { const int p = 32 * (q >> 2) + 8 * (q & 3) + 4 * hi;
            xv[q] = *(const u32x2*)(XBCC + (t0 + i) * XBC + hd * 64 + p); zv[q] = *(const u32x2*)(PROJ + (t0 + i) * PROJ_N + PC_Z + hd * 64 + p); }
        __builtin_amdgcn_sched_barrier(0);
        FIN_YOFF(hB, 1);
        FIN_LOADB(bA, 0); FIN_LOADX(xA, 0); __builtin_amdgcn_sched_barrier(0);
        float ss = 0.f;
#pragma unroll
        for (int q8 = 0; q8 < 8; ++q8) {
            const int pb = q8 >> 2, q = q8 & 3;
            const float xs[4] = {bf2f(xv[q8].x & 0xffffu), bf2f(xv[q8].x >> 16), bf2f(xv[q8].y & 0xffffu), bf2f(xv[q8].y >> 16)};
            const float zs[4] = {bf2f(zv[q8].x & 0xffffu), bf2f(zv[q8].x >> 16), bf2f(zv[q8].y & 0xffffu), bf2f(zv[q8].y >> 16)};
#pragma unroll
            for (int e = 0; e < 4; ++e) { const float y = yT[pb][4 * q + e] + dsk * xs[e]; const float gv = y * (zs[e] / (1.f + __expf(-zs[e]))); yT[pb][4 * q + e] = gv; ss += gv * gv; }
        }
        ss = att::half_sum(ss);
        __syncthreads();
        if (hi == 0) red[hd * 32 + r32] = ss;
        __syncthreads();
        float tot = 0.f;
#pragma unroll
        for (int w8 = 0; w8 < 8; ++w8) tot += red[w8 * 32 + r32];
        const float rstd = 1.f / sqrtf(tot * (1.f / 512.f) + EPS);
#pragma unroll
        for (int pb = 0; pb < 2; ++pb)
#pragma unroll
            for (int q = 0; q < 4; ++q) {
                const int p = 32 * pb + 8 * q + 4 * hi;
                const f32x4 wv = *(const f32x4*)(ssdnw + hd * 64 + p);
                u32x2 o; o.x = cvtpk(yT[pb][4 * q] * rstd * wv.x, yT[pb][4 * q + 1] * rstd * wv.y); o.y = cvtpk(yT[pb][4 * q + 2] * rstd * wv.z, yT[pb][4 * q + 3] * rstd * wv.w);
                *(u32x2*)(MIX + (t0 + i) * D + 512 + hd * 64 + p) = o;
            }
    }
#undef FIN_LOADB
#undef FIN_LOADX
#undef FIN_LOADH
#undef FIN_TILE
#undef FIN_YOFF
    __syncthreads();
}
}

struct Args { const void* in[31]; float* out; unsigned char* ws; int ph_lo, ph_hi; };
#define IN_F(i) ((const float*)a.in[i])
enum { I_X = 0, I_P, I_POS, I_ATTN_NW, I_WIN, I_QNW, I_WUQ, I_KVNW, I_WUKV, I_AONW, I_CONVW, I_CONVB, I_DTB, I_ALOG, I_SSDD, I_SSDNW, I_WO, I_FFNNW,
       I_WRG, I_BRG, I_WRE, I_BRE, I_WEG, I_WEU, I_WED, I_PLENW, I_WPG, I_BPG, I_WPP, I_PPNW, I_FNW };

template <class FA, class FB, class FE>
__device__ __forceinline__ void naive_gemm(int M, int N, int K, FA fa, FB fb, FE fe, float* sm) {
    const int tid = threadIdx.x, tx = tid & 63, ty = tid >> 6;
    float* As = sm; float* Bs = sm + 64 * 17;
    const int ntm = M / 64, ntn = (N + 63) / 64;
    for (int tile = blockIdx.x; tile < ntm * ntn; tile += gridDim.x) {
        const int tm = tile / ntn, tn = tile % ntn;
        float acc[8];
#pragma unroll
        for (int j = 0; j < 8; ++j) acc[j] = 0.f;
        for (int k0 = 0; k0 < K; k0 += 16) {
            __syncthreads();
            for (int i = tid; i < 1024; i += 512) { const int r = i >> 4, c = i & 15; As[r * 17 + c] = fa(tm * 64 + r, k0 + c); }
            for (int i = tid; i < 1024; i += 512) { const int r = i >> 6, c = i & 63; const int n = tn * 64 + c; Bs[r * 64 + c] = (n < N) ? fb(k0 + r, n) : 0.f; }
            __syncthreads();
#pragma unroll
            for (int k = 0; k < 16; ++k) { const float b = Bs[k * 64 + tx];
#pragma unroll
                for (int j = 0; j < 8; ++j) acc[j] += As[(ty * 8 + j) * 17 + k] * b; }
        }
#pragma unroll
        for (int j = 0; j < 8; ++j) { const int m = tm * 64 + ty * 8 + j, n = tn * 64 + tx; if (n < N) fe(m, n, acc[j]); }
    }
    __syncthreads();
}

__device__ __forceinline__ int proj_src_col(int j) {
    if (j < 416) return j;
    if (j < 432) return 1696 + (j - 416);
    if (j < 512) return -1;
    if (j < 1024) return 416 + (j - 512);
    return 928 + (j - 1024);
}

__device__ __forceinline__ void rms_row_to_bf16(const float* xrow, const float* w, bf16_t* orow, int lane) {
    const f32x4* xr = (const f32x4*)xrow + lane; const f32x4* wr = (const f32x4*)w + lane;
    f32x4 v[4]; float s = 0.f;
#pragma unroll
    for (int j = 0; j < 4; ++j) { v[j] = xr[64 * j]; s += (v[j].x * v[j].x + v[j].y * v[j].y) + (v[j].z * v[j].z + v[j].w * v[j].w); }
    const float rstd = 1.f / sqrtf(wave_sum(s) * (1.f / D) + EPS);
    u32x2* o8 = (u32x2*)orow + lane;
#pragma unroll
    for (int j = 0; j < 4; ++j) { const f32x4 g = wr[64 * j]; u32x2 o; o.x = pk2(v[j].x * rstd * g.x, v[j].y * rstd * g.y); o.y = pk2(v[j].z * rstd * g.z, v[j].w * rstd * g.w); o8[64 * j] = o; }
}

constexpr int LDS_BYTES = 147456;
constexpr int MISC_OFF = 131072;

__global__ void __launch_bounds__(512, 2) fwd(Args a) {
    extern __shared__ __attribute__((aligned(16))) unsigned char lds_raw[];
    float* smf = (float*)lds_raw;
    const int G = gridDim.x, NGW = G * 8, NGT = G * 512;
#define FRESH_IDS() int tid = threadIdx.x; asm volatile("" : "+v"(tid)); const int lane = tid & 63, wave = __builtin_amdgcn_readfirstlane(tid >> 6); \
    const int gw = blockIdx.x * 8 + wave, gtid = blockIdx.x * 512 + tid; (void)lane; (void)gw; (void)gtid;
    unsigned char* ws = a.ws;
    unsigned* ctl = (unsigned*)(ws + WS_CTL);
    volatile LAS unsigned* MISC = (volatile LAS unsigned*)((LAS unsigned char*)lds_raw + MISC_OFF);
    if (threadIdx.x < 32) MISC[threadIdx.x] = 0u;
    __syncthreads();
#if !MK_PER_PHASE
    XcdBarrier bar = xcd_barrier_post(ctl + CW_BAR, MISC + 8);
#define GRID_BAR() xcd_barrier(bar)
#else
#define GRID_BAR() do {} while (0)
#endif
    const int lo = a.ph_lo, hi = a.ph_hi;
#ifndef PHMASK
#define PHMASK 0xFFFF
#endif
#define IN(k) (((PHMASK >> (k)) & 1) && lo <= (k) && (k) < hi)
#ifndef REPMASK
#define REPMASK 0
#endif
#define NREP(k) (1 + ((REPMASK >> (k)) & 1))
#define SEAM(k) do { if (IN(k) && IN((k) + 1)) GRID_BAR(); } while (0)

    const float* x = IN_F(I_X);
    float* out = a.out;
    bf16_t* H = (bf16_t*)(ws + WS_H);
    bf16_t* PROJ = (bf16_t*)(ws + WS_PROJ);
    bf16_t* PLERAW = (bf16_t*)(ws + WS_PROJ);
    bf16_t* Qb = (bf16_t*)(ws + WS_Q); bf16_t* Kb = (bf16_t*)(ws + WS_K); bf16_t* Vb = (bf16_t*)(ws + WS_V);
    bf16_t* MIX = (bf16_t*)(ws + WS_MIX);
    bf16_t* XBCC = (bf16_t*)(ws + WS_XBCC);
    float* STATES = out;
    bf16_t* XT = (bf16_t*)((char*)out + 64 * MiB);
    bf16_t* BT = (bf16_t*)((char*)out + 96 * MiB);
    bf16_t* HPB = (bf16_t*)(ws + WS_H);
    bf16_t* X1B = (bf16_t*)out;
    float* RSTDP = (float*)(ws + WS_RSTDP);
    float* CDEC = (float*)(ws + WS_CDEC);
    float* COS = (float*)(ws + WS_COS); float* SIN = (float*)(ws + WS_SIN);
    float* DT = (float*)(ws + WS_DT); float* DTRAW = (float*)(ws + WS_DTRAW);
    float* ROUTE = (float*)(ws + WS_ROUTE);
    int* BUCKET = (int*)(ws + WS_BUCKET);
    const int* pos = (const int*)a.in[I_POS];

    bf16_t* WT_IN = (bf16_t*)(ws + WS_WEIGHTS);
    bf16_t* WT_UQ = WT_IN + (size_t)PROJ_N * D;
    bf16_t* WT_UKV = WT_UQ + 768 * 256;
    bf16_t* WT_O = WT_UKV + 1024 * 128;
    bf16_t* WT_PG = WT_O + (size_t)D * D;
    bf16_t* WT_PP = WT_PG + (size_t)D * D;
    bf16_t* WT_GU = WT_PP + (size_t)D * 256;
    bf16_t* WT_DN = WT_GU + (size_t)32 * 512 * 1024;
    bf16_t* PB = (bf16_t*)(ws + WS_PB);
    float* SSQQ = (float*)(ws + WS_SSQQ); float* SSQKV = (float*)(ws + WS_SSQKV); float* SSQPLE = (float*)(ws + WS_SSQPLE);
    LAS unsigned char* ldsb = (LAS unsigned char*)lds_raw;
    bf16_t* WRF = (bf16_t*)(ws + WS_WRF);
    float* SSQX1 = (float*)(ws + WS_SSQX1);

    if (IN(0)) {
        FRESH_IDS();
        for (int rep_ = 0; rep_ < NREP(0); ++rep_) {
        float* scr = smf + wave * 4096;
        constexpr int I_IN = 16 * 56, I_UQ = 4 * 24, I_UKV = 2 * 32, I_O = 16 * 32, I_PG = 16 * 32, I_PP = 4 * 32, I_GU = 32 * 16 * 16, I_DN = 32 * 4 * 32;
        constexpr int NITEMS = I_IN + I_UQ + I_UKV + I_O + I_PG + I_PP + I_GU + I_DN;
        const float* qnw = IN_F(I_QNW); const float* kvnw = IN_F(I_KVNW);
        const float qscale = 0.10206207261596575f * 1.4426950408889634f;
        auto one = [](int) { return 1.f; };
        auto ident = [](int n) { return n; };
        for (int it = gw; it < NITEMS; it += NGW) {
            int r = it;
            if (r < I_IN) { transpose_item(IN_F(I_WIN), IN_COLS, D, WT_IN, scr, r / 56, r % 56, lane, [](int n) { return proj_src_col(n); }, one); continue; } r -= I_IN;
            if (r < I_UQ) { transpose_item(IN_F(I_WUQ), 768, 256, WT_UQ, scr, r / 24, r % 24, lane, ident, [&](int k) { return qnw[k] * qscale; }); continue; } r -= I_UQ;
            if (r < I_UKV) { transpose_item(IN_F(I_WUKV), 1024, 128, WT_UKV, scr, r / 32, r % 32, lane, ident, [&](int k) { return kvnw[k]; }); continue; } r -= I_UKV;
            if (r < I_O) { transpose_item(IN_F(I_WO), D, D, WT_O, scr, r / 32, r % 32, lane, ident, one); continue; } r -= I_O;
            if (r < I_PG) { transpose_item(IN_F(I_WPG), D, D, WT_PG, scr, r / 32, r % 32, lane, ident, one); continue; } r -= I_PG;
            if (r < I_PP) { transpose_item(IN_F(I_WPP), D, 256, WT_PP, scr, r / 32, r % 32, lane, ident, one); continue; } r -= I_PP;
            if (r < I_GU) { const int e = r / 256, q = r % 256, kb = q / 16, nb = q % 16;
                const float* W = ((nb & 7) < 4 ? IN_F(I_WEG) : IN_F(I_WEU)) + (size_t)e * 1024 * 256;
                transpose_item(W, 256, D, WT_GU + (size_t)e * 512 * 1024, scr, kb, nb, lane, [](int n) { return (n >> 8) * 128 + (n & 127); }, one); continue; } r -= I_GU;
            { const int e = r / 128, q = r % 128; transpose_item(IN_F(I_WED) + (size_t)e * 256 * 1024, D, 256, WT_DN + (size_t)e * 1024 * 256, scr, q / 32, q % 32, lane, ident, one); }
        }
        { const f32x4* wr4 = (const f32x4*)IN_F(I_ATTN_NW) + lane;
          for (int m0 = gw * 4; m0 < T; m0 += NGW * 4) {
              f32x4 v[4][4];
#pragma unroll
              for (int r = 0; r < 4; ++r)
#pragma unroll
                  for (int j = 0; j < 4; ++j) v[r][j] = ((const f32x4*)(x + (size_t)(m0 + r) * D) + lane)[64 * j];
#pragma unroll
              for (int r = 0; r < 4; ++r) {
                  float s = 0.f;
#pragma unroll
                  for (int j = 0; j < 4; ++j) s += (v[r][j].x * v[r][j].x + v[r][j].y * v[r][j].y) + (v[r][j].z * v[r][j].z + v[r][j].w * v[r][j].w);
                  const float rstd = 1.f / sqrtf(wave_sum(s) * (1.f / D) + EPS);
                  u32x2* o8 = (u32x2*)(H + (size_t)(m0 + r) * D) + lane;
#pragma unroll
                  for (int j = 0; j < 4; ++j) { const f32x4 g4 = wr4[64 * j]; u32x2 o; o.x = pk2(v[r][j].x * rstd * g4.x, v[r][j].y * rstd * g4.y); o.y = pk2(v[r][j].z * rstd * g4.z, v[r][j].w * rstd * g4.w); o8[64 * j] = o; }
              } } }
        { const f32x4* pp = (const f32x4*)IN_F(I_P); u32x2* po = (u32x2*)PB;
          for (int i0 = gtid; i0 < T * 256 / 4; i0 += NGT * 8) { f32x4 v[8];
#pragma unroll
              for (int q = 0; q < 8; ++q) v[q] = pp[i0 + q * NGT];
#pragma unroll
              for (int q = 0; q < 8; ++q) { u32x2 o; o.x = pk2(v[q].x, v[q].y); o.y = pk2(v[q].z, v[q].w); po[i0 + q * NGT] = o; } } }
        { const float* wrg = IN_F(I_WRG); const float* wre = IN_F(I_WRE);
          for (int i = gtid; i < 32 * 3 * 64 * 8; i += NGT) { const int e = i & 7, l = (i >> 3) & 63, nb = (i >> 9) % 3, ks = i / 1536;
              const int k = 32 * ks + 8 * (l >> 4) + e, col = 16 * nb + (l & 15);
              const float w = col < 4 ? wrg[k * 4 + col] : (col < 36 ? wre[k * 32 + (col - 4)] : 0.f);
              const unsigned hi = f2bf(w); const float lo = w - bf2f(hi);
              const size_t base = ((size_t)(ks * 3 + nb) * 2) * 512 + l * 8 + e;
              WRF[base] = (bf16_t)hi; WRF[base + 512] = (bf16_t)f2bf(lo); } }
        for (int i = gtid; i < T * 16; i += NGT) {
            const int t = i >> 4, f = i & 15;
            const float inv = 1.0f / powf(10000.0f, (float)(2 * f) / 32.0f);
            const float ang = (float)pos[t] * inv;
            COS[i] = cosf(ang); SIN[i] = sinf(ang);
        }
        }
    }
    SEAM(0);
    if (IN(1)) {
        FRESH_IDS();
        for (int rep_ = 0; rep_ < NREP(1); ++rep_) {
        pg8::Gemm g{H, WT_IN, T, PROJ_N, D, D, D}; pg8::StaticOrder So; So.init(T, PROJ_N, G, (int)blockIdx.x);
        EpiInProj E{PROJ, DTRAW, SSQQ, SSQKV};
        pg8::gemm_phase(ldsb, g, So, E);
        }
    }
    SEAM(1);
    if (IN(2)) {
        FRESH_IDS();
        for (int rep_ = 0; rep_ < NREP(2); ++rep_)
        for (int u = blockIdx.x; u < NB * ssd::NCH; u += G) {
            ssd::conv_chunk(smf, PROJ, IN_F(I_CONVW), IN_F(I_CONVB), XBCC, XT, BT, DTRAW, IN_F(I_DTB), DT, u >> 5, u & 31);
            ssd::states_chunk(smf + 20480, XT, BT, DT, IN_F(I_ALOG), STATES, CDEC, u >> 5, u & 31);
            __syncthreads();
        }
        for (int i = gtid; i < T * 16; i += NGT) {
            const int t = i >> 4, f = i & 15, b = t / S, s = t % S;
            const float c = COS[i], sn = SIN[i];
            const float t1 = bf2f(PROJ[(size_t)t * PROJ_N + PC_KR + f]), t2 = bf2f(PROJ[(size_t)t * PROJ_N + PC_KR + 16 + f]);
            const bf16_t o1 = (bf16_t)f2bf(t1 * c - t2 * sn), o2 = (bf16_t)f2bf(t2 * c + t1 * sn);
            for (int h = 0; h < NH; ++h) { bf16_t* kt = Kb + ((size_t)(b * NH + h) * (S / 64) + (s >> 6)) * (12 * 512) + (s & 63) * 8 + (f & 7); kt[(8 + (f >> 3)) * 512] = o1; kt[(10 + (f >> 3)) * 512] = o2; }
        }
        __syncthreads();
        for (int rep2_ = 0; rep2_ < NREP(12); ++rep2_) {
        { pg8::Gemm g{PROJ + PC_CQ, WT_UQ, T, 768, 256, PROJ_N, 256}; pg8::StaticOrder So; So.init(T, 768, G, (int)blockIdx.x);
          EpiQUp E{Qb, SSQQ, COS, SIN}; pg8::gemm_phase(ldsb, g, So, E); }
        { pg8::Gemm g{PROJ + PC_CKV, WT_UKV, T, 1024, 128, PROJ_N, 128}; pg8::StaticOrder So; So.init(T, 1024, G, (int)blockIdx.x);
          EpiKVUp E{Kb, Vb, SSQKV}; pg8::gemm_phase(ldsb, g, So, E); }
        }
    }
    SEAM(2);
    if (IN(3)) {
        FRESH_IDS();
        for (int rep_ = 0; rep_ < NREP(13); ++rep_)
        for (int idx = gtid; idx < 128 * 1024; idx += NGT) {
            const int chain = idx >> 10, e4 = (idx & 1023) * 4, b = chain >> 4, dir = (chain >> 3) & 1, hd = chain & 7;
            f32x4 h4 = (f32x4){0.f, 0.f, 0.f, 0.f};
#pragma unroll 8
            for (int step = 0; step < ssd::NCH; ++step) {
                const int c = dir == 0 ? step : ssd::NCH - 1 - step;
                const int sidx = ((b * ssd::NCH + c) * 2 + dir) * 8 + hd;
                const f32x4* ptr = (const f32x4*)(STATES + (size_t)sidx * 4096 + e4);
                const f32x4 s4 = *ptr; { u32x2 hb; hb.x = pk2(h4.x, h4.y); hb.y = pk2(h4.z, h4.w); *(u32x2*)(HPB + (size_t)sidx * 4096 + e4) = hb; } h4 = h4 * CDEC[sidx] + s4;
            }
        }
        __syncthreads();
        for (int rep_ = 0; rep_ < NREP(3); ++rep_) {
        {
            const int vcu = (G % 8 == 0) ? ((int)blockIdx.x % 8) * (G / 8) + (int)blockIdx.x / 8 : (int)blockIdx.x;
            for (int u = vcu; u < NB * NH * 16; u += G) att::attn_unit(ldsb, Qb, Kb, Vb, MIX, u >> 4, u & 15);
        }
        }
    }
    SEAM(3);
    if (IN(4)) {
        FRESH_IDS();
        const float* aonw = IN_F(I_AONW);
        for (int u = blockIdx.x; u < NB * ssd::NCH; u += G) {
            for (int rep_ = 0; rep_ < NREP(4); ++rep_)
                ssd::finalize_chunk(smf, XBCC, XT, PROJ, DT, IN_F(I_ALOG), HPB, IN_F(I_SSDD), IN_F(I_SSDNW), MIX, u >> 5, u & 31);
            for (int r0 = wave * 4; r0 < ssd::CH; r0 += 32) {
                u32x4 raw[4];
#pragma unroll
                for (int q = 0; q < 4; ++q) raw[q] = *(const u32x4*)(MIX + ((size_t)(u >> 5) * S + (u & 31) * ssd::CH + r0 + q) * D + lane * 8);
                const f32x4 w0 = *(const f32x4*)(aonw + lane * 8), w1 = *(const f32x4*)(aonw + lane * 8 + 4);
#pragma unroll
                for (int q = 0; q < 4; ++q) {
                    float v[8] = {bf2f(raw[q].x & 0xffffu), bf2f(raw[q].x >> 16), bf2f(raw[q].y & 0xffffu), bf2f(raw[q].y >> 16), bf2f(raw[q].z & 0xffffu), bf2f(raw[q].z >> 16), bf2f(raw[q].w & 0xffffu), bf2f(raw[q].w >> 16)};
                    float ss = 0.f;
#pragma unroll
                    for (int j = 0; j < 8; ++j) ss += v[j] * v[j];
                    const float rstd = 1.f / sqrtf(wave_sum(ss) * (1.f / 512.f) + EPS);
                    u32x4 o; o.x = pk2(v[0] * rstd * w0.x, v[1] * rstd * w0.y); o.y = pk2(v[2] * rstd * w0.z, v[3] * rstd * w0.w);
                    o.z = pk2(v[4] * rstd * w1.x, v[5] * rstd * w1.y); o.w = pk2(v[6] * rstd * w1.z, v[7] * rstd * w1.w);
                    *(u32x4*)(MIX + ((size_t)(u >> 5) * S + (u & 31) * ssd::CH + r0 + q) * D + lane * 8) = o;
                }
            }
        }
    }
    SEAM(4);
    if (IN(5)) {
        FRESH_IDS();
        for (int rep_ = 0; rep_ < NREP(5); ++rep_) {
        pg8::Gemm g{MIX, WT_O, T, D, D, D, D}; pg8::StaticOrder So; So.init(T, D, G, (int)blockIdx.x);
        EpiResid E{x, X1B, SSQX1}; pg8::gemm_phase(ldsb, g, So, E);
        }
    }
    SEAM(5);
    if (IN(6)) {
        FRESH_IDS();
        {
            typedef short bf16x8r __attribute__((ext_vector_type(8)));
            const float* fw = IN_F(I_FFNNW); const float* brg = IN_F(I_BRG); const float* bre = IN_F(I_BRE);
            const int r16 = lane & 15, kq = lane >> 4;
            float* lg = smf + wave * (16 * 48);
            for (int rep_ = 0; rep_ < NREP(6); ++rep_)
            for (int rb = gw; rb < T / 16; rb += NGW) {
                const int row = rb * 16 + r16;
                float ss = 0.f;
#pragma unroll
                for (int q = 0; q < 4; ++q) { const f32x4 sv = *(const f32x4*)(SSQX1 + row * 16 + 4 * q); ss += (sv.x + sv.y) + (sv.z + sv.w); }
                const float rstd = 1.f / sqrtf(ss * (1.f / D) + EPS);
                f32x4 acc[3]; acc[0] = (f32x4){0.f, 0.f, 0.f, 0.f}; acc[1] = acc[0]; acc[2] = acc[0];
                const bf16_t* xrow = X1B + (size_t)row * D + 8 * kq;
#pragma unroll 8
                for (int ks = 0; ks < 32; ++ks) {
                    const u32x4 xb = *(const u32x4*)(xrow + 32 * ks);
                    const f32x4 x0 = (f32x4){bf2f(xb.x & 0xffffu), bf2f(xb.x >> 16), bf2f(xb.y & 0xffffu), bf2f(xb.y >> 16)}, x1v = (f32x4){bf2f(xb.z & 0xffffu), bf2f(xb.z >> 16), bf2f(xb.w & 0xffffu), bf2f(xb.w >> 16)};
                    const f32x4 g0 = *(const f32x4*)(fw + 32 * ks + 8 * kq), g1 = *(const f32x4*)(fw + 32 * ks + 8 * kq + 4);
                    const f32x4 h0 = x0 * rstd * g0, h1 = x1v * rstd * g1;
                    u32x4 hi; hi.x = att::cvtpk(h0.x, h0.y); hi.y = att::cvtpk(h0.z, h0.w); hi.z = att::cvtpk(h1.x, h1.y); hi.w = att::cvtpk(h1.z, h1.w);
                    *(u32x4*)(H + (size_t)row * D + 32 * ks + 8 * kq) = hi;
                    u32x4 lo; lo.x = att::cvtpk(h0.x - bf2f(hi.x & 0xffffu), h0.y - bf2f(hi.x >> 16)); lo.y = att::cvtpk(h0.z - bf2f(hi.y & 0xffffu), h0.w - bf2f(hi.y >> 16));
                    lo.z = att::cvtpk(h1.x - bf2f(hi.z & 0xffffu), h1.y - bf2f(hi.z >> 16)); lo.w = att::cvtpk(h1.z - bf2f(hi.w & 0xffffu), h1.w - bf2f(hi.w >> 16));
                    const bf16x8r ah = __builtin_bit_cast(bf16x8r, hi), al = __builtin_bit_cast(bf16x8r, lo);
#pragma unroll
                    for (int nb = 0; nb < 3; ++nb) {
                        const bf16_t* wf = WRF + ((size_t)(ks * 3 + nb) * 2) * 512 + lane * 8;
                        const bf16x8r bh = *(const bf16x8r*)wf, bl = *(const bf16x8r*)(wf + 512);
                        acc[nb] = __builtin_amdgcn_mfma_f32_16x16x32_bf16(ah, bh, acc[nb], 0, 0, 0);
                        acc[nb] = __builtin_amdgcn_mfma_f32_16x16x32_bf16(ah, bl, acc[nb], 0, 0, 0);
                        acc[nb] = __builtin_amdgcn_mfma_f32_16x16x32_bf16(al, bh, acc[nb], 0, 0, 0);
                    }
                }
#pragma unroll
                for (int nb = 0; nb < 3; ++nb)
#pragma unroll
                    for (int j = 0; j < 4; ++j) lg[(4 * kq + j) * 48 + 16 * nb + r16] = acc[nb][j];
                asm volatile("s_waitcnt lgkmcnt(0)" ::: "memory");
                if (lane < 16 && rep_ == NREP(6) - 1) {
                    const int m = rb * 16 + lane;
                    float lgt[36];
#pragma unroll
                    for (int q = 0; q < 9; ++q) { const f32x4 v = *(const f32x4*)(lg + lane * 48 + 4 * q); lgt[4 * q] = v.x; lgt[4 * q + 1] = v.y; lgt[4 * q + 2] = v.z; lgt[4 * q + 3] = v.w; }
                    float gl[4]; int gi = 0;
#pragma unroll
                    for (int q = 0; q < 4; ++q) gl[q] = lgt[q] + brg[q];
                    float gmax = gl[0];
#pragma unroll
                    for (int q = 1; q < 4; ++q) if (gl[q] > gmax) { gmax = gl[q]; gi = q; }
                    float gs = 0.f;
#pragma unroll
                    for (int q = 0; q < 4; ++q) gs += expf(gl[q] - gmax);
                    const float gwt = 1.f / gs;
                    float el[8];
#pragma unroll
                    for (int q = 0; q < 8; ++q) { float vv = 0.f;
#pragma unroll
                        for (int g2 = 0; g2 < 4; ++g2) vv = (g2 == gi) ? lgt[4 + g2 * 8 + q] + bre[g2 * 8 + q] : vv;
                        el[q] = vv; }
                    int i0 = 0; float v0 = el[0];
#pragma unroll
                    for (int q = 1; q < 8; ++q) if (el[q] > v0) { v0 = el[q]; i0 = q; }
                    int i1 = -1; float v1 = -3.4e38f;
#pragma unroll
                    for (int q = 0; q < 8; ++q) if (q != i0 && el[q] > v1) { v1 = el[q]; i1 = q; }
                    const float e1 = expf(v1 - v0), w0 = gwt / (1.f + e1), w1 = gwt * e1 / (1.f + e1);
                    const int ex0 = gi * 8 + i0, ex1 = gi * 8 + i1;
                    *(f32x4*)(ROUTE + m * 4) = (f32x4){__int_as_float(ex0), __int_as_float(ex1), w0, w1};
                    const unsigned p0 = atomicAdd(ctl + CW_ECNT + 64 * ex0, 1u); BUCKET[(size_t)ex0 * T + p0] = m * 2;
                    const unsigned p1 = atomicAdd(ctl + CW_ECNT + 64 * ex1, 1u); BUCKET[(size_t)ex1 * T + p1] = m * 2 + 1;
                }
                asm volatile("s_waitcnt lgkmcnt(0)" ::: "memory");
            }
        }
    }
    SEAM(6);
    volatile LAS unsigned* CNT_L = MISC + 64; volatile LAS unsigned* PTILE_L = MISC + 96;
    LAS unsigned* ROWTAB = (LAS unsigned*)(ldsb + MISC_OFF + 1024);
    bf16_t* HE = (bf16_t*)(ws + WS_HE); bf16_t* YPAIR = (bf16_t*)(ws + WS_Q);
    bf16_t* X2B = (bf16_t*)(ws + WS_MIX);
    bf16_t* GB = (bf16_t*)(ws + WS_Q);
    if (IN(7) || IN(8)) {
        if (threadIdx.x == 0) { unsigned acc = 0;
            for (int e2 = 0; e2 < 32; ++e2) { const unsigned c = __hip_atomic_load(ctl + CW_ECNT + 64 * e2, __ATOMIC_RELAXED, __HIP_MEMORY_SCOPE_AGENT); CNT_L[e2] = c; PTILE_L[e2] = acc; acc += (c + 255u) >> 8; }
            PTILE_L[32] = acc; }
        __syncthreads();
    }
    if (IN(7)) {
        FRESH_IDS();
        for (int rep_ = 0; rep_ < NREP(7); ++rep_) {
        GroupSched Sg{PTILE_L, 2, G, (int)blockIdx.x};
        { pg8::Unit u;
          for (int i = 0; i < 8 && Sg.next(i, u); ++i) { const int e2 = u.pn >> 1, pm_l = u.pm - (int)PTILE_L[e2];
              if (tid < 256) { const int idx = pm_l * 256 + tid; const int tok = idx < (int)CNT_L[e2] ? (BUCKET[(size_t)e2 * T + idx] >> 1) : 0; ROWTAB[i * 256 + tid] = (unsigned)tok * 2048u; } } }
        __syncthreads();
        pg8::Gemm g{H, WT_GU, T, 32 * 512, D, D, D};
        EpiMoeGU E{HE};
        pg8::gemm_phase<EpiMoeGU, GroupSched, true>(ldsb, g, Sg, E, ROWTAB);
        { const int total = (int)PTILE_L[32] * 2, nmax = (total + G - 1) / G, extra = total - (nmax - 1) * G;
          pg8::Gemm g2{PB, WT_PP, T, D, 256, 256, 256}; pg8::TailOrder St; St.init(T, D, G, (int)blockIdx.x, extra);
          EpiPleProj E2{PLERAW, SSQPLE}; pg8::gemm_phase(ldsb, g2, St, E2); }
        }
    }
    SEAM(7);
    if (IN(8)) {
        for (int rep_ = 0; rep_ < NREP(8); ++rep_) {
        GroupSched Sg{PTILE_L, 4, G, (int)blockIdx.x};
        pg8::Gemm g{HE, WT_DN, 0, 32 * 1024, 256, 256, 256};
        EpiMoeDown E{YPAIR, BUCKET, ROUTE, PTILE_L, CNT_L};
        pg8::gemm_phase(ldsb, g, Sg, E);
        }
    }
    SEAM(8);
    if (IN(9)) {
        FRESH_IDS();
        const f32x4* wr4 = (const f32x4*)IN_F(I_PLENW) + lane;
        for (int rep_ = 0; rep_ < NREP(9); ++rep_)
        for (int m0 = gw * 4; m0 < T; m0 += NGW * 4) {
            f32x4 v[4][4]; u32x2 ya[4][4], yb[4][4];
#pragma unroll
            for (int r = 0; r < 4; ++r)
#pragma unroll
                for (int j = 0; j < 4; ++j) { const size_t m = m0 + r; { const u32x2 xb = ((const u32x2*)(X1B + m * D) + lane)[64 * j]; v[r][j] = (f32x4){bf2f(xb.x & 0xffffu), bf2f(xb.x >> 16), bf2f(xb.y & 0xffffu), bf2f(xb.y >> 16)}; }
                    ya[r][j] = ((const u32x2*)(YPAIR + (2 * m) * D) + lane)[64 * j]; yb[r][j] = ((const u32x2*)(YPAIR + (2 * m + 1) * D) + lane)[64 * j]; }
#pragma unroll
            for (int r = 0; r < 4; ++r) {
                const size_t m = m0 + r; float s = 0.f;
                u32x2* x2r = (u32x2*)(X2B + m * D) + lane;
#pragma unroll
                for (int j = 0; j < 4; ++j) { const u32x2 a0 = ya[r][j], a1 = yb[r][j];
                    v[r][j] = v[r][j] + (f32x4){bf2f(a0.x & 0xffffu) + bf2f(a1.x & 0xffffu), bf2f(a0.x >> 16) + bf2f(a1.x >> 16), bf2f(a0.y & 0xffffu) + bf2f(a1.y & 0xffffu), bf2f(a0.y >> 16) + bf2f(a1.y >> 16)};
                    { u32x2 xo; xo.x = pk2(v[r][j].x, v[r][j].y); xo.y = pk2(v[r][j].z, v[r][j].w); x2r[64 * j] = xo; }
                    s += (v[r][j].x * v[r][j].x + v[r][j].y * v[r][j].y) + (v[r][j].z * v[r][j].z + v[r][j].w * v[r][j].w); }
                const float rstd = 1.f / sqrtf(wave_sum(s) * (1.f / D) + EPS);
                if (lane < 16) { float sp = SSQPLE[m * 16 + lane]; sp += __shfl_xor(sp, 1); sp += __shfl_xor(sp, 2); sp += __shfl_xor(sp, 4); sp += __shfl_xor(sp, 8);
                    if (lane == 0) RSTDP[m] = 1.f / sqrtf(sp * (1.f / D) + EPS); }
                u32x2* o8 = (u32x2*)(H + m * D) + lane;
#pragma unroll
                for (int j = 0; j < 4; ++j) { const f32x4 g4 = wr4[64 * j]; u32x2 o; o.x = pk2(v[r][j].x * rstd * g4.x, v[r][j].y * rstd * g4.y); o.y = pk2(v[r][j].z * rstd * g4.z, v[r][j].w * rstd * g4.w); o8[64 * j] = o; }
            }
        }
    }
    SEAM(9);
    if (IN(10)) {
        pg8::Gemm g{H, WT_PG, T, D, D, D, D}; pg8::StaticOrder So; So.init(T, D, G, (int)blockIdx.x);
        EpiPleGate E{GB, PLERAW, RSTDP, IN_F(I_BPG), IN_F(I_PPNW)}; for (int rep_ = 0; rep_ < NREP(10); ++rep_) pg8::gemm_phase(ldsb, g, So, E);
    }
    SEAM(10);
    if (IN(11)) {
        FRESH_IDS();
        const f32x4* wr4 = (const f32x4*)IN_F(I_FNW) + lane;
        for (int rep_ = 0; rep_ < NREP(11); ++rep_)
        for (int m0 = gw * 4; m0 < T; m0 += NGW * 4) {
            u32x2 xa[4][4], ga[4][4];
#pragma unroll
            for (int r = 0; r < 4; ++r)
#pragma unroll
                for (int j = 0; j < 4; ++j) { const size_t m = m0 + r; xa[r][j] = ((const u32x2*)(X2B + m * D) + lane)[64 * j]; ga[r][j] = ((const u32x2*)(GB + m * D) + lane)[64 * j]; }
#pragma unroll
            for (int r = 0; r < 4; ++r) {
                f32x4 v[4]; float s = 0.f;
#pragma unroll
                for (int j = 0; j < 4; ++j) { const u32x2 a0 = xa[r][j], a1 = ga[r][j];
                    v[j] = (f32x4){bf2f(a0.x & 0xffffu) + bf2f(a1.x & 0xffffu), bf2f(a0.x >> 16) + bf2f(a1.x >> 16), bf2f(a0.y & 0xffffu) + bf2f(a1.y & 0xffffu), bf2f(a0.y >> 16) + bf2f(a1.y >> 16)};
                    s += (v[j].x * v[j].x + v[j].y * v[j].y) + (v[j].z * v[j].z + v[j].w * v[j].w); }
                const float rstd = 1.f / sqrtf(wave_sum(s) * (1.f / D) + EPS);
                f32x4* xr = (f32x4*)(out + (size_t)(m0 + r) * D) + lane;
#pragma unroll
                for (int j = 0; j < 4; ++j) xr[64 * j] = v[j] * rstd * wr4[64 * j];
            }
        }
    }
#undef IN
#undef SEAM
}

extern "C" void kernel_launch(void* const* d_in, const int* in_sizes, int n_in, void* d_out, int out_size, void* d_ws, size_t ws_size, hipStream_t stream) {
    static int grid = 0;
    if (grid == 0) {
        if (n_in != 31 || out_size != T * D || ws_size < WS_END) { fprintf(stderr, "kernel_launch: unexpected shapes (n_in %d out %d ws %zu)\n", n_in, out_size, ws_size); grid = -1; return; }
        int dev = 0, cus = 0, per_cu = 0;
        if (hipGetDevice(&dev) != hipSuccess || hipDeviceGetAttribute(&cus, hipDeviceAttributeMultiprocessorCount, dev) != hipSuccess) { grid = -1; return; }
        if (hipFuncSetAttribute((const void*)fwd, hipFuncAttributeMaxDynamicSharedMemorySize, LDS_BYTES) != hipSuccess) { fprintf(stderr, "kernel_launch: hipFuncSetAttribute failed\n"); grid = -1; return; }
        if (hipOccupancyMaxActiveBlocksPerMultiprocessor(&per_cu, (const void*)fwd, 512, LDS_BYTES) != hipSuccess || per_cu < 1) { fprintf(stderr, "kernel_launch: occupancy query says %d\n", per_cu); }
        (void)hipGetLastError();
        grid = cus;
    }
    if (grid < 0) return;
    (void)hipMemsetAsync((char*)d_ws + WS_CTL, 0, CTL_ZERO_BYTES, stream);
    Args a{};
    for (int i = 0; i < 31; ++i) a.in[i] = d_in[i];
    a.out = (float*)d_out; a.ws = (unsigned char*)d_ws;
#if MK_PER_PHASE
    for (int p = 0; p < NPHASES; ++p) { a.ph_lo = p; a.ph_hi = p + 1; hipLaunchKernelGGL(fwd, dim3(grid), dim3(512), LDS_BYTES, stream, a); }
#else
    a.ph_lo = 0; a.ph_hi = NPHASES;
    hipLaunchKernelGGL(fwd, dim3(grid), dim3(512), LDS_BYTES, stream, a);
#endif
}
```

```cpp
#include <hip/hip_runtime.h>
#include <cstdio>
#include <cstdint>

#ifndef MK_PER_PHASE
#define MK_PER_PHASE 0
#endif

#define LAS __attribute__((address_space(3)))
#define GAS __attribute__((address_space(1)))
typedef unsigned short bf16_t;
typedef float f32x4 __attribute__((ext_vector_type(4)));
typedef unsigned u32x4 __attribute__((ext_vector_type(4)));
typedef unsigned u32x2 __attribute__((ext_vector_type(2)));

constexpr int NB = 8, S = 4096, T = NB * S, D = 1024;
constexpr int NH = 8, DQK = 96, DV = 64;
constexpr int PROJ_N = 1792, IN_COLS = 1712;
constexpr int PC_CQ = 0, PC_CKV = 256, PC_KR = 384, PC_DT = 416, PC_Z = 512, PC_XBC = 1024;
constexpr int XBC = 768;
constexpr float EPS = 1e-6f;
constexpr int NPHASES = 12;

constexpr size_t MiB = 1u << 20;
constexpr size_t WS_CTL = 0, CTL_ZERO_BYTES = 1 * MiB;
constexpr size_t WS_COS = 1 * MiB, WS_SIN = 3 * MiB, WS_DT = 5 * MiB, WS_ROUTE = 7 * MiB, WS_BUCKET = 8 * MiB;
constexpr size_t WS_SSQQ = 12 * MiB, WS_SSQKV = 12 * MiB + 512 * 1024, WS_DTRAW = 13 * MiB, WS_SSQPLE = 15 * MiB;
constexpr size_t WS_WR = 7 * MiB + 512 * 1024;
constexpr size_t WS_CDEC = 7 * MiB + 768 * 1024;
constexpr size_t WS_RSTDP = 7 * MiB + 832 * 1024;
constexpr size_t WS_WRF = 7 * MiB + 512 * 1024;
constexpr size_t WS_SSQX1 = 17 * MiB;
constexpr size_t WS_WEIGHTS = 19 * MiB;
constexpr size_t WS_H = 80 * MiB;
constexpr size_t WS_PROJ = 144 * MiB;
constexpr size_t WS_HE = 208 * MiB;
constexpr size_t WS_Q = 256 * MiB, WS_K = 304 * MiB, WS_V = 352 * MiB;
constexpr size_t WS_MIX = 384 * MiB;
constexpr size_t WS_XBCC = 448 * MiB;
constexpr size_t WS_PB = 496 * MiB;
constexpr size_t WS_END = 512 * MiB;
constexpr int CW_BAR = 4096, CW_ECNT = 8192;

__device__ __forceinline__ unsigned f2bf(float f) { unsigned u = __builtin_bit_cast(unsigned, f); return (u + 0x7fffu + ((u >> 16) & 1u)) >> 16; }
__device__ __forceinline__ float bf2f(unsigned h) { return __builtin_bit_cast(float, h << 16); }
__device__ __forceinline__ unsigned pk2(float lo, float hi) { return f2bf(lo) | (f2bf(hi) << 16); }
__device__ __forceinline__ float wave_sum(float v) {
#pragma unroll
    for (int o = 1; o < 64; o <<= 1) v += __shfl_xor(v, o);
    return v;
}
__device__ __forceinline__ float silu_f(float v) { return v / (1.f + __expf(-v)); }

#define XB_TMO      128
#define XB_XCNT(j)  (256  + 64 * (j))
#define XB_XSUB(j)  (1280 + 64 * (j))
#define XB_XGEN(j)  (2304 + 64 * (j))
#define XB_TOP      3328
#define XB_TOPGEN   3392
#define XCD_BAR_WORDS 3456
#define XB_SPIN_CAP (1u << 22)

__device__ __forceinline__ unsigned xb_ld(unsigned* p)              { return __hip_atomic_load(p, __ATOMIC_RELAXED, __HIP_MEMORY_SCOPE_AGENT); }
__device__ __forceinline__ unsigned xb_add(unsigned* p, unsigned v) { return __hip_atomic_fetch_add(p, v, __ATOMIC_RELAXED, __HIP_MEMORY_SCOPE_AGENT); }
__device__ __forceinline__ unsigned xb_xcc_id() { return (unsigned)__builtin_amdgcn_s_getreg((3 << 11) | 20) & 0xFu; }
#define XB_SPIN(cond, bar) do { unsigned _sp = 0; while (cond) { __builtin_amdgcn_s_sleep(1); \
    if ((++_sp & 255u) == 0u) { if (xb_ld(&(bar)[XB_TMO])) break; if (_sp > XB_SPIN_CAP) { atomicAdd(&(bar)[XB_TMO], 1u); break; } } } } while (0)

struct XcdBarrier { unsigned* bar; unsigned x; volatile LAS unsigned* st; };
__device__ __forceinline__ XcdBarrier xcd_barrier_post(unsigned* bar, volatile LAS unsigned* st) {
    XcdBarrier b; b.bar = bar; b.x = xb_xcc_id(); b.st = st;
    if (threadIdx.x == 0) (void)xb_add(&bar[XB_XCNT(b.x)], 1u);
    return b;
}
__device__ __forceinline__ void xcd_barrier_complete(unsigned* bar, unsigned x, unsigned& nloc, unsigned& nx) {
    const unsigned G = gridDim.x * gridDim.y * gridDim.z;
    unsigned sum, cnt, mine, sp = 0u;
    for (;;) {
        sum = 0u; cnt = 0u; mine = 0u;
#pragma unroll
        for (unsigned j = 0; j < 16; ++j) { const unsigned c = xb_ld(&bar[XB_XCNT(j)]); sum += c; cnt += (c > 0u) ? 1u : 0u; mine = (j == x) ? c : mine; }
        if (sum == G) break;
        __builtin_amdgcn_s_sleep(1);
        if ((++sp & 255u) == 0u) { if (xb_ld(&bar[XB_TMO])) break; if (sp > XB_SPIN_CAP) { atomicAdd(&bar[XB_TMO], 1u); break; } }
    }
    nloc = mine > 0u ? mine : 1u; nx = cnt > 0u ? cnt : 1u;
}
__device__ __forceinline__ void xcd_barrier(const XcdBarrier& b) {
    asm volatile("s_waitcnt vmcnt(0)" ::: "memory");
    __syncthreads();
    if (threadIdx.x == 0) {
        unsigned* bar = b.bar;
        __builtin_amdgcn_s_waitcnt(0);
        unsigned nloc = b.st[0], nx = b.st[1];
        if (nloc == 0u) { xcd_barrier_complete(bar, b.x, nloc, nx); b.st[0] = nloc; b.st[1] = nx; }
        const unsigned old = xb_add(&bar[XB_XSUB(b.x)], 1u);
        const unsigned gen = old / nloc;
        if (old + 1u == (gen + 1u) * nloc) {
            __builtin_amdgcn_fence(__ATOMIC_RELEASE, "agent");
            asm volatile("s_waitcnt vmcnt(0)" ::: "memory");
            const unsigned og = xb_add(&bar[XB_TOP], 1u);
            const unsigned tg = og / nx;
            if (og + 1u == (tg + 1u) * nx) xb_add(&bar[XB_TOPGEN], 1u);
            else XB_SPIN(xb_ld(&bar[XB_TOPGEN]) == tg, bar);
            __builtin_amdgcn_fence(__ATOMIC_ACQUIRE, "agent");
            xb_add(&bar[XB_XGEN(b.x)], 1u);
            asm volatile("s_waitcnt vmcnt(0)" ::: "memory");
        } else {
            XB_SPIN(xb_ld(&bar[XB_XGEN(b.x)]) == gen, bar);
            __builtin_amdgcn_fence(__ATOMIC_ACQUIRE, "agent");
            asm volatile("s_waitcnt vmcnt(0)" ::: "memory");
        }
    }
    __syncthreads();
}


namespace pg8 {
typedef short bf16x8 __attribute__((ext_vector_type(8)));
constexpr int BM = 256, BK = 64, HALF = 128, HTB = HALF * BK * 2, STAGE_BYTES = 8 * HTB, NXCD = 8, WGM = 8;
__host__ __device__ __forceinline__ int lds_byte(int r, int c) { const int st = (r >> 4) * 2 + (c >> 5), rr = r & 15, cc = c & 31, ob = rr * 64 + cc * 2; return st * 1024 + (ob ^ (((ob >> 9) & 1) << 5)); }
__host__ __device__ __forceinline__ void stage_rc(int b, int& R, int& C) { const int st = b / 1024, sb = b % 1024, swz = sb ^ (((sb >> 9) & 1) << 5); R = (st >> 1) * 16 + swz / 64; C = (st & 1) * 32 + (swz % 64) / 2; }
__host__ __device__ __forceinline__ int perm32(int rho) { const int n = rho >> 4, i = rho & 15; return 8 * (i >> 2) + 4 * n + (i & 3); }
struct Unit { int pm, pn; };
struct Gemm { const bf16_t* A; const bf16_t* Bt; int M, N, K, lda, ldb; };
struct StaticOrder {
    int nM, nN, nwg, G, c;
    __host__ __device__ void init(int M, int N, int G_, int c_) { nM = M / BM; nN = N / BM; nwg = nM * nN; G = G_; c = c_; }
    __host__ __device__ bool next(int i, Unit& u) const {
        const long L = (long)i * G + c; if (L >= nwg) return false;
        int wgid = (int)L; { const int q = nwg / NXCD, r = nwg % NXCD, xcd = wgid % NXCD, off = wgid / NXCD; wgid = (xcd < r ? xcd * (q + 1) : r * (q + 1) + (xcd - r) * q) + off; }
        const int nig = WGM * nN, gid = wgid / nig, fm = gid * WGM, gsz = (nM - fm) < WGM ? (nM - fm) : WGM;
        u.pm = fm + ((wgid % nig) % gsz); u.pn = (wgid % nig) / gsz; return true;
    }
};
struct TailOrder {
    int nM, nN, nwg, G, c, first, span;
    __host__ __device__ void init(int M, int N, int G_, int c_, int first_) { nM = M / BM; nN = N / BM; nwg = nM * nN; G = G_; c = c_; first = (first_ > 0 && first_ < G_) ? first_ : 0; span = G - first; }
    __host__ __device__ bool next(int i, Unit& u) const {
        if (c < first) return false;
        const long L = (long)i * span + (c - first); if (L >= nwg) return false;
        const int wgid = (int)L;
        const int nig = WGM * nN, gid = wgid / nig, fm = gid * WGM, gsz = (nM - fm) < WGM ? (nM - fm) : WGM;
        u.pm = fm + ((wgid % nig) % gsz); u.pn = (wgid % nig) / gsz; return true;
    }
};
__device__ __forceinline__ unsigned cvt_pk_bf16(float lo, float hi) { unsigned r; asm volatile("v_cvt_pk_bf16_f32 %0, %1, %2" : "=v"(r) : "v"(lo), "v"(hi)); return r; }

template <class Epi, class Sched, bool GATHER = false>
__device__ __forceinline__ void gemm_phase(LAS unsigned char* lds, const Gemm g, const Sched& S, const Epi& E, const LAS unsigned* rowtab = nullptr) {
    int tid = threadIdx.x; asm volatile("" : "+v"(tid));
    const int wid = __builtin_amdgcn_readfirstlane(tid >> 6), lane = tid & 63, wr = wid >> 2, wc = wid & 3, fr = lane & 15, fq = lane >> 4;
    int nt = g.K / BK; asm volatile("" : "+s"(nt));
    unsigned vAc[2][2], vAn[2][2], voffB[2]; int RA[2], CA[2];
#pragma unroll
    for (int i = 0; i < 2; ++i) { int R, C; stage_rc(tid * 16 + i * 8192, R, C); const int Rb = Epi::PERM ? ((R & ~31) + perm32(R & 31)) : R; RA[i] = R; CA[i] = C;
        voffB[i] = (unsigned)(Rb * g.ldb + C) * 2u;
#pragma unroll
        for (int h = 0; h < 2; ++h) { vAc[h][i] = GATHER ? rowtab[h * HALF + R] + (unsigned)C * 2u : (unsigned)((h * HALF + R) * g.lda + C) * 2u; vAn[h][i] = vAc[h][i]; } }
    const size_t kstep = (size_t)(BK * 2);
    const size_t hstepB = (size_t)HALF * g.ldb * 2;
    const size_t tstepA = GATHER ? 0 : (size_t)BM * g.lda * 2, tstepB = 2 * hstepB;
    const unsigned ldsw = (unsigned)wid * 1024u;
    const int aoff = lds_byte(wr * 64 + fr, fq * 8), boff = lds_byte(wc * 32 + fr, fq * 8);
#define PG8_SA(b, h) (((b) * 2 + (h)) * HTB)
#define PG8_SB(b, h) ((4 + (b) * 2 + (h)) * HTB)
#define PG8_STAGE(bufoff, gbase, voff) do { _Pragma("unroll") for (int _i = 0; _i < 2; ++_i) \
        __builtin_amdgcn_global_load_lds((const unsigned*)((const char*)(gbase) + (voff)[_i]), (LAS unsigned*)(lds + (bufoff) + ldsw + _i * 8192), 16, 0, 0); } while (0)
#define PG8_LDA(dst, b, h) do { _Pragma("unroll") for (int m = 0; m < 4; ++m) _Pragma("unroll") for (int k = 0; k < 2; ++k) dst[m][k] = *(const LAS bf16x8*)(lds + PG8_SA(b, h) + aoff + m * 2048 + k * 1024); } while (0)
#define PG8_LDB(dst, b, h) do { _Pragma("unroll") for (int n = 0; n < 2; ++n) _Pragma("unroll") for (int k = 0; k < 2; ++k) dst[n][k] = *(const LAS bf16x8*)(lds + PG8_SB(b, h) + boff + n * 2048 + k * 1024); } while (0)
#define PG8_MMA(ai, bj, At, Bt) do { __builtin_amdgcn_s_setprio(1); _Pragma("unroll") for (int m = 0; m < 4; ++m) _Pragma("unroll") for (int n = 0; n < 2; ++n) _Pragma("unroll") for (int k = 0; k < 2; ++k) \
        acc[ai][bj][m][n] = __builtin_amdgcn_mfma_f32_16x16x32_bf16(Bt[n][k], At[m][k], acc[ai][bj][m][n], 0, 0, 0); __builtin_amdgcn_s_setprio(0); } while (0)
#define PG8_WAIT_V(n) asm volatile("s_waitcnt vmcnt(" #n ")" ::: "memory")
#define PG8_WAIT_L(n) asm volatile("s_waitcnt lgkmcnt(" #n ")" ::: "memory")
#define PG8_BAR __builtin_amdgcn_s_barrier()
#define PG8_SCHED __builtin_amdgcn_sched_barrier(0)
    Unit cur, nxt; int ui = 0;
    if (!S.next(0, cur)) return;
    f32x4 acc[2][2][4][2];
#pragma unroll
    for (int a = 0; a < 2; ++a)
#pragma unroll
        for (int b = 0; b < 2; ++b)
#pragma unroll
            for (int m = 0; m < 4; ++m)
#pragma unroll
                for (int n = 0; n < 2; ++n) acc[a][b][m][n] = (f32x4){0.f, 0.f, 0.f, 0.f};
    bf16x8 At[4][2], B0[2][2], B1[2][2];
    const char* cA = (const char*)g.A + (size_t)cur.pm * tstepA; const char* cB = (const char*)g.Bt + (size_t)cur.pn * tstepB;
    PG8_STAGE(PG8_SB(0, 0), cB, voffB); PG8_STAGE(PG8_SB(0, 1), cB + hstepB, voffB); PG8_STAGE(PG8_SA(0, 0), cA, vAc[0]); PG8_STAGE(PG8_SA(0, 1), cA, vAc[1]);
    if (wr == 1) PG8_BAR;
    PG8_WAIT_V(2); PG8_BAR;
    PG8_STAGE(PG8_SB(1, 0), cB + kstep, voffB); PG8_STAGE(PG8_SA(1, 0), cA + kstep, vAc[0]); PG8_STAGE(PG8_SB(1, 1), cB + hstepB + kstep, voffB);
    PG8_WAIT_V(6); PG8_BAR;
    for (;;) {
        const bool has_next = S.next(ui + 1, nxt);
        const char* nA = has_next ? (const char*)g.A + (size_t)nxt.pm * tstepA : cA; const char* nB = has_next ? (const char*)g.Bt + (size_t)nxt.pn * tstepB : cB;
        if (GATHER && has_next) {
#pragma unroll
            for (int i = 0; i < 2; ++i)
#pragma unroll
                for (int h = 0; h < 2; ++h) vAn[h][i] = rowtab[(ui + 1) * BM + h * HALF + RA[i]] + (unsigned)CA[i] * 2u;
        }
        for (int t = 0; t < nt; t += 2) {
            const bool last = (t == nt - 2);
            const char* a1 = cA + (size_t)(t + 1) * kstep;
            const char* a2 = last ? nA : cA + (size_t)(t + 2) * kstep; const char* b2 = last ? nB : cB + (size_t)(t + 2) * kstep;
            const char* a3 = a2 + kstep; const char* b3 = b2 + kstep;
            unsigned v2[2][2];
#pragma unroll
            for (int i = 0; i < 2; ++i)
#pragma unroll
                for (int h = 0; h < 2; ++h) v2[h][i] = (GATHER && last) ? vAn[h][i] : vAc[h][i];
            PG8_LDB(B0, 0, 0); PG8_LDB(B1, 0, 1); PG8_SCHED; PG8_LDA(At, 0, 0); PG8_STAGE(PG8_SA(1, 1), a1, vAc[1]);
            PG8_WAIT_V(8); PG8_WAIT_L(0); PG8_BAR; PG8_MMA(0, 0, At, B0); PG8_MMA(0, 1, At, B1); PG8_BAR; PG8_SCHED;
            PG8_LDA(At, 0, 1); PG8_STAGE(PG8_SB(0, 0), b2, voffB); PG8_STAGE(PG8_SB(0, 1), b2 + hstepB, voffB); PG8_STAGE(PG8_SA(0, 0), a2, v2[0]);
            PG8_WAIT_V(8); PG8_WAIT_L(0); PG8_BAR; PG8_MMA(1, 0, At, B0); PG8_MMA(1, 1, At, B1); PG8_BAR; PG8_SCHED;
            PG8_LDB(B0, 1, 0); PG8_LDB(B1, 1, 1); PG8_SCHED; PG8_LDA(At, 1, 0); PG8_STAGE(PG8_SA(0, 1), a2, v2[1]);
            PG8_WAIT_V(8); PG8_WAIT_L(0); PG8_BAR; PG8_MMA(0, 0, At, B0); PG8_MMA(0, 1, At, B1); PG8_BAR; PG8_SCHED;
            PG8_LDA(At, 1, 1); PG8_STAGE(PG8_SB(1, 0), b3, voffB); PG8_STAGE(PG8_SB(1, 1), b3 + hstepB, voffB); PG8_STAGE(PG8_SA(1, 0), a3, v2[0]);
            PG8_WAIT_V(8); PG8_WAIT_L(0); PG8_BAR; PG8_MMA(1, 0, At, B0); PG8_MMA(1, 1, At, B1); PG8_BAR; PG8_SCHED;
        }
        if (wr == 0) PG8_BAR;
        E(acc, cur, wr, wc, fr, fq);
        if (!has_next) break;
#pragma unroll
        for (int a = 0; a < 2; ++a)
#pragma unroll
            for (int b = 0; b < 2; ++b)
#pragma unroll
                for (int m = 0; m < 4; ++m)
#pragma unroll
                    for (int n = 0; n < 2; ++n) acc[a][b][m][n] = (f32x4){0.f, 0.f, 0.f, 0.f};
        cur = nxt; cA = nA; cB = nB; ++ui;
        if (GATHER) {
#pragma unroll
            for (int i = 0; i < 2; ++i)
#pragma unroll
                for (int h = 0; h < 2; ++h) vAc[h][i] = vAn[h][i];
        }
        if (wr == 1) PG8_BAR;
    }
    PG8_WAIT_V(0);
    PG8_BAR;
#undef PG8_SA
#undef PG8_SB
#undef PG8_STAGE
#undef PG8_LDA
#undef PG8_LDB
#undef PG8_MMA
#undef PG8_WAIT_V
#undef PG8_WAIT_L
#undef PG8_BAR
#undef PG8_SCHED
}
}

typedef f32x4 AccT[2][2][4][2];
__device__ __forceinline__ float sq4(const f32x4 v) { return (v.x * v.x + v.y * v.y) + (v.z * v.z + v.w * v.w); }
__device__ __forceinline__ u32x4 pack8(const f32x4 a, const f32x4 b) { u32x4 w; w.x = pg8::cvt_pk_bf16(a.x, a.y); w.y = pg8::cvt_pk_bf16(a.z, a.w); w.z = pg8::cvt_pk_bf16(b.x, b.y); w.w = pg8::cvt_pk_bf16(b.z, b.w); return w; }
__device__ __forceinline__ u32x2 pack4(const f32x4 a) { u32x2 w; w.x = pg8::cvt_pk_bf16(a.x, a.y); w.y = pg8::cvt_pk_bf16(a.z, a.w); return w; }

struct EpiInProj {
    static constexpr bool PERM = true;
    bf16_t* PROJ; float* DTRAW; float* SSQQ; float* SSQKV;
    __device__ __forceinline__ void operator()(const AccT& acc, const pg8::Unit& u, int wr, int wc, int fr, int fq) const {
        const int row0 = u.pm * 256 + wr * 64 + fr, col0 = u.pn * 256 + wc * 32 + 8 * fq;
#pragma unroll
        for (int ai = 0; ai < 2; ++ai)
#pragma unroll
            for (int m = 0; m < 4; ++m) {
                const int row = row0 + ai * 128 + m * 16;
                bf16_t* rowp = PROJ + (size_t)row * PROJ_N + col0;
#pragma unroll
                for (int bj = 0; bj < 2; ++bj) *(u32x4*)(rowp + bj * 128) = pack8(acc[ai][bj][m][0], acc[ai][bj][m][1]);
                if (u.pn == 0) {
                    float s = (sq4(acc[ai][0][m][0]) + sq4(acc[ai][0][m][1])) + (sq4(acc[ai][1][m][0]) + sq4(acc[ai][1][m][1]));
                    s += __shfl_xor(s, 16); s += __shfl_xor(s, 32);
                    if (fq == 0) SSQQ[row * 4 + wc] = s;
                } else if (u.pn == 1) {
                    float s = sq4(acc[ai][0][m][0]) + sq4(acc[ai][0][m][1]);
                    s += __shfl_xor(s, 16); s += __shfl_xor(s, 32);
                    if (fq == 0) SSQKV[row * 4 + wc] = s;
                    if (wc == 1 && fq < 2) { *(f32x4*)(DTRAW + row * 16 + 8 * fq) = acc[ai][1][m][0]; *(f32x4*)(DTRAW + row * 16 + 8 * fq + 4) = acc[ai][1][m][1]; }
                }
            }
    }
};
struct EpiQUp {
    static constexpr bool PERM = false;
    bf16_t* Q; const float* SSQQ; const float* COS; const float* SIN;
    __device__ __forceinline__ void operator()(const AccT& acc, const pg8::Unit& u, int wr, int wc, int fr, int fq) const {
#pragma unroll
        for (int ai = 0; ai < 2; ++ai) {
            asm volatile("" ::: "memory");
            f32x4 sv[4], cs[4], sn[4];
#pragma unroll
            for (int m = 0; m < 4; ++m) { const int row = u.pm * 256 + ai * 128 + wr * 64 + m * 16 + fr;
                sv[m] = *(const f32x4*)(SSQQ + row * 4); cs[m] = *(const f32x4*)(COS + row * 16 + 4 * fq); sn[m] = *(const f32x4*)(SIN + row * 16 + 4 * fq); }
#pragma unroll
            for (int m = 0; m < 4; ++m) {
                const int row = u.pm * 256 + ai * 128 + wr * 64 + m * 16 + fr, b = row / S, s = row % S;
                const float rs = 1.f / sqrtf(((sv[m].x + sv[m].y) + (sv[m].z + sv[m].w)) * (1.f / 256.f) + EPS);
#pragma unroll
                for (int bj = 0; bj < 2; ++bj) {
                    const int g32 = 8 * u.pn + 4 * bj + wc, h = g32 / 3, part = g32 % 3;
                    f32x4 v0 = acc[ai][bj][m][0] * rs, v1 = acc[ai][bj][m][1] * rs;
                    if (part == 2) { const f32x4 o0 = v0 * cs[m] - v1 * sn[m], o1 = v1 * cs[m] + v0 * sn[m]; v0 = o0; v1 = o1; }
                    bf16_t* qp = Q + ((size_t)(b * NH + h) * S + s) * DQK + part * 32 + 4 * fq;
                    *(u32x2*)qp = pack4(v0); *(u32x2*)(qp + 16) = pack4(v1);
                }
            }
        }
    }
};
struct EpiKVUp {
    static constexpr bool PERM = true;
    bf16_t* Kb; bf16_t* Vb; const float* SSQKV;
    __device__ __forceinline__ void operator()(const AccT& acc, const pg8::Unit& u, int wr, int wc, int fr, int fq) const {
        f32x4 svv[2][4];
#pragma unroll
        for (int ai = 0; ai < 2; ++ai)
#pragma unroll
            for (int m = 0; m < 4; ++m) svv[ai][m] = *(const f32x4*)(SSQKV + (u.pm * 256 + ai * 128 + wr * 64 + m * 16 + fr) * 4);
#pragma unroll
        for (int ai = 0; ai < 2; ++ai)
#pragma unroll
            for (int m = 0; m < 4; ++m) {
                const int row = u.pm * 256 + ai * 128 + wr * 64 + m * 16 + fr, b = row / S, s = row % S;
                const f32x4 sv = svv[ai][m];
                const float rs = 1.f / sqrtf(((sv.x + sv.y) + (sv.z + sv.w)) * (1.f / 128.f) + EPS);
#pragma unroll
                for (int bj = 0; bj < 2; ++bj) {
                    const int h = 2 * u.pn + bj; const size_t tile = (size_t)(b * NH + h) * (S / 64) + (s >> 6);
                    const u32x4 w = pack8(acc[ai][bj][m][0] * rs, acc[ai][bj][m][1] * rs);
                    if (wc < 2) *(u32x4*)(Kb + (tile * 12 + 4 * wc + fq) * 512 + (s & 63) * 8) = w;
                    else *(u32x4*)(Vb + (tile * 16 + (wc - 2) * 8 + ((s & 63) >> 3)) * 256 + (s & 7) * 32 + 8 * fq) = w;
                }
            }
    }
};
struct EpiResid {
    static constexpr bool PERM = true;
    const float* base; bf16_t* X1; float* SSQ;
    __device__ __forceinline__ void operator()(const AccT& acc, const pg8::Unit& u, int wr, int wc, int fr, int fq) const {
#pragma unroll
        for (int ai = 0; ai < 2; ++ai) {
            asm volatile("" ::: "memory");
            f32x4 xv[4][2][2];
#pragma unroll
            for (int m = 0; m < 4; ++m)
#pragma unroll
                for (int bj = 0; bj < 2; ++bj) { const size_t o = (size_t)(u.pm * 256 + ai * 128 + wr * 64 + m * 16 + fr) * D + u.pn * 256 + wc * 32 + 8 * fq + bj * 128;
                    xv[m][bj][0] = *(const f32x4*)(base + o); xv[m][bj][1] = *(const f32x4*)(base + o + 4); }
#pragma unroll
            for (int m = 0; m < 4; ++m) {
                const int row = u.pm * 256 + ai * 128 + wr * 64 + m * 16 + fr;
                const size_t ro = (size_t)row * D + u.pn * 256 + wc * 32 + 8 * fq;
                float s = 0.f;
#pragma unroll
                for (int bj = 0; bj < 2; ++bj) { const f32x4 v0 = xv[m][bj][0] + acc[ai][bj][m][0], v1 = xv[m][bj][1] + acc[ai][bj][m][1];
                    *(u32x4*)(X1 + ro + bj * 128) = pack8(v0, v1); s += sq4(v0) + sq4(v1); }
                s += __shfl_xor(s, 16); s += __shfl_xor(s, 32);
                if (fq == 0) SSQ[row * 16 + u.pn * 4 + wc] = s;
            }
        }
    }
};
struct EpiPleProj {
    static constexpr bool PERM = true;
    bf16_t* O; float* SSQ;
    __device__ __forceinline__ void operator()(const AccT& acc, const pg8::Unit& u, int wr, int wc, int fr, int fq) const {
#pragma unroll
        for (int ai = 0; ai < 2; ++ai)
#pragma unroll
            for (int m = 0; m < 4; ++m) {
                const int row = u.pm * 256 + ai * 128 + wr * 64 + m * 16 + fr;
                bf16_t* rowp = O + (size_t)row * D + u.pn * 256 + wc * 32 + 8 * fq;
#pragma unroll
                for (int bj = 0; bj < 2; ++bj) *(u32x4*)(rowp + bj * 128) = pack8(acc[ai][bj][m][0], acc[ai][bj][m][1]);
                float s = (sq4(acc[ai][0][m][0]) + sq4(acc[ai][0][m][1])) + (sq4(acc[ai][1][m][0]) + sq4(acc[ai][1][m][1]));
                s += __shfl_xor(s, 16); s += __shfl_xor(s, 32);
                if (fq == 0) SSQ[row * 16 + u.pn * 4 + wc] = s;
            }
    }
};
struct EpiPleGate {
    static constexpr bool PERM = true;
    bf16_t* G; const bf16_t* PR; const float* RSTDP; const float* bias; const float* wpost;
    __device__ __forceinline__ void operator()(const AccT& acc, const pg8::Unit& u, int wr, int wc, int fr, int fq) const {
        f32x4 bv[2][2], wv[2][2];
#pragma unroll
        for (int bj = 0; bj < 2; ++bj)
#pragma unroll
            for (int n = 0; n < 2; ++n) { const int col = u.pn * 256 + bj * 128 + wc * 32 + 8 * fq + 4 * n; bv[bj][n] = *(const f32x4*)(bias + col); wv[bj][n] = *(const f32x4*)(wpost + col); }
#pragma unroll
        for (int ai = 0; ai < 2; ++ai) {
            asm volatile("" ::: "memory");
            u32x4 pr[4][2]; float rsv[4];
#pragma unroll
            for (int m = 0; m < 4; ++m) { const int row = u.pm * 256 + ai * 128 + wr * 64 + m * 16 + fr; rsv[m] = RSTDP[row];
#pragma unroll
                for (int bj = 0; bj < 2; ++bj) pr[m][bj] = *(const u32x4*)(PR + (size_t)row * D + u.pn * 256 + bj * 128 + wc * 32 + 8 * fq); }
#pragma unroll
            for (int m = 0; m < 4; ++m) {
                const int row = u.pm * 256 + ai * 128 + wr * 64 + m * 16 + fr;
                const float rs = rsv[m];
#pragma unroll
                for (int bj = 0; bj < 2; ++bj) {
                    const unsigned pw[4] = {pr[m][bj].x, pr[m][bj].y, pr[m][bj].z, pr[m][bj].w};
                    f32x4 o[2];
#pragma unroll
                    for (int n = 0; n < 2; ++n) {
                        const f32x4 av = acc[ai][bj][m][n] + bv[bj][n];
                        const f32x4 pl = (f32x4){bf2f(pw[2 * n] & 0xffffu), bf2f(pw[2 * n] >> 16), bf2f(pw[2 * n + 1] & 0xffffu), bf2f(pw[2 * n + 1] >> 16)} * rs * wv[bj][n];
#pragma unroll
                        for (int j = 0; j < 4; ++j) o[n][j] = pl[j] / (1.f + __expf(-av[j]));
                    }
                    *(u32x4*)(G + (size_t)row * D + u.pn * 256 + bj * 128 + wc * 32 + 8 * fq) = pack8(o[0], o[1]);
                }
            }
        }
    }
};

struct GroupSched {
    const volatile LAS unsigned* ptile; int npn, G, c;
    __device__ __forceinline__ bool next(int i, pg8::Unit& u) const {
        const int L = i * G + c, total = (int)ptile[32] * npn; if (L >= total) return false;
        int e = 0;
        for (int q = 1; q < 32; ++q) e = (L >= (int)ptile[q] * npn) ? q : e;
        const int l = L - (int)ptile[e] * npn;
        u.pm = __builtin_amdgcn_readfirstlane((int)ptile[e] + l / npn); u.pn = __builtin_amdgcn_readfirstlane(e * npn + l % npn); return true;
    }
};
struct EpiMoeGU {
    static constexpr bool PERM = true;
    bf16_t* HE;
    __device__ __forceinline__ void operator()(const AccT& acc, const pg8::Unit& u, int wr, int wc, int fr, int fq) const {
        const int pn_l = u.pn & 1;
#pragma unroll
        for (int ai = 0; ai < 2; ++ai)
#pragma unroll
            for (int m = 0; m < 4; ++m) {
                const size_t row = (size_t)u.pm * 256 + ai * 128 + wr * 64 + m * 16 + fr;
                f32x4 h0, h1;
#pragma unroll
                for (int j = 0; j < 4; ++j) { const float g0 = acc[ai][0][m][0][j], g1 = acc[ai][0][m][1][j];
                    h0[j] = g0 / (1.f + __expf(-g0)) * acc[ai][1][m][0][j]; h1[j] = g1 / (1.f + __expf(-g1)) * acc[ai][1][m][1][j]; }
                *(u32x4*)(HE + row * 256 + pn_l * 128 + wc * 32 + 8 * fq) = pack8(h0, h1);
            }
    }
};
struct EpiMoeDown {
    static constexpr bool PERM = true;
    bf16_t* Y; const int* BUCKET; const float* ROUTE; const volatile LAS unsigned* ptile; const volatile LAS unsigned* cnt;
    __device__ __forceinline__ void operator()(const AccT& acc, const pg8::Unit& u, int wr, int wc, int fr, int fq) const {
        const int e = u.pn >> 2, pn_l = u.pn & 3, pm_l = u.pm - (int)ptile[e], n_e = (int)cnt[e];
        int entv[2][4]; float wvv[2][4];
#pragma unroll
        for (int ai = 0; ai < 2; ++ai)
#pragma unroll
            for (int m = 0; m < 4; ++m) { const int idx = pm_l * 256 + ai * 128 + wr * 64 + m * 16 + fr; entv[ai][m] = idx < n_e ? BUCKET[(size_t)e * T + idx] : 0; }
#pragma unroll
        for (int ai = 0; ai < 2; ++ai)
#pragma unroll
            for (int m = 0; m < 4; ++m) wvv[ai][m] = ROUTE[(entv[ai][m] >> 1) * 4 + 2 + (entv[ai][m] & 1)];
#pragma unroll
        for (int ai = 0; ai < 2; ++ai)
#pragma unroll
            for (int m = 0; m < 4; ++m) {
                const int idx = pm_l * 256 + ai * 128 + wr * 64 + m * 16 + fr;
                if (idx < n_e) {
                    const int ent = entv[ai][m];
                    const float w = wvv[ai][m];
                    bf16_t* yp = Y + (size_t)ent * D + pn_l * 256 + wc * 32 + 8 * fq;
#pragma unroll
                    for (int bj = 0; bj < 2; ++bj) *(u32x4*)(yp + bj * 128) = pack8(acc[ai][bj][m][0] * w, acc[ai][bj][m][1] * w);
                }
            }
    }
};

template <class CM, class GN>
__device__ __forceinline__ void transpose_item(const float* W, int ldw, int K, bf16_t* WT, float* scr, int kb, int nb, int lane, CM cm, GN gain) {
    const int k0 = 64 * kb, n0 = 32 * nb;
    const int sc = cm(n0 + (lane & 31));
    float tv[32];
#pragma unroll
    for (int i = 0; i < 32; ++i) { const int kk = 2 * i + (lane >> 5); tv[i] = sc >= 0 ? W[(size_t)(k0 + kk) * ldw + sc] : 0.f; }
#pragma unroll
    for (int i = 0; i < 32; ++i) { const int kk = 2 * i + (lane >> 5); scr[kk * 33 + (lane & 31)] = tv[i] * gain(k0 + kk); }
    asm volatile("s_waitcnt lgkmcnt(0)" ::: "memory");
    const int c = lane & 7;
#pragma unroll
    for (int j = 0; j < 4; ++j) { const int n = (lane >> 3) + 8 * j; const float* s = scr + (8 * c) * 33 + n;
        u32x4 o; o.x = pk2(s[0 * 33], s[1 * 33]); o.y = pk2(s[2 * 33], s[3 * 33]); o.z = pk2(s[4 * 33], s[5 * 33]); o.w = pk2(s[6 * 33], s[7 * 33]);
        *(u32x4*)(WT + (size_t)(n0 + n) * K + k0 + 8 * c) = o; }
    asm volatile("s_waitcnt lgkmcnt(0)" ::: "memory");
}


namespace att {
typedef short bf16x8 __attribute__((ext_vector_type(8)));
typedef short s16x4 __attribute__((ext_vector_type(4)));
typedef float f32x16 __attribute__((ext_vector_type(16)));
typedef short v4i16_t __attribute__((ext_vector_type(4)));
typedef float f32x2_t __attribute__((ext_vector_type(2))); typedef __bf16 bf16x2_t __attribute__((ext_vector_type(2)));
constexpr int KT = 64, NT = S / KT, KBYTES = KT * DQK * 2, VBYTES = KT * DV * 2, STAGE = KBYTES + VBYTES;
__device__ __forceinline__ unsigned cvtpk(float lo, float hi) { f32x2_t v = {lo, hi}; bf16x2_t b = __builtin_convertvector(v, bf16x2_t); return __builtin_bit_cast(unsigned, b); }
__device__ __forceinline__ s16x4 vtr(const LAS unsigned char* p) { return __builtin_bit_cast(s16x4, __builtin_amdgcn_ds_read_tr16_b64_v4i16((LAS v4i16_t*)p)); }
__device__ __forceinline__ float half_max(float m) { auto rr = __builtin_amdgcn_permlane32_swap(__float_as_uint(m), __float_as_uint(m), false, false); return fmaxf(__uint_as_float(rr[0]), __uint_as_float(rr[1])); }
__device__ __forceinline__ float half_sum(float m) { auto rr = __builtin_amdgcn_permlane32_swap(__float_as_uint(m), __float_as_uint(m), false, false); return __uint_as_float(rr[0]) + __uint_as_float(rr[1]); }

constexpr int KRING = 0, VRING = 4 * KBYTES, ATT_THR = 8;
__device__ __forceinline__ void attn_unit(LAS unsigned char* lds, const bf16_t* Qg, const bf16_t* Kg, const bf16_t* Vg, bf16_t* MIXg, int bh, int qb) {
    int tid = threadIdx.x; asm volatile("" : "+v"(tid));
    const int lane = tid & 63, wid = __builtin_amdgcn_readfirstlane(tid >> 6), r32 = lane & 31, hi = lane >> 5;
    const size_t rowbase = (size_t)bh * S;
    const bf16_t* qrow = Qg + (rowbase + qb * 256 + wid * 32 + r32) * DQK + 8 * hi;
    bf16x8 qf[6];
#pragma unroll
    for (int ds = 0; ds < 6; ++ds) qf[ds] = *(const bf16x8*)(qrow + ds * 16);
    const char* ksrc0 = (const char*)(Kg + rowbase * DQK) + wid * 1024 + lane * 16;
    const char* ksrc1 = ksrc0 + 8 * 1024;
    const char* vsrc = (const char*)(Vg + rowbase * DV) + wid * 1024 + lane * 16;
#define ATT_DMA_K(t, slot) do { \
        __builtin_amdgcn_global_load_lds((const unsigned*)(ksrc0 + (size_t)(t) * (KT * DQK * 2)), (LAS unsigned*)(lds + KRING + (slot) * KBYTES + wid * 1024), 16, 0, 0); \
        if (wid < 4) __builtin_amdgcn_global_load_lds((const unsigned*)(ksrc1 + (size_t)(t) * (KT * DQK * 2)), (LAS unsigned*)(lds + KRING + (slot) * KBYTES + (wid + 8) * 1024), 16, 0, 0); } while (0)
#define ATT_DMA_V(t, slot) __builtin_amdgcn_global_load_lds((const unsigned*)(vsrc + (size_t)(t) * (KT * DV * 2)), (LAS unsigned*)(lds + VRING + (slot) * VBYTES + wid * 1024), 16, 0, 0)
#define ATT_SYNC() do { asm volatile("s_waitcnt vmcnt(0) lgkmcnt(0)" ::: "memory"); __builtin_amdgcn_s_barrier(); __builtin_amdgcn_sched_barrier(0); } while (0)
#define ATT_SYNCN(tau) do { if ((tau) + 2 < NT) { if (g0) asm volatile("s_waitcnt vmcnt(3) lgkmcnt(0)" ::: "memory"); else asm volatile("s_waitcnt vmcnt(2) lgkmcnt(0)" ::: "memory"); } \
        else asm volatile("s_waitcnt vmcnt(0) lgkmcnt(0)" ::: "memory"); __builtin_amdgcn_s_barrier(); __builtin_amdgcn_sched_barrier(0); } while (0)
    const int koff = KRING + hi * 1024 + r32 * 16;
    const int voff = VRING + (4 * hi + ((lane & 15) >> 2)) * 64 + ((lane >> 4) & 1) * 32 + (lane & 3) * 8;
    f32x16 o0 = {}, o1 = {}, negm = {};
    float mref = 0.f, lpart = 0.f;
    f32x16 sA0, sA1, sB0, sB1;
    u32x4 pw[4];
    bf16x8 kf[12], vf[8];
#define ATT_SB() __builtin_amdgcn_sched_barrier(0)
#define ATT_LOADK(kslot) do { const LAS unsigned char* kb_ = lds + koff + (kslot) * KBYTES; \
        _Pragma("unroll") for (int ds = 0; ds < 6; ++ds) { kf[2 * ds] = *(const LAS bf16x8*)(kb_ + ds * 2048); kf[2 * ds + 1] = *(const LAS bf16x8*)(kb_ + ds * 2048 + 512); } } while (0)
#define ATT_LOADV(vslot) do { const LAS unsigned char* vb_ = lds + voff + (vslot) * VBYTES; \
        _Pragma("unroll") for (int ks = 0; ks < 4; ++ks) { \
            const s16x4 a0_ = vtr(vb_ + (2 * ks) * 512), a1_ = vtr(vb_ + (2 * ks + 1) * 512), b0_ = vtr(vb_ + (8 + 2 * ks) * 512), b1_ = vtr(vb_ + (8 + 2 * ks + 1) * 512); \
            vf[2 * ks] = (bf16x8){a0_[0], a0_[1], a0_[2], a0_[3], a1_[0], a1_[1], a1_[2], a1_[3]}; \
            vf[2 * ks + 1] = (bf16x8){b0_[0], b0_[1], b0_[2], b0_[3], b1_[0], b1_[1], b1_[2], b1_[3]}; } } while (0)
#define ATT_QK(X0, X1) do { \
        X0 = __builtin_amdgcn_mfma_f32_32x32x16_bf16(kf[0], qf[0], negm, 0, 0, 0); X1 = __builtin_amdgcn_mfma_f32_32x32x16_bf16(kf[1], qf[0], negm, 0, 0, 0); \
        _Pragma("unroll") for (int ds = 1; ds < 6; ++ds) { X0 = __builtin_amdgcn_mfma_f32_32x32x16_bf16(kf[2 * ds], qf[ds], X0, 0, 0, 0); X1 = __builtin_amdgcn_mfma_f32_32x32x16_bf16(kf[2 * ds + 1], qf[ds], X1, 0, 0, 0); } } while (0)
#define ATT_PV() do { \
        _Pragma("unroll") for (int ks = 0; ks < 4; ++ks) { const bf16x8 pf_ = __builtin_bit_cast(bf16x8, pw[ks]); \
            o0 = __builtin_amdgcn_mfma_f32_32x32x16_bf16(vf[2 * ks], pf_, o0, 0, 0, 0); o1 = __builtin_amdgcn_mfma_f32_32x32x16_bf16(vf[2 * ks + 1], pf_, o1, 0, 0, 0); } } while (0)
#define ATT_MAXPHASE(X0, X1, FIRST) do { \
        float mx_ = fmaxf(fmaxf(X0[0], X0[1]), X1[0]); float my_ = fmaxf(fmaxf(X0[2], X0[3]), X1[1]); mx_ = fmaxf(fmaxf(mx_, X1[2]), X1[3]); \
        _Pragma("unroll") for (int r = 4; r < 16; r += 4) { mx_ = fmaxf(fmaxf(mx_, X0[r]), X0[r + 1]); my_ = fmaxf(fmaxf(my_, X0[r + 2]), X0[r + 3]); mx_ = fmaxf(fmaxf(mx_, X1[r]), X1[r + 1]); my_ = fmaxf(fmaxf(my_, X1[r + 2]), X1[r + 3]); } \
        mx_ = half_max(fmaxf(mx_, my_)); \
        if ((FIRST) || __builtin_expect(__any(mx_ > (float)ATT_THR), 0)) { \
            asm volatile("; rescale (rare)" ::: "memory"); const float dl_ = (FIRST) ? mx_ : fmaxf(mx_, 0.f); mref += dl_; const float f_ = (FIRST) ? 1.f : __builtin_amdgcn_exp2f(-dl_); \
            _Pragma("unroll") for (int r = 0; r < 16; ++r) { X0[r] -= dl_; X1[r] -= dl_; o0[r] *= f_; o1[r] *= f_; negm[r] = -mref; } \
            lpart *= f_; asm volatile("" : "+v"(negm)); } } while (0)
#define ATT_EXPPHASE(X0, X1) do { float ls_ = 0.f; \
        _Pragma("unroll") for (int r = 0; r < 16; ++r) { X0[r] = __builtin_amdgcn_exp2f(X0[r]); X1[r] = __builtin_amdgcn_exp2f(X1[r]); ls_ += X0[r] + X1[r]; } \
        lpart += ls_; \
        _Pragma("unroll") for (int s = 0; s < 2; ++s) { \
            pw[s] = (u32x4){cvtpk(X0[8 * s], X0[8 * s + 1]), cvtpk(X0[8 * s + 2], X0[8 * s + 3]), cvtpk(X0[8 * s + 4], X0[8 * s + 5]), cvtpk(X0[8 * s + 6], X0[8 * s + 7])}; \
            pw[2 + s] = (u32x4){cvtpk(X1[8 * s], X1[8 * s + 1]), cvtpk(X1[8 * s + 2], X1[8 * s + 3]), cvtpk(X1[8 * s + 4], X1[8 * s + 5]), cvtpk(X1[8 * s + 6], X1[8 * s + 7])}; } } while (0)
#define ATT_ISSUE(t) do { if ((t) + 3 < NT) ATT_DMA_K((t) + 3, ((t) + 3) & 3); if ((t) + 2 < NT) ATT_DMA_V((t) + 2, ((t) + 2) & 3); } while (0)

    const bool g0 = wid < 4;
#define ATT_X(C0, C1, t) do { ATT_LOADV(((t) - 1) & 3); ATT_SB(); ATT_PV(); ATT_SB(); ATT_MAXPHASE(C0, C1, false); ATT_SB(); } while (0)
#define ATT_Y(C0, C1, N0, N1, t) do { ATT_LOADK(((t) + 1) & 3); ATT_SB(); ATT_EXPPHASE(C0, C1); ATT_SB(); ATT_QK(N0, N1); ATT_SB(); } while (0)
    ATT_DMA_K(0, 0); ATT_DMA_V(0, 0); ATT_DMA_K(1, 1);
    ATT_SYNC();
    ATT_DMA_K(2, 2); ATT_DMA_V(1, 1);
    ATT_LOADK(0); ATT_QK(sA0, sA1);
    ATT_SYNC();
    ATT_ISSUE(0);
    ATT_MAXPHASE(sA0, sA1, true);
    if (!g0) { ATT_SYNCN(1); ATT_ISSUE(1); }
    ATT_Y(sA0, sA1, sB0, sB1, 0);
    for (int t = 1; t + 2 < NT; t += 2) {
        if (g0) { ATT_SYNCN(t); ATT_ISSUE(t); }
        ATT_X(sB0, sB1, t);
        if (!g0) { ATT_SYNCN(t + 1); ATT_ISSUE(t + 1); }
        ATT_Y(sB0, sB1, sA0, sA1, t);
        if (g0) { ATT_SYNCN(t + 1); ATT_ISSUE(t + 1); }
        ATT_X(sA0, sA1, t + 1);
        if (!g0) { ATT_SYNCN(t + 2); ATT_ISSUE(t + 2); }
        ATT_Y(sA0, sA1, sB0, sB1, t + 1);
    }
    if (g0) { ATT_SYNCN(NT - 1); }
    ATT_X(sB0, sB1, NT - 1);
    ATT_EXPPHASE(sB0, sB1);
    ATT_LOADV((NT - 1) & 3); ATT_PV();
#undef ATT_X
#undef ATT_Y
    const float rl = 1.f / half_sum(lpart);
    const int b = bh >> 3, h = bh & 7;
    bf16_t* orow = MIXg + ((size_t)b * S + qb * 256 + wid * 32 + r32) * D + h * 64 + 4 * hi;
#pragma unroll
    for (int g4 = 0; g4 < 4; ++g4) {
        u32x2 w0, w1;
        w0.x = cvtpk(o0[4 * g4] * rl, o0[4 * g4 + 1] * rl); w0.y = cvtpk(o0[4 * g4 + 2] * rl, o0[4 * g4 + 3] * rl);
        w1.x = cvtpk(o1[4 * g4] * rl, o1[4 * g4 + 1] * rl); w1.y = cvtpk(o1[4 * g4 + 2] * rl, o1[4 * g4 + 3] * rl);
        *(u32x2*)(orow + 8 * g4) = w0; *(u32x2*)(orow + 32 + 8 * g4) = w1;
    }
    asm volatile("s_waitcnt lgkmcnt(0)" ::: "memory"); __builtin_amdgcn_s_barrier();
#undef ATT_DMA_K
#undef ATT_DMA_V
#undef ATT_SYNC
#undef ATT_QK
#undef ATT_PV
#undef ATT_MAXPHASE
#undef ATT_EXPPHASE
#undef ATT_SYNCN
#undef ATT_LOADK
#undef ATT_LOADV
#undef ATT_SB
#undef ATT_ISSUE
}
}


namespace ssd {
typedef short bf16x8 __attribute__((ext_vector_type(8)));
typedef short bf16x4 __attribute__((ext_vector_type(4)));
typedef float f32x16 __attribute__((ext_vector_type(16)));
constexpr int CH = 128, NCH = S / CH;
constexpr float LOG2E = 1.4426950408889634f;
__device__ __forceinline__ int crow(int r, int hi) { return (r & 3) + 8 * (r >> 2) + 4 * hi; }
__device__ __forceinline__ unsigned cvtpk(float lo, float hi) { return att::cvtpk(lo, hi); }
__device__ __forceinline__ void scan128(float a0, float a1, int lane, float& p0, float& p1, float& tot) {
    float s = a0 + a1;
#pragma unroll
    for (int o = 1; o < 64; o <<= 1) { const float t = __shfl_up(s, o); if (lane >= o) s += t; }
    tot = __shfl(s, 63); p1 = s; p0 = s - a1;
}
__device__ __forceinline__ void conv_chunk(float* smf, const bf16_t* PROJ, const float* cw, const float* cb, bf16_t* XBCC, bf16_t* XT, bf16_t* BT,
                                           const float* DTRAW, const float* dtb, float* DT, int b, int c) {
    int tid = threadIdx.x; asm volatile("" : "+v"(tid));
    const int t0 = b * S + c * CH, s0 = c * CH;
    if (tid < 2048 / 4) {
        const f32x4 raw = *(const f32x4*)(DTRAW + (size_t)t0 * 16 + tid * 4); const f32x4 bb = *(const f32x4*)(dtb + ((tid * 4) & 15)); f32x4 o;
#pragma unroll
        for (int j = 0; j < 4; ++j) { const float v = raw[j] + bb[j]; o[j] = v > 20.f ? v : log1pf(expf(v)); }
        *(f32x4*)(DT + (size_t)t0 * 16 + tid * 4) = o;
    }
    const int ch = tid & 127, lq = tid >> 7;
    for (int cbk = 0; cbk < 6; ++cbk) {
        __syncthreads();
        {
            u32x4 v[5];
#pragma unroll
            for (int q = 0; q < 5; ++q) { const int i = tid + q * 512, r = i >> 4, c8 = (i & 15) * 8, ss = s0 - 2 + r;
                v[q] = (u32x4){0u, 0u, 0u, 0u};
                if (i < 132 * 16 && ss >= 0 && ss < S) v[q] = *(const u32x4*)(PROJ + (size_t)(b * S + ss) * PROJ_N + PC_XBC + cbk * 128 + c8); }
#pragma unroll
            for (int q = 0; q < 5; ++q) { const int i = tid + q * 512, r = i >> 4, c8 = (i & 15) * 8;
                if (i < 132 * 16) { float* d = smf + r * 128 + c8;
                    d[0] = bf2f(v[q].x & 0xffffu); d[1] = bf2f(v[q].x >> 16); d[2] = bf2f(v[q].y & 0xffffu); d[3] = bf2f(v[q].y >> 16);
                    d[4] = bf2f(v[q].z & 0xffffu); d[5] = bf2f(v[q].z >> 16); d[6] = bf2f(v[q].w & 0xffffu); d[7] = bf2f(v[q].w >> 16); } }
        }
        __syncthreads();
        const int gch = cbk * 128 + ch;
        float w[5];
#pragma unroll
        for (int k = 0; k < 5; ++k) w[k] = cw[k * XBC + gch];
        const float bias = cb[gch];
        unsigned pk[16];
        float x0 = smf[(lq * 32 + 0) * 128 + ch], x1 = smf[(lq * 32 + 1) * 128 + ch], x2 = smf[(lq * 32 + 2) * 128 + ch], x3 = smf[(lq * 32 + 3) * 128 + ch];
        float prev = 0.f;
#pragma unroll
        for (int l = 0; l < 32; ++l) {
            const float x4 = smf[(lq * 32 + l + 4) * 128 + ch];
            const float acc = bias + w[0] * x0 + w[1] * x1 + w[2] * x2 + w[3] * x3 + w[4] * x4;
            const float v = acc / (1.f + __expf(-acc));
            XBCC[(size_t)(t0 + lq * 32 + l) * XBC + gch] = (bf16_t)f2bf(v);
            if (l & 1) pk[l >> 1] = pk2(prev, v); else prev = v;
            x0 = x1; x1 = x2; x2 = x3; x3 = x4;
        }
        if (cbk < 5) {
            const int cc = cbk < 4 ? gch : ch, hg = cc >> 6, rb = (cc >> 5) & 1, r5 = cc & 31;
            bf16_t* dst = (cbk < 4 ? XT + (size_t)(b * NCH + c) * 512 * CH + (size_t)hg * 64 * CH : BT + (size_t)(b * NCH + c) * 128 * CH + (size_t)hg * 64 * CH) + (size_t)lq * 2048;
#pragma unroll
            for (int s = 0; s < 2; ++s)
#pragma unroll
                for (int h2 = 0; h2 < 2; ++h2)
                    *(u32x4*)(dst + ((s * 2 + rb) * 64 + h2 * 32 + r5) * 8) = (u32x4){pk[8 * s + 2 * h2], pk[8 * s + 2 * h2 + 1], pk[8 * s + 4 + 2 * h2], pk[8 * s + 4 + 2 * h2 + 1]};
        }
    }
    __syncthreads();
}
__device__ __forceinline__ void states_chunk(float* wtab_all, const bf16_t* XT, const bf16_t* BT, const float* DT, const float* alog, float* STATES, float* CDEC, int b, int c) {
    int tid = threadIdx.x; asm volatile("" : "+v"(tid));
    const int lane = tid & 63, hd = __builtin_amdgcn_readfirstlane(tid >> 6), g = hd >> 2, r32 = lane & 31, hi = lane >> 5;
    float* wtab = wtab_all + hd * 128;
    const size_t t0 = (size_t)b * S + c * CH;
    const bf16_t* xt = XT + ((size_t)(b * NCH + c) * 512 + hd * 64) * CH; const bf16_t* bt = BT + ((size_t)(b * NCH + c) * 128 + g * 64) * CH;
    for (int dir = 0; dir < 2; ++dir) {
        const float av = -expf(alog[dir * 8 + hd]);
        const float d0 = DT[(t0 + 2 * lane) * 16 + dir * 8 + hd], d1 = DT[(t0 + 2 * lane + 1) * 16 + dir * 8 + hd];
        float p0, p1, tot; scan128(d0 * av, d1 * av, lane, p0, p1, tot);
        const float w0 = dir == 0 ? __expf(tot - p0) * d0 : __expf(p0 - d0 * av) * d0;
        const float w1 = dir == 0 ? __expf(tot - p1) * d1 : __expf(p1 - d1 * av) * d1;
        wtab[2 * lane] = w0; wtab[2 * lane + 1] = w1;
        if (lane == 0) CDEC[((b * NCH + c) * 2 + dir) * 8 + hd] = __expf(tot);
        asm volatile("s_waitcnt lgkmcnt(0)" ::: "memory");
        f32x16 acc[2][2];
#pragma unroll
        for (int i = 0; i < 2; ++i)
#pragma unroll
            for (int j = 0; j < 2; ++j) acc[i][j] = (f32x16){};
#pragma unroll 4
        for (int ks = 0; ks < 8; ++ks) {
            const f32x4 wa = *(const f32x4*)(wtab + 16 * ks + 4 * hi), wb = *(const f32x4*)(wtab + 16 * ks + 8 + 4 * hi);
            bf16x8 xb[2], bb[2];
#pragma unroll
            for (int pb = 0; pb < 2; ++pb) {
                const u32x4 v = *(const u32x4*)(xt + ((size_t)(ks * 2 + pb) * 64 + lane) * 8);
                u32x4 o; o.x = cvtpk(bf2f(v.x & 0xffffu) * wa.x, bf2f(v.x >> 16) * wa.y); o.y = cvtpk(bf2f(v.y & 0xffffu) * wa.z, bf2f(v.y >> 16) * wa.w);
                o.z = cvtpk(bf2f(v.z & 0xffffu) * wb.x, bf2f(v.z >> 16) * wb.y); o.w = cvtpk(bf2f(v.w & 0xffffu) * wb.z, bf2f(v.w >> 16) * wb.w);
                xb[pb] = __builtin_bit_cast(bf16x8, o);
            }
#pragma unroll
            for (int nb = 0; nb < 2; ++nb) bb[nb] = *(const bf16x8*)(bt + ((size_t)(ks * 2 + nb) * 64 + lane) * 8);
#pragma unroll
            for (int nb = 0; nb < 2; ++nb)
#pragma unroll
                for (int pb = 0; pb < 2; ++pb) acc[nb][pb] = __builtin_amdgcn_mfma_f32_32x32x16_bf16(bb[nb], xb[pb], acc[nb][pb], 0, 0, 0);
        }
        float* st = STATES + ((size_t)((b * NCH + c) * 2 + dir) * 8 + hd) * 4096;
#pragma unroll
        for (int nb = 0; nb < 2; ++nb)
#pragma unroll
            for (int pb = 0; pb < 2; ++pb)
#pragma unroll
                for (int q = 0; q < 4; ++q)
                    *(f32x4*)(st + (32 * pb + r32) * 64 + 32 * nb + 8 * q + 4 * hi) = (f32x4){acc[nb][pb][4 * q], acc[nb][pb][4 * q + 1], acc[nb][pb][4 * q + 2], acc[nb][pb][4 * q + 3]};
    }
}
__device__ __forceinline__ void finalize_chunk(float* smf, const bf16_t* XBCC, const bf16_t* XT, const bf16_t* PROJ, const float* DT, const float* alog, const bf16_t* HPB,
                                               const float* ssdd, const float* ssdnw, bf16_t* MIX, int b, int c) {
    int tid = threadIdx.x; asm volatile("" : "+v"(tid));
    const int lane = tid & 63, hd = __builtin_amdgcn_readfirstlane(tid >> 6), g = hd >> 2, r32 = lane & 31, hi = lane >> 5;
    f32x4* tab = (f32x4*)smf + hd * 128;
    float* red = smf + 8 * 128 * 4;
    const size_t t0 = (size_t)b * S + c * CH;
    {
        const float af = -expf(alog[hd]), ab = -expf(alog[8 + hd]);
        const float f0 = DT[(t0 + 2 * lane) * 16 + hd], f1 = DT[(t0 + 2 * lane + 1) * 16 + hd];
        const float b0 = DT[(t0 + 2 * lane) * 16 + 8 + hd], b1 = DT[(t0 + 2 * lane + 1) * 16 + 8 + hd];
        float pf0, pf1, tf, pb0, pb1, tb;
        scan128(f0 * af, f1 * af, lane, pf0, pf1, tf); scan128(b0 * ab, b1 * ab, lane, pb0, pb1, tb);
        tab[2 * lane] = (f32x4){pf0, f0, tb - (pb0 - b0 * ab), b0}; tab[2 * lane + 1] = (f32x4){pf1, f1, tb - (pb1 - b1 * ab), b1};
        asm volatile("s_waitcnt lgkmcnt(0)" ::: "memory");
    }
    LAS unsigned char* bc = (LAS unsigned char*)smf + 32768;
    {
        u32x4 v[8];
#pragma unroll
        for (int q = 0; q < 8; ++q) { const int i2 = tid + q * 512; v[q] = *(const u32x4*)(XBCC + (t0 + (i2 >> 5)) * XBC + 512 + (i2 & 31) * 8); }
#pragma unroll
        for (int q = 0; q < 8; ++q) { const int i2 = tid + q * 512; *(LAS u32x4*)(bc + (i2 & 31) * 2048 + (i2 >> 5) * 16) = v[q]; }
    }
    __syncthreads();
    const LAS unsigned char* bfrag = bc + (g * 8 + hi) * 2048 + r32 * 16;
    const LAS unsigned char* cfrag = bc + (16 + g * 8 + hi) * 2048 + r32 * 16;
    const bf16_t* xt = XT + ((size_t)(b * NCH + c) * 512 + hd * 64) * CH + lane * 8;
    const bf16_t* hpb = HPB + ((size_t)((b * NCH + c) * 2) * 8 + hd) * 4096 + lane * 8;
    const float dsk = ssdd[hd];
#define FIN_LOADX(dst, jb) do { _Pragma("unroll") for (int s = 0; s < 2; ++s) _Pragma("unroll") for (int pb = 0; pb < 2; ++pb) \
        dst[2 * s + pb] = *(const bf16x8*)(xt + (size_t)((((jb) * 2 + s) * 2 + pb) * 512)); } while (0)
#define FIN_LOADH(dst, dir) do { _Pragma("unroll") for (int ks = 0; ks < 4; ++ks) _Pragma("unroll") for (int pb = 0; pb < 2; ++pb) \
        dst[2 * ks + pb] = *(const bf16x8*)(hpb + (size_t)(dir) * 8 * 4096 + (pb * 4 + ks) * 512); } while (0)
#define FIN_TILE(jb, xf) do { \
        f32x16 gt = (f32x16){}; \
        _Pragma("unroll") for (int ks = 0; ks < 4; ++ks) gt = __builtin_amdgcn_mfma_f32_32x32x16_bf16(*(const LAS bf16x8*)(bfrag + ks * 4096 + (jb) * 512), cf[ks], gt, 0, 0, 0); \
        _Pragma("unroll") for (int r = 0; r < 16; ++r) { \
            const int j = 32 * (jb) + crow(r, hi); const f32x4 tj = tab[j]; \
            const bool lt = j < i, gtj = j > i; \
            const float arg = lt ? ti.x - tj.x : (gtj ? ti.z - tj.z : 0.f); \
            const float dj = lt ? tj.y : (gtj ? tj.w : ti.y + ti.w); \
            gt[r] = gt[r] * __builtin_amdgcn_exp2f(arg * LOG2E) * dj; } \
        u32x4 pw[2]; \
        _Pragma("unroll") for (int s = 0; s < 2; ++s) pw[s] = (u32x4){cvtpk(gt[8 * s], gt[8 * s + 1]), cvtpk(gt[8 * s + 2], gt[8 * s + 3]), cvtpk(gt[8 * s + 4], gt[8 * s + 5]), cvtpk(gt[8 * s + 6], gt[8 * s + 7])}; \
        _Pragma("unroll") for (int s = 0; s < 2; ++s) _Pragma("unroll") for (int pb = 0; pb < 2; ++pb) \
            yT[pb] = __builtin_amdgcn_mfma_f32_32x32x16_bf16(xf[2 * s + pb], __builtin_bit_cast(bf16x8, pw[s]), yT[pb], 0, 0, 0); } while (0)
#define FIN_YOFF(hp, dir) do { const float ei = __builtin_amdgcn_exp2f(((dir) == 0 ? ti.x : ti.z) * LOG2E); \
        _Pragma("unroll") for (int ks = 0; ks < 4; ++ks) { \
            const u32x4 cv = __builtin_bit_cast(u32x4, cf[ks]); u32x4 cs; \
            cs.x = cvtpk(bf2f(cv.x & 0xffffu) * ei, bf2f(cv.x >> 16) * ei); cs.y = cvtpk(bf2f(cv.y & 0xffffu) * ei, bf2f(cv.y >> 16) * ei); \
            cs.z = cvtpk(bf2f(cv.z & 0xffffu) * ei, bf2f(cv.z >> 16) * ei); cs.w = cvtpk(bf2f(cv.w & 0xffffu) * ei, bf2f(cv.w >> 16) * ei); \
            _Pragma("unroll") for (int pb = 0; pb < 2; ++pb) yT[pb] = __builtin_amdgcn_mfma_f32_32x32x16_bf16(hp[2 * ks + pb], __builtin_bit_cast(bf16x8, cs), yT[pb], 0, 0, 0); } } while (0)
    bf16x8 xA[4], xB[4], hA[8];
    FIN_LOADX(xA, 0);
#pragma unroll 1
    for (int ib = 0; ib < 4; ++ib) {
        asm volatile("" : "+v"(xt), "+v"(hpb));
        const int i = 32 * ib + r32;
        const f32x4 ti = tab[i];
        bf16x8 cf[4];
#pragma unroll
        for (int ks = 0; ks < 4; ++ks) cf[ks] = *(const LAS bf16x8*)(cfrag + ks * 4096 + ib * 512);
        f32x16 yT[2]; yT[0] = (f32x16){}; yT[1] = (f32x16){};
        FIN_LOADX(xB, 1); __builtin_amdgcn_sched_barrier(0);
        FIN_TILE(0, xA);
        FIN_LOADX(xA, 2); __builtin_amdgcn_sched_barrier(0);
        FIN_TILE(1, xB);
        FIN_LOADX(xB, 3); __builtin_amdgcn_sched_barrier(0);
        FIN_TILE(2, xA);
        FIN_LOADH(hA, 0); __builtin_amdgcn_sched_barrier(0);
        FIN_TILE(3, xB);
        u32x2 xv[8], zv[8];
#pragma unroll
        for (int q = 0; q < 8; ++q) { const int p = 32 * (q >> 2) + 8 * (q & 3) + 4 * hi;
            xv[q] = *(const u32x2*)(XBCC + (t0 + i) * XBC + hd * 64 + p); zv[q] = *(const u32x2*)(PROJ + (t0 + i) * PROJ_N + PC_Z + hd * 64 + p); }
        __builtin_amdgcn_sched_barrier(0);
        FIN_YOFF(hA, 0);
        FIN_LOADH(hA, 1); FIN_LOADX(xA, 0); __builtin_amdgcn_sched_barrier(0);
        FIN_YOFF(hA, 1);
        float ss = 0.f;
#pragma unroll
        for (int q8 = 0; q8 < 8; ++q8) {
            const int pb = q8 >> 2, q = q8 & 3;
            const float xs[4] = {bf2f(xv[q8].x & 0xffffu), bf2f(xv[q8].x >> 16), bf2f(xv[q8].y & 0xffffu), bf2f(xv[q8].y >> 16)};
            const float zs[4] = {bf2f(zv[q8].x & 0xffffu), bf2f(zv[q8].x >> 16), bf2f(zv[q8].y & 0xffffu), bf2f(zv[q8].y >> 16)};
#pragma unroll
            for (int e = 0; e < 4; ++e) { const float y = yT[pb][4 * q + e] + dsk * xs[e]; const float gv = y * (zs[e] / (1.f + __expf(-zs[e]))); yT[pb][4 * q + e] = gv; ss += gv * gv; }
        }
        ss = att::half_sum(ss);
        __syncthreads();
        if (hi == 0) red[hd * 32 + r32] = ss;
        __syncthreads();
        float tot = 0.f;
#pragma unroll
        for (int w8 = 0; w8 < 8; ++w8) tot += red[w8 * 32 + r32];
        const float rstd = 1.f / sqrtf(tot * (1.f / 512.f) + EPS);
#pragma unroll
        for (int pb = 0; pb < 2; ++pb)
#pragma unroll
            for (int q = 0; q < 4; ++q) {
                const int p = 32 * pb + 8 * q + 4 * hi;
                const f32x4 wv = *(const f32x4*)(ssdnw + hd * 64 + p);
                u32x2 o; o.x = cvtpk(yT[pb][4 * q] * rstd * wv.x, yT[pb][4 * q + 1] * rstd * wv.y); o.y = cvtpk(yT[pb][4 * q + 2] * rstd * wv.z, yT[pb][4 * q + 3] * rstd * wv.w);
                *(u32x2*)(MIX + (t0 + i) * D + 512 + hd * 64 + p) = o;
            }
    }
#undef FIN_LOADX
#undef FIN_LOADH
#undef FIN_TILE
#undef FIN_YOFF
    __syncthreads();
}
}

struct Args { const void* in[31]; float* out; unsigned char* ws; int ph_lo, ph_hi; };
#define IN_F(i) ((const float*)a.in[i])
enum { I_X = 0, I_P, I_POS, I_ATTN_NW, I_WIN, I_QNW, I_WUQ, I_KVNW, I_WUKV, I_AONW, I_CONVW, I_CONVB, I_DTB, I_ALOG, I_SSDD, I_SSDNW, I_WO, I_FFNNW,
       I_WRG, I_BRG, I_WRE, I_BRE, I_WEG, I_WEU, I_WED, I_PLENW, I_WPG, I_BPG, I_WPP, I_PPNW, I_FNW };

template <class FA, class FB, class FE>
__device__ __forceinline__ void naive_gemm(int M, int N, int K, FA fa, FB fb, FE fe, float* sm) {
    const int tid = threadIdx.x, tx = tid & 63, ty = tid >> 6;
    float* As = sm; float* Bs = sm + 64 * 17;
    const int ntm = M / 64, ntn = (N + 63) / 64;
    for (int tile = blockIdx.x; tile < ntm * ntn; tile += gridDim.x) {
        const int tm = tile / ntn, tn = tile % ntn;
        float acc[8];
#pragma unroll
        for (int j = 0; j < 8; ++j) acc[j] = 0.f;
        for (int k0 = 0; k0 < K; k0 += 16) {
            __syncthreads();
            for (int i = tid; i < 1024; i += 512) { const int r = i >> 4, c = i & 15; As[r * 17 + c] = fa(tm * 64 + r, k0 + c); }
            for (int i = tid; i < 1024; i += 512) { const int r = i >> 6, c = i & 63; const int n = tn * 64 + c; Bs[r * 64 + c] = (n < N) ? fb(k0 + r, n) : 0.f; }
            __syncthreads();
#pragma unroll
            for (int k = 0; k < 16; ++k) { const float b = Bs[k * 64 + tx];
#pragma unroll
                for (int j = 0; j < 8; ++j) acc[j] += As[(ty * 8 + j) * 17 + k] * b; }
        }
#pragma unroll
        for (int j = 0; j < 8; ++j) { const int m = tm * 64 + ty * 8 + j, n = tn * 64 + tx; if (n < N) fe(m, n, acc[j]); }
    }
    __syncthreads();
}

__device__ __forceinline__ int proj_src_col(int j) {
    if (j < 416) return j;
    if (j < 432) return 1696 + (j - 416);
    if (j < 512) return -1;
    if (j < 1024) return 416 + (j - 512);
    return 928 + (j - 1024);
}

__device__ __forceinline__ void rms_row_to_bf16(const float* xrow, const float* w, bf16_t* orow, int lane) {
    const f32x4* xr = (const f32x4*)xrow + lane; const f32x4* wr = (const f32x4*)w + lane;
    f32x4 v[4]; float s = 0.f;
#pragma unroll
    for (int j = 0; j < 4; ++j) { v[j] = xr[64 * j]; s += (v[j].x * v[j].x + v[j].y * v[j].y) + (v[j].z * v[j].z + v[j].w * v[j].w); }
    const float rstd = 1.f / sqrtf(wave_sum(s) * (1.f / D) + EPS);
    u32x2* o8 = (u32x2*)orow + lane;
#pragma unroll
    for (int j = 0; j < 4; ++j) { const f32x4 g = wr[64 * j]; u32x2 o; o.x = pk2(v[j].x * rstd * g.x, v[j].y * rstd * g.y); o.y = pk2(v[j].z * rstd * g.z, v[j].w * rstd * g.w); o8[64 * j] = o; }
}

constexpr int LDS_BYTES = 147456;
constexpr int MISC_OFF = 131072;

__global__ void __launch_bounds__(512, 2) fwd(Args a) {
    extern __shared__ __attribute__((aligned(16))) unsigned char lds_raw[];
    float* smf = (float*)lds_raw;
    const int G = gridDim.x, NGW = G * 8, NGT = G * 512;
#define FRESH_IDS() int tid = threadIdx.x; asm volatile("" : "+v"(tid)); const int lane = tid & 63, wave = __builtin_amdgcn_readfirstlane(tid >> 6); \
    const int gw = blockIdx.x * 8 + wave, gtid = blockIdx.x * 512 + tid; (void)lane; (void)gw; (void)gtid;
    unsigned char* ws = a.ws;
    unsigned* ctl = (unsigned*)(ws + WS_CTL);
    volatile LAS unsigned* MISC = (volatile LAS unsigned*)((LAS unsigned char*)lds_raw + MISC_OFF);
    if (threadIdx.x < 32) MISC[threadIdx.x] = 0u;
    __syncthreads();
#if !MK_PER_PHASE
    XcdBarrier bar = xcd_barrier_post(ctl + CW_BAR, MISC + 8);
#define GRID_BAR() xcd_barrier(bar)
#else
#define GRID_BAR() do {} while (0)
#endif
    const int lo = a.ph_lo, hi = a.ph_hi;
#ifndef PHMASK
#define PHMASK 0xFFFF
#endif
#define IN(k) (((PHMASK >> (k)) & 1) && lo <= (k) && (k) < hi)
#ifndef REPMASK
#define REPMASK 0
#endif
#define NREP(k) (1 + ((REPMASK >> (k)) & 1))
#define SEAM(k) do { if (IN(k) && IN((k) + 1)) GRID_BAR(); } while (0)

    const float* x = IN_F(I_X);
    float* out = a.out;
    bf16_t* H = (bf16_t*)(ws + WS_H);
    bf16_t* PROJ = (bf16_t*)(ws + WS_PROJ);
    bf16_t* PLERAW = (bf16_t*)(ws + WS_PROJ);
    bf16_t* Qb = (bf16_t*)(ws + WS_Q); bf16_t* Kb = (bf16_t*)(ws + WS_K); bf16_t* Vb = (bf16_t*)(ws + WS_V);
    bf16_t* MIX = (bf16_t*)(ws + WS_MIX);
    bf16_t* XBCC = (bf16_t*)(ws + WS_XBCC);
    float* STATES = out;
    bf16_t* XT = (bf16_t*)((char*)out + 64 * MiB);
    bf16_t* BT = (bf16_t*)((char*)out + 96 * MiB);
    bf16_t* HPB = (bf16_t*)(ws + WS_H);
    bf16_t* X1B = (bf16_t*)out;
    float* RSTDP = (float*)(ws + WS_RSTDP);
    float* CDEC = (float*)(ws + WS_CDEC);
    float* COS = (float*)(ws + WS_COS); float* SIN = (float*)(ws + WS_SIN);
    float* DT = (float*)(ws + WS_DT); float* DTRAW = (float*)(ws + WS_DTRAW);
    float* ROUTE = (float*)(ws + WS_ROUTE);
    int* BUCKET = (int*)(ws + WS_BUCKET);
    const int* pos = (const int*)a.in[I_POS];

    bf16_t* WT_IN = (bf16_t*)(ws + WS_WEIGHTS);
    bf16_t* WT_UQ = WT_IN + (size_t)PROJ_N * D;
    bf16_t* WT_UKV = WT_UQ + 768 * 256;
    bf16_t* WT_O = WT_UKV + 1024 * 128;
    bf16_t* WT_PG = WT_O + (size_t)D * D;
    bf16_t* WT_PP = WT_PG + (size_t)D * D;
    bf16_t* WT_GU = WT_PP + (size_t)D * 256;
    bf16_t* WT_DN = WT_GU + (size_t)32 * 512 * 1024;
    bf16_t* PB = (bf16_t*)(ws + WS_PB);
    float* SSQQ = (float*)(ws + WS_SSQQ); float* SSQKV = (float*)(ws + WS_SSQKV); float* SSQPLE = (float*)(ws + WS_SSQPLE);
    LAS unsigned char* ldsb = (LAS unsigned char*)lds_raw;
    bf16_t* WRF = (bf16_t*)(ws + WS_WRF);
    float* SSQX1 = (float*)(ws + WS_SSQX1);

    if (IN(0)) {
        FRESH_IDS();
        for (int rep_ = 0; rep_ < NREP(0); ++rep_) {
        float* scr = smf + wave * 4096;
        constexpr int I_IN = 16 * 56, I_UQ = 4 * 24, I_UKV = 2 * 32, I_O = 16 * 32, I_PG = 16 * 32, I_PP = 4 * 32, I_GU = 32 * 16 * 16, I_DN = 32 * 4 * 32;
        constexpr int NITEMS = I_IN + I_UQ + I_UKV + I_O + I_PG + I_PP + I_GU + I_DN;
        const float* qnw = IN_F(I_QNW); const float* kvnw = IN_F(I_KVNW);
        const float qscale = 0.10206207261596575f * 1.4426950408889634f;
        auto one = [](int) { return 1.f; };
        auto ident = [](int n) { return n; };
        for (int it = gw; it < NITEMS; it += NGW) {
            int r = it;
            if (r < I_IN) { transpose_item(IN_F(I_WIN), IN_COLS, D, WT_IN, scr, r / 56, r % 56, lane, [](int n) { return proj_src_col(n); }, one); continue; } r -= I_IN;
            if (r < I_UQ) { transpose_item(IN_F(I_WUQ), 768, 256, WT_UQ, scr, r / 24, r % 24, lane, ident, [&](int k) { return qnw[k] * qscale; }); continue; } r -= I_UQ;
            if (r < I_UKV) { transpose_item(IN_F(I_WUKV), 1024, 128, WT_UKV, scr, r / 32, r % 32, lane, ident, [&](int k) { return kvnw[k]; }); continue; } r -= I_UKV;
            if (r < I_O) { transpose_item(IN_F(I_WO), D, D, WT_O, scr, r / 32, r % 32, lane, ident, one); continue; } r -= I_O;
            if (r < I_PG) { transpose_item(IN_F(I_WPG), D, D, WT_PG, scr, r / 32, r % 32, lane, ident, one); continue; } r -= I_PG;
            if (r < I_PP) { transpose_item(IN_F(I_WPP), D, 256, WT_PP, scr, r / 32, r % 32, lane, ident, one); continue; } r -= I_PP;
            if (r < I_GU) { const int e = r / 256, q = r % 256, kb = q / 16, nb = q % 16;
                const float* W = ((nb & 7) < 4 ? IN_F(I_WEG) : IN_F(I_WEU)) + (size_t)e * 1024 * 256;
                transpose_item(W, 256, D, WT_GU + (size_t)e * 512 * 1024, scr, kb, nb, lane, [](int n) { return (n >> 8) * 128 + (n & 127); }, one); continue; } r -= I_GU;
            { const int e = r / 128, q = r % 128; transpose_item(IN_F(I_WED) + (size_t)e * 256 * 1024, D, 256, WT_DN + (size_t)e * 1024 * 256, scr, q / 32, q % 32, lane, ident, one); }
        }
        { const f32x4* wr4 = (const f32x4*)IN_F(I_ATTN_NW) + lane;
          for (int m0 = gw * 4; m0 < T; m0 += NGW * 4) {
              f32x4 v[4][4];
#pragma unroll
              for (int r = 0; r < 4; ++r)
#pragma unroll
                  for (int j = 0; j < 4; ++j) v[r][j] = ((const f32x4*)(x + (size_t)(m0 + r) * D) + lane)[64 * j];
#pragma unroll
              for (int r = 0; r < 4; ++r) {
                  float s = 0.f;
#pragma unroll
                  for (int j = 0; j < 4; ++j) s += (v[r][j].x * v[r][j].x + v[r][j].y * v[r][j].y) + (v[r][j].z * v[r][j].z + v[r][j].w * v[r][j].w);
                  const float rstd = 1.f / sqrtf(wave_sum(s) * (1.f / D) + EPS);
                  u32x2* o8 = (u32x2*)(H + (size_t)(m0 + r) * D) + lane;
#pragma unroll
                  for (int j = 0; j < 4; ++j) { const f32x4 g4 = wr4[64 * j]; u32x2 o; o.x = pk2(v[r][j].x * rstd * g4.x, v[r][j].y * rstd * g4.y); o.y = pk2(v[r][j].z * rstd * g4.z, v[r][j].w * rstd * g4.w); o8[64 * j] = o; }
              } } }
        { const f32x4* pp = (const f32x4*)IN_F(I_P); u32x2* po = (u32x2*)PB;
          for (int i0 = gtid; i0 < T * 256 / 4; i0 += NGT * 8) { f32x4 v[8];
#pragma unroll
              for (int q = 0; q < 8; ++q) v[q] = pp[i0 + q * NGT];
#pragma unroll
              for (int q = 0; q < 8; ++q) { u32x2 o; o.x = pk2(v[q].x, v[q].y); o.y = pk2(v[q].z, v[q].w); po[i0 + q * NGT] = o; } } }
        { const float* wrg = IN_F(I_WRG); const float* wre = IN_F(I_WRE);
          for (int i = gtid; i < 32 * 3 * 64 * 8; i += NGT) { const int e = i & 7, l = (i >> 3) & 63, nb = (i >> 9) % 3, ks = i / 1536;
              const int k = 32 * ks + 8 * (l >> 4) + e, col = 16 * nb + (l & 15);
              const float w = col < 4 ? wrg[k * 4 + col] : (col < 36 ? wre[k * 32 + (col - 4)] : 0.f);
              const unsigned hi = f2bf(w); const float lo = w - bf2f(hi);
              const size_t base = ((size_t)(ks * 3 + nb) * 2) * 512 + l * 8 + e;
              WRF[base] = (bf16_t)hi; WRF[base + 512] = (bf16_t)f2bf(lo); } }
        for (int i = gtid; i < T * 16; i += NGT) {
            const int t = i >> 4, f = i & 15;
            const float inv = 1.0f / powf(10000.0f, (float)(2 * f) / 32.0f);
            const float ang = (float)pos[t] * inv;
            COS[i] = cosf(ang); SIN[i] = sinf(ang);
        }
        }
    }
    SEAM(0);
    if (IN(1)) {
        FRESH_IDS();
        for (int rep_ = 0; rep_ < NREP(1); ++rep_) {
        pg8::Gemm g{H, WT_IN, T, PROJ_N, D, D, D}; pg8::StaticOrder So; So.init(T, PROJ_N, G, (int)blockIdx.x);
        EpiInProj E{PROJ, DTRAW, SSQQ, SSQKV};
        pg8::gemm_phase(ldsb, g, So, E);
        }
    }
    SEAM(1);
    if (IN(2)) {
        FRESH_IDS();
        for (int rep_ = 0; rep_ < NREP(2); ++rep_)
        for (int u = blockIdx.x; u < NB * ssd::NCH; u += G) {
            ssd::conv_chunk(smf, PROJ, IN_F(I_CONVW), IN_F(I_CONVB), XBCC, XT, BT, DTRAW, IN_F(I_DTB), DT, u >> 5, u & 31);
            ssd::states_chunk(smf + 20480, XT, BT, DT, IN_F(I_ALOG), STATES, CDEC, u >> 5, u & 31);
            __syncthreads();
        }
        for (int i = gtid; i < T * 16; i += NGT) {
            const int t = i >> 4, f = i & 15, b = t / S, s = t % S;
            const float c = COS[i], sn = SIN[i];
            const float t1 = bf2f(PROJ[(size_t)t * PROJ_N + PC_KR + f]), t2 = bf2f(PROJ[(size_t)t * PROJ_N + PC_KR + 16 + f]);
            const bf16_t o1 = (bf16_t)f2bf(t1 * c - t2 * sn), o2 = (bf16_t)f2bf(t2 * c + t1 * sn);
            for (int h = 0; h < NH; ++h) { bf16_t* kt = Kb + ((size_t)(b * NH + h) * (S / 64) + (s >> 6)) * (12 * 512) + (s & 63) * 8 + (f & 7); kt[(8 + (f >> 3)) * 512] = o1; kt[(10 + (f >> 3)) * 512] = o2; }
        }
        __syncthreads();
        for (int rep2_ = 0; rep2_ < NREP(12); ++rep2_) {
        { pg8::Gemm g{PROJ + PC_CQ, WT_UQ, T, 768, 256, PROJ_N, 256}; pg8::StaticOrder So; So.init(T, 768, G, (int)blockIdx.x);
          EpiQUp E{Qb, SSQQ, COS, SIN}; pg8::gemm_phase(ldsb, g, So, E); }
        { pg8::Gemm g{PROJ + PC_CKV, WT_UKV, T, 1024, 128, PROJ_N, 128}; pg8::StaticOrder So; So.init(T, 1024, G, (int)blockIdx.x);
          EpiKVUp E{Kb, Vb, SSQKV}; pg8::gemm_phase(ldsb, g, So, E); }
        }
    }
    SEAM(2);
    if (IN(3)) {
        FRESH_IDS();
        for (int rep_ = 0; rep_ < NREP(13); ++rep_)
        for (int idx = gtid; idx < 128 * 1024; idx += NGT) {
            const int chain = idx >> 10, e4 = (idx & 1023) * 4, b = chain >> 4, dir = (chain >> 3) & 1, hd = chain & 7;
            f32x4 h4 = (f32x4){0.f, 0.f, 0.f, 0.f};
#pragma unroll 8
            for (int step = 0; step < ssd::NCH; ++step) {
                const int c = dir == 0 ? step : ssd::NCH - 1 - step;
                const int sidx = ((b * ssd::NCH + c) * 2 + dir) * 8 + hd;
                const f32x4* ptr = (const f32x4*)(STATES + (size_t)sidx * 4096 + e4);
                const f32x4 s4 = *ptr; { u32x2 hb; hb.x = pk2(h4.x, h4.y); hb.y = pk2(h4.z, h4.w); const int p_ = e4 >> 6, n0_ = e4 & 63; *(u32x2*)(HPB + (size_t)sidx * 4096 + (((p_ >> 5) * 4 + (n0_ >> 4)) * 64 + ((n0_ >> 3) & 1) * 32 + (p_ & 31)) * 8 + (n0_ & 7)) = hb; } h4 = h4 * CDEC[sidx] + s4;
            }
        }
        __syncthreads();
        for (int rep_ = 0; rep_ < NREP(3); ++rep_) {
        {
            const int vcu = (G % 8 == 0) ? ((int)blockIdx.x % 8) * (G / 8) + (int)blockIdx.x / 8 : (int)blockIdx.x;
            for (int u = vcu; u < NB * NH * 16; u += G) att::attn_unit(ldsb, Qb, Kb, Vb, MIX, u >> 4, u & 15);
        }
        }
    }
    SEAM(3);
    if (IN(4)) {
        FRESH_IDS();
        const float* aonw = IN_F(I_AONW);
        for (int u = blockIdx.x; u < NB * ssd::NCH; u += G) {
            for (int rep_ = 0; rep_ < NREP(4); ++rep_)
                ssd::finalize_chunk(smf, XBCC, XT, PROJ, DT, IN_F(I_ALOG), HPB, IN_F(I_SSDD), IN_F(I_SSDNW), MIX, u >> 5, u & 31);
            for (int r0 = wave * 4; r0 < ssd::CH; r0 += 32) {
                u32x4 raw[4];
#pragma unroll
                for (int q = 0; q < 4; ++q) raw[q] = *(const u32x4*)(MIX + ((size_t)(u >> 5) * S + (u & 31) * ssd::CH + r0 + q) * D + lane * 8);
                const f32x4 w0 = *(const f32x4*)(aonw + lane * 8), w1 = *(const f32x4*)(aonw + lane * 8 + 4);
#pragma unroll
                for (int q = 0; q < 4; ++q) {
                    float v[8] = {bf2f(raw[q].x & 0xffffu), bf2f(raw[q].x >> 16), bf2f(raw[q].y & 0xffffu), bf2f(raw[q].y >> 16), bf2f(raw[q].z & 0xffffu), bf2f(raw[q].z >> 16), bf2f(raw[q].w & 0xffffu), bf2f(raw[q].w >> 16)};
                    float ss = 0.f;
#pragma unroll
                    for (int j = 0; j < 8; ++j) ss += v[j] * v[j];
                    const float rstd = 1.f / sqrtf(wave_sum(ss) * (1.f / 512.f) + EPS);
                    u32x4 o; o.x = pk2(v[0] * rstd * w0.x, v[1] * rstd * w0.y); o.y = pk2(v[2] * rstd * w0.z, v[3] * rstd * w0.w);
                    o.z = pk2(v[4] * rstd * w1.x, v[5] * rstd * w1.y); o.w = pk2(v[6] * rstd * w1.z, v[7] * rstd * w1.w);
                    *(u32x4*)(MIX + ((size_t)(u >> 5) * S + (u & 31) * ssd::CH + r0 + q) * D + lane * 8) = o;
                }
            }
        }
    }
    SEAM(4);
    if (IN(5)) {
        FRESH_IDS();
        for (int rep_ = 0; rep_ < NREP(5); ++rep_) {
        pg8::Gemm g{MIX, WT_O, T, D, D, D, D}; pg8::StaticOrder So; So.init(T, D, G, (int)blockIdx.x);
        EpiResid E{x, X1B, SSQX1}; pg8::gemm_phase(ldsb, g, So, E);
        }
    }
    SEAM(5);
    if (IN(6)) {
        FRESH_IDS();
        {
            typedef short bf16x8r __attribute__((ext_vector_type(8)));
            const float* fw = IN_F(I_FFNNW); const float* brg = IN_F(I_BRG); const float* bre = IN_F(I_BRE);
            const int r16 = lane & 15, kq = lane >> 4;
            float* lg = smf + wave * (16 * 48);
            for (int rep_ = 0; rep_ < NREP(6); ++rep_)
            for (int rb = gw; rb < T / 16; rb += NGW) {
                const int row = rb * 16 + r16;
                float ss = 0.f;
#pragma unroll
                for (int q = 0; q < 4; ++q) { const f32x4 sv = *(const f32x4*)(SSQX1 + row * 16 + 4 * q); ss += (sv.x + sv.y) + (sv.z + sv.w); }
                const float rstd = 1.f / sqrtf(ss * (1.f / D) + EPS);
                f32x4 acc[3]; acc[0] = (f32x4){0.f, 0.f, 0.f, 0.f}; acc[1] = acc[0]; acc[2] = acc[0];
                const bf16_t* xrow = X1B + (size_t)row * D + 8 * kq;
#pragma unroll 8
                for (int ks = 0; ks < 32; ++ks) {
                    const u32x4 xb = *(const u32x4*)(xrow + 32 * ks);
                    const f32x4 x0 = (f32x4){bf2f(xb.x & 0xffffu), bf2f(xb.x >> 16), bf2f(xb.y & 0xffffu), bf2f(xb.y >> 16)}, x1v = (f32x4){bf2f(xb.z & 0xffffu), bf2f(xb.z >> 16), bf2f(xb.w & 0xffffu), bf2f(xb.w >> 16)};
                    const f32x4 g0 = *(const f32x4*)(fw + 32 * ks + 8 * kq), g1 = *(const f32x4*)(fw + 32 * ks + 8 * kq + 4);
                    const f32x4 h0 = x0 * rstd * g0, h1 = x1v * rstd * g1;
                    u32x4 hi; hi.x = att::cvtpk(h0.x, h0.y); hi.y = att::cvtpk(h0.z, h0.w); hi.z = att::cvtpk(h1.x, h1.y); hi.w = att::cvtpk(h1.z, h1.w);
                    *(u32x4*)(H + (size_t)row * D + 32 * ks + 8 * kq) = hi;
                    u32x4 lo; lo.x = att::cvtpk(h0.x - bf2f(hi.x & 0xffffu), h0.y - bf2f(hi.x >> 16)); lo.y = att::cvtpk(h0.z - bf2f(hi.y & 0xffffu), h0.w - bf2f(hi.y >> 16));
                    lo.z = att::cvtpk(h1.x - bf2f(hi.z & 0xffffu), h1.y - bf2f(hi.z >> 16)); lo.w = att::cvtpk(h1.z - bf2f(hi.w & 0xffffu), h1.w - bf2f(hi.w >> 16));
                    const bf16x8r ah = __builtin_bit_cast(bf16x8r, hi), al = __builtin_bit_cast(bf16x8r, lo);
#pragma unroll
                    for (int nb = 0; nb < 3; ++nb) {
                        const bf16_t* wf = WRF + ((size_t)(ks * 3 + nb) * 2) * 512 + lane * 8;
                        const bf16x8r bh = *(const bf16x8r*)wf, bl = *(const bf16x8r*)(wf + 512);
                        acc[nb] = __builtin_amdgcn_mfma_f32_16x16x32_bf16(ah, bh, acc[nb], 0, 0, 0);
                        acc[nb] = __builtin_amdgcn_mfma_f32_16x16x32_bf16(ah, bl, acc[nb], 0, 0, 0);
                        acc[nb] = __builtin_amdgcn_mfma_f32_16x16x32_bf16(al, bh, acc[nb], 0, 0, 0);
                    }
                }
#pragma unroll
                for (int nb = 0; nb < 3; ++nb)
#pragma unroll
                    for (int j = 0; j < 4; ++j) lg[(4 * kq + j) * 48 + 16 * nb + r16] = acc[nb][j];
                asm volatile("s_waitcnt lgkmcnt(0)" ::: "memory");
                if (lane < 16 && rep_ == NREP(6) - 1) {
                    const int m = rb * 16 + lane;
                    float lgt[36];
#pragma unroll
                    for (int q = 0; q < 9; ++q) { const f32x4 v = *(const f32x4*)(lg + lane * 48 + 4 * q); lgt[4 * q] = v.x; lgt[4 * q + 1] = v.y; lgt[4 * q + 2] = v.z; lgt[4 * q + 3] = v.w; }
                    float gl[4]; int gi = 0;
#pragma unroll
                    for (int q = 0; q < 4; ++q) gl[q] = lgt[q] + brg[q];
                    float gmax = gl[0];
#pragma unroll
                    for (int q = 1; q < 4; ++q) if (gl[q] > gmax) { gmax = gl[q]; gi = q; }
                    float gs = 0.f;
#pragma unroll
                    for (int q = 0; q < 4; ++q) gs += expf(gl[q] - gmax);
                    const float gwt = 1.f / gs;
                    float el[8];
#pragma unroll
                    for (int q = 0; q < 8; ++q) { float vv = 0.f;
#pragma unroll
                        for (int g2 = 0; g2 < 4; ++g2) vv = (g2 == gi) ? lgt[4 + g2 * 8 + q] + bre[g2 * 8 + q] : vv;
                        el[q] = vv; }
                    int i0 = 0; float v0 = el[0];
#pragma unroll
                    for (int q = 1; q < 8; ++q) if (el[q] > v0) { v0 = el[q]; i0 = q; }
                    int i1 = -1; float v1 = -3.4e38f;
#pragma unroll
                    for (int q = 0; q < 8; ++q) if (q != i0 && el[q] > v1) { v1 = el[q]; i1 = q; }
                    const float e1 = expf(v1 - v0), w0 = gwt / (1.f + e1), w1 = gwt * e1 / (1.f + e1);
                    const int ex0 = gi * 8 + i0, ex1 = gi * 8 + i1;
                    *(f32x4*)(ROUTE + m * 4) = (f32x4){__int_as_float(ex0), __int_as_float(ex1), w0, w1};
                    const unsigned p0 = atomicAdd(ctl + CW_ECNT + 64 * ex0, 1u); BUCKET[(size_t)ex0 * T + p0] = m * 2;
                    const unsigned p1 = atomicAdd(ctl + CW_ECNT + 64 * ex1, 1u); BUCKET[(size_t)ex1 * T + p1] = m * 2 + 1;
                }
                asm volatile("s_waitcnt lgkmcnt(0)" ::: "memory");
            }
        }
    }
    SEAM(6);
    volatile LAS unsigned* CNT_L = MISC + 64; volatile LAS unsigned* PTILE_L = MISC + 96;
    LAS unsigned* ROWTAB = (LAS unsigned*)(ldsb + MISC_OFF + 1024);
    bf16_t* HE = (bf16_t*)(ws + WS_HE); bf16_t* YPAIR = (bf16_t*)(ws + WS_Q);
    bf16_t* X2B = (bf16_t*)(ws + WS_MIX);
    bf16_t* GB = (bf16_t*)(ws + WS_Q);
    if (IN(7) || IN(8)) {
        if (threadIdx.x == 0) { unsigned acc = 0;
            for (int e2 = 0; e2 < 32; ++e2) { const unsigned c = __hip_atomic_load(ctl + CW_ECNT + 64 * e2, __ATOMIC_RELAXED, __HIP_MEMORY_SCOPE_AGENT); CNT_L[e2] = c; PTILE_L[e2] = acc; acc += (c + 255u) >> 8; }
            PTILE_L[32] = acc; }
        __syncthreads();
    }
    if (IN(7)) {
        FRESH_IDS();
        for (int rep_ = 0; rep_ < NREP(7); ++rep_) {
        GroupSched Sg{PTILE_L, 2, G, (int)blockIdx.x};
        { pg8::Unit u;
          for (int i = 0; i < 8 && Sg.next(i, u); ++i) { const int e2 = u.pn >> 1, pm_l = u.pm - (int)PTILE_L[e2];
              if (tid < 256) { const int idx = pm_l * 256 + tid; const int tok = idx < (int)CNT_L[e2] ? (BUCKET[(size_t)e2 * T + idx] >> 1) : 0; ROWTAB[i * 256 + tid] = (unsigned)tok * 2048u; } } }
        __syncthreads();
        pg8::Gemm g{H, WT_GU, T, 32 * 512, D, D, D};
        EpiMoeGU E{HE};
        pg8::gemm_phase<EpiMoeGU, GroupSched, true>(ldsb, g, Sg, E, ROWTAB);
        { const int total = (int)PTILE_L[32] * 2, nmax = (total + G - 1) / G, extra = total - (nmax - 1) * G;
          pg8::Gemm g2{PB, WT_PP, T, D, 256, 256, 256}; pg8::TailOrder St; St.init(T, D, G, (int)blockIdx.x, extra);
          EpiPleProj E2{PLERAW, SSQPLE}; pg8::gemm_phase(ldsb, g2, St, E2); }
        }
    }
    SEAM(7);
    if (IN(8)) {
        for (int rep_ = 0; rep_ < NREP(8); ++rep_) {
        GroupSched Sg{PTILE_L, 4, G, (int)blockIdx.x};
        pg8::Gemm g{HE, WT_DN, 0, 32 * 1024, 256, 256, 256};
        EpiMoeDown E{YPAIR, BUCKET, ROUTE, PTILE_L, CNT_L};
        pg8::gemm_phase(ldsb, g, Sg, E);
        }
    }
    SEAM(8);
    if (IN(9)) {
        FRESH_IDS();
        const f32x4* wr4 = (const f32x4*)IN_F(I_PLENW) + lane;
        for (int rep_ = 0; rep_ < NREP(9); ++rep_)
        for (int m0 = gw * 4; m0 < T; m0 += NGW * 4) {
            f32x4 v[4][4]; u32x2 ya[4][4], yb[4][4];
#pragma unroll
            for (int r = 0; r < 4; ++r)
#pragma unroll
                for (int j = 0; j < 4; ++j) { const size_t m = m0 + r; { const u32x2 xb = ((const u32x2*)(X1B + m * D) + lane)[64 * j]; v[r][j] = (f32x4){bf2f(xb.x & 0xffffu), bf2f(xb.x >> 16), bf2f(xb.y & 0xffffu), bf2f(xb.y >> 16)}; }
                    ya[r][j] = ((const u32x2*)(YPAIR + (2 * m) * D) + lane)[64 * j]; yb[r][j] = ((const u32x2*)(YPAIR + (2 * m + 1) * D) + lane)[64 * j]; }
#pragma unroll
            for (int r = 0; r < 4; ++r) {
                const size_t m = m0 + r; float s = 0.f;
                u32x2* x2r = (u32x2*)(X2B + m * D) + lane;
#pragma unroll
                for (int j = 0; j < 4; ++j) { const u32x2 a0 = ya[r][j], a1 = yb[r][j];
                    v[r][j] = v[r][j] + (f32x4){bf2f(a0.x & 0xffffu) + bf2f(a1.x & 0xffffu), bf2f(a0.x >> 16) + bf2f(a1.x >> 16), bf2f(a0.y & 0xffffu) + bf2f(a1.y & 0xffffu), bf2f(a0.y >> 16) + bf2f(a1.y >> 16)};
                    { u32x2 xo; xo.x = pk2(v[r][j].x, v[r][j].y); xo.y = pk2(v[r][j].z, v[r][j].w); x2r[64 * j] = xo; }
                    s += (v[r][j].x * v[r][j].x + v[r][j].y * v[r][j].y) + (v[r][j].z * v[r][j].z + v[r][j].w * v[r][j].w); }
                const float rstd = 1.f / sqrtf(wave_sum(s) * (1.f / D) + EPS);
                if (lane < 16) { float sp = SSQPLE[m * 16 + lane]; sp += __shfl_xor(sp, 1); sp += __shfl_xor(sp, 2); sp += __shfl_xor(sp, 4); sp += __shfl_xor(sp, 8);
                    if (lane == 0) RSTDP[m] = 1.f / sqrtf(sp * (1.f / D) + EPS); }
                u32x2* o8 = (u32x2*)(H + m * D) + lane;
#pragma unroll
                for (int j = 0; j < 4; ++j) { const f32x4 g4 = wr4[64 * j]; u32x2 o; o.x = pk2(v[r][j].x * rstd * g4.x, v[r][j].y * rstd * g4.y); o.y = pk2(v[r][j].z * rstd * g4.z, v[r][j].w * rstd * g4.w); o8[64 * j] = o; }
            }
        }
    }
    SEAM(9);
    if (IN(10)) {
        pg8::Gemm g{H, WT_PG, T, D, D, D, D}; pg8::StaticOrder So; So.init(T, D, G, (int)blockIdx.x);
        EpiPleGate E{GB, PLERAW, RSTDP, IN_F(I_BPG), IN_F(I_PPNW)}; for (int rep_ = 0; rep_ < NREP(10); ++rep_) pg8::gemm_phase(ldsb, g, So, E);
    }
    SEAM(10);
    if (IN(11)) {
        FRESH_IDS();
        const f32x4* wr4 = (const f32x4*)IN_F(I_FNW) + lane;
        for (int rep_ = 0; rep_ < NREP(11); ++rep_)
        for (int m0 = gw * 4; m0 < T; m0 += NGW * 4) {
            u32x2 xa[4][4], ga[4][4];
#pragma unroll
            for (int r = 0; r < 4; ++r)
#pragma unroll
                for (int j = 0; j < 4; ++j) { const size_t m = m0 + r; xa[r][j] = ((const u32x2*)(X2B + m * D) + lane)[64 * j]; ga[r][j] = ((const u32x2*)(GB + m * D) + lane)[64 * j]; }
#pragma unroll
            for (int r = 0; r < 4; ++r) {
                f32x4 v[4]; float s = 0.f;
#pragma unroll
                for (int j = 0; j < 4; ++j) { const u32x2 a0 = xa[r][j], a1 = ga[r][j];
                    v[j] = (f32x4){bf2f(a0.x & 0xffffu) + bf2f(a1.x & 0xffffu), bf2f(a0.x >> 16) + bf2f(a1.x >> 16), bf2f(a0.y & 0xffffu) + bf2f(a1.y & 0xffffu), bf2f(a0.y >> 16) + bf2f(a1.y >> 16)};
                    s += (v[j].x * v[j].x + v[j].y * v[j].y) + (v[j].z * v[j].z + v[j].w * v[j].w); }
                const float rstd = 1.f / sqrtf(wave_sum(s) * (1.f / D) + EPS);
                f32x4* xr = (f32x4*)(out + (size_t)(m0 + r) * D) + lane;
#pragma unroll
                for (int j = 0; j < 4; ++j) xr[64 * j] = v[j] * rstd * wr4[64 * j];
            }
        }
    }
#undef IN
#undef SEAM
}

extern "C" void kernel_launch(void* const* d_in, const int* in_sizes, int n_in, void* d_out, int out_size, void* d_ws, size_t ws_size, hipStream_t stream) {
    static int grid = 0;
    if (grid == 0) {
        if (n_in != 31 || out_size != T * D || ws_size < WS_END) { fprintf(stderr, "kernel_launch: unexpected shapes (n_in %d out %d ws %zu)\n", n_in, out_size, ws_size); grid = -1; return; }
        int dev = 0, cus = 0, per_cu = 0;
        if (hipGetDevice(&dev) != hipSuccess || hipDeviceGetAttribute(&cus, hipDeviceAttributeMultiprocessorCount, dev) != hipSuccess) { grid = -1; return; }
        if (hipFuncSetAttribute((const void*)fwd, hipFuncAttributeMaxDynamicSharedMemorySize, LDS_BYTES) != hipSuccess) { fprintf(stderr, "kernel_launch: hipFuncSetAttribute failed\n"); grid = -1; return; }
        if (hipOccupancyMaxActiveBlocksPerMultiprocessor(&per_cu, (const void*)fwd, 512, LDS_BYTES) != hipSuccess || per_cu < 1) { fprintf(stderr, "kernel_launch: occupancy query says %d\n", per_cu); }
        (void)hipGetLastError();
        grid = cus;
    }
    if (grid < 0) return;
    (void)hipMemsetAsync((char*)d_ws + WS_CTL, 0, CTL_ZERO_BYTES, stream);
    Args a{};
    for (int i = 0; i < 31; ++i) a.in[i] = d_in[i];
    a.out = (float*)d_out; a.ws = (unsigned char*)d_ws;
#if MK_PER_PHASE
    for (int p = 0; p < NPHASES; ++p) { a.ph_lo = p; a.ph_hi = p + 1; hipLaunchKernelGGL(fwd, dim3(grid), dim3(512), LDS_BYTES, stream, a); }
#else
    a.ph_lo = 0; a.ph_hi = NPHASES;
    hipLaunchKernelGGL(fwd, dim3(grid), dim3(512), LDS_BYTES, stream, a);
#endif
}
```
